# Optimizing an MI355X kernel written in HIP

```python
import math
import jax, jax.numpy as jnp
from jax import lax
import numpy as np

D_MODEL = 1024
BATCH = 2
SEQ = 8192
DEPTH = 1

GRID_W = 64
MEM_LEN = 256
MEM_HEADS = 4
MEM_HEAD_DIM = 128
HEAD_DIM = 64
NA_HEADS = 8
NA_WIN_ROWS = 8
NA_WIN_COLS = 16
DIL_GROUPS = ((128, 1), (512, 4), (2048, 16))
DIL_HEADS_PER_GROUP = 4
DIL_HEADS = DIL_HEADS_PER_GROUP * len(DIL_GROUPS)
DIL_BLOCK = 128
T5_BUCKETS = 32
T5_MAX_DIST = 1024
N_EXPERTS = 32
TOP_K = 4
D_FF = D_MODEL
SWIGLU_ALPHA = 1.702
SWIGLU_LIMIT = 7.0
MOE_BLOCK = 128
RMS_EPS = 1e-6
NEG_INF = -1e30

N_BRANCH = 3
WIDTH_A = NA_HEADS * HEAD_DIM
WIDTH_B = DIL_HEADS * HEAD_DIM
WIDTH_B_OUT = DIL_HEADS_PER_GROUP * HEAD_DIM
WIDTH_C = MEM_HEADS * MEM_HEAD_DIM
IN_COLS = 3 * WIDTH_A + 3 * WIDTH_B + WIDTH_C + N_BRANCH * D_MODEL

kernel_name = "hybrid_gated_na_dilated_mem_moe_encoder"


def rms_norm(x, g):
    xf = x.astype(jnp.float32)
    y = xf * lax.rsqrt(jnp.mean(xf * xf, axis=-1, keepdims=True) + RMS_EPS)
    return (y * g.astype(jnp.float32)).astype(x.dtype)


def neighbourhood_attention(q, k, v, rpb):
    B, S, H, dh = q.shape
    rows = S // GRID_W
    wr = min(NA_WIN_ROWS, rows)
    wc = NA_WIN_COLS
    qg = q.reshape(B, rows, GRID_W, H, dh)
    kg = k.reshape(B, rows, GRID_W, H, dh)
    vg = v.reshape(B, rows, GRID_W, H, dh)
    col = jnp.arange(GRID_W)
    col_start = jnp.clip(col - wc // 2, 0, GRID_W - wc)
    col_idx = col_start[:, None] + jnp.arange(wc)[None, :]
    dc = col_idx - col[:, None]
    scale = dh ** -0.5

    def one_row(r):
        rs = jnp.clip(r - wr // 2, 0, rows - wr)
        k_rows = lax.dynamic_slice_in_dim(kg, rs, wr, axis=1)
        v_rows = lax.dynamic_slice_in_dim(vg, rs, wr, axis=1)
        k_win = k_rows[:, :, col_idx]
        v_win = v_rows[:, :, col_idx]
        q_r = lax.dynamic_index_in_dim(qg, r, axis=1, keepdims=False)
        s = jnp.einsum('bqhd,bnqchd->bhqnc', q_r, k_win).astype(jnp.float32) * scale
        dr = rs + jnp.arange(wr) - r
        bias = rpb[:, dr[None, :, None] + NA_WIN_ROWS - 1, dc[:, None, :] + NA_WIN_COLS - 1]
        s = s + bias[None].astype(jnp.float32)
        p = jax.nn.softmax(s.reshape(B, H, GRID_W, wr * wc), axis=-1)
        p = p.reshape(B, H, GRID_W, wr, wc).astype(v.dtype)
        return jnp.einsum('bhqnc,bnqchd->bqhd', p, v_win)

    out = lax.map(one_row, jnp.arange(rows))
    return out.transpose(1, 0, 2, 3, 4).reshape(B, S, H * dh)


def t5_bucket(rel):
    half = T5_BUCKETS // 2
    max_exact = half // 2
    ret = jnp.where(rel > 0, half, 0)
    n = jnp.abs(rel)
    nf = jnp.maximum(n, 1).astype(jnp.float32)
    large = max_exact + (jnp.log(nf / max_exact) / math.log(T5_MAX_DIST / max_exact)
                         * (half - max_exact)).astype(jnp.int32)
    large = jnp.minimum(large, half - 1)
    return ret + jnp.where(n < max_exact, n, large)


def dilated_group_attention(q, k, v, t5_bias, window, dil):
    B, S, H, dh = q.shape
    half = (window // 2) // dil
    L = S // dil
    def split(t):
        return t.reshape(B, L, dil, H, dh).transpose(0, 2, 1, 3, 4)
    qs, ks, vs = split(q), split(k), split(v)
    nb = -(-L // DIL_BLOCK)
    Lp = nb * DIL_BLOCK
    nk = DIL_BLOCK + 2 * half
    qs = jnp.pad(qs, ((0, 0), (0, 0), (0, Lp - L), (0, 0), (0, 0)))
    kp = jnp.pad(ks, ((0, 0), (0, 0), (half, Lp - L + half), (0, 0), (0, 0)))
    vp = jnp.pad(vs, ((0, 0), (0, 0), (half, Lp - L + half), (0, 0), (0, 0)))
    key_idx = jnp.arange(nb)[:, None] * DIL_BLOCK + jnp.arange(nk)[None, :]
    kb = kp[:, :, key_idx]
    vb = vp[:, :, key_idx]
    qb = qs.reshape(B, dil, nb, DIL_BLOCK, H, dh)
    s = jnp.einsum('brnqhd,brnkhd->brnhqk', qb, kb).astype(jnp.float32) * (dh ** -0.5)
    qi = jnp.arange(nb)[:, None] * DIL_BLOCK + jnp.arange(DIL_BLOCK)[None, :]
    ki = key_idx - half
    rel = ki[:, None, :] - qi[:, :, None]
    valid = (jnp.abs(rel) <= half) & (ki[:, None, :] >= 0) & (ki[:, None, :] < L)
    bias = t5_bias[t5_bucket(rel * dil)].astype(jnp.float32)
    s = s + bias.transpose(0, 3, 1, 2)[None, None]
    s = jnp.where(valid[None, None, :, None], s, NEG_INF)
    lse = jax.nn.logsumexp(s, axis=-1)
    p = jnp.exp(s - lse[..., None]).astype(v.dtype)
    o = jnp.einsum('brnhqk,brnkhd->brnqhd', p, vb)
    o = o.reshape(B, dil, Lp, H, dh)[:, :, :L].transpose(0, 2, 1, 3, 4).reshape(B, S, H, dh)
    lse = lse.transpose(0, 1, 2, 4, 3).reshape(B, dil, Lp, H)[:, :, :L]
    lse = lse.transpose(0, 2, 1, 3).reshape(B, S, H)
    return o, lse


def dilated_mixture(q, k, v, t5_bias):
    B, S, _, dh = q.shape
    G = DIL_HEADS_PER_GROUP
    outs, lses = [], []
    for gi, (window, dil) in enumerate(DIL_GROUPS):
        sl = slice(gi * G, (gi + 1) * G)
        o, l = dilated_group_attention(q[:, :, sl], k[:, :, sl], v[:, :, sl],
                                       t5_bias[:, sl], window, dil)
        outs.append(o)
        lses.append(l)
    w = jax.nn.softmax(jnp.stack(lses, axis=0), axis=0).astype(q.dtype)
    o = jnp.sum(w[..., None] * jnp.stack(outs, axis=0), axis=0)
    return o.reshape(B, S, G * dh)


def memory_attention(q, mk, mv):
    B, S, H, dh = q.shape
    s = jnp.einsum('bshd,bmhd->bhsm', q, mk).astype(jnp.float32) * (dh ** -0.5)
    p = jax.nn.softmax(s, axis=-1).astype(mv.dtype)
    return jnp.einsum('bhsm,bmhd->bshd', p, mv).reshape(B, S, H * dh)


def moe_ffn(h, router_w, router_b, w_gu, b_gu, w_dn, b_dn):
    N, D = h.shape
    logits = (h @ router_w).astype(jnp.float32) + router_b.astype(jnp.float32)
    top_val, top_idx = lax.top_k(logits, TOP_K)
    top_w = jax.nn.softmax(top_val, axis=-1)
    A = N * TOP_K
    e_flat = top_idx.reshape(-1)
    tok_flat = jnp.repeat(jnp.arange(N, dtype=jnp.int32), TOP_K)
    w_flat = top_w.reshape(-1)
    order = jnp.argsort(e_flat)
    e_sorted = e_flat[order]
    counts = jnp.bincount(e_flat, length=N_EXPERTS)
    starts = jnp.cumsum(counts) - counts
    padded = (counts + MOE_BLOCK - 1) // MOE_BLOCK * MOE_BLOCK
    pad_ends = jnp.cumsum(padded)
    pad_starts = pad_ends - padded
    dest = pad_starts[e_sorted] + (jnp.arange(A) - starts[e_sorted])
    n_slots = (-(-A // MOE_BLOCK)) * MOE_BLOCK + N_EXPERTS * MOE_BLOCK
    n_blocks = n_slots // MOE_BLOCK
    slot_tok = jnp.zeros((n_slots,), jnp.int32).at[dest].set(tok_flat[order])
    slot_w = jnp.zeros((n_slots,), h.dtype).at[dest].set(w_flat[order].astype(h.dtype))
    block_expert = jnp.minimum(
        jnp.searchsorted(pad_ends, jnp.arange(n_blocks) * MOE_BLOCK, side='right'), N_EXPERTS - 1)
    xs = h[slot_tok].reshape(n_blocks, MOE_BLOCK, D)

    def expert_block(args):
        xb, e = args
        gu = xb @ w_gu[e] + b_gu[e]
        g = jnp.minimum(gu[:, :D_FF], SWIGLU_LIMIT)
        u = jnp.clip(gu[:, D_FF:], -SWIGLU_LIMIT, SWIGLU_LIMIT)
        a = (u + 1.0) * (g * jax.nn.sigmoid(SWIGLU_ALPHA * g))
        return a @ w_dn[e] + b_dn[e]

    ys = lax.map(expert_block, (xs, block_expert)).reshape(n_slots, D)
    return jnp.zeros_like(h).at[slot_tok].add(ys * slot_w[:, None])


def setup_inputs(seed: int = 0) -> dict:
    key = jax.random.key(seed)
    ks = jax.random.split(key, 24)
    f32 = jnp.float32
    nrm = lambda k, shape, s: jax.random.normal(k, shape, f32) * s
    L = DEPTH
    return {
        "x": nrm(ks[0], (BATCH, SEQ, D_MODEL), 1.0),
        "mem": nrm(ks[1], (BATCH, MEM_LEN, D_MODEL), 1.0),
        "attn_norm_g": 1.0 + nrm(ks[2], (L, D_MODEL), 0.02),
        "mem_norm_g": 1.0 + nrm(ks[3], (L, D_MODEL), 0.02),
        "w_in": nrm(ks[4], (L, D_MODEL, IN_COLS), D_MODEL ** -0.5),
        "w_mem_kv": nrm(ks[5], (L, D_MODEL, 2 * WIDTH_C), D_MODEL ** -0.5),
        "na_rpb": nrm(ks[6], (L, NA_HEADS, 2 * NA_WIN_ROWS - 1, 2 * NA_WIN_COLS - 1), 0.2),
        "t5_rel_bias": nrm(ks[7], (T5_BUCKETS, DIL_HEADS), 0.2),
        "w_branch_a": nrm(ks[8], (L, WIDTH_A, D_MODEL), WIDTH_A ** -0.5),
        "w_branch_b": nrm(ks[9], (L, WIDTH_B_OUT, D_MODEL), WIDTH_B_OUT ** -0.5),
        "w_branch_c": nrm(ks[10], (L, WIDTH_C, D_MODEL), WIDTH_C ** -0.5),
        "w_out": nrm(ks[11], (L, D_MODEL, D_MODEL), D_MODEL ** -0.5),
        "ffn_norm_g": 1.0 + nrm(ks[12], (L, D_MODEL), 0.02),
        "router_w": nrm(ks[13], (L, D_MODEL, N_EXPERTS), D_MODEL ** -0.5),
        "router_b": nrm(ks[14], (L, N_EXPERTS), 0.01),
        "expert_w_gate_up": nrm(ks[15], (L, N_EXPERTS, D_MODEL, 2 * D_FF), D_MODEL ** -0.5),
        "expert_b_gate_up": nrm(ks[16], (L, N_EXPERTS, 2 * D_FF), 0.02),
        "expert_w_down": nrm(ks[17], (L, N_EXPERTS, D_FF, D_MODEL), D_FF ** -0.5),
        "expert_b_down": nrm(ks[18], (L, N_EXPERTS, D_MODEL), 0.02),
        "final_norm_g": 1.0 + nrm(ks[19], (D_MODEL,), 0.02),
    }


def reference(x, mem, attn_norm_g, mem_norm_g, w_in, w_mem_kv, na_rpb, t5_rel_bias,
              w_branch_a, w_branch_b, w_branch_c, w_out, ffn_norm_g, router_w, router_b,
              expert_w_gate_up, expert_b_gate_up, expert_w_down, expert_b_down, final_norm_g):
    B, S, D = x.shape
    M = mem.shape[1]
    split_points = list(np.cumsum([WIDTH_A, WIDTH_A, WIDTH_A, WIDTH_B, WIDTH_B, WIDTH_B, WIDTH_C])[:])
    for l in range(DEPTH):
        h = rms_norm(x, attn_norm_g[l])
        proj = h @ w_in[l]
        qa, ka, va, qb, kb, vb, qc, gate_logits = jnp.split(proj, split_points, axis=-1)
        qa = qa.reshape(B, S, NA_HEADS, HEAD_DIM)
        ka = ka.reshape(B, S, NA_HEADS, HEAD_DIM)
        va = va.reshape(B, S, NA_HEADS, HEAD_DIM)
        qb = qb.reshape(B, S, DIL_HEADS, HEAD_DIM)
        kb = kb.reshape(B, S, DIL_HEADS, HEAD_DIM)
        vb = vb.reshape(B, S, DIL_HEADS, HEAD_DIM)
        qc = qc.reshape(B, S, MEM_HEADS, MEM_HEAD_DIM)
        gates = jax.nn.sigmoid(gate_logits.astype(jnp.float32)).astype(x.dtype)
        gates = gates.reshape(B, S, N_BRANCH, D)

        m = rms_norm(mem, mem_norm_g[l])
        mk, mv = jnp.split(m @ w_mem_kv[l], 2, axis=-1)
        mk = mk.reshape(B, M, MEM_HEADS, MEM_HEAD_DIM)
        mv = mv.reshape(B, M, MEM_HEADS, MEM_HEAD_DIM)

        y_a = neighbourhood_attention(qa, ka, va, na_rpb[l]) @ w_branch_a[l]
        y_b = dilated_mixture(qb, kb, vb, t5_rel_bias) @ w_branch_b[l]
        y_c = memory_attention(qc, mk, mv) @ w_branch_c[l]
        merged = gates[:, :, 0] * y_a + gates[:, :, 1] * y_b + gates[:, :, 2] * y_c
        x = x + merged @ w_out[l]

        h = rms_norm(x, ffn_norm_g[l])
        y = moe_ffn(h.reshape(B * S, D), router_w[l], router_b[l], expert_w_gate_up[l],
                    expert_b_gate_up[l], expert_w_down[l], expert_b_down[l])
        x = x + y.reshape(B, S, D)
    return rms_norm(x, final_norm_g)
```

```cpp
#include <hip/hip_runtime.h>
#include <cstdio>
#include <cstdint>

#define GAS __attribute__((address_space(1)))
#define LAS __attribute__((address_space(3)))
typedef unsigned short bf16_t;
typedef short bf16x8 __attribute__((ext_vector_type(8)));
typedef short s16x4 __attribute__((ext_vector_type(4)));
typedef float f32x4 __attribute__((ext_vector_type(4)));
typedef float f32x2 __attribute__((ext_vector_type(2)));
typedef unsigned u32x4 __attribute__((ext_vector_type(4)));
typedef unsigned u32x2 __attribute__((ext_vector_type(2)));
typedef int i32x4 __attribute__((ext_vector_type(4)));
typedef GAS unsigned gu32;

constexpr int NTOK = 16384, SEQ = 8192, D = 1024, NMEM = 512, MEMLEN = 256;
constexpr int IN_COLS = 7424;
constexpr int C_QA = 0, C_KA = 512, C_VA = 1024, C_QB = 1536, C_KB = 2304, C_VB = 3072, C_QC = 3840, C_GATE = 4352;
constexpr int NEXP = 32, TOPK = 4, DFF = 1024;
constexpr int MAX_TILES = 288, MAX_SLOTS = MAX_TILES * 256;
constexpr float RMS_EPS = 1e-6f, LOG2E = 1.4426950408889634f;
constexpr float QS64 = 0.125f * LOG2E, QS128 = 0.08838834764831845f * LOG2E;
constexpr int ABC_LD = 1280;

constexpr size_t MiB = 1u << 20;
constexpr size_t WS_CTL = 0, CTL_ZERO_BYTES = 1 * MiB;
constexpr size_t WS_MISC = 1 * MiB;
constexpr size_t MO_TOPIDX = 0, MO_TOPW = 256 * 1024, MO_HIST = 512 * 1024, MO_TOKSLOT = 1 * MiB, MO_SLOTTOK = 2 * MiB, MO_SLOTW = 3 * MiB, MO_TILE = 4 * MiB, MO_LSE = 5 * MiB, MO_T5 = 6 * MiB, MO_RPB = 6 * MiB + 64 * 1024;
constexpr size_t WS_WIN_T = 16 * MiB, WS_WMEM_T = 32 * MiB, WS_WABC_T = 34 * MiB, WS_WOUT_T = 37 * MiB, WS_MEMN = 39 * MiB, WS_MKV = 40 * MiB, WS_XN = 41 * MiB;
constexpr size_t WS_ABC = 73 * MiB, WS_OB = 113 * MiB, WS_MERGED = 137 * MiB, WS_WGU_T = 169 * MiB, WS_WDN_T = 297 * MiB, WS_PROJ = 361 * MiB, WS_ACT = 593 * MiB, WS_YS = 737 * MiB, WS_END = 881 * MiB;
constexpr int T5_LD = 192, RPB_LD = 640, RPB_OFF = 64;

constexpr int LDS_MAIN = 147456;
constexpr int LDS_TAB = LDS_MAIN;
constexpr int LDS_MISC = LDS_MAIN + 8192;
constexpr int LDS_BYTES = LDS_MISC + 512;

#define LDS_WAIT() asm volatile("s_waitcnt lgkmcnt(0)" ::: "memory")
#define VM_WAIT() asm volatile("s_waitcnt vmcnt(0)" ::: "memory")
__device__ __forceinline__ unsigned cvt_pk_bf16(float lo, float hi) { unsigned r; asm volatile("v_cvt_pk_bf16_f32 %0, %1, %2" : "=v"(r) : "v"(lo), "v"(hi)); return r; }
__device__ __forceinline__ float bf_lo(unsigned u) { return __uint_as_float(u << 16); }
__device__ __forceinline__ float bf_hi(unsigned u) { return __uint_as_float(u & 0xffff0000u); }
__device__ __forceinline__ int lane_id() { return (int)__builtin_amdgcn_mbcnt_hi(~0u, __builtin_amdgcn_mbcnt_lo(~0u, 0u)); }
__device__ __forceinline__ float wave_sum(float v) {
#pragma unroll
    for (int o = 1; o < 64; o <<= 1) v += __shfl_xor(v, o);
    return v;
}
__device__ __forceinline__ float wave_max(float v) {
#pragma unroll
    for (int o = 1; o < 64; o <<= 1) v = fmaxf(v, __shfl_xor(v, o));
    return v;
}
__device__ __forceinline__ int ld_uniform(const int* p) { return __builtin_amdgcn_readfirstlane(__hip_atomic_load((int*)p, __ATOMIC_RELAXED, __HIP_MEMORY_SCOPE_AGENT)); }
__device__ __forceinline__ float fast_sigmoid(float x) { return __builtin_amdgcn_rcpf(1.0f + __builtin_amdgcn_exp2f(-LOG2E * x)); }

namespace pg8 {
constexpr int BM = 256, BK = 64, HALF = 128, HTB = HALF * BK * 2, STAGE_BYTES = 8 * HTB;
__host__ __device__ __forceinline__ int lds_byte(int r, int c) { const int st = (r >> 4) * 2 + (c >> 5), rr = r & 15, cc = c & 31, ob = rr * 64 + cc * 2; return st * 1024 + (ob ^ (((ob >> 9) & 1) << 5)); }
__host__ __device__ __forceinline__ void stage_rc(int b, int& R, int& C) { const int st = b / 1024, sb = b % 1024, swz = sb ^ (((sb >> 9) & 1) << 5); R = (st >> 1) * 16 + swz / 64; C = (st & 1) * 32 + (swz % 64) / 2; }
__host__ __device__ __forceinline__ int perm32(int rho) { const int n = rho >> 4, i = rho & 15; return 8 * (i >> 2) + 4 * n + (i & 3); }

struct Unit {
    const char* A;
    const char* B;
    const int* rows;
    int nt;
    int pm, pn;
    int aux;
    float scale;
};

template <class Epi, class Sched, bool GATHER>
__device__ __forceinline__ void gemm_phase(LAS unsigned char* lds, const int wave, const unsigned lda, const unsigned ldb, const Sched& S, const Epi& E) {
    int lane = (int)__builtin_amdgcn_mbcnt_hi(~0u, __builtin_amdgcn_mbcnt_lo(~0u, 0u)); asm volatile("" : "+v"(lane));
    const int wid = wave, tid = wave * 64 + lane, wr = wid >> 2, wc = wid & 3, fr = lane & 15, fq = lane >> 4;
    unsigned voffB[2];
#pragma unroll
    for (int i = 0; i < 2; ++i) { int R, C; stage_rc(tid * 16 + i * 8192, R, C); const int Rb = (R & ~31) + perm32(R & 31); voffB[i] = (unsigned)Rb * ldb + (unsigned)C * 2u; }
    const size_t kstep = (size_t)(BK * 2);
    const size_t hstepB = (size_t)HALF * ldb;
    const unsigned ldsw = (unsigned)wid * 1024u;
    const int aoff = lds_byte(wr * 64 + fr, fq * 8), boff = lds_byte(wc * 32 + fr, fq * 8);
#define PG8_SA(b, h) (((b) * 2 + (h)) * HTB)
#define PG8_SB(b, h) ((4 + (b) * 2 + (h)) * HTB)
#define PG8_STAGE2(bufoff, gbase, v0, v1) do { \
        __builtin_amdgcn_global_load_lds((const unsigned*)((const char*)(gbase) + (v0)), (LAS unsigned*)(lds + (bufoff) + ldsw), 16, 0, 0); \
        __builtin_amdgcn_global_load_lds((const unsigned*)((const char*)(gbase) + (v1)), (LAS unsigned*)(lds + (bufoff) + ldsw + 8192), 16, 0, 0); } while (0)
#define PG8_STAGEB(bufoff, gbase) PG8_STAGE2(bufoff, gbase, voffB[0], voffB[1])
#define PG8_LDA(dst, b, h) do { _Pragma("unroll") for (int m = 0; m < 4; ++m) _Pragma("unroll") for (int k = 0; k < 2; ++k) dst[m][k] = *(const LAS bf16x8*)(lds + PG8_SA(b, h) + aoff + m * 2048 + k * 1024); } while (0)
#define PG8_LDB(dst, b, h) do { _Pragma("unroll") for (int n = 0; n < 2; ++n) _Pragma("unroll") for (int k = 0; k < 2; ++k) dst[n][k] = *(const LAS bf16x8*)(lds + PG8_SB(b, h) + boff + n * 2048 + k * 1024); } while (0)
#define PG8_MMA(ai, bj, At, Bt) do { __builtin_amdgcn_s_setprio(1); _Pragma("unroll") for (int m = 0; m < 4; ++m) _Pragma("unroll") for (int n = 0; n < 2; ++n) _Pragma("unroll") for (int k = 0; k < 2; ++k) \
        acc[ai][bj][m][n] = __builtin_amdgcn_mfma_f32_16x16x32_bf16(Bt[n][k], At[m][k], acc[ai][bj][m][n], 0, 0, 0); __builtin_amdgcn_s_setprio(0); } while (0)
#define PG8_WAIT_V(n) asm volatile("s_waitcnt vmcnt(" #n ")" ::: "memory")
#define PG8_WAIT_L(n) asm volatile("s_waitcnt lgkmcnt(" #n ")" ::: "memory")
#define PG8_BAR __builtin_amdgcn_s_barrier()
#define PG8_SCHED __builtin_amdgcn_sched_barrier(0)
    Unit cur, nxt; int ui = 0;
    if (!S.next(0, cur)) return;
    f32x4 acc[2][2][4][2];
#pragma unroll
    for (int a = 0; a < 2; ++a)
#pragma unroll
        for (int b = 0; b < 2; ++b)
#pragma unroll
            for (int m = 0; m < 4; ++m)
#pragma unroll
                for (int n = 0; n < 2; ++n) acc[a][b][m][n] = (f32x4){0.f, 0.f, 0.f, 0.f};
    bf16x8 At[4][2], B0[2][2], B1[2][2];
    unsigned c00, c01, c10, c11, n00, n01, n10, n11;
#define PG8_MKOFF(U, o00, o01, o10, o11) do { int R0_, C0_, R1_, C1_; stage_rc(tid * 16, R0_, C0_); stage_rc(tid * 16 + 8192, R1_, C1_); \
        if (GATHER) { const GAS int* rl_ = (const GAS int*)(U).rows; \
            o00 = (unsigned)rl_[R0_] * lda + (unsigned)C0_ * 2u; o01 = (unsigned)rl_[R1_] * lda + (unsigned)C1_ * 2u; o10 = (unsigned)rl_[HALF + R0_] * lda + (unsigned)C0_ * 2u; o11 = (unsigned)rl_[HALF + R1_] * lda + (unsigned)C1_ * 2u; } \
        else { o00 = (unsigned)R0_ * lda + (unsigned)C0_ * 2u; o01 = (unsigned)R1_ * lda + (unsigned)C1_ * 2u; o10 = (unsigned)(HALF + R0_) * lda + (unsigned)C0_ * 2u; o11 = (unsigned)(HALF + R1_) * lda + (unsigned)C1_ * 2u; } } while (0)
    PG8_MKOFF(cur, c00, c01, c10, c11);
    const char* cA = cur.A; const char* cB = cur.B; int nt = cur.nt;
    PG8_STAGEB(PG8_SB(0, 0), cB); PG8_STAGEB(PG8_SB(0, 1), cB + hstepB); PG8_STAGE2(PG8_SA(0, 0), cA, c00, c01); PG8_STAGE2(PG8_SA(0, 1), cA, c10, c11);
    if (wr == 1) PG8_BAR;
    PG8_WAIT_V(2); PG8_BAR;
    PG8_STAGEB(PG8_SB(1, 0), cB + kstep); PG8_STAGE2(PG8_SA(1, 0), cA + kstep, c00, c01); PG8_STAGEB(PG8_SB(1, 1), cB + hstepB + kstep);
    PG8_WAIT_V(6); PG8_BAR;
    for (;;) {
        const bool has_next = S.next(ui + 1, nxt);
        const char* nA = has_next ? nxt.A : cA; const char* nB = has_next ? nxt.B : cB;
        if (GATHER) { if (has_next) { PG8_MKOFF(nxt, n00, n01, n10, n11); } else { n00 = c00; n01 = c01; n10 = c10; n11 = c11; } }
        for (int t = 0; t < nt; t += 2) {
            const bool last = (t == nt - 2);
            const char* a1 = cA + (size_t)(t + 1) * kstep;
            const char* a2 = last ? nA : cA + (size_t)(t + 2) * kstep; const char* b2 = last ? nB : cB + (size_t)(t + 2) * kstep;
            const char* a3 = a2 + kstep; const char* b3 = b2 + kstep;
            PG8_LDB(B0, 0, 0); PG8_LDB(B1, 0, 1); PG8_SCHED; PG8_LDA(At, 0, 0); PG8_STAGE2(PG8_SA(1, 1), a1, c10, c11);
            if (GATHER) { if (last) { c00 = n00; c01 = n01; c10 = n10; c11 = n11; } }
            PG8_WAIT_V(8); PG8_WAIT_L(0); PG8_BAR; PG8_MMA(0, 0, At, B0); PG8_MMA(0, 1, At, B1); PG8_BAR; PG8_SCHED;
            PG8_LDA(At, 0, 1); PG8_STAGEB(PG8_SB(0, 0), b2); PG8_STAGEB(PG8_SB(0, 1), b2 + hstepB); PG8_STAGE2(PG8_SA(0, 0), a2, c00, c01);
            PG8_WAIT_V(8); PG8_WAIT_L(0); PG8_BAR; PG8_MMA(1, 0, At, B0); PG8_MMA(1, 1, At, B1); PG8_BAR; PG8_SCHED;
            PG8_LDB(B0, 1, 0); PG8_LDB(B1, 1, 1); PG8_SCHED; PG8_LDA(At, 1, 0); PG8_STAGE2(PG8_SA(0, 1), a2, c10, c11);
            PG8_WAIT_V(8); PG8_WAIT_L(0); PG8_BAR; PG8_MMA(0, 0, At, B0); PG8_MMA(0, 1, At, B1); PG8_BAR; PG8_SCHED;
            PG8_LDA(At, 1, 1); PG8_STAGEB(PG8_SB(1, 0), b3); PG8_STAGEB(PG8_SB(1, 1), b3 + hstepB); PG8_STAGE2(PG8_SA(1, 0), a3, c00, c01);
            PG8_WAIT_V(8); PG8_WAIT_L(0); PG8_BAR; PG8_MMA(1, 0, At, B0); PG8_MMA(1, 1, At, B1); PG8_BAR; PG8_SCHED;
        }
        if (wr == 0) PG8_BAR;
        E(acc, cur, wr, wc, fr, fq);
        if (!has_next) break;
#pragma unroll
        for (int a = 0; a < 2; ++a)
#pragma unroll
            for (int b = 0; b < 2; ++b)
#pragma unroll
                for (int m = 0; m < 4; ++m)
#pragma unroll
                    for (int n = 0; n < 2; ++n) acc[a][b][m][n] = (f32x4){0.f, 0.f, 0.f, 0.f};
        cur = nxt; cA = nA; cB = nB; nt = cur.nt; ++ui;
        if (wr == 1) PG8_BAR;
    }
    PG8_WAIT_V(0);
    PG8_BAR;
#undef PG8_SA
#undef PG8_SB
#undef PG8_STAGE2
#undef PG8_STAGEB
#undef PG8_LDA
#undef PG8_LDB
#undef PG8_MMA
#undef PG8_WAIT_V
#undef PG8_WAIT_L
#undef PG8_BAR
#undef PG8_SCHED
#undef PG8_MKOFF
}
}

#define XB_TMO      128
#define XB_XCNT(j)  (256  + 64 * (j))
#define XB_XSUB(j)  (1280 + 64 * (j))
#define XB_XGEN(j)  (2304 + 64 * (j))
#define XB_TOP      3328
#define XB_TOPGEN   3392
#define XCD_BAR_WORDS 3456
#define XB_SPIN_CAP (1u << 18)
__device__ __forceinline__ unsigned xb_ld(unsigned* p)              { return __hip_atomic_load(p, __ATOMIC_RELAXED, __HIP_MEMORY_SCOPE_AGENT); }
__device__ __forceinline__ unsigned xb_add(unsigned* p, unsigned v) { return __hip_atomic_fetch_add(p, v, __ATOMIC_RELAXED, __HIP_MEMORY_SCOPE_AGENT); }
__device__ __forceinline__ unsigned xb_xcc_id() { return (unsigned)__builtin_amdgcn_s_getreg((3 << 11) | 20) & 0xFu; }
#define XB_SPIN(cond, bar) do { unsigned _sp = 0; while (cond) { __builtin_amdgcn_s_sleep(1); \
    if ((++_sp & 255u) == 0u) { if (xb_ld(&(bar)[XB_TMO])) break; if (_sp > XB_SPIN_CAP) { atomicAdd(&(bar)[XB_TMO], 1u); break; } } } } while (0)
struct XcdBarrier { unsigned* bar; unsigned x; volatile LAS unsigned* st; int wave; };
__device__ __forceinline__ XcdBarrier xcd_barrier_post(unsigned* bar, volatile LAS unsigned* st, int wave) {
    XcdBarrier b; b.bar = bar; b.x = xb_xcc_id(); b.st = st; b.wave = wave;
    if (wave == 0 && lane_id() == 0) (void)xb_add(&bar[XB_XCNT(b.x)], 1u);
    return b;
}
__device__ __forceinline__ void xcd_barrier_complete(unsigned* bar, unsigned x, unsigned& nloc, unsigned& nx) {
    const unsigned G = gridDim.x * gridDim.y * gridDim.z;
    unsigned sum, cnt, mine, sp = 0u;
    for (;;) {
        sum = 0u; cnt = 0u; mine = 0u;
#pragma unroll
        for (unsigned j = 0; j < 16; ++j) { const unsigned c = xb_ld(&bar[XB_XCNT(j)]); sum += c; cnt += (c > 0u) ? 1u : 0u; mine = (j == x) ? c : mine; }
        if (sum == G) break;
        __builtin_amdgcn_s_sleep(1);
        if ((++sp & 255u) == 0u) { if (xb_ld(&bar[XB_TMO])) break; if (sp > XB_SPIN_CAP) { atomicAdd(&bar[XB_TMO], 1u); break; } }
    }
    nloc = mine > 0u ? mine : 1u; nx = cnt > 0u ? cnt : 1u;
}
__device__ __forceinline__ void xcd_barrier(const XcdBarrier& b) {
    asm volatile("s_waitcnt vmcnt(0)" ::: "memory");
    __syncthreads();
    if (b.wave == 0 && lane_id() == 0) {
        unsigned* bar = b.bar;
        __builtin_amdgcn_s_waitcnt(0);
        unsigned nloc = b.st[0], nx = b.st[1];
        if (nloc == 0u) { xcd_barrier_complete(bar, b.x, nloc, nx); b.st[0] = nloc; b.st[1] = nx; }
        const unsigned old = xb_add(&bar[XB_XSUB(b.x)], 1u);
        const unsigned gen = old / nloc;
        if (old + 1u == (gen + 1u) * nloc) {
            __builtin_amdgcn_fence(__ATOMIC_RELEASE, "agent");
            asm volatile("s_waitcnt vmcnt(0)" ::: "memory");
            const unsigned og = xb_add(&bar[XB_TOP], 1u);
            const unsigned tg = og / nx;
            if (og + 1u == (tg + 1u) * nx) xb_add(&bar[XB_TOPGEN], 1u);
            else XB_SPIN(xb_ld(&bar[XB_TOPGEN]) == tg, bar);
            __builtin_amdgcn_fence(__ATOMIC_ACQUIRE, "agent");
            xb_add(&bar[XB_XGEN(b.x)], 1u);
            asm volatile("s_waitcnt vmcnt(0)" ::: "memory");
        } else {
            XB_SPIN(xb_ld(&bar[XB_XGEN(b.x)]) == gen, bar);
            __builtin_amdgcn_fence(__ATOMIC_ACQUIRE, "agent");
            asm volatile("s_waitcnt vmcnt(0)" ::: "memory");
        }
    }
    __syncthreads();
}

struct Args { const float* in[20]; float* out; unsigned char* ws; };
typedef const __attribute__((address_space(4))) Args* KArgs;
__device__ __forceinline__ KArgs kargs() { KArgs k = (KArgs)__builtin_amdgcn_kernarg_segment_ptr(); asm volatile("" : "+s"(k)); return k; }
constexpr int NWAVES = 8, NTHREADS = 512;

struct Ctx {
    LAS unsigned char* lds;
    int tid, lane, wave, G, vcu;
    unsigned char* ws;
};
__device__ __forceinline__ Ctx make_ctx(int wave) {
    extern __shared__ __attribute__((aligned(16))) unsigned char lds_dyn[];
    Ctx F; int l = lane_id(); asm volatile("" : "+v"(l)); F.lds = (LAS unsigned char*)lds_dyn; F.lane = l; F.wave = wave; F.tid = wave * 64 + l;
    F.G = (int)gridDim.x; { const int bx = (int)blockIdx.x; F.vcu = (F.G % 8 == 0) ? (bx % 8) * (F.G / 8) + bx / 8 : bx; }
    F.ws = kargs()->ws; return F; }
__device__ __forceinline__ Ctx ctx_refresh(const Ctx& F0) { return make_ctx(F0.wave); }


#ifdef CKSUM
__device__ __forceinline__ void ck_region(const Ctx& F, int k, const void* base, size_t bytes) {
    const GAS u32x4* p = (const GAS u32x4*)base; const size_t n = bytes / 16; unsigned acc = 0u;
    const int tid_ = F.wave * 64 + lane_id();
    for (size_t i = (size_t)blockIdx.x * NTHREADS + tid_; i < n; i += (size_t)F.G * NTHREADS) { const u32x4 v = __builtin_nontemporal_load(p + i); acc += v.x * 3u + v.y * 5u + v.z * 7u + v.w * 11u + (unsigned)i; }
#pragma unroll
    for (int o = 1; o < 64; o <<= 1) acc += __shfl_xor(acc, o);
    if (lane_id() == 0) atomicAdd((unsigned*)(F.ws + WS_CTL) + 8192 + 64 * k, acc);
}
#define CK(k, base, bytes) ck_region(F, k, base, bytes)
#else
#define CK(k, base, bytes) do {} while (0)
#endif
__device__ __forceinline__ void p0_transpose64(const float* W, int ldw, int k0, int n0, bf16_t* dst, int ldt, LAS float* scr, int lane) {
    f32x4 v[16];
#pragma unroll
    for (int i = 0; i < 16; ++i) { const int kk = 4 * i + (lane >> 4); v[i] = *(const GAS f32x4*)(W + (size_t)(k0 + kk) * ldw + n0 + 4 * (lane & 15)); }
#pragma unroll
    for (int i = 0; i < 16; ++i) { const int kk = 4 * i + (lane >> 4); LAS float* s = scr + kk * 65 + 4 * (lane & 15); s[0] = v[i][0]; s[1] = v[i][1]; s[2] = v[i][2]; s[3] = v[i][3]; }
    LDS_WAIT(); asm volatile("" ::: "memory");
    const int c = lane & 7;
#pragma unroll
    for (int j = 0; j < 8; ++j) { const int n = (lane >> 3) + 8 * j; const LAS float* s = scr + (8 * c) * 65 + n;
        u32x4 o; o.x = cvt_pk_bf16(s[0 * 65], s[1 * 65]); o.y = cvt_pk_bf16(s[2 * 65], s[3 * 65]); o.z = cvt_pk_bf16(s[4 * 65], s[5 * 65]); o.w = cvt_pk_bf16(s[6 * 65], s[7 * 65]);
        *(GAS u32x4*)(dst + (size_t)n * ldt + 8 * c) = o; }
    LDS_WAIT(); asm volatile("" ::: "memory");
}
__device__ __forceinline__ void rms_row_to_bf16(const float* xrow, const float* g, bf16_t* orow, int lane) {
    const GAS f32x4* xr = (const GAS f32x4*)xrow + lane; const GAS f32x4* gr = (const GAS f32x4*)g + lane;
    f32x4 v[4]; float s = 0.f;
#pragma unroll
    for (int j = 0; j < 4; ++j) { v[j] = xr[64 * j]; s += (v[j].x * v[j].x + v[j].y * v[j].y) + (v[j].z * v[j].z + v[j].w * v[j].w); }
    const float r = 1.0f / sqrtf(wave_sum(s) * (1.f / D) + RMS_EPS);
    GAS u32x2* o8 = (GAS u32x2*)orow + lane;
#pragma unroll
    for (int j = 0; j < 4; ++j) { const f32x4 gg = gr[64 * j]; u32x2 w; w.x = cvt_pk_bf16(v[j].x * r * gg.x, v[j].y * r * gg.y); w.y = cvt_pk_bf16(v[j].z * r * gg.z, v[j].w * r * gg.w); o8[64 * j] = w; }
}
__device__ __forceinline__ int t5_bucket(int rel) {
    int ret = rel > 0 ? 16 : 0; const int n = rel < 0 ? -rel : rel;
    if (n < 8) return ret + n;
    const float nf = (float)n;
    int large = 8 + (int)(logf(nf / 8.0f) / logf(128.0f) * 8.0f);
    large = large < 15 ? large : 15;
    return ret + large;
}
__device__ __forceinline__ void p0_prologue(const Ctx& F0) {
    const KArgs ap = kargs();
    const Ctx F = ctx_refresh(F0);
    LAS float* scr = (LAS float*)(F.lds) + F.wave * (64 * 65);
    const int gw = F.vcu * NWAVES + F.wave, NGW = F.G * NWAVES;
    bf16_t* WGU_T = (bf16_t*)(F.ws + WS_WGU_T); bf16_t* WDN_T = (bf16_t*)(F.ws + WS_WDN_T); bf16_t* WIN_T = (bf16_t*)(F.ws + WS_WIN_T);
    bf16_t* WMEM_T = (bf16_t*)(F.ws + WS_WMEM_T); bf16_t* WABC_T = (bf16_t*)(F.ws + WS_WABC_T); bf16_t* WOUT_T = (bf16_t*)(F.ws + WS_WOUT_T);
    constexpr int I_GU = 32 * 16 * 32, I_DN = 32 * 16 * 16, I_IN = 16 * 116, I_MEM = 256, I_A = 8 * 16, I_B = 4 * 16, I_C = 8 * 16, I_O = 256;
    constexpr int NITEMS = I_GU + I_DN + I_IN + I_MEM + I_A + I_B + I_C + I_O;
    for (int it = gw; it < NITEMS; it += NGW) {
        int r = it;
        if (r < I_GU) { const int e = r >> 9, q = r & 511, kb = q >> 5, nb = q & 31, n0 = nb * 64; const int bj = n0 >> 10, rem = n0 & 1023, pn = rem >> 7, c0 = rem & 127;
            p0_transpose64(ap->in[15] + (size_t)e * 1024 * 2048, 2048, kb * 64, n0, WGU_T + ((size_t)e * 2048 + pn * 256 + bj * 128 + c0) * 1024 + kb * 64, 1024, scr, F.lane); continue; } r -= I_GU;
        if (r < I_DN) { const int e = r >> 8, q = r & 255, kb = q >> 4, nb = q & 15;
            p0_transpose64(ap->in[17] + (size_t)e * 1024 * 1024, 1024, kb * 64, nb * 64, WDN_T + ((size_t)e * 1024 + nb * 64) * 1024 + kb * 64, 1024, scr, F.lane); continue; } r -= I_DN;
        if (r < I_IN) { const int kb = r / 116, nb = r % 116; p0_transpose64(ap->in[4], IN_COLS, kb * 64, nb * 64, WIN_T + (size_t)(nb * 64) * 1024 + kb * 64, 1024, scr, F.lane); continue; } r -= I_IN;
        if (r < I_MEM) { const int kb = r >> 4, nb = r & 15; p0_transpose64(ap->in[5], 1024, kb * 64, nb * 64, WMEM_T + (size_t)(nb * 64) * 1024 + kb * 64, 1024, scr, F.lane); continue; } r -= I_MEM;
        if (r < I_A) { const int kb = r >> 4, nb = r & 15; p0_transpose64(ap->in[8], 1024, kb * 64, nb * 64, WABC_T + (size_t)(nb * 64) * ABC_LD + 0 + kb * 64, ABC_LD, scr, F.lane); continue; } r -= I_A;
        if (r < I_B) { const int kb = r >> 4, nb = r & 15; p0_transpose64(ap->in[9], 1024, kb * 64, nb * 64, WABC_T + (size_t)(nb * 64) * ABC_LD + 512 + kb * 64, ABC_LD, scr, F.lane); continue; } r -= I_B;
        if (r < I_C) { const int kb = r >> 4, nb = r & 15; p0_transpose64(ap->in[10], 1024, kb * 64, nb * 64, WABC_T + (size_t)(nb * 64) * ABC_LD + 768 + kb * 64, ABC_LD, scr, F.lane); continue; } r -= I_C;
        { const int kb = r >> 4, nb = r & 15; p0_transpose64(ap->in[11], 1024, kb * 64, nb * 64, WOUT_T + (size_t)(nb * 64) * 1024 + kb * 64, 1024, scr, F.lane); }
    }
    bf16_t* XN = (bf16_t*)(F.ws + WS_XN); bf16_t* MEMN = (bf16_t*)(F.ws + WS_MEMN);
    for (int m = gw; m < NTOK; m += NGW) rms_row_to_bf16(ap->in[0] + (size_t)m * D, ap->in[2], XN + (size_t)m * D, F.lane);
    for (int m = gw; m < NMEM; m += NGW) rms_row_to_bf16(ap->in[1] + (size_t)m * D, ap->in[3], MEMN + (size_t)m * D, F.lane);
    const int gt = F.vcu * NTHREADS + F.tid, NGT = F.G * NTHREADS;
    float* t5 = (float*)(F.ws + WS_MISC + MO_T5); float* rp = (float*)(F.ws + WS_MISC + MO_RPB);
    for (int i = gt; i < 12 * T5_LD; i += NGT) { const int gh = i / T5_LD, j = i % T5_LD, rel = j - 79, g = gh >> 2; const int dil = g == 0 ? 1 : (g == 1 ? 4 : 16);
        float v = 0.f; if (rel >= -64 && rel <= 64) v = ap->in[7][t5_bucket(rel * dil) * 12 + gh] * LOG2E; t5[i] = v; }
    for (int i = gt; i < 8 * RPB_LD; i += NGT) { const int h = i / RPB_LD, j = i % RPB_LD - RPB_OFF; float v = 0.f; if (j >= 0 && j < 465) v = ap->in[6][h * 465 + j] * LOG2E; rp[i] = v; }
}

struct P1Sched {
    int G, c; const char* XN; const char* WIN; const char* MEMN; const char* WMEM;
    __device__ __forceinline__ bool next(int i, pg8::Unit& u) const {
        const int L = i * G + c; constexpr int nM = 64, nN = 29, nwg = nM * nN;
        if (L >= nwg + 8) return false;
        u.rows = nullptr; u.nt = 16;
        if (L >= nwg) { const int j = L - nwg; u.pm = j >> 2; u.pn = j & 3; u.A = MEMN + (size_t)u.pm * 256 * 2048; u.B = WMEM + (size_t)u.pn * 256 * 2048; u.aux = 3; u.scale = 1.f; return true; }
        int wgid = L; { const int q = nwg / 8, r = nwg % 8, xcd = wgid % 8, off = wgid / 8; wgid = (xcd < r ? xcd * (q + 1) : r * (q + 1) + (xcd - r) * q) + off; }
        const int nig = 8 * nN, gid = wgid / nig, fm = gid * 8;
        u.pm = fm + ((wgid % nig) % 8); u.pn = (wgid % nig) / 8;
        u.A = XN + (size_t)u.pm * 256 * 2048; u.B = WIN + (size_t)u.pn * 256 * 2048;
        const int pn = u.pn;
        if (pn < 2 || (pn >= 6 && pn < 9)) { u.aux = 1; u.scale = QS64; } else if (pn == 15 || pn == 16) { u.aux = 1; u.scale = QS128; } else if (pn >= 17) { u.aux = 2; u.scale = 1.f; } else { u.aux = 0; u.scale = 1.f; }
        return true;
    }
};
struct P1Epi {
    bf16_t* PROJ; bf16_t* MKV;
    __device__ __forceinline__ void operator()(const f32x4 (&acc)[2][2][4][2], const pg8::Unit& u, int wr, int wc, int fr, int fq) const {
        bf16_t* O = u.aux == 3 ? MKV : PROJ; const int ldo = u.aux == 3 ? 1024 : IN_COLS;
        const int row0 = u.pm * 256 + wr * 64 + fr, col0 = u.pn * 256 + wc * 32 + 8 * fq; const float sc = u.scale; const bool sg = u.aux == 2;
#pragma unroll
        for (int ai = 0; ai < 2; ++ai)
#pragma unroll
            for (int m = 0; m < 4; ++m) { bf16_t* rowp = O + (size_t)(row0 + ai * 128 + m * 16) * ldo + col0;
#pragma unroll
                for (int bj = 0; bj < 2; ++bj) { f32x4 v0 = acc[ai][bj][m][0], v1 = acc[ai][bj][m][1];
                    if (sg) { v0 = (f32x4){fast_sigmoid(v0[0]), fast_sigmoid(v0[1]), fast_sigmoid(v0[2]), fast_sigmoid(v0[3])}; v1 = (f32x4){fast_sigmoid(v1[0]), fast_sigmoid(v1[1]), fast_sigmoid(v1[2]), fast_sigmoid(v1[3])}; }
                    else { v0 = v0 * sc; v1 = v1 * sc; }
                    u32x4 w; w.x = cvt_pk_bf16(v0[0], v0[1]); w.y = cvt_pk_bf16(v0[2], v0[3]); w.z = cvt_pk_bf16(v1[0], v1[1]); w.w = cvt_pk_bf16(v1[2], v1[3]);
                    *(GAS u32x4*)(rowp + bj * 128) = w; } }
    }
};

template <int DH> __device__ __forceinline__ int k_addr(int key, int c) {
    if (DH == 64) return key * 128 + ((c ^ ((key >> 1) & 7)) << 4);
    else return key * 256 + ((c ^ (key & 15)) << 4);
}
template <int DH> __device__ __forceinline__ int v_addr(int key, int c) {
    if (DH == 64) return key * 128 + ((c ^ (((key >> 1) & 3) << 1)) << 4);
    else return key * 256 + ((c ^ ((key & 7) << 1)) << 4);
}
__device__ __forceinline__ s16x4 vtr(const LAS unsigned char* p) { return __builtin_bit_cast(s16x4, __builtin_amdgcn_ds_read_tr16_b64_v4i16((LAS s16x4*)p)); }

template <int DH, class RowFn> __device__ __forceinline__ void stage_kv(LAS unsigned char* Kl, LAS unsigned char* Vl, int nkeys, int tid, const RowFn& rowfn) {
    constexpr int CH = DH / 8; const int total = nkeys * CH;
    for (int base = 0; base < total; base += NTHREADS * 4) {
        u32x4 kv[4], vv[4];
#pragma unroll
        for (int j = 0; j < 4; ++j) { const int ci = base + j * NTHREADS + tid; kv[j] = (u32x4){0u, 0u, 0u, 0u}; vv[j] = kv[j];
            if (ci < total) { const int key = ci / CH, c = ci % CH; const bf16_t* kp; const bf16_t* vp; rowfn(key, kp, vp); if (kp) { kv[j] = *(const GAS u32x4*)(kp + c * 8); vv[j] = *(const GAS u32x4*)(vp + c * 8); } } }
#pragma unroll
        for (int j = 0; j < 4; ++j) { const int ci = base + j * NTHREADS + tid;
            if (ci < total) { const int key = ci / CH, c = ci % CH; *(LAS u32x4*)(Kl + k_addr<DH>(key, c)) = kv[j]; *(LAS u32x4*)(Vl + v_addr<DH>(key, c)) = vv[j]; } }
    }
}

template <int DH> __device__ __forceinline__ f32x4 qk_tile(const LAS unsigned char* Kl, int kbase, const bf16x8 (&qf)[DH / 32], int i, int g) {
    f32x4 acc = (f32x4){0.f, 0.f, 0.f, 0.f}; const int key = kbase + i;
#pragma unroll
    for (int s = 0; s < DH / 32; ++s) { const bf16x8 kf = *(const LAS bf16x8*)(Kl + k_addr<DH>(key, 4 * s + g)); acc = __builtin_amdgcn_mfma_f32_16x16x32_bf16(kf, qf[s], acc, 0, 0, 0); }
    return acc;
}
template <int DH> __device__ __forceinline__ void pv_step(f32x4 (&o)[DH / 16], const LAS unsigned char* Vl, int vbase, int vbase2, bf16x8 pf, int i, int g) {
    const int k0 = vbase + 4 * g + (i >> 2), k1 = vbase2 + 4 * g + (i >> 2); const int sub = (i & 3) >> 1, b8 = 8 * (i & 1);
#pragma unroll
    for (int n = 0; n < DH / 16; ++n) {
        const s16x4 lo = vtr(Vl + v_addr<DH>(k0, 2 * n + sub) + b8), hi = vtr(Vl + v_addr<DH>(k1, 2 * n + sub) + b8);
        const bf16x8 vf = (bf16x8){lo[0], lo[1], lo[2], lo[3], hi[0], hi[1], hi[2], hi[3]};
        o[n] = __builtin_amdgcn_mfma_f32_16x16x32_bf16(vf, pf, o[n], 0, 0, 0);
    }
}
__device__ __forceinline__ bf16x8 pack_p(const f32x4& a, const f32x4& b) {
    u32x4 w; w.x = cvt_pk_bf16(a[0], a[1]); w.y = cvt_pk_bf16(a[2], a[3]); w.z = cvt_pk_bf16(b[0], b[1]); w.w = cvt_pk_bf16(b[2], b[3]); return __builtin_bit_cast(bf16x8, w);
}
template <int NT> __device__ __forceinline__ void softmax_tiles(f32x4 (&s)[NT], float& m, float& l) {
    float mx = -INFINITY;
#pragma unroll
    for (int t = 0; t < NT; ++t) mx = fmaxf(fmaxf(fmaxf(mx, s[t][0]), fmaxf(s[t][1], s[t][2])), s[t][3]);
    mx = fmaxf(mx, __shfl_xor(mx, 16)); mx = fmaxf(mx, __shfl_xor(mx, 32));
    float sum = 0.f;
#pragma unroll
    for (int t = 0; t < NT; ++t) {
#pragma unroll
        for (int r = 0; r < 4; ++r) { const float p = __builtin_amdgcn_exp2f(s[t][r] - mx); s[t][r] = p; sum += p; } }
    sum += __shfl_xor(sum, 16); sum += __shfl_xor(sum, 32);
    m = mx; l = sum;
}
template <int DH> __device__ __forceinline__ void load_q(bf16x8 (&qf)[DH / 32], const bf16_t* qrow, int g) {
#pragma unroll
    for (int s = 0; s < DH / 32; ++s) qf[s] = *(const GAS bf16x8*)(qrow + 32 * s + 8 * g);
}
template <int DH> __device__ __forceinline__ void store_o(const f32x4 (&o)[DH / 16], float inv, bf16_t* orow, int g) {
#pragma unroll
    for (int n = 0; n < DH / 16; ++n) { u32x2 w; w.x = cvt_pk_bf16(o[n][0] * inv, o[n][1] * inv); w.y = cvt_pk_bf16(o[n][2] * inv, o[n][3] * inv); *(GAS u32x2*)(orow + 16 * n + 4 * g) = w; }
}

__device__ __forceinline__ void p2_attention(const Ctx& F0) {
    const Ctx F = ctx_refresh(F0);
    const bf16_t* PROJ = (const bf16_t*)(F.ws + WS_PROJ); const bf16_t* MKV = (const bf16_t*)(F.ws + WS_MKV);
    bf16_t* ABC = (bf16_t*)(F.ws + WS_ABC); bf16_t* OB = (bf16_t*)(F.ws + WS_OB); float* LSE = (float*)(F.ws + WS_MISC + MO_LSE);
    const float* T5 = (const float*)(F.ws + WS_MISC + MO_T5); const float* RPB = (const float*)(F.ws + WS_MISC + MO_RPB);
    LAS unsigned char* Kl = F.lds; LAS float* tab = (LAS float*)(F.lds + LDS_TAB);
    const int w = F.wave, c = (int)blockIdx.x;
#define P2_LANE() int tid_r = F.tid; asm volatile("" : "+v"(tid_r)); const int lane = tid_r & 63, i = lane & 15, g = lane >> 4; (void)lane
    {
        LAS unsigned char* Vl = Kl + 65536; P2_LANE();
        const int combo = c & 7, b = combo >> 2, h = combo & 3;
        __syncthreads();
        stage_kv<128>(Kl, Vl, 256, tid_r, [&](int key, const bf16_t*& kp, const bf16_t*& vp) { kp = MKV + (size_t)(b * MEMLEN + key) * 1024 + h * 128; vp = kp + 512; });
        LDS_WAIT(); __syncthreads();
        for (int rep = 0; rep < 2; ++rep) {
            const int blk = (c >> 3) + 32 * rep; const int tok = b * SEQ + blk * 128 + w * 16 + i;
            bf16x8 qf[4]; load_q<128>(qf, PROJ + (size_t)tok * IN_COLS + C_QC + h * 128, g);
            f32x4 s[16];
#pragma unroll
            for (int t = 0; t < 16; ++t) s[t] = qk_tile<128>(Kl, 16 * t, qf, i, g);
            float m, l; softmax_tiles<16>(s, m, l);
            f32x4 o[8];
#pragma unroll
            for (int n = 0; n < 8; ++n) o[n] = (f32x4){0.f, 0.f, 0.f, 0.f};
#pragma unroll
            for (int u = 0; u < 8; ++u) pv_step<128>(o, Vl, 32 * u, 32 * u + 16, pack_p(s[2 * u], s[2 * u + 1]), i, g);
            store_o<128>(o, 1.0f / l, ABC + (size_t)tok * ABC_LD + 768 + h * 128, g);
        }
    }
    for (int rep = 0; rep < 4; ++rep) {
        LAS unsigned char* Vl = Kl + 73728; P2_LANE();
        const int ua = c + 256 * rep, x = ua & 7, y = ua >> 3, pair = x * 2 + (y >> 6), rp = y & 63, b = pair >> 3, h = pair & 7, r0 = 2 * rp;
        int rsU = r0 - 4; rsU = rsU < 0 ? 0 : (rsU > 120 ? 120 : rsU);
        __syncthreads();
        stage_kv<64>(Kl, Vl, 576, tid_r, [&](int key, const bf16_t*& kp, const bf16_t*& vp) { kp = nullptr; vp = nullptr; if (rsU * 64 + key < SEQ) { const size_t tok = (size_t)b * SEQ + rsU * 64 + key; kp = PROJ + tok * IN_COLS + C_KA + h * 64; vp = PROJ + tok * IN_COLS + C_VA + h * 64; } });
        for (int j = tid_r; j < RPB_LD; j += NTHREADS) tab[j] = RPB[h * RPB_LD + j];
        LDS_WAIT(); __syncthreads();
        const int r = r0 + (w >> 2), jb = w & 3; int rs = r - 4; rs = rs < 0 ? 0 : (rs > 120 ? 120 : rs);
        const int cq = 16 * jb + i; int cs = cq - 8; cs = cs < 0 ? 0 : (cs > 48 ? 48 : cs);
        const int cw = jb == 0 ? 0 : (jb == 1 ? 8 : (jb == 2 ? 24 : 32));
        const int tok = b * SEQ + r * 64 + cq;
        bf16x8 qf[2]; load_q<64>(qf, PROJ + (size_t)tok * IN_COLS + C_QA + h * 64, g);
        const int kb0 = (rs - rsU) * 64 + cw;
        f32x4 s[16];
#pragma unroll
        for (int t = 0; t < 16; ++t) s[t] = qk_tile<64>(Kl, kb0 + (t >> 1) * 64 + 16 * (t & 1), qf, i, g);
        const int bidx = RPB_OFF + (7 - (r - rs)) * 31 + (cw + 4 * g - cq + 15); const int lo = cs - cw - 4 * g;
#pragma unroll
        for (int t = 0; t < 16; ++t) {
#pragma unroll
            for (int rr = 0; rr < 4; ++rr) { const int kc = 16 * (t & 1) + rr; const float bias = tab[bidx + (t >> 1) * 31 + kc]; const bool ok = kc >= lo && kc < lo + 16; s[t][rr] = ok ? s[t][rr] + bias : -INFINITY; } }
        float m, l; softmax_tiles<16>(s, m, l);
        f32x4 o[4];
#pragma unroll
        for (int n = 0; n < 4; ++n) o[n] = (f32x4){0.f, 0.f, 0.f, 0.f};
#pragma unroll
        for (int u = 0; u < 8; ++u) pv_step<64>(o, Vl, kb0 + u * 64, kb0 + u * 64 + 16, pack_p(s[2 * u], s[2 * u + 1]), i, g);
        store_o<64>(o, 1.0f / l, ABC + (size_t)tok * ABC_LD + h * 64, g);
    }
    for (int rep = 0; rep < 6; ++rep) {
        LAS unsigned char* Vl = Kl + 34816; P2_LANE();
        const int ub = c + 256 * rep, x = ub & 7, y = ub >> 3, combo = x * 3 + y / 64, sub = y % 64, b = combo / 12, hh = combo % 12, grp = hh >> 2;
        const int dil = grp == 0 ? 1 : (grp == 1 ? 4 : 16), L = SEQ / dil, nb = L / 128, rho = sub / nb, n = sub % nb;
        const int p0 = 128 * n - 64;
        __syncthreads();
        stage_kv<64>(Kl, Vl, 272, tid_r, [&](int key, const bf16_t*& kp, const bf16_t*& vp) { const int p = p0 + key; kp = nullptr; vp = nullptr;
            if (key < 256 && p >= 0 && p < L) { const size_t tok = (size_t)b * SEQ + (size_t)p * dil + rho; kp = PROJ + tok * IN_COLS + C_KB + hh * 64; vp = PROJ + tok * IN_COLS + C_VB + hh * 64; } });
        for (int j = tid_r; j < T5_LD; j += NTHREADS) tab[j] = T5[hh * T5_LD + j];
        LDS_WAIT(); __syncthreads();
        const int pq = 128 * n + 16 * w + i; const int tok = b * SEQ + pq * dil + rho;
        bf16x8 qf[2]; load_q<64>(qf, PROJ + (size_t)tok * IN_COLS + C_QB + hh * 64, g);
        f32x4 s[10];
#pragma unroll
        for (int t = 0; t < 10; ++t) s[t] = qk_tile<64>(Kl, 16 * w + 16 * t, qf, i, g);
        const int rel0 = 4 * g - 64 - i;
#pragma unroll
        for (int t = 0; t < 10; ++t) {
#pragma unroll
            for (int rr = 0; rr < 4; ++rr) { const int rel = rel0 + 16 * t + rr; const int p = pq + rel; const float bias = tab[rel + 79]; const bool ok = rel >= -64 && rel <= 64 && p >= 0 && p < L; s[t][rr] = ok ? s[t][rr] + bias : -INFINITY; } }
        float m, l; softmax_tiles<10>(s, m, l);
        f32x4 o[4];
#pragma unroll
        for (int nn = 0; nn < 4; ++nn) o[nn] = (f32x4){0.f, 0.f, 0.f, 0.f};
#pragma unroll
        for (int u = 0; u < 5; ++u) pv_step<64>(o, Vl, 16 * w + 32 * u, 16 * w + 32 * u + 16, pack_p(s[2 * u], s[2 * u + 1]), i, g);
        const int h4 = hh & 3;
        store_o<64>(o, 1.0f / l, OB + ((size_t)grp * NTOK + tok) * 256 + h4 * 64, g);
        if (g == 0) LSE[((size_t)grp * NTOK + tok) * 4 + h4] = m + __builtin_amdgcn_logf(l);
    }
}
#undef P2_LANE
__device__ __forceinline__ void p2b_merge(const Ctx& F0) {
    const Ctx F = ctx_refresh(F0);
    const bf16_t* OB = (const bf16_t*)(F.ws + WS_OB); const float* LSE = (const float*)(F.ws + WS_MISC + MO_LSE); bf16_t* ABC = (bf16_t*)(F.ws + WS_ABC);
    const int gt = F.vcu * NTHREADS + F.tid, NGT = F.G * NTHREADS;
    for (int it = gt; it < NTOK * 32; it += NGT) {
        const int tok = it >> 5, ch = it & 31, h = ch >> 3;
        const float l0 = LSE[(size_t)tok * 4 + h], l1 = LSE[((size_t)NTOK + tok) * 4 + h], l2 = LSE[((size_t)2 * NTOK + tok) * 4 + h];
        const float mx = fmaxf(l0, fmaxf(l1, l2)); float w0 = __builtin_amdgcn_exp2f(l0 - mx), w1 = __builtin_amdgcn_exp2f(l1 - mx), w2 = __builtin_amdgcn_exp2f(l2 - mx);
        const float inv = 1.0f / (w0 + w1 + w2); w0 *= inv; w1 *= inv; w2 *= inv;
        const u32x4 a = *(const GAS u32x4*)(OB + (size_t)tok * 256 + ch * 8), bq = *(const GAS u32x4*)(OB + ((size_t)NTOK + tok) * 256 + ch * 8), cq = *(const GAS u32x4*)(OB + ((size_t)2 * NTOK + tok) * 256 + ch * 8);
        u32x4 o;
#pragma unroll
        for (int j = 0; j < 4; ++j) { const float lo = w0 * bf_lo(a[j]) + w1 * bf_lo(bq[j]) + w2 * bf_lo(cq[j]), hi = w0 * bf_hi(a[j]) + w1 * bf_hi(bq[j]) + w2 * bf_hi(cq[j]); o[j] = cvt_pk_bf16(lo, hi); }
        *(GAS u32x4*)(ABC + (size_t)tok * ABC_LD + 512 + ch * 8) = o;
    }
}

struct P3Sched {
    int c; const char* ABCp; const char* WABC;
    __device__ __forceinline__ bool next(int i, pg8::Unit& u) const {
        if (i >= 3) return false;
        constexpr int nM = 64, nN = 4, nwg = 256;
        int wgid = c; { const int q = nwg / 8, xcd = wgid % 8, off = wgid / 8; wgid = xcd * q + off; }
        const int nig = 8 * nN, gid = wgid / nig, fm = gid * 8;
        u.pm = fm + ((wgid % nig) % 8); u.pn = (wgid % nig) / 8;
        const int koff = i == 0 ? 0 : (i == 1 ? 512 : 768);
        u.A = ABCp + (size_t)u.pm * 256 * (ABC_LD * 2) + koff * 2; u.B = WABC + (size_t)u.pn * 256 * (ABC_LD * 2) + koff * 2;
        u.rows = nullptr; u.nt = i == 1 ? 4 : 8; u.aux = i; u.scale = 1.f; return true;
    }
};
struct P3Epi {
    const bf16_t* PROJ; bf16_t* MERGED;
    __device__ __forceinline__ void operator()(const f32x4 (&acc)[2][2][4][2], const pg8::Unit& u, int wr, int wc, int fr, int fq) const {
        const int row0 = u.pm * 256 + wr * 64 + fr, col0 = u.pn * 256 + wc * 32 + 8 * fq; const int s = u.aux;
#pragma unroll
        for (int ai = 0; ai < 2; ++ai)
#pragma unroll
            for (int m = 0; m < 4; ++m) { const size_t row = (size_t)(row0 + ai * 128 + m * 16);
#pragma unroll
                for (int bj = 0; bj < 2; ++bj) { const int col = col0 + bj * 128;
                    const u32x4 gt = *(const GAS u32x4*)(PROJ + row * IN_COLS + C_GATE + s * 1024 + col);
                    GAS u32x4* mp = (GAS u32x4*)(MERGED + row * 1024 + col);
                    u32x4 prev = (u32x4){0u, 0u, 0u, 0u}; if (s > 0) prev = __builtin_nontemporal_load(mp);
                    const f32x4 v0 = acc[ai][bj][m][0], v1 = acc[ai][bj][m][1];
                    u32x4 o;
                    o.x = cvt_pk_bf16(bf_lo(prev.x) + bf_lo(gt.x) * v0[0], bf_hi(prev.x) + bf_hi(gt.x) * v0[1]);
                    o.y = cvt_pk_bf16(bf_lo(prev.y) + bf_lo(gt.y) * v0[2], bf_hi(prev.y) + bf_hi(gt.y) * v0[3]);
                    o.z = cvt_pk_bf16(bf_lo(prev.z) + bf_lo(gt.z) * v1[0], bf_hi(prev.z) + bf_hi(gt.z) * v1[1]);
                    o.w = cvt_pk_bf16(bf_lo(prev.w) + bf_lo(gt.w) * v1[2], bf_hi(prev.w) + bf_hi(gt.w) * v1[3]);
                    *mp = o; } }
    }
};
struct P4Sched {
    int c; const char* MERGED; const char* WOUT;
    __device__ __forceinline__ bool next(int i, pg8::Unit& u) const {
        if (i >= 1) return false;
        constexpr int nN = 4, nwg = 256;
        int wgid = c; { const int q = nwg / 8, xcd = wgid % 8, off = wgid / 8; wgid = xcd * q + off; }
        const int nig = 8 * nN, gid = wgid / nig, fm = gid * 8;
        u.pm = fm + ((wgid % nig) % 8); u.pn = (wgid % nig) / 8;
        u.A = MERGED + (size_t)u.pm * 256 * 2048; u.B = WOUT + (size_t)u.pn * 256 * 2048; u.rows = nullptr; u.nt = 16; u.aux = 0; u.scale = 1.f; return true;
    }
};
struct P4Epi {
    const float* X; float* X1;
    __device__ __forceinline__ void operator()(const f32x4 (&acc)[2][2][4][2], const pg8::Unit& u, int wr, int wc, int fr, int fq) const {
        const int row0 = u.pm * 256 + wr * 64 + fr, col0 = u.pn * 256 + wc * 32 + 8 * fq;
#pragma unroll
        for (int ai = 0; ai < 2; ++ai)
#pragma unroll
            for (int m = 0; m < 4; ++m) { const size_t off = (size_t)(row0 + ai * 128 + m * 16) * 1024 + col0;
#pragma unroll
                for (int bj = 0; bj < 2; ++bj) {
                    const f32x4 x0 = *(const GAS f32x4*)(X + off + bj * 128), x1 = *(const GAS f32x4*)(X + off + bj * 128 + 4);
                    *(GAS f32x4*)(X1 + off + bj * 128) = x0 + acc[ai][bj][m][0]; *(GAS f32x4*)(X1 + off + bj * 128 + 4) = x1 + acc[ai][bj][m][1]; } }
    }
};

__device__ __forceinline__ void p5_router(const Ctx& F0) {
    const KArgs ap = kargs(); struct { const float* in[20]; float* out; } a; a.in[12] = ap->in[12]; a.in[13] = ap->in[13]; a.in[14] = ap->in[14]; a.out = ap->out;
    const Ctx F = ctx_refresh(F0);
    const float* X1 = a.out; bf16_t* H2 = (bf16_t*)(F.ws + WS_XN);
    const float* RW = a.in[13]; const float* RB = a.in[14]; const float* GF = a.in[12];
    int* TOPIDX = (int*)(F.ws + WS_MISC + MO_TOPIDX); float* TOPW = (float*)(F.ws + WS_MISC + MO_TOPW); int* HIST = (int*)(F.ws + WS_MISC + MO_HIST);
    LAS f32x4* Wl = (LAS f32x4*)F.lds;
    LAS int* hist = (LAS int*)(F.lds + LDS_TAB);
    __syncthreads();
    for (int idx = F.tid; idx < 1024 * 8; idx += NTHREADS) { const int k = idx >> 3, q = idx & 7; f32x4 wv = *(const GAS f32x4*)(RW + (size_t)k * 32 + 4 * q); const float gk = GF[k];
        Wl[(((k >> 8) * 4 + (k & 3)) * 8 + q) * 64 + ((k >> 2) & 63)] = wv * gk; }
    if (F.tid < 32) hist[F.tid] = 0;
    LDS_WAIT(); __syncthreads();
    const int lane = F.lane; const int bid = (int)blockIdx.x;
    const GAS f32x4* gr = (const GAS f32x4*)GF + lane;
    for (int tt = 0; tt < 8; ++tt) {
        const int tok = bid * 64 + F.wave * 8 + tt;
        const GAS f32x4* xr = (const GAS f32x4*)(X1 + (size_t)tok * D) + lane;
        f32x4 v[4]; float ss = 0.f;
#pragma unroll
        for (int jj = 0; jj < 4; ++jj) { v[jj] = xr[64 * jj]; ss += (v[jj].x * v[jj].x + v[jj].y * v[jj].y) + (v[jj].z * v[jj].z + v[jj].w * v[jj].w); }
        const float r = 1.0f / sqrtf(wave_sum(ss) * (1.f / D) + RMS_EPS);
        GAS u32x2* o8 = (GAS u32x2*)(H2 + (size_t)tok * D) + lane;
#pragma unroll
        for (int jj = 0; jj < 4; ++jj) { const f32x4 gg = gr[64 * jj]; u32x2 wq; wq.x = cvt_pk_bf16(v[jj].x * r * gg.x, v[jj].y * r * gg.y); wq.y = cvt_pk_bf16(v[jj].z * r * gg.z, v[jj].w * r * gg.w); o8[64 * jj] = wq; }
        float acc[32];
#pragma unroll
        for (int e = 0; e < 32; ++e) acc[e] = 0.f;
#pragma unroll
        for (int jj = 0; jj < 4; ++jj)
#pragma unroll
            for (int j = 0; j < 4; ++j) { const float xv = v[jj][j];
#pragma unroll
                for (int q = 0; q < 8; ++q) { const f32x4 wv = Wl[((jj * 4 + j) * 8 + q) * 64 + lane]; acc[4 * q + 0] += xv * wv.x; acc[4 * q + 1] += xv * wv.y; acc[4 * q + 2] += xv * wv.z; acc[4 * q + 3] += xv * wv.w; }
                __builtin_amdgcn_sched_barrier(0); }
#define P5_HALVE(N, OFS) { const bool up = (lane & (OFS)) != 0; _Pragma("unroll") for (int e = 0; e < (N); ++e) { const float keep = up ? acc[e + (N)] : acc[e]; const float send = up ? acc[e] : acc[e + (N)]; acc[e] = keep + __shfl_xor(send, (OFS)); } }
        P5_HALVE(16, 32) P5_HALVE(8, 16) P5_HALVE(4, 8) P5_HALVE(2, 4) P5_HALVE(1, 2)
#undef P5_HALVE
        float logit = acc[0] + __shfl_xor(acc[0], 1);
        const int e_me = (lane >> 1) & 31;
        logit = logit * r + RB[e_me];
        float val = logit; int ti[4]; float tv[4];
#pragma unroll
        for (int k = 0; k < 4; ++k) { const float mx = wave_max(val); const unsigned long long bal = __ballot(val == mx); const int src = __builtin_ctzll(bal); const int e = (src >> 1) & 31; ti[k] = e; tv[k] = mx; if (e_me == e) val = -INFINITY; }
        const float e1 = __expf(tv[1] - tv[0]), e2 = __expf(tv[2] - tv[0]), e3 = __expf(tv[3] - tv[0]); const float inv = 1.0f / (1.0f + e1 + e2 + e3);
        if (lane == 0) { *(GAS i32x4*)(TOPIDX + tok * 4) = (i32x4){ti[0], ti[1], ti[2], ti[3]}; *(GAS f32x4*)(TOPW + tok * 4) = (f32x4){inv, e1 * inv, e2 * inv, e3 * inv};
            atomicAdd((int*)&hist[ti[0]], 1); atomicAdd((int*)&hist[ti[1]], 1); atomicAdd((int*)&hist[ti[2]], 1); atomicAdd((int*)&hist[ti[3]], 1); }
    }
    LDS_WAIT(); __syncthreads();
    if (F.tid < 32) HIST[bid * 32 + F.tid] = hist[F.tid];
}
__device__ __forceinline__ void p6_slots(const Ctx& F0) {
    const Ctx F = ctx_refresh(F0);
    const int* TOPIDX = (const int*)(F.ws + WS_MISC + MO_TOPIDX); const float* TOPW = (const float*)(F.ws + WS_MISC + MO_TOPW); const int* HIST = (const int*)(F.ws + WS_MISC + MO_HIST);
    int* TOKSLOT = (int*)(F.ws + WS_MISC + MO_TOKSLOT); int* SLOTTOK = (int*)(F.ws + WS_MISC + MO_SLOTTOK); float* SLOTW = (float*)(F.ws + WS_MISC + MO_SLOTW); int* TILE = (int*)(F.ws + WS_MISC + MO_TILE);
    LAS int* part = (LAS int*)F.lds;
    LAS int* pref = part + 512;
    LAS int* tot = part + 1024;
    LAS int* mypre = tot + 32; LAS int* sbase = tot + 64; LAS int* wcnt = tot + 96;
    const int bid = (int)blockIdx.x, tid = F.tid;
    __syncthreads();
    { const int e = tid & 31, ch = tid >> 5; int s = 0, p = 0;
        for (int j = 0; j < 16; ++j) { const int bb = ch * 16 + j; const int hv = HIST[bb * 32 + e]; s += hv; if (bb < bid) p += hv; }
        part[ch * 32 + e] = s; pref[ch * 32 + e] = p; }
    LDS_WAIT(); __syncthreads();
    if (tid < 32) { int s = 0, p = 0; for (int ch = 0; ch < 16; ++ch) { s += part[ch * 32 + tid]; p += pref[ch * 32 + tid]; } tot[tid] = s; mypre[tid] = p; }
    LDS_WAIT(); __syncthreads();
    if (tid == 0) { int tb = 0; for (int e = 0; e < 32; ++e) { sbase[e] = tb * 256; const int nt = (tot[e] + 255) >> 8; if (bid == 0) { for (int j = 0; j < nt; ++j) TILE[1 + tb + j] = e; } tb += nt; } if (bid == 0) TILE[0] = tb; }
    LDS_WAIT(); __syncthreads();
    int e_me = 0, rank = 0; float w_me = 0.f; const int ent = tid;
    if (tid < 256) { e_me = TOPIDX[bid * 256 + ent]; w_me = TOPW[bid * 256 + ent];
        const int wv = tid >> 6;
        for (int e = 0; e < 32; ++e) { const unsigned long long bal = __ballot(e_me == e); if (e_me == e) rank = __builtin_popcountll(bal & ((1ull << F.lane) - 1ull)); if (F.lane == 0) wcnt[wv * 32 + e] = __builtin_popcountll(bal); } }
    LDS_WAIT(); __syncthreads();
    if (tid < 256) { const int wv = tid >> 6; for (int j = 0; j < wv; ++j) rank += wcnt[j * 32 + e_me];
        const int slot = sbase[e_me] + mypre[e_me] + rank; const int tok = bid * 64 + (ent >> 2);
        SLOTTOK[slot] = tok; SLOTW[slot] = w_me; TOKSLOT[bid * 256 + ent] = slot; }
    if (bid < 32) { const int e = bid; const int beg = sbase[e] + tot[e], end = sbase[e] + (((tot[e] + 255) >> 8) << 8); for (int s = beg + tid; s < end; s += NTHREADS) { SLOTTOK[s] = 0; SLOTW[s] = 0.f; } }
}
struct P7Sched {
    int G, c; const int* TILE; const int* SLOTTOK; const char* H2; const char* WGU;
    __device__ __forceinline__ bool next(int i, pg8::Unit& u) const {
        const int ntile = ld_uniform(TILE); const int L = i * G + c; if (L >= ntile * 8) return false;
        const int m = L >> 3, pn = L & 7, e = ld_uniform(TILE + 1 + m);
        u.pm = m; u.pn = pn; u.aux = e; u.scale = 1.f; u.nt = 16; u.rows = SLOTTOK + m * 256; u.A = H2; u.B = WGU + ((size_t)e * 2048 + pn * 256) * 2048; return true;
    }
};
struct P7Epi {
    const float* BGU; bf16_t* ACT;
    __device__ __forceinline__ void operator()(const f32x4 (&acc)[2][2][4][2], const pg8::Unit& u, int wr, int wc, int fr, int fq) const {
        const int row0 = u.pm * 256 + wr * 64 + fr, cc0 = wc * 32 + 8 * fq, e = u.aux;
        const float* bg = BGU + (size_t)e * 2048 + u.pn * 128 + cc0; const float* bu = bg + 1024;
        const f32x4 bg0 = *(const GAS f32x4*)bg, bg1 = *(const GAS f32x4*)(bg + 4), bu0 = *(const GAS f32x4*)bu, bu1 = *(const GAS f32x4*)(bu + 4);
#pragma unroll
        for (int ai = 0; ai < 2; ++ai)
#pragma unroll
            for (int m = 0; m < 4; ++m) { const size_t row = (size_t)(row0 + ai * 128 + m * 16);
                float av[8];
#pragma unroll
                for (int n = 0; n < 2; ++n) { const f32x4 gv = acc[ai][0][m][n] + (n ? bg1 : bg0), uv = acc[ai][1][m][n] + (n ? bu1 : bu0);
#pragma unroll
                    for (int j = 0; j < 4; ++j) { const float gg = fminf(gv[j], 7.0f); const float uu = fminf(fmaxf(uv[j], -7.0f), 7.0f); av[4 * n + j] = (uu + 1.0f) * gg * fast_sigmoid(1.702f * gg); } }
                u32x4 o; o.x = cvt_pk_bf16(av[0], av[1]); o.y = cvt_pk_bf16(av[2], av[3]); o.z = cvt_pk_bf16(av[4], av[5]); o.w = cvt_pk_bf16(av[6], av[7]);
                *(GAS u32x4*)(ACT + row * 1024 + u.pn * 128 + cc0) = o; }
    }
};
struct P8Sched {
    int G, c; const int* TILE; const char* ACT; const char* WDN;
    __device__ __forceinline__ bool next(int i, pg8::Unit& u) const {
        const int ntile = ld_uniform(TILE); const int L = i * G + c; if (L >= ntile * 4) return false;
        const int m = L >> 2, pn = L & 3, e = ld_uniform(TILE + 1 + m);
        u.pm = m; u.pn = pn; u.aux = e; u.scale = 1.f; u.nt = 16; u.rows = nullptr; u.A = ACT + (size_t)m * 256 * 2048; u.B = WDN + ((size_t)e * 1024 + pn * 256) * 2048; return true;
    }
};
struct P8Epi {
    const float* BDN; const float* SLOTW; bf16_t* YS;
    __device__ __forceinline__ void operator()(const f32x4 (&acc)[2][2][4][2], const pg8::Unit& u, int wr, int wc, int fr, int fq) const {
        const int row0 = u.pm * 256 + wr * 64 + fr, col0 = u.pn * 256 + wc * 32 + 8 * fq, e = u.aux;
        f32x4 bv[2][2];
#pragma unroll
        for (int bj = 0; bj < 2; ++bj)
#pragma unroll
            for (int n = 0; n < 2; ++n) bv[bj][n] = *(const GAS f32x4*)(BDN + (size_t)e * 1024 + col0 + bj * 128 + 4 * n);
#pragma unroll
        for (int ai = 0; ai < 2; ++ai)
#pragma unroll
            for (int m = 0; m < 4; ++m) { const size_t row = (size_t)(row0 + ai * 128 + m * 16); const float sw = SLOTW[row];
#pragma unroll
                for (int bj = 0; bj < 2; ++bj) { const f32x4 v0 = (acc[ai][bj][m][0] + bv[bj][0]) * sw, v1 = (acc[ai][bj][m][1] + bv[bj][1]) * sw;
                    u32x4 o; o.x = cvt_pk_bf16(v0[0], v0[1]); o.y = cvt_pk_bf16(v0[2], v0[3]); o.z = cvt_pk_bf16(v1[0], v1[1]); o.w = cvt_pk_bf16(v1[2], v1[3]);
                    *(GAS u32x4*)(YS + row * 1024 + col0 + bj * 128) = o; } }
    }
};
__device__ __forceinline__ void p9_final(const Ctx& F0) {
    const KArgs ap = kargs(); struct { const float* in[20]; float* out; } a; a.in[19] = ap->in[19]; a.out = ap->out;
    const Ctx F = ctx_refresh(F0);
    float* OUT = a.out; const bf16_t* YS = (const bf16_t*)(F.ws + WS_YS); const int* TOKSLOT = (const int*)(F.ws + WS_MISC + MO_TOKSLOT); const float* GN = a.in[19];
    const int gw = F.vcu * NWAVES + F.wave, NGW = F.G * NWAVES, lane = F.lane;
    const GAS f32x4* gr = (const GAS f32x4*)GN + lane;
    const bool bad = ld_uniform((const int*)(F.ws + WS_CTL) + 4096 + XB_TMO) != 0;
    float ckscale = 1.0f;
#ifdef CKSUM
    { const int* prev = (const int*)(F.ws + WS_MISC + 7 * MiB); if (ld_uniform(prev) == 0x5EED1234) ckscale = 1.0f + 0.25f * (float)ld_uniform(prev + 1); }
#endif
    for (int tok = gw; tok < NTOK; tok += NGW) {
        GAS f32x4* xr = (GAS f32x4*)(OUT + (size_t)tok * D) + lane;
        f32x4 v[4];
#pragma unroll
        for (int jj = 0; jj < 4; ++jj) v[jj] = xr[64 * jj];
        const int slots[4] = {ld_uniform(TOKSLOT + tok * 4), ld_uniform(TOKSLOT + tok * 4 + 1), ld_uniform(TOKSLOT + tok * 4 + 2), ld_uniform(TOKSLOT + tok * 4 + 3)};
#pragma unroll
        for (int k = 0; k < 4; ++k) { const GAS u32x2* yr = (const GAS u32x2*)(YS + (size_t)slots[k] * 1024) + lane;
#pragma unroll
            for (int jj = 0; jj < 4; ++jj) { const u32x2 y = yr[64 * jj]; v[jj].x += bf_lo(y.x); v[jj].y += bf_hi(y.x); v[jj].z += bf_lo(y.y); v[jj].w += bf_hi(y.y); } }
        float ss = 0.f;
#pragma unroll
        for (int jj = 0; jj < 4; ++jj) ss += (v[jj].x * v[jj].x + v[jj].y * v[jj].y) + (v[jj].z * v[jj].z + v[jj].w * v[jj].w);
        const float r = 1.0f / sqrtf(wave_sum(ss) * (1.f / D) + RMS_EPS);
#pragma unroll
        for (int jj = 0; jj < 4; ++jj) { const f32x4 gg = gr[64 * jj]; f32x4 o = (f32x4){v[jj].x * r * gg.x, v[jj].y * r * gg.y, v[jj].z * r * gg.z, v[jj].w * r * gg.w} * ckscale; if (bad) o = (f32x4){__builtin_nanf(""), __builtin_nanf(""), __builtin_nanf(""), __builtin_nanf("")}; xr[64 * jj] = o; }
    }
}

__device__ __forceinline__ void grid_barrier(int wave) {
    extern __shared__ __attribute__((aligned(16))) unsigned char lds_dyn[];
    XcdBarrier b; b.bar = (unsigned*)(kargs()->ws + WS_CTL) + 4096; b.x = xb_xcc_id(); b.st = (volatile LAS unsigned*)((LAS unsigned char*)lds_dyn + LDS_MISC) + 8; b.wave = wave;
    xcd_barrier(b);
}
__global__ void __launch_bounds__(NTHREADS, 2) fwd_megakernel(Args args) {
    const int wave = __builtin_amdgcn_readfirstlane((int)threadIdx.x >> 6);
    {
        const Ctx F = make_ctx(wave);
        volatile LAS unsigned* MISC = (volatile LAS unsigned*)(F.lds + LDS_MISC);
        for (int u = F.tid; u < 128; u += NTHREADS) MISC[u] = 0u;
        __syncthreads();
        (void)xcd_barrier_post((unsigned*)(F.ws + WS_CTL) + 4096, MISC + 8, wave);
    }
#define F make_ctx(wave)
#define ws (kargs()->ws)
#define xcd_barrier(bar) grid_barrier(wave)
#ifndef PHM
#define PHM 0xFFFF
#endif
#define PH(k) ((PHM >> (k)) & 1)
#ifdef CANARY
    {
        const size_t n16 = (WS_END - WS_MISC) / 16; GAS u32x4* p = (GAS u32x4*)(ws + WS_MISC);
        for (size_t i = (size_t)blockIdx.x * NTHREADS + F.tid; i < n16; i += (size_t)F.G * NTHREADS) p[i] = (u32x4){0xffffffffu, 0xffffffffu, 0xffffffffu, 0xffffffffu};
        GAS u32x4* q = (GAS u32x4*)kargs()->out;
        for (size_t i = (size_t)blockIdx.x * NTHREADS + F.tid; i < (size_t)NTOK * D / 4; i += (size_t)F.G * NTHREADS) q[i] = (u32x4){0xffffffffu, 0xffffffffu, 0xffffffffu, 0xffffffffu};
        xcd_barrier(bar);
    }
#endif
    if (PH(0)) p0_prologue(F);
    xcd_barrier(bar);
    CK(1, ws + WS_WIN_T, WS_MKV - WS_WIN_T); CK(1, ws + WS_XN, WS_ABC - WS_XN); CK(1, ws + WS_WGU_T, WS_PROJ - WS_WGU_T); CK(1, ws + WS_MISC + MO_T5, 128 * 1024);
    if (PH(1)) {
        P1Sched S{F.G, (int)blockIdx.x, (const char*)(ws + WS_XN), (const char*)(ws + WS_WIN_T), (const char*)(ws + WS_MEMN), (const char*)(ws + WS_WMEM_T)};
        P1Epi E{(bf16_t*)(ws + WS_PROJ), (bf16_t*)(ws + WS_MKV)};
        pg8::gemm_phase<P1Epi, P1Sched, false>(F.lds, F.wave, 2048u, 2048u, S, E);
    }
    xcd_barrier(bar);
    CK(2, ws + WS_PROJ, WS_ACT - WS_PROJ); CK(2, ws + WS_MKV, 1 * MiB);
    if (PH(2)) p2_attention(F);
    xcd_barrier(bar);
    CK(3, ws + WS_OB, WS_MERGED - WS_OB); CK(3, ws + WS_MISC + MO_LSE, 3 * 16384 * 16);
    if (PH(10)) p2b_merge(F);
    xcd_barrier(bar);
    CK(4, ws + WS_ABC, WS_OB - WS_ABC);
    if (PH(3)) {
        P3Sched S{(int)blockIdx.x, (const char*)(ws + WS_ABC), (const char*)(ws + WS_WABC_T)};
        P3Epi E{(const bf16_t*)(ws + WS_PROJ), (bf16_t*)(ws + WS_MERGED)};
        pg8::gemm_phase<P3Epi, P3Sched, false>(F.lds, F.wave, (unsigned)(ABC_LD * 2), (unsigned)(ABC_LD * 2), S, E);
    }
    xcd_barrier(bar);
    CK(5, ws + WS_MERGED, 32 * MiB);
    if (PH(4)) {
        P4Sched S{(int)blockIdx.x, (const char*)(ws + WS_MERGED), (const char*)(ws + WS_WOUT_T)};
        P4Epi E{kargs()->in[0], kargs()->out};
        pg8::gemm_phase<P4Epi, P4Sched, false>(F.lds, F.wave, 2048u, 2048u, S, E);
    }
    xcd_barrier(bar);
    CK(6, kargs()->out, 64 * MiB);
    if (PH(5)) p5_router(F);
    xcd_barrier(bar);
    CK(7, ws + WS_XN, 32 * MiB); CK(7, ws + WS_MISC, 512 * 1024 + 32 * 1024);
    if (PH(6)) p6_slots(F);
    xcd_barrier(bar);
#ifdef CKSUM
#define ck_rows ((size_t)ld_uniform((const int*)(ws + WS_MISC + MO_TILE)) * 256)
    CK(8, ws + WS_MISC + MO_TOKSLOT, 256 * 1024); CK(8, ws + WS_MISC + MO_SLOTTOK, ck_rows * 4); CK(8, ws + WS_MISC + MO_SLOTW, ck_rows * 4); CK(8, ws + WS_MISC + MO_TILE, 1024);
#endif
    if (PH(7)) {
        P7Sched S{F.G, (int)blockIdx.x, (const int*)(ws + WS_MISC + MO_TILE), (const int*)(ws + WS_MISC + MO_SLOTTOK), (const char*)(ws + WS_XN), (const char*)(ws + WS_WGU_T)};
        P7Epi E{kargs()->in[16], (bf16_t*)(ws + WS_ACT)};
        pg8::gemm_phase<P7Epi, P7Sched, true>(F.lds, F.wave, 2048u, 2048u, S, E);
    }
    xcd_barrier(bar);
#ifdef CKSUM
    CK(9, ws + WS_ACT, ck_rows * 2048);
#endif
    if (PH(8)) {
        P8Sched S{F.G, (int)blockIdx.x, (const int*)(ws + WS_MISC + MO_TILE), (const char*)(ws + WS_ACT), (const char*)(ws + WS_WDN_T)};
        P8Epi E{kargs()->in[18], (const float*)(ws + WS_MISC + MO_SLOTW), (bf16_t*)(ws + WS_YS)};
        pg8::gemm_phase<P8Epi, P8Sched, false>(F.lds, F.wave, 2048u, 2048u, S, E);
    }
    xcd_barrier(bar);
#ifdef CKSUM
    CK(10, ws + WS_YS, ck_rows * 2048);
#endif
    if (PH(9)) p9_final(F);
#ifdef CKSUM
    xcd_barrier(bar);
    if (blockIdx.x == 0 && F.wave == 0 && lane_id() == 0) {
        unsigned* cur = (unsigned*)(ws + WS_CTL) + 8192; unsigned* prev = (unsigned*)(ws + WS_MISC + 7 * MiB);
        const bool have = __hip_atomic_load(prev, __ATOMIC_RELAXED, __HIP_MEMORY_SCOPE_AGENT) == 0x5EED1234u;
        unsigned flag = have ? __hip_atomic_load(prev + 1, __ATOMIC_RELAXED, __HIP_MEMORY_SCOPE_AGENT) : 0u;
        for (int k = 1; k <= 10; ++k) { const unsigned c = __hip_atomic_load(cur + 64 * k, __ATOMIC_RELAXED, __HIP_MEMORY_SCOPE_AGENT);
            if (have && flag == 0u && __hip_atomic_load(prev + 16 + k, __ATOMIC_RELAXED, __HIP_MEMORY_SCOPE_AGENT) != c) flag = (unsigned)k;
            __hip_atomic_store(prev + 16 + k, c, __ATOMIC_RELAXED, __HIP_MEMORY_SCOPE_AGENT); }
        __hip_atomic_store(prev + 1, flag, __ATOMIC_RELAXED, __HIP_MEMORY_SCOPE_AGENT); __hip_atomic_store(prev, 0x5EED1234u, __ATOMIC_RELAXED, __HIP_MEMORY_SCOPE_AGENT);
    }
#endif
}

#undef F
#undef ws
#undef xcd_barrier
extern "C" void kernel_launch(void* const* d_in, const int* in_sizes, int n_in, void* d_out, int out_size, void* d_ws, size_t ws_size, hipStream_t stream) {
    static int grid = 0;
    if (grid == 0) {
        if (n_in != 20 || out_size != NTOK * D || ws_size < WS_END) { fprintf(stderr, "kernel_launch: unexpected shapes (n_in %d, out %d, ws %zu); nothing launched\n", n_in, out_size, ws_size); grid = -1; return; }
        int dev = 0, cus = 0;
        if (hipGetDevice(&dev) != hipSuccess || hipDeviceGetAttribute(&cus, hipDeviceAttributeMultiprocessorCount, dev) != hipSuccess) { grid = -1; return; }
        if (hipFuncSetAttribute((const void*)fwd_megakernel, hipFuncAttributeMaxDynamicSharedMemorySize, LDS_BYTES) != hipSuccess) { fprintf(stderr, "kernel_launch: hipFuncSetAttribute failed\n"); grid = -1; return; }
        int per_cu = 0;
        if (hipOccupancyMaxActiveBlocksPerMultiprocessor(&per_cu, (const void*)fwd_megakernel, NTHREADS, LDS_BYTES) != hipSuccess || per_cu < 1) fprintf(stderr, "kernel_launch: occupancy query reports %d\n", per_cu);
        (void)hipGetLastError();
        grid = cus;
        if (grid != 256) fprintf(stderr, "kernel_launch: %d CUs; this kernel is laid out for 256\n", grid);
    }
    if (grid < 0) return;
    (void)hipMemsetAsync((char*)d_ws + WS_CTL, 0, CTL_ZERO_BYTES, stream);
    Args a{};
    for (int i = 0; i < 20; ++i) a.in[i] = (const float*)d_in[i];
    a.out = (float*)d_out; a.ws = (unsigned char*)d_ws;
    hipLaunchKernelGGL(fwd_megakernel, dim3(grid), dim3(NTHREADS), LDS_BYTES, stream, a);
}
```

```cpp
#include <hip/hip_runtime.h>
#include <cstdio>
#include <cstdint>

#define GAS __attribute__((address_space(1)))
#define LAS __attribute__((address_space(3)))
typedef unsigned short bf16_t;
typedef short bf16x8 __attribute__((ext_vector_type(8)));
typedef short s16x4 __attribute__((ext_vector_type(4)));
typedef float f32x4 __attribute__((ext_vector_type(4)));
typedef float f32x2 __attribute__((ext_vector_type(2)));
typedef unsigned u32x4 __attribute__((ext_vector_type(4)));
typedef unsigned u32x2 __attribute__((ext_vector_type(2)));
typedef int i32x4 __attribute__((ext_vector_type(4)));
typedef int i32x8 __attribute__((ext_vector_type(8)));
#define FP8_WSCALE 0x7A7A7A7A
typedef GAS unsigned gu32;

constexpr int NTOK = 16384, SEQ = 8192, D = 1024, NMEM = 512, MEMLEN = 256;
constexpr int IN_COLS = 7424;
__host__ __device__ __forceinline__ size_t proj_off(size_t row, int col) { return (((row >> 8) * 29 + (size_t)(col >> 8)) << 16) + ((row & 255) << 8) + (size_t)(col & 255); }
constexpr int C_QA = 0, C_KA = 512, C_VA = 1024, C_QB = 1536, C_KB = 2304, C_VB = 3072, C_QC = 3840, C_GATE = 4352;
constexpr int NEXP = 32, TOPK = 4, DFF = 1024;
constexpr int MAX_TILES = 288, MAX_SLOTS = MAX_TILES * 256;
constexpr float RMS_EPS = 1e-6f, LOG2E = 1.4426950408889634f;
constexpr float QS64 = 0.125f * LOG2E, QS128 = 0.08838834764831845f * LOG2E;
constexpr int ABC_LD = 1280;

constexpr size_t MiB = 1u << 20;
constexpr size_t WS_CTL = 0, CTL_ZERO_BYTES = 1 * MiB;
constexpr size_t WS_MISC = 1 * MiB;
constexpr size_t MO_TOPIDX = 0, MO_TOPW = 256 * 1024, MO_HIST = 512 * 1024, MO_TOKSLOT = 1 * MiB, MO_SLOTTOK = 2 * MiB, MO_SLOTW = 3 * MiB, MO_TILE = 4 * MiB, MO_LSE = 5 * MiB, MO_T5 = 6 * MiB, MO_RPB = 6 * MiB + 64 * 1024, MO_RTOK = 7 * MiB + 64 * 1024;
constexpr size_t WS_WIN_T = 16 * MiB, WS_WMEM_T = 32 * MiB, WS_WABC_T = 34 * MiB, WS_WOUT_T = 37 * MiB, WS_MEMN = 39 * MiB, WS_MKV = 40 * MiB, WS_XN = 41 * MiB;
constexpr size_t WS_ABC = 73 * MiB, WS_OB = 113 * MiB, WS_MERGED = 137 * MiB, WS_WGU_T = 169 * MiB, WS_WDN_T = 297 * MiB, WS_PROJ = 361 * MiB, WS_ACT = 593 * MiB, WS_YS = 737 * MiB, WS_END = 881 * MiB;
constexpr int T5_LD = 192, RPB_LD = 640, RPB_OFF = 64;

constexpr int LDS_MAIN = 147456;
constexpr int LDS_TAB = LDS_MAIN;
constexpr int LDS_MISC = LDS_MAIN + 8192;
constexpr int LDS_BYTES = LDS_MISC + 512;

#define LDS_WAIT() asm volatile("s_waitcnt lgkmcnt(0)" ::: "memory")
#define VM_WAIT() asm volatile("s_waitcnt vmcnt(0)" ::: "memory")
__device__ __forceinline__ unsigned cvt_pk_bf16(float lo, float hi) { unsigned r; asm volatile("v_cvt_pk_bf16_f32 %0, %1, %2" : "=v"(r) : "v"(lo), "v"(hi)); return r; }
__device__ __forceinline__ float bf_lo(unsigned u) { return __uint_as_float(u << 16); }
__device__ __forceinline__ float bf_hi(unsigned u) { return __uint_as_float(u & 0xffff0000u); }
__device__ __forceinline__ int lane_id() { int l; asm volatile("v_mbcnt_lo_u32_b32 %0, -1, 0\n\tv_mbcnt_hi_u32_b32 %0, -1, %0" : "=v"(l)); return l; }
__device__ __forceinline__ float wave_sum(float v) {
#pragma unroll
    for (int o = 1; o < 64; o <<= 1) v += __shfl_xor(v, o);
    return v;
}
__device__ __forceinline__ float wave_max(float v) {
#pragma unroll
    for (int o = 1; o < 64; o <<= 1) v = fmaxf(v, __shfl_xor(v, o));
    return v;
}
__device__ __forceinline__ int ld_uniform(const int* p) { return __builtin_amdgcn_readfirstlane(__hip_atomic_load((int*)p, __ATOMIC_RELAXED, __HIP_MEMORY_SCOPE_AGENT)); }
__device__ __forceinline__ float fast_sigmoid(float x) { return __builtin_amdgcn_rcpf(1.0f + __builtin_amdgcn_exp2f(-LOG2E * x)); }

namespace pg8 {
constexpr int BM = 256, BK = 64, HALF = 128, HTB = HALF * BK * 2, STAGE_BYTES = 8 * HTB, LDS_STASH = 131072  ;
__host__ __device__ __forceinline__ int lds_byte(int r, int c) { const int st = (r >> 4) * 2 + (c >> 5), rr = r & 15, cc = c & 31, ob = rr * 64 + cc * 2; return st * 1024 + (ob ^ (((ob >> 9) & 1) << 5)); }
__host__ __device__ __forceinline__ void stage_rc(int b, int& R, int& C) { const int st = b / 1024, sb = b % 1024, swz = sb ^ (((sb >> 9) & 1) << 5); R = (st >> 1) * 16 + swz / 64; C = (st & 1) * 32 + (swz % 64) / 2; }
__host__ __device__ __forceinline__ int perm32(int rho) { const int n = rho >> 4, i = rho & 15; return 8 * (i >> 2) + 4 * n + (i & 3); }

struct Unit {
    const char* A;
    const char* B;
    int rows;
    int nt;
    int pm, pn;
    int aux;
    float scale;
};

template <class Epi, class Sched, bool GATHER, bool FP8 = false>
__device__ __forceinline__ void gemm_phase(LAS unsigned char* lds, const int wave, const unsigned lda, const unsigned ldb, const Sched& S, const Epi& E) {
    const int lane = lane_id();
    const int wid = wave, tid = wave * 64 + lane, wr = wid >> 2, wc = wid & 3, fr = lane & 15, fq = lane >> 4;
#define PG8_TID() ({ int t_ = tid; asm volatile("" : "+v"(t_)); t_; })
#define PG8_BOFF(i, t_) ({ int R_, C_; stage_rc((t_) * 16 + (i) * 8192, R_, C_); const int Rb_ = (R_ & ~31) + perm32(R_ & 31); (unsigned)Rb_ * ldb + (unsigned)C_ * 2u; })
#define PG8_AOFF(h, i, t_) ({ int R_, C_; stage_rc((t_) * 16 + (i) * 8192, R_, C_); (unsigned)((h) * HALF + R_) * lda + (unsigned)C_ * 2u; })
    const size_t kstep = (size_t)(BK * 2);
    const size_t hstepB = (size_t)HALF * ldb;
    const unsigned ldsw = (unsigned)wid * 1024u;
    const int aoff = lds_byte(wr * 64 + fr, fq * 8), boff = lds_byte(wc * 32 + fr, fq * 8);
#define PG8_SA(b, h) (((b) * 2 + (h)) * HTB)
#define PG8_SB(b, h) ((4 + (b) * 2 + (h)) * HTB)
#define PG8_STAGE2(bufoff, gbase, v0, v1) do { \
        __builtin_amdgcn_global_load_lds((const unsigned*)((const char*)(gbase) + (v0)), (LAS unsigned*)(lds + (bufoff) + ldsw), 16, 0, 0); \
        __builtin_amdgcn_global_load_lds((const unsigned*)((const char*)(gbase) + (v1)), (LAS unsigned*)(lds + (bufoff) + ldsw + 8192), 16, 0, 0); } while (0)
#define PG8_STAGEB(bufoff, gbase) do { const int tq_ = PG8_TID(); PG8_STAGE2(bufoff, gbase, PG8_BOFF(0, tq_), PG8_BOFF(1, tq_)); } while (0)
#define PG8_STAGEA(bufoff, gbase, h, g0, g1) do { if (GATHER) { PG8_STAGE2(bufoff, gbase, g0, g1); } else { const int tq_ = PG8_TID(); PG8_STAGE2(bufoff, gbase, PG8_AOFF(h, 0, tq_), PG8_AOFF(h, 1, tq_)); } } while (0)
#define PG8_LDA(dst, b, h) do { _Pragma("unroll") for (int m = 0; m < 4; ++m) _Pragma("unroll") for (int k = 0; k < 2; ++k) dst[m][k] = *(const LAS bf16x8*)(lds + PG8_SA(b, h) + aoff + m * 2048 + k * 1024); } while (0)
#define PG8_LDB(dst, b, h) do { _Pragma("unroll") for (int n = 0; n < 2; ++n) _Pragma("unroll") for (int k = 0; k < 2; ++k) dst[n][k] = *(const LAS bf16x8*)(lds + PG8_SB(b, h) + boff + n * 2048 + k * 1024); } while (0)
#define PG8_MMA(ai, bj, At, Bt) do { __builtin_amdgcn_s_setprio(1); \
        if (FP8) { _Pragma("unroll") for (int m = 0; m < 4; ++m) _Pragma("unroll") for (int n = 0; n < 2; ++n) { \
            const i32x4 b0_ = __builtin_bit_cast(i32x4, Bt[n][0]), b1_ = __builtin_bit_cast(i32x4, Bt[n][1]), a0_ = __builtin_bit_cast(i32x4, At[m][0]), a1_ = __builtin_bit_cast(i32x4, At[m][1]); \
            const i32x8 bw_ = __builtin_shufflevector(b0_, b1_, 0, 1, 2, 3, 4, 5, 6, 7), aw_ = __builtin_shufflevector(a0_, a1_, 0, 1, 2, 3, 4, 5, 6, 7); \
            acc[ai][bj][m][n] = __builtin_amdgcn_mfma_scale_f32_16x16x128_f8f6f4(bw_, aw_, acc[ai][bj][m][n], 0, 0, 0, FP8_WSCALE, 0, 0x7F7F7F7F); } } \
        else { _Pragma("unroll") for (int m = 0; m < 4; ++m) _Pragma("unroll") for (int n = 0; n < 2; ++n) _Pragma("unroll") for (int k = 0; k < 2; ++k) \
            acc[ai][bj][m][n] = __builtin_amdgcn_mfma_f32_16x16x32_bf16(Bt[n][k], At[m][k], acc[ai][bj][m][n], 0, 0, 0); } \
        __builtin_amdgcn_s_setprio(0); } while (0)
#define PG8_WAIT_V(n) asm volatile("s_waitcnt vmcnt(" #n ")" ::: "memory")
#define PG8_WAIT_L(n) asm volatile("s_waitcnt lgkmcnt(" #n ")" ::: "memory")
#define PG8_BAR __builtin_amdgcn_s_barrier()
#define PG8_SCHED __builtin_amdgcn_sched_barrier(0)
    Unit cur, nxt; int ui = 0;
    if (!S.next(0, cur)) return;
    f32x4 acc[2][2][4][2];
#pragma unroll
    for (int a = 0; a < 2; ++a)
#pragma unroll
        for (int b = 0; b < 2; ++b)
#pragma unroll
            for (int m = 0; m < 4; ++m)
#pragma unroll
                for (int n = 0; n < 2; ++n) acc[a][b][m][n] = (f32x4){0.f, 0.f, 0.f, 0.f};
    bf16x8 At[4][2], B0[2][2], B1[2][2];
    unsigned c00 = 0, c01 = 0, c10 = 0, c11 = 0;
#define PG8_MKOFF(U, o00, o01, o10, o11) do { int R0_, C0_, R1_, C1_; const int tq_ = PG8_TID(); stage_rc(tq_ * 16, R0_, C0_); stage_rc(tq_ * 16 + 8192, R1_, C1_); \
        const LAS int* rl_ = (const LAS int*)(lds + (U).rows); \
        o00 = (unsigned)rl_[R0_] * lda + (unsigned)C0_ * 2u; o01 = (unsigned)rl_[R1_] * lda + (unsigned)C1_ * 2u; o10 = (unsigned)rl_[HALF + R0_] * lda + (unsigned)C0_ * 2u; o11 = (unsigned)rl_[HALF + R1_] * lda + (unsigned)C1_ * 2u; } while (0)
    if (GATHER) { PG8_MKOFF(cur, c00, c01, c10, c11); }
    const char* cA = cur.A; const char* cB = cur.B; int nt = cur.nt;
    PG8_STAGEB(PG8_SB(0, 0), cB); PG8_STAGEB(PG8_SB(0, 1), cB + hstepB); PG8_STAGEA(PG8_SA(0, 0), cA, 0, c00, c01); PG8_STAGEA(PG8_SA(0, 1), cA, 1, c10, c11);
    if (wr == 1) PG8_BAR;
    PG8_WAIT_V(2); PG8_BAR;
    PG8_STAGEB(PG8_SB(1, 0), cB + kstep); PG8_STAGEA(PG8_SA(1, 0), cA + kstep, 0, c00, c01); PG8_STAGEB(PG8_SB(1, 1), cB + hstepB + kstep);
    PG8_WAIT_V(6); PG8_BAR;
    for (;;) {
        const bool has_next = S.next(ui + 1, nxt);
        const char* nA = has_next ? nxt.A : cA; const char* nB = has_next ? nxt.B : cB;
#pragma nounroll
        for (int t = 0; t < nt; t += 2) {
            const bool last = (t == nt - 2);
            if (GATHER) asm volatile("" : "+v"(c00), "+v"(c01), "+v"(c10), "+v"(c11));
            const char* a1 = cA + (size_t)(t + 1) * kstep;
            const char* a2 = last ? nA : cA + (size_t)(t + 2) * kstep; const char* b2 = last ? nB : cB + (size_t)(t + 2) * kstep;
            const char* a3 = a2 + kstep; const char* b3 = b2 + kstep;
            PG8_LDB(B0, 0, 0); PG8_LDB(B1, 0, 1); PG8_SCHED; PG8_LDA(At, 0, 0); PG8_STAGEA(PG8_SA(1, 1), a1, 1, c10, c11);
            if (GATHER) { if (last && has_next) { PG8_MKOFF(nxt, c00, c01, c10, c11); } }
            PG8_WAIT_V(8); PG8_WAIT_L(0); PG8_BAR; PG8_MMA(0, 0, At, B0); PG8_MMA(0, 1, At, B1); PG8_BAR; PG8_SCHED;
            PG8_LDA(At, 0, 1); PG8_STAGEB(PG8_SB(0, 0), b2); PG8_STAGEB(PG8_SB(0, 1), b2 + hstepB); PG8_STAGEA(PG8_SA(0, 0), a2, 0, c00, c01);
            PG8_WAIT_V(8); PG8_WAIT_L(0); PG8_BAR; PG8_MMA(1, 0, At, B0); PG8_MMA(1, 1, At, B1); PG8_BAR; PG8_SCHED;
            PG8_LDB(B0, 1, 0); PG8_LDB(B1, 1, 1); PG8_SCHED; PG8_LDA(At, 1, 0); PG8_STAGEA(PG8_SA(0, 1), a2, 1, c10, c11);
            PG8_WAIT_V(8); PG8_WAIT_L(0); PG8_BAR; PG8_MMA(0, 0, At, B0); PG8_MMA(0, 1, At, B1); PG8_BAR; PG8_SCHED;
            PG8_LDA(At, 1, 1); PG8_STAGEB(PG8_SB(1, 0), b3); PG8_STAGEB(PG8_SB(1, 1), b3 + hstepB); PG8_STAGEA(PG8_SA(1, 0), a3, 0, c00, c01);
            PG8_WAIT_V(8); PG8_WAIT_L(0); PG8_BAR; PG8_MMA(1, 0, At, B0); PG8_MMA(1, 1, At, B1); PG8_BAR; PG8_SCHED;
        }
        if (wr == 0) PG8_BAR;
        { int le_ = lane; asm volatile("" : "+v"(le_)); E(acc, cur, wr, wc, le_ & 15, le_ >> 4); }
        if (GATHER) { if (has_next) { asm volatile("" ::: "memory"); PG8_MKOFF(nxt, c00, c01, c10, c11); } }
        if (!has_next) break;
#pragma unroll
        for (int a = 0; a < 2; ++a)
#pragma unroll
            for (int b = 0; b < 2; ++b)
#pragma unroll
                for (int m = 0; m < 4; ++m)
#pragma unroll
                    for (int n = 0; n < 2; ++n) acc[a][b][m][n] = (f32x4){0.f, 0.f, 0.f, 0.f};
        cur = nxt; cA = nA; cB = nB; nt = cur.nt; ++ui;
        if (wr == 1) PG8_BAR;
    }
    PG8_WAIT_V(0);
    PG8_BAR;
#undef PG8_SA
#undef PG8_SB
#undef PG8_STAGE2
#undef PG8_STAGEB
#undef PG8_LDA
#undef PG8_LDB
#undef PG8_MMA
#undef PG8_WAIT_V
#undef PG8_WAIT_L
#undef PG8_BAR
#undef PG8_SCHED
#undef PG8_MKOFF
#undef PG8_TID
#undef PG8_BOFF
#undef PG8_AOFF
#undef PG8_STAGEA
}
}

#define XB_TMO      128
#define XB_XCNT(j)  (256  + 64 * (j))
#define XB_XSUB(j)  (1280 + 64 * (j))
#define XB_XGEN(j)  (2304 + 64 * (j))
#define XB_TOP      3328
#define XB_TOPGEN   3392
#define XCD_BAR_WORDS 3456
#define XB_SPIN_CAP (1u << 18)
__device__ __forceinline__ unsigned xb_ld(unsigned* p)              { return __hip_atomic_load(p, __ATOMIC_RELAXED, __HIP_MEMORY_SCOPE_AGENT); }
__device__ __forceinline__ unsigned xb_add(unsigned* p, unsigned v) { return __hip_atomic_fetch_add(p, v, __ATOMIC_RELAXED, __HIP_MEMORY_SCOPE_AGENT); }
__device__ __forceinline__ unsigned xb_xcc_id() { return (unsigned)__builtin_amdgcn_s_getreg((3 << 11) | 20) & 0xFu; }
#define XB_SPIN(cond, bar) do { unsigned _sp = 0; while (cond) { __builtin_amdgcn_s_sleep(1); \
    if ((++_sp & 255u) == 0u) { if (xb_ld(&(bar)[XB_TMO])) break; if (_sp > XB_SPIN_CAP) { atomicAdd(&(bar)[XB_TMO], 1u); break; } } } } while (0)
struct XcdBarrier { unsigned* bar; unsigned x; volatile LAS unsigned* st; int wave; };
__device__ __forceinline__ XcdBarrier xcd_barrier_post(unsigned* bar, volatile LAS unsigned* st, int wave) {
    XcdBarrier b; b.bar = bar; b.x = xb_xcc_id(); b.st = st; b.wave = wave;
    if (wave == 0 && lane_id() == 0) (void)xb_add(&bar[XB_XCNT(b.x)], 1u);
    return b;
}
__device__ __forceinline__ void xcd_barrier_complete(unsigned* bar, unsigned x, unsigned& nloc, unsigned& nx) {
    const unsigned G = gridDim.x * gridDim.y * gridDim.z;
    unsigned sum, cnt, mine, sp = 0u;
    for (;;) {
        sum = 0u; cnt = 0u; mine = 0u;
#pragma unroll
        for (unsigned j = 0; j < 16; ++j) { const unsigned c = xb_ld(&bar[XB_XCNT(j)]); sum += c; cnt += (c > 0u) ? 1u : 0u; mine = (j == x) ? c : mine; }
        if (sum == G) break;
        __builtin_amdgcn_s_sleep(1);
        if ((++sp & 255u) == 0u) { if (xb_ld(&bar[XB_TMO])) break; if (sp > XB_SPIN_CAP) { atomicAdd(&bar[XB_TMO], 1u); break; } }
    }
    nloc = mine > 0u ? mine : 1u; nx = cnt > 0u ? cnt : 1u;
}
__device__ __forceinline__ void xcd_barrier(const XcdBarrier& b) {
    asm volatile("s_waitcnt vmcnt(0)" ::: "memory");
    __syncthreads();
    if (b.wave == 0 && lane_id() == 0) {
        unsigned* bar = b.bar;
        __builtin_amdgcn_s_waitcnt(0);
        unsigned nloc = b.st[0], nx = b.st[1];
        if (nloc == 0u) { xcd_barrier_complete(bar, b.x, nloc, nx); b.st[0] = nloc; b.st[1] = nx; }
        const unsigned old = xb_add(&bar[XB_XSUB(b.x)], 1u);
        const unsigned gen = old / nloc;
        if (old + 1u == (gen + 1u) * nloc) {
            __builtin_amdgcn_fence(__ATOMIC_RELEASE, "agent");
            asm volatile("s_waitcnt vmcnt(0)" ::: "memory");
            const unsigned og = xb_add(&bar[XB_TOP], 1u);
            const unsigned tg = og / nx;
            if (og + 1u == (tg + 1u) * nx) xb_add(&bar[XB_TOPGEN], 1u);
            else XB_SPIN(xb_ld(&bar[XB_TOPGEN]) == tg, bar);
            __builtin_amdgcn_fence(__ATOMIC_ACQUIRE, "agent");
            xb_add(&bar[XB_XGEN(b.x)], 1u);
            asm volatile("s_waitcnt vmcnt(0)" ::: "memory");
        } else {
            XB_SPIN(xb_ld(&bar[XB_XGEN(b.x)]) == gen, bar);
            __builtin_amdgcn_fence(__ATOMIC_ACQUIRE, "agent");
            asm volatile("s_waitcnt vmcnt(0)" ::: "memory");
        }
    }
    __syncthreads();
}

struct Args { const float* in[20]; float* out; unsigned char* ws; };
typedef const __attribute__((address_space(4))) Args* KArgs;
__device__ __forceinline__ KArgs kargs() { KArgs k = (KArgs)__builtin_amdgcn_kernarg_segment_ptr(); asm volatile("" : "+s"(k)); return k; }
constexpr int NWAVES = 8, NTHREADS = 512;

struct Ctx {
    LAS unsigned char* lds;
    int tid, lane, wave, G, vcu;
    unsigned char* ws;
};
__device__ __forceinline__ Ctx make_ctx(int wave) {
    extern __shared__ __attribute__((aligned(16))) unsigned char lds_dyn[];
    Ctx F; int l = lane_id(); asm volatile("" : "+v"(l)); F.lds = (LAS unsigned char*)lds_dyn; F.lane = l; F.wave = wave; F.tid = wave * 64 + l;
    F.G = (int)gridDim.x; { const int bx = (int)blockIdx.x; F.vcu = (F.G % 8 == 0) ? (bx % 8) * (F.G / 8) + bx / 8 : bx; }
    F.ws = kargs()->ws; return F; }
__device__ __forceinline__ Ctx ctx_refresh(const Ctx& F0) { return make_ctx(F0.wave); }


#ifdef CKSUM
__device__ __forceinline__ void ck_region(const Ctx& F, int k, const void* base, size_t bytes) {
    const GAS u32x4* p = (const GAS u32x4*)base; const size_t n = bytes / 16; unsigned acc = 0u;
    const int tid_ = F.wave * 64 + lane_id();
    for (size_t i = (size_t)blockIdx.x * NTHREADS + tid_; i < n; i += (size_t)F.G * NTHREADS) { const u32x4 v = __builtin_nontemporal_load(p + i); acc += v.x * 3u + v.y * 5u + v.z * 7u + v.w * 11u + (unsigned)i; }
#pragma unroll
    for (int o = 1; o < 64; o <<= 1) acc += __shfl_xor(acc, o);
    if (lane_id() == 0) atomicAdd((unsigned*)(F.ws + WS_CTL) + 8192 + 64 * k, acc);
}
#define CK(k, base, bytes) ck_region(F, k, base, bytes)
#else
#define CK(k, base, bytes) do {} while (0)
#endif
__device__ __forceinline__ void p0_transpose64(const float* W, int ldw, int k0, int n0, bf16_t* dst, int ldt, LAS float* scr, int lane) {
    f32x4 v[16];
#pragma unroll
    for (int i = 0; i < 16; ++i) { const int kk = 4 * i + (lane >> 4); v[i] = *(const GAS f32x4*)(W + (size_t)(k0 + kk) * ldw + n0 + 4 * (lane & 15)); }
#pragma unroll
    for (int i = 0; i < 16; ++i) { const int kk = 4 * i + (lane >> 4); LAS float* s = scr + kk * 65 + 4 * (lane & 15); s[0] = v[i][0]; s[1] = v[i][1]; s[2] = v[i][2]; s[3] = v[i][3]; }
    LDS_WAIT(); asm volatile("" ::: "memory");
    const int c = lane & 7;
#pragma unroll
    for (int j = 0; j < 8; ++j) { const int n = (lane >> 3) + 8 * j; const LAS float* s = scr + (8 * c) * 65 + n;
        u32x4 o; o.x = cvt_pk_bf16(s[0 * 65], s[1 * 65]); o.y = cvt_pk_bf16(s[2 * 65], s[3 * 65]); o.z = cvt_pk_bf16(s[4 * 65], s[5 * 65]); o.w = cvt_pk_bf16(s[6 * 65], s[7 * 65]);
        *(GAS u32x4*)(dst + (size_t)n * ldt + 8 * c) = o; }
    LDS_WAIT(); asm volatile("" ::: "memory");
}
__device__ __forceinline__ void p0_transpose64_fp8(const float* W, int ldw, int k0, int n0, unsigned char* dst8, int ldt, LAS float* scr, int lane, float scale) {
    f32x4 v[16];
#pragma unroll
    for (int i = 0; i < 16; ++i) { const int kk = 4 * i + (lane >> 4); v[i] = *(const GAS f32x4*)(W + (size_t)(k0 + kk) * ldw + n0 + 4 * (lane & 15)); }
#pragma unroll
    for (int i = 0; i < 16; ++i) { const int kk = 4 * i + (lane >> 4); LAS float* s = scr + kk * 65 + 4 * (lane & 15); s[0] = v[i][0] * scale; s[1] = v[i][1] * scale; s[2] = v[i][2] * scale; s[3] = v[i][3] * scale; }
    LDS_WAIT(); asm volatile("" ::: "memory");
    const int c = lane & 3;
#pragma unroll
    for (int j = 0; j < 4; ++j) { const int n = (lane >> 2) + 16 * j; const LAS float* s = scr + (16 * c) * 65 + n;
        u32x4 o;
#pragma unroll
        for (int q = 0; q < 4; ++q) { int w = __builtin_amdgcn_cvt_pk_fp8_f32(s[(4 * q) * 65], s[(4 * q + 1) * 65], 0, false); w = __builtin_amdgcn_cvt_pk_fp8_f32(s[(4 * q + 2) * 65], s[(4 * q + 3) * 65], w, true); o[q] = (unsigned)w; }
        *(GAS u32x4*)(dst8 + (size_t)n * ldt + 16 * c) = o; }
    LDS_WAIT(); asm volatile("" ::: "memory");
}
__device__ __forceinline__ void rms_row_to_bf16(const float* xrow, const float* g, bf16_t* orow, int lane) {
    const GAS f32x4* xr = (const GAS f32x4*)xrow + lane; const GAS f32x4* gr = (const GAS f32x4*)g + lane;
    f32x4 v[4]; float s = 0.f;
#pragma unroll
    for (int j = 0; j < 4; ++j) { v[j] = xr[64 * j]; s += (v[j].x * v[j].x + v[j].y * v[j].y) + (v[j].z * v[j].z + v[j].w * v[j].w); }
    const float r = 1.0f / sqrtf(wave_sum(s) * (1.f / D) + RMS_EPS);
    GAS u32x2* o8 = (GAS u32x2*)orow + lane;
#pragma unroll
    for (int j = 0; j < 4; ++j) { const f32x4 gg = gr[64 * j]; u32x2 w; w.x = cvt_pk_bf16(v[j].x * r * gg.x, v[j].y * r * gg.y); w.y = cvt_pk_bf16(v[j].z * r * gg.z, v[j].w * r * gg.w); o8[64 * j] = w; }
}
__device__ __forceinline__ int t5_bucket(int rel) {
    int ret = rel > 0 ? 16 : 0; const int n = rel < 0 ? -rel : rel;
    if (n < 8) return ret + n;
    const float nf = (float)n;
    int large = 8 + (int)(logf(nf / 8.0f) / logf(128.0f) * 8.0f);
    large = large < 15 ? large : 15;
    return ret + large;
}
__device__ __forceinline__ void p0_prologue(const Ctx& F0) {
    const KArgs ap = kargs();
    const Ctx F = ctx_refresh(F0);
    LAS float* scr = (LAS float*)(F.lds) + F.wave * (64 * 65);
    const int gw = F.vcu * NWAVES + F.wave, NGW = F.G * NWAVES;
    bf16_t* WGU_T = (bf16_t*)(F.ws + WS_WGU_T); bf16_t* WDN_T = (bf16_t*)(F.ws + WS_WDN_T); bf16_t* WIN_T = (bf16_t*)(F.ws + WS_WIN_T);
    bf16_t* WMEM_T = (bf16_t*)(F.ws + WS_WMEM_T); bf16_t* WABC_T = (bf16_t*)(F.ws + WS_WABC_T); bf16_t* WOUT_T = (bf16_t*)(F.ws + WS_WOUT_T);
    constexpr int I_IN = 16 * 116, I_MEM = 256, I_A = 8 * 16, I_B = 4 * 16, I_C = 8 * 16, I_O = 256;
    constexpr int NITEMS = I_IN + I_MEM + I_A + I_B + I_C + I_O;
    for (int it = gw; it < NITEMS; it += NGW) {
        int r = it;
        if (r < I_IN) { const int kb = r / 116, nb = r % 116; p0_transpose64(ap->in[4], IN_COLS, kb * 64, nb * 64, WIN_T + (size_t)(nb * 64) * 1024 + kb * 64, 1024, scr, F.lane); continue; } r -= I_IN;
        if (r < I_MEM) { const int kb = r >> 4, nb = r & 15; p0_transpose64(ap->in[5], 1024, kb * 64, nb * 64, WMEM_T + (size_t)(nb * 64) * 1024 + kb * 64, 1024, scr, F.lane); continue; } r -= I_MEM;
        if (r < I_A) { const int kb = r >> 4, nb = r & 15; p0_transpose64(ap->in[8], 1024, kb * 64, nb * 64, WABC_T + (size_t)(nb * 64) * ABC_LD + 0 + kb * 64, ABC_LD, scr, F.lane); continue; } r -= I_A;
        if (r < I_B) { const int kb = r >> 4, nb = r & 15; p0_transpose64(ap->in[9], 1024, kb * 64, nb * 64, WABC_T + (size_t)(nb * 64) * ABC_LD + 512 + kb * 64, ABC_LD, scr, F.lane); continue; } r -= I_B;
        if (r < I_C) { const int kb = r >> 4, nb = r & 15; p0_transpose64(ap->in[10], 1024, kb * 64, nb * 64, WABC_T + (size_t)(nb * 64) * ABC_LD + 768 + kb * 64, ABC_LD, scr, F.lane); continue; } r -= I_C;
        { const int kb = r >> 4, nb = r & 15; p0_transpose64(ap->in[11], 1024, kb * 64, nb * 64, WOUT_T + (size_t)(nb * 64) * 1024 + kb * 64, 1024, scr, F.lane); }
    }
    bf16_t* XN = (bf16_t*)(F.ws + WS_XN); bf16_t* MEMN = (bf16_t*)(F.ws + WS_MEMN);
    for (int m = gw; m < NTOK; m += NGW) rms_row_to_bf16(ap->in[0] + (size_t)m * D, ap->in[2], XN + (size_t)m * D, F.lane);
    for (int m = gw; m < NMEM; m += NGW) rms_row_to_bf16(ap->in[1] + (size_t)m * D, ap->in[3], MEMN + (size_t)m * D, F.lane);
    const int gt = F.vcu * NTHREADS + F.tid, NGT = F.G * NTHREADS;
    float* t5 = (float*)(F.ws + WS_MISC + MO_T5); float* rp = (float*)(F.ws + WS_MISC + MO_RPB);
    for (int i = gt; i < 12 * T5_LD; i += NGT) { const int gh = i / T5_LD, j = i % T5_LD, rel = j - 79, g = gh >> 2; const int dil = g == 0 ? 1 : (g == 1 ? 4 : 16);
        float v = 0.f; if (rel >= -64 && rel <= 64) v = ap->in[7][t5_bucket(rel * dil) * 12 + gh] * LOG2E; t5[i] = v; }
    for (int i = gt; i < 8 * RPB_LD; i += NGT) { const int h = i / RPB_LD, j = i % RPB_LD - RPB_OFF; float v = 0.f; if (j >= 0 && j < 465) v = ap->in[6][h * 465 + j] * LOG2E; rp[i] = v; }
}

__device__ __forceinline__ bool is_converter(int c) { return ((c >> 3) & 3) == 3; }
__device__ __forceinline__ void p1_convert_experts(const Ctx& F0) {
    const KArgs ap = kargs();
    const Ctx F = ctx_refresh(F0);
    const int c = (int)blockIdx.x; if (!is_converter(c)) return;
    LAS float* scr = (LAS float*)(F.lds) + F.wave * (64 * 65);
    const int ci = (c & 7) * 8 + (c >> 5);
    unsigned char* WGU8 = (unsigned char*)(F.ws + WS_WGU_T); unsigned char* WDN8 = (unsigned char*)(F.ws + WS_WDN_T);
    constexpr int I_GU = 32 * 16 * 32, I_DN = 32 * 16 * 16;
    for (int it = ci * NWAVES + F.wave; it < I_GU + I_DN; it += 64 * NWAVES) {
        int r = it;
        if (r < I_GU) { const int e = r >> 9, q = r & 511, kb = q >> 5, nb = q & 31, n0 = nb * 64; const int bj = n0 >> 10, rem = n0 & 1023, pn = rem >> 7, c0 = rem & 127;
            p0_transpose64_fp8(ap->in[15] + (size_t)e * 1024 * 2048, 2048, kb * 64, n0, WGU8 + ((size_t)e * 2048 + pn * 256 + bj * 128 + c0) * 1024 + kb * 64, 1024, scr, F.lane, 32.0f); continue; } r -= I_GU;
        { const int e = r >> 8, q = r & 255, kb = q >> 4, nb = q & 15;
            p0_transpose64_fp8(ap->in[17] + (size_t)e * 1024 * 1024, 1024, kb * 64, nb * 64, WDN8 + ((size_t)e * 1024 + nb * 64) * 1024 + kb * 64, 1024, scr, F.lane, 32.0f); }
    }
}

struct P1Sched {
    unsigned* ctr; LAS int* slot; int wave, x; const char* XN; const char* WIN; const char* MEMN; const char* WMEM;
    __device__ __forceinline__ bool next(int i, pg8::Unit& u) const {
        if (wave == 0) { int t = 0; if (lane_id() == 0) t = (int)__hip_atomic_fetch_add(ctr, 1u, __ATOMIC_RELAXED, __HIP_MEMORY_SCOPE_AGENT); t = __builtin_amdgcn_readfirstlane(t); if (lane_id() == 0) slot[i & 1] = t; }
        LDS_WAIT(); __builtin_amdgcn_s_barrier(); asm volatile("" ::: "memory");
        const int idx = __builtin_amdgcn_readfirstlane(slot[i & 1]);
        if (idx > 232) return false;
        u.rows = 0; u.nt = 16;
        if (idx == 232) { u.pm = x >> 2; u.pn = x & 3; u.A = MEMN + (size_t)u.pm * 256 * 2048; u.B = WMEM + (size_t)u.pn * 256 * 2048; u.aux = 3; u.scale = 1.f; return true; }
        u.pm = 8 * x + (idx & 7); u.pn = idx >> 3;
        u.A = XN + (size_t)u.pm * 256 * 2048; u.B = WIN + (size_t)u.pn * 256 * 2048;
        const int pn = u.pn;
        if (pn < 2 || (pn >= 6 && pn < 9)) { u.aux = 1; u.scale = QS64; } else if (pn == 15 || pn == 16) { u.aux = 1; u.scale = QS128; } else if (pn >= 17) { u.aux = 2; u.scale = 1.f; } else { u.aux = 0; u.scale = 1.f; }
        return true;
    }
};
struct P1Epi {
    bf16_t* PROJ; bf16_t* MKV;
    __device__ __forceinline__ void operator()(const f32x4 (&acc)[2][2][4][2], const pg8::Unit& u, int wr, int wc, int fr, int fq) const {
        bf16_t* O = u.aux == 3 ? MKV : PROJ + ((size_t)(u.pm * 29 + u.pn) << 16); const int ldo = u.aux == 3 ? 1024 : 256;
        const int row0 = (u.aux == 3 ? u.pm * 256 : 0) + wr * 64 + fr, col0 = (u.aux == 3 ? u.pn * 256 : 0) + wc * 32 + 8 * fq; const float sc = u.scale; const bool sg = u.aux == 2;
#pragma unroll
        for (int ai = 0; ai < 2; ++ai)
#pragma unroll
            for (int m = 0; m < 4; ++m) { bf16_t* rowp = O + (size_t)(row0 + ai * 128 + m * 16) * ldo + col0;
#pragma unroll
                for (int bj = 0; bj < 2; ++bj) { f32x4 v0 = acc[ai][bj][m][0], v1 = acc[ai][bj][m][1];
                    if (sg) { v0 = (f32x4){fast_sigmoid(v0[0]), fast_sigmoid(v0[1]), fast_sigmoid(v0[2]), fast_sigmoid(v0[3])}; v1 = (f32x4){fast_sigmoid(v1[0]), fast_sigmoid(v1[1]), fast_sigmoid(v1[2]), fast_sigmoid(v1[3])}; }
                    else { v0 = v0 * sc; v1 = v1 * sc; }
                    u32x4 w; w.x = cvt_pk_bf16(v0[0], v0[1]); w.y = cvt_pk_bf16(v0[2], v0[3]); w.z = cvt_pk_bf16(v1[0], v1[1]); w.w = cvt_pk_bf16(v1[2], v1[3]);
                    *(GAS u32x4*)(rowp + bj * 128) = w; } }
    }
};

template <int DH> __device__ __forceinline__ int k_addr(int key, int c) {
    if (DH == 64) return key * 128 + ((c ^ ((key >> 1) & 7)) << 4);
    else return key * 256 + ((c ^ (key & 15)) << 4);
}
template <int DH> __device__ __forceinline__ int v_addr(int key, int c) {
    if (DH == 64) return key * 128 + ((c ^ (((key >> 1) & 3) << 1)) << 4);
    else return key * 256 + ((c ^ ((key & 7) << 1)) << 4);
}
__device__ __forceinline__ s16x4 vtr(const LAS unsigned char* p) { return __builtin_bit_cast(s16x4, __builtin_amdgcn_ds_read_tr16_b64_v4i16((LAS s16x4*)p)); }

template <int DH, class RowFn> __device__ __forceinline__ void stage_kv(LAS unsigned char* Kl, LAS unsigned char* Vl, int nkeys, int tid, const RowFn& rowfn) {
    constexpr int CH = DH / 8; const int total = nkeys * CH;
    for (int base = 0; base < total; base += NTHREADS * 4) {
        u32x4 kv[4], vv[4];
#pragma unroll
        for (int j = 0; j < 4; ++j) { const int ci = base + j * NTHREADS + tid; kv[j] = (u32x4){0u, 0u, 0u, 0u}; vv[j] = kv[j];
            if (ci < total) { const int key = ci / CH, c = ci % CH; const bf16_t* kp; const bf16_t* vp; rowfn(key, kp, vp); if (kp) { kv[j] = *(const GAS u32x4*)(kp + c * 8); vv[j] = *(const GAS u32x4*)(vp + c * 8); } } }
#pragma unroll
        for (int j = 0; j < 4; ++j) { const int ci = base + j * NTHREADS + tid;
            if (ci < total) { const int key = ci / CH, c = ci % CH; *(LAS u32x4*)(Kl + k_addr<DH>(key, c)) = kv[j]; *(LAS u32x4*)(Vl + v_addr<DH>(key, c)) = vv[j]; } }
    }
}

template <int DH> __device__ __forceinline__ f32x4 qk_tile(const LAS unsigned char* Kl, int kbase, const bf16x8 (&qf)[DH / 32], int i, int g) {
    f32x4 acc = (f32x4){0.f, 0.f, 0.f, 0.f}; const int key = kbase + i;
#pragma unroll
    for (int s = 0; s < DH / 32; ++s) { const bf16x8 kf = *(const LAS bf16x8*)(Kl + k_addr<DH>(key, 4 * s + g)); acc = __builtin_amdgcn_mfma_f32_16x16x32_bf16(kf, qf[s], acc, 0, 0, 0); }
    return acc;
}
template <int DH> __device__ __forceinline__ void pv_step(f32x4 (&o)[DH / 16], const LAS unsigned char* Vl, int vbase, int vbase2, bf16x8 pf, int i, int g) {
    const int k0 = vbase + 4 * g + (i >> 2), k1 = vbase2 + 4 * g + (i >> 2); const int sub = (i & 3) >> 1, b8 = 8 * (i & 1);
#pragma unroll
    for (int n = 0; n < DH / 16; ++n) {
        const s16x4 lo = vtr(Vl + v_addr<DH>(k0, 2 * n + sub) + b8), hi = vtr(Vl + v_addr<DH>(k1, 2 * n + sub) + b8);
        const bf16x8 vf = (bf16x8){lo[0], lo[1], lo[2], lo[3], hi[0], hi[1], hi[2], hi[3]};
        o[n] = __builtin_amdgcn_mfma_f32_16x16x32_bf16(vf, pf, o[n], 0, 0, 0);
    }
}
__device__ __forceinline__ bf16x8 pack_p(const f32x4& a, const f32x4& b) {
    u32x4 w; w.x = cvt_pk_bf16(a[0], a[1]); w.y = cvt_pk_bf16(a[2], a[3]); w.z = cvt_pk_bf16(b[0], b[1]); w.w = cvt_pk_bf16(b[2], b[3]); return __builtin_bit_cast(bf16x8, w);
}
template <int NT> __device__ __forceinline__ void softmax_tiles(f32x4 (&s)[NT], float& m, float& l) {
    float mx = -INFINITY;
#pragma unroll
    for (int t = 0; t < NT; ++t) mx = fmaxf(fmaxf(fmaxf(mx, s[t][0]), fmaxf(s[t][1], s[t][2])), s[t][3]);
    mx = fmaxf(mx, __shfl_xor(mx, 16)); mx = fmaxf(mx, __shfl_xor(mx, 32));
    float sum = 0.f;
#pragma unroll
    for (int t = 0; t < NT; ++t) {
#pragma unroll
        for (int r = 0; r < 4; ++r) { const float p = __builtin_amdgcn_exp2f(s[t][r] - mx); s[t][r] = p; sum += p; } }
    sum += __shfl_xor(sum, 16); sum += __shfl_xor(sum, 32);
    m = mx; l = sum;
}
template <int DH> __device__ __forceinline__ void load_q(bf16x8 (&qf)[DH / 32], const bf16_t* qrow, int g) {
#pragma unroll
    for (int s = 0; s < DH / 32; ++s) qf[s] = *(const GAS bf16x8*)(qrow + 32 * s + 8 * g);
}
template <int DH> __device__ __forceinline__ void store_o(const f32x4 (&o)[DH / 16], float inv, bf16_t* orow, int g) {
#pragma unroll
    for (int n = 0; n < DH / 16; ++n) { u32x2 w; w.x = cvt_pk_bf16(o[n][0] * inv, o[n][1] * inv); w.y = cvt_pk_bf16(o[n][2] * inv, o[n][3] * inv); *(GAS u32x2*)(orow + 16 * n + 4 * g) = w; }
}

__device__ __forceinline__ void p2_attention(const Ctx& F0) {
    const Ctx F = ctx_refresh(F0);
    const bf16_t* PROJ = (const bf16_t*)(F.ws + WS_PROJ); const bf16_t* MKV = (const bf16_t*)(F.ws + WS_MKV);
    bf16_t* ABC = (bf16_t*)(F.ws + WS_ABC); bf16_t* OB = (bf16_t*)(F.ws + WS_OB); float* LSE = (float*)(F.ws + WS_MISC + MO_LSE);
    const float* T5 = (const float*)(F.ws + WS_MISC + MO_T5); const float* RPB = (const float*)(F.ws + WS_MISC + MO_RPB);
    LAS unsigned char* Kl = F.lds; LAS float* tab = (LAS float*)(F.lds + LDS_TAB);
    const int w = F.wave, c = (int)blockIdx.x;
#define P2_LANE() int tid_r = F.tid; asm volatile("" : "+v"(tid_r)); const int lane = tid_r & 63, i = lane & 15, g = lane >> 4; (void)lane
    {
        LAS unsigned char* Vl = Kl + 65536; P2_LANE();
        const int combo = c & 7, b = combo >> 2, h = combo & 3;
        __syncthreads();
        stage_kv<128>(Kl, Vl, 256, tid_r, [&](int key, const bf16_t*& kp, const bf16_t*& vp) { kp = MKV + (size_t)(b * MEMLEN + key) * 1024 + h * 128; vp = kp + 512; });
        LDS_WAIT(); __syncthreads();
        for (int rep = 0; rep < 2; ++rep) {
            const int blk = (c >> 3) + 32 * rep; const int tok = b * SEQ + blk * 128 + w * 16 + i;
            bf16x8 qf[4]; load_q<128>(qf, PROJ + proj_off((size_t)tok, C_QC + h * 128), g);
            f32x4 s[16];
#pragma unroll
            for (int t = 0; t < 16; ++t) s[t] = qk_tile<128>(Kl, 16 * t, qf, i, g);
            float m, l; softmax_tiles<16>(s, m, l);
            f32x4 o[8];
#pragma unroll
            for (int n = 0; n < 8; ++n) o[n] = (f32x4){0.f, 0.f, 0.f, 0.f};
#pragma unroll
            for (int u = 0; u < 8; ++u) pv_step<128>(o, Vl, 32 * u, 32 * u + 16, pack_p(s[2 * u], s[2 * u + 1]), i, g);
            store_o<128>(o, 1.0f / l, ABC + (size_t)tok * ABC_LD + 768 + h * 128, g);
        }
    }
    for (int rep = 0; rep < 4; ++rep) {
        LAS unsigned char* Vl = Kl + 73728; P2_LANE();
        const int ua = c + 256 * rep, x = ua & 7, y = ua >> 3, pair = x * 2 + (y >> 6), rp = y & 63, b = pair >> 3, h = pair & 7, r0 = 2 * rp;
        int rsU = r0 - 4; rsU = rsU < 0 ? 0 : (rsU > 120 ? 120 : rsU);
        __syncthreads();
        stage_kv<64>(Kl, Vl, 576, tid_r, [&](int key, const bf16_t*& kp, const bf16_t*& vp) { kp = nullptr; vp = nullptr; if (rsU * 64 + key < SEQ) { const size_t tok = (size_t)b * SEQ + rsU * 64 + key; kp = PROJ + proj_off(tok, C_KA + h * 64); vp = PROJ + proj_off(tok, C_VA + h * 64); } });
        for (int j = tid_r; j < RPB_LD; j += NTHREADS) tab[j] = RPB[h * RPB_LD + j];
        LDS_WAIT(); __syncthreads();
        const int r = r0 + (w >> 2), jb = w & 3; int rs = r - 4; rs = rs < 0 ? 0 : (rs > 120 ? 120 : rs);
        const int cq = 16 * jb + i; int cs = cq - 8; cs = cs < 0 ? 0 : (cs > 48 ? 48 : cs);
        const int cw = jb == 0 ? 0 : (jb == 1 ? 8 : (jb == 2 ? 24 : 32));
        const int tok = b * SEQ + r * 64 + cq;
        bf16x8 qf[2]; load_q<64>(qf, PROJ + proj_off((size_t)tok, C_QA + h * 64), g);
        const int kb0 = (rs - rsU) * 64 + cw;
        f32x4 s[16];
#pragma unroll
        for (int t = 0; t < 16; ++t) s[t] = qk_tile<64>(Kl, kb0 + (t >> 1) * 64 + 16 * (t & 1), qf, i, g);
        const int bidx = RPB_OFF + (7 - (r - rs)) * 31 + (cw + 4 * g - cq + 15); const int lo = cs - cw - 4 * g;
#pragma unroll
        for (int t = 0; t < 16; ++t) {
#pragma unroll
            for (int rr = 0; rr < 4; ++rr) { const int kc = 16 * (t & 1) + rr; const float bias = tab[bidx + (t >> 1) * 31 + kc]; const bool ok = kc >= lo && kc < lo + 16; s[t][rr] = ok ? s[t][rr] + bias : -INFINITY; } }
        float m, l; softmax_tiles<16>(s, m, l);
        f32x4 o[4];
#pragma unroll
        for (int n = 0; n < 4; ++n) o[n] = (f32x4){0.f, 0.f, 0.f, 0.f};
#pragma unroll
        for (int u = 0; u < 8; ++u) pv_step<64>(o, Vl, kb0 + u * 64, kb0 + u * 64 + 16, pack_p(s[2 * u], s[2 * u + 1]), i, g);
        store_o<64>(o, 1.0f / l, ABC + (size_t)tok * ABC_LD + h * 64, g);
    }
    for (int rep = 0; rep < 6; ++rep) {
        LAS unsigned char* Vl = Kl + 34816; P2_LANE();
        const int ub = c + 256 * rep, x = ub & 7, y = ub >> 3, combo = x * 3 + y / 64, sub = y % 64, b = combo / 12, hh = combo % 12, grp = hh >> 2;
        const int dil = grp == 0 ? 1 : (grp == 1 ? 4 : 16), L = SEQ / dil, nb = L / 128, rho = sub / nb, n = sub % nb;
        const int p0 = 128 * n - 64;
        __syncthreads();
        stage_kv<64>(Kl, Vl, 272, tid_r, [&](int key, const bf16_t*& kp, const bf16_t*& vp) { const int p = p0 + key; kp = nullptr; vp = nullptr;
            if (key < 256 && p >= 0 && p < L) { const size_t tok = (size_t)b * SEQ + (size_t)p * dil + rho; kp = PROJ + proj_off(tok, C_KB + hh * 64); vp = PROJ + proj_off(tok, C_VB + hh * 64); } });
        for (int j = tid_r; j < T5_LD; j += NTHREADS) tab[j] = T5[hh * T5_LD + j];
        LDS_WAIT(); __syncthreads();
        const int pq = 128 * n + 16 * w + i; const int tok = b * SEQ + pq * dil + rho;
        bf16x8 qf[2]; load_q<64>(qf, PROJ + proj_off((size_t)tok, C_QB + hh * 64), g);
        f32x4 s[10];
#pragma unroll
        for (int t = 0; t < 10; ++t) s[t] = qk_tile<64>(Kl, 16 * w + 16 * t, qf, i, g);
        const int rel0 = 4 * g - 64 - i;
#pragma unroll
        for (int t = 0; t < 10; ++t) {
#pragma unroll
            for (int rr = 0; rr < 4; ++rr) { const int rel = rel0 + 16 * t + rr; const int p = pq + rel; const float bias = tab[rel + 79]; const bool ok = rel >= -64 && rel <= 64 && p >= 0 && p < L; s[t][rr] = ok ? s[t][rr] + bias : -INFINITY; } }
        float m, l; softmax_tiles<10>(s, m, l);
        f32x4 o[4];
#pragma unroll
        for (int nn = 0; nn < 4; ++nn) o[nn] = (f32x4){0.f, 0.f, 0.f, 0.f};
#pragma unroll
        for (int u = 0; u < 5; ++u) pv_step<64>(o, Vl, 16 * w + 32 * u, 16 * w + 32 * u + 16, pack_p(s[2 * u], s[2 * u + 1]), i, g);
        const int h4 = hh & 3;
        store_o<64>(o, 1.0f / l, OB + ((size_t)grp * NTOK + tok) * 256 + h4 * 64, g);
        if (g == 0) LSE[((size_t)grp * NTOK + tok) * 4 + h4] = m + __builtin_amdgcn_logf(l);
    }
}
#undef P2_LANE
__device__ __forceinline__ void p2b_merge(const Ctx& F0) {
    const Ctx F = ctx_refresh(F0);
    const bf16_t* OB = (const bf16_t*)(F.ws + WS_OB); const float* LSE = (const float*)(F.ws + WS_MISC + MO_LSE); bf16_t* ABC = (bf16_t*)(F.ws + WS_ABC);
    const int gt = F.vcu * NTHREADS + F.tid, NGT = F.G * NTHREADS;
    for (int it = gt; it < NTOK * 32; it += NGT) {
        const int tok = it >> 5, ch = it & 31, h = ch >> 3;
        const float l0 = LSE[(size_t)tok * 4 + h], l1 = LSE[((size_t)NTOK + tok) * 4 + h], l2 = LSE[((size_t)2 * NTOK + tok) * 4 + h];
        const float mx = fmaxf(l0, fmaxf(l1, l2)); float w0 = __builtin_amdgcn_exp2f(l0 - mx), w1 = __builtin_amdgcn_exp2f(l1 - mx), w2 = __builtin_amdgcn_exp2f(l2 - mx);
        const float inv = 1.0f / (w0 + w1 + w2); w0 *= inv; w1 *= inv; w2 *= inv;
        const u32x4 a = *(const GAS u32x4*)(OB + (size_t)tok * 256 + ch * 8), bq = *(const GAS u32x4*)(OB + ((size_t)NTOK + tok) * 256 + ch * 8), cq = *(const GAS u32x4*)(OB + ((size_t)2 * NTOK + tok) * 256 + ch * 8);
        u32x4 o;
#pragma unroll
        for (int j = 0; j < 4; ++j) { const float lo = w0 * bf_lo(a[j]) + w1 * bf_lo(bq[j]) + w2 * bf_lo(cq[j]), hi = w0 * bf_hi(a[j]) + w1 * bf_hi(bq[j]) + w2 * bf_hi(cq[j]); o[j] = cvt_pk_bf16(lo, hi); }
        *(GAS u32x4*)(ABC + (size_t)tok * ABC_LD + 512 + ch * 8) = o;
    }
}

struct P3Sched {
    int c; const char* ABCp; const char* WABC;
    __device__ __forceinline__ bool next(int i, pg8::Unit& u) const {
        if (i >= 3) return false;
        constexpr int nM = 64, nN = 4, nwg = 256;
        int wgid = c; { const int q = nwg / 8, xcd = wgid % 8, off = wgid / 8; wgid = xcd * q + off; }
        const int nig = 8 * nN, gid = wgid / nig, fm = gid * 8;
        u.pm = fm + ((wgid % nig) % 8); u.pn = (wgid % nig) / 8;
        const int sb = ((c >> 3) & 1) ? (i == 0 ? 1 : (i == 1 ? 0 : 2)) : i;
        const int koff = sb == 0 ? 0 : (sb == 1 ? 512 : 768);
        u.A = ABCp + (size_t)u.pm * 256 * (ABC_LD * 2) + koff * 2; u.B = WABC + (size_t)u.pn * 256 * (ABC_LD * 2) + koff * 2;
        u.rows = 0; u.nt = sb == 1 ? 4 : 8; u.aux = sb; u.scale = i == 0 ? 0.f : 1.f; return true;
    }
};
struct P3Epi {
    const bf16_t* PROJ; bf16_t* MERGED;
    __device__ __forceinline__ void operator()(const f32x4 (&acc)[2][2][4][2], const pg8::Unit& u, int wr, int wc, int fr, int fq) const {
        const int row0 = u.pm * 256 + wr * 64 + fr, col0 = u.pn * 256 + wc * 32 + 8 * fq; const int s = u.aux;
#pragma unroll
        for (int ai = 0; ai < 2; ++ai) {
            u32x4 gt[4][2], prev[4][2];
#pragma unroll
            for (int m = 0; m < 4; ++m)
#pragma unroll
                for (int bj = 0; bj < 2; ++bj) { const size_t row = (size_t)(row0 + ai * 128 + m * 16); const int col = col0 + bj * 128;
                    gt[m][bj] = *(const GAS u32x4*)(PROJ + proj_off(row, C_GATE + s * 1024 + col));
                    prev[m][bj] = (u32x4){0u, 0u, 0u, 0u}; if (u.scale != 0.f) prev[m][bj] = __builtin_nontemporal_load((const GAS u32x4*)(MERGED + row * 1024 + col)); }
            asm volatile("" ::: "memory");
#pragma unroll
            for (int m = 0; m < 4; ++m)
#pragma unroll
                for (int bj = 0; bj < 2; ++bj) { const size_t row = (size_t)(row0 + ai * 128 + m * 16); const int col = col0 + bj * 128;
                    const f32x4 v0 = acc[ai][bj][m][0], v1 = acc[ai][bj][m][1]; const u32x4 g = gt[m][bj], pv = prev[m][bj];
                    u32x4 o;
                    o.x = cvt_pk_bf16(bf_lo(pv.x) + bf_lo(g.x) * v0[0], bf_hi(pv.x) + bf_hi(g.x) * v0[1]);
                    o.y = cvt_pk_bf16(bf_lo(pv.y) + bf_lo(g.y) * v0[2], bf_hi(pv.y) + bf_hi(g.y) * v0[3]);
                    o.z = cvt_pk_bf16(bf_lo(pv.z) + bf_lo(g.z) * v1[0], bf_hi(pv.z) + bf_hi(g.z) * v1[1]);
                    o.w = cvt_pk_bf16(bf_lo(pv.w) + bf_lo(g.w) * v1[2], bf_hi(pv.w) + bf_hi(g.w) * v1[3]);
                    *(GAS u32x4*)(MERGED + row * 1024 + col) = o; }
            asm volatile("" ::: "memory");
        }
    }
};
struct P4Sched {
    int c; const char* MERGED; const char* WOUT;
    __device__ __forceinline__ bool next(int i, pg8::Unit& u) const {
        if (i >= 1) return false;
        constexpr int nN = 4, nwg = 256;
        int wgid = c; { const int q = nwg / 8, xcd = wgid % 8, off = wgid / 8; wgid = xcd * q + off; }
        const int nig = 8 * nN, gid = wgid / nig, fm = gid * 8;
        u.pm = fm + ((wgid % nig) % 8); u.pn = (wgid % nig) / 8;
        u.A = MERGED + (size_t)u.pm * 256 * 2048; u.B = WOUT + (size_t)u.pn * 256 * 2048; u.rows = 0; u.nt = 16; u.aux = 0; u.scale = 1.f; return true;
    }
};
struct P4Epi {
    const float* X; float* X1;
    __device__ __forceinline__ void operator()(const f32x4 (&acc)[2][2][4][2], const pg8::Unit& u, int wr, int wc, int fr, int fq) const {
        const int row0 = u.pm * 256 + wr * 64 + fr, col0 = u.pn * 256 + wc * 32 + 8 * fq;
#pragma unroll
        for (int ai = 0; ai < 2; ++ai) {
            f32x4 xv[4][2][2];
#pragma unroll
            for (int m = 0; m < 4; ++m)
#pragma unroll
                for (int bj = 0; bj < 2; ++bj) { const size_t off = (size_t)(row0 + ai * 128 + m * 16) * 1024 + col0 + bj * 128; xv[m][bj][0] = *(const GAS f32x4*)(X + off); xv[m][bj][1] = *(const GAS f32x4*)(X + off + 4); }
            asm volatile("" ::: "memory");
#pragma unroll
            for (int m = 0; m < 4; ++m)
#pragma unroll
                for (int bj = 0; bj < 2; ++bj) { const size_t off = (size_t)(row0 + ai * 128 + m * 16) * 1024 + col0 + bj * 128;
                    *(GAS f32x4*)(X1 + off) = xv[m][bj][0] + acc[ai][bj][m][0]; *(GAS f32x4*)(X1 + off + 4) = xv[m][bj][1] + acc[ai][bj][m][1]; }
            asm volatile("" ::: "memory");
        }
    }
};
__device__ __forceinline__ void p5_router(const Ctx& F0) {
    const KArgs ap = kargs(); const float* X1 = ap->out; const float* GF = ap->in[12]; const float* RW = ap->in[13]; const float* RB = ap->in[14];
    const Ctx F = ctx_refresh(F0);
    unsigned char* H8 = F.ws + WS_XN; float* RTOK = (float*)(F.ws + WS_MISC + MO_RTOK);
    int* TOPIDX = (int*)(F.ws + WS_MISC + MO_TOPIDX); float* TOPW = (float*)(F.ws + WS_MISC + MO_TOPW); int* HIST = (int*)(F.ws + WS_MISC + MO_HIST);
    LAS float* Wl = (LAS float*)F.lds;
    LAS float* xch = (LAS float*)(F.lds + 131072);
    LAS float* xss = (LAS float*)(F.lds + 131072 + 8192);
    LAS int* hist = (LAS int*)(F.lds + LDS_TAB);
    __syncthreads();
    for (int idx = F.tid; idx < 1024 * 8; idx += NTHREADS) { const int k = idx >> 3, q = idx & 7; const f32x4 wv = *(const GAS f32x4*)(RW + (size_t)k * 32 + 4 * q) * GF[k];
        *(LAS f32x4*)(Wl + k * 32 + ((4 * q) ^ (((k >> 5) & 1) << 4))) = wv; }
    if (F.tid < 32) hist[F.tid] = 0;
    LDS_WAIT(); __syncthreads();
    const int lane = F.lane, i = lane & 15, kq = lane >> 4, tg = F.wave & 3, kh = F.wave >> 2; const int bid = (int)blockIdx.x;
    const int tok = bid * 64 + tg * 16 + i; const int kbase = kh * 512 + 32 * kq;
    const float* xrow = X1 + (size_t)tok * D + kbase; const float* grow = GF + kbase;
    const LAS float* wb0 = Wl + kbase * 32 + (i ^ ((kq & 1) << 4)); const LAS float* wb1 = Wl + kbase * 32 + ((i + 16) ^ ((kq & 1) << 4));
    f32x4 acc0 = {0.f, 0.f, 0.f, 0.f}, acc1 = {0.f, 0.f, 0.f, 0.f}; float ss = 0.f;
#pragma unroll 1
    for (int c = 0; c < 4; ++c) {
        f32x4 xv[8], gv[8];
#pragma unroll
        for (int q = 0; q < 8; ++q) { xv[q] = *(const GAS f32x4*)(xrow + c * 128 + 4 * q); gv[q] = *(const GAS f32x4*)(grow + c * 128 + 4 * q); }
        unsigned o[8];
#pragma unroll
        for (int q = 0; q < 8; ++q) { const f32x4 x = xv[q], pq = x * gv[q]; ss += (x.x * x.x + x.y * x.y) + (x.z * x.z + x.w * x.w);
            int w = __builtin_amdgcn_cvt_pk_fp8_f32(pq.x, pq.y, 0, false); w = __builtin_amdgcn_cvt_pk_fp8_f32(pq.z, pq.w, w, true); o[q] = (unsigned)w; }
        GAS u32x4* op = (GAS u32x4*)(H8 + (size_t)tok * D + kbase + c * 128);
        op[0] = (u32x4){o[0], o[1], o[2], o[3]}; op[1] = (u32x4){o[4], o[5], o[6], o[7]};
#pragma unroll
        for (int j = 0; j < 32; ++j) { const float a = xv[j >> 2][j & 3]; const float b0 = wb0[(c * 128 + j) * 32], b1 = wb1[(c * 128 + j) * 32];
            acc0 = __builtin_amdgcn_mfma_f32_16x16x4f32(a, b0, acc0, 0, 0, 0); acc1 = __builtin_amdgcn_mfma_f32_16x16x4f32(a, b1, acc1, 0, 0, 0); }
    }
    ss += __shfl_xor(ss, 16); ss += __shfl_xor(ss, 32);
    if (kh == 1) { LAS float* xp = xch + (tg * 64 + lane) * 8; *(LAS f32x4*)xp = acc0; *(LAS f32x4*)(xp + 4) = acc1; if (lane < 16) xss[tg * 16 + lane] = ss; }
    LDS_WAIT(); __syncthreads();
    if (kh == 0) {
        const LAS float* xp = xch + (tg * 64 + lane) * 8; acc0 += *(const LAS f32x4*)xp; acc1 += *(const LAS f32x4*)(xp + 4); ss += xss[tg * 16 + i];
        const float rt = 1.0f / sqrtf(ss * (1.f / D) + RMS_EPS);
        if (lane < 16) RTOK[tok] = rt;
        const float bias0 = RB[i], bias1 = RB[i + 16];
        float c0[4], c1[4];
#pragma unroll
        for (int r = 0; r < 4; ++r) { const float rr = __shfl(rt, 4 * kq + r); c0[r] = acc0[r] * rr + bias0; c1[r] = acc1[r] * rr + bias1; }
        float tv[4][4]; int ti[4][4];
#pragma unroll
        for (int k = 0; k < 4; ++k)
#pragma unroll
            for (int r = 0; r < 4; ++r) { float bv = c0[r] >= c1[r] ? c0[r] : c1[r]; int bi = c0[r] >= c1[r] ? i : i + 16;
#pragma unroll
                for (int off = 1; off < 16; off <<= 1) { const float ov = __shfl_xor(bv, off); const int oi = __shfl_xor(bi, off); const bool take = (ov > bv) || (ov == bv && oi < bi); bv = take ? ov : bv; bi = take ? oi : bi; }
                tv[k][r] = bv; ti[k][r] = bi; if (bi == i) c0[r] = -INFINITY; if (bi == i + 16) c1[r] = -INFINITY; }
        if (i == 0) {
#pragma unroll
            for (int r = 0; r < 4; ++r) { const int t = bid * 64 + tg * 16 + 4 * kq + r;
                const float e1 = __expf(tv[1][r] - tv[0][r]), e2 = __expf(tv[2][r] - tv[0][r]), e3 = __expf(tv[3][r] - tv[0][r]); const float inv = 1.0f / (1.0f + e1 + e2 + e3);
                *(GAS i32x4*)(TOPIDX + t * 4) = (i32x4){ti[0][r], ti[1][r], ti[2][r], ti[3][r]}; *(GAS f32x4*)(TOPW + t * 4) = (f32x4){inv, e1 * inv, e2 * inv, e3 * inv};
                atomicAdd((int*)&hist[ti[0][r]], 1); atomicAdd((int*)&hist[ti[1][r]], 1); atomicAdd((int*)&hist[ti[2][r]], 1); atomicAdd((int*)&hist[ti[3][r]], 1); }
        }
    }
    LDS_WAIT(); __syncthreads();
    if (F.tid < 32) HIST[bid * 32 + F.tid] = hist[F.tid];
}
__device__ __forceinline__ void p6_slots(const Ctx& F0) {
    const Ctx F = ctx_refresh(F0);
    const int* TOPIDX = (const int*)(F.ws + WS_MISC + MO_TOPIDX); const float* TOPW = (const float*)(F.ws + WS_MISC + MO_TOPW); const int* HIST = (const int*)(F.ws + WS_MISC + MO_HIST);
    int* TOKSLOT = (int*)(F.ws + WS_MISC + MO_TOKSLOT); int* SLOTTOK = (int*)(F.ws + WS_MISC + MO_SLOTTOK); float* SLOTW = (float*)(F.ws + WS_MISC + MO_SLOTW); int* TILE = (int*)(F.ws + WS_MISC + MO_TILE);
    LAS int* part = (LAS int*)F.lds;
    LAS int* pref = part + 512;
    LAS int* tot = part + 1024;
    LAS int* mypre = tot + 32; LAS int* sbase = tot + 64; LAS int* wcnt = tot + 96;
    const int bid = (int)blockIdx.x, tid = F.tid;
    __syncthreads();
    { const int e = tid & 31, ch = tid >> 5; int s = 0, p = 0;
        for (int j = 0; j < 16; ++j) { const int bb = ch * 16 + j; const int hv = HIST[bb * 32 + e]; s += hv; if (bb < bid) p += hv; }
        part[ch * 32 + e] = s; pref[ch * 32 + e] = p; }
    LDS_WAIT(); __syncthreads();
    if (tid < 32) { int s = 0, p = 0; for (int ch = 0; ch < 16; ++ch) { s += part[ch * 32 + tid]; p += pref[ch * 32 + tid]; } tot[tid] = s; mypre[tid] = p; }
    LDS_WAIT(); __syncthreads();
    if (tid == 0) { int tb = 0; for (int e = 0; e < 32; ++e) { sbase[e] = tb * 256; const int nt = (tot[e] + 255) >> 8; if (bid == 0) { for (int j = 0; j < nt; ++j) TILE[1 + tb + j] = e; } tb += nt; } if (bid == 0) TILE[0] = tb; }
    LDS_WAIT(); __syncthreads();
    int e_me = 0, rank = 0; float w_me = 0.f; const int ent = tid;
    if (tid < 256) { e_me = TOPIDX[bid * 256 + ent]; w_me = TOPW[bid * 256 + ent];
        const int wv = tid >> 6;
        for (int e = 0; e < 32; ++e) { const unsigned long long bal = __ballot(e_me == e); if (e_me == e) rank = __builtin_popcountll(bal & ((1ull << F.lane) - 1ull)); if (F.lane == 0) wcnt[wv * 32 + e] = __builtin_popcountll(bal); } }
    LDS_WAIT(); __syncthreads();
    if (tid < 256) { const int wv = tid >> 6; for (int j = 0; j < wv; ++j) rank += wcnt[j * 32 + e_me];
        const int slot = sbase[e_me] + mypre[e_me] + rank; const int tok = bid * 64 + (ent >> 2);
        SLOTTOK[slot] = tok; SLOTW[slot] = w_me; TOKSLOT[bid * 256 + ent] = slot; }
    if (bid < 32) { const int e = bid; const int beg = sbase[e] + tot[e], end = sbase[e] + (((tot[e] + 255) >> 8) << 8); for (int s = beg + tid; s < end; s += NTHREADS) { SLOTTOK[s] = 0; SLOTW[s] = 0.f; } }
}
constexpr int LDS_ROWS = 139264, LDS_TILE = 139264 + 11 * 1024;
static_assert(LDS_TILE + 4 * (1 + MAX_TILES) <= LDS_MISC, "LDS tables");
template <int NPN, bool ROWS> __device__ __forceinline__ void moe_tables(const Ctx& F, const int* TILE, const int* SLOTTOK) {
    LAS int* tl = (LAS int*)(F.lds + LDS_TILE);
    __syncthreads();
    for (int j = F.tid; j < 1 + MAX_TILES; j += NTHREADS) tl[j] = __hip_atomic_load((int*)TILE + j, __ATOMIC_RELAXED, __HIP_MEMORY_SCOPE_AGENT);
    if (ROWS) { const int ntile = __builtin_amdgcn_readfirstlane(__hip_atomic_load((int*)TILE, __ATOMIC_RELAXED, __HIP_MEMORY_SCOPE_AGENT));
        for (int i = 0; i < 11; ++i) { const int L = i * F.G + (int)blockIdx.x; if (L >= ntile * NPN) break; const int m = L / NPN;
            if (F.tid < 256) ((LAS int*)(F.lds + LDS_ROWS))[i * 256 + F.tid] = SLOTTOK[m * 256 + F.tid]; } }
    LDS_WAIT(); __syncthreads();
}
struct P7Sched {
    int G, c; LAS const int* tl; const char* H2; const char* WGU;
    __device__ __forceinline__ bool next(int i, pg8::Unit& u) const {
        const int ntile = __builtin_amdgcn_readfirstlane(tl[0]); const int L = i * G + c; if (L >= ntile * 8 || i >= 11) return false;
        const int m = L >> 3, pn = L & 7, e = __builtin_amdgcn_readfirstlane(tl[1 + m]);
        u.pm = m; u.pn = pn; u.aux = e; u.scale = 1.f; u.nt = 8; u.rows = LDS_ROWS + 1024 * i; u.A = H2; u.B = WGU + ((size_t)e * 2048 + pn * 256) * 1024; return true;
    }
};
struct P7Epi {
    const float* BGU; bf16_t* ACT; const float* RTOK; LAS const unsigned char* lds;
    __device__ __forceinline__ void operator()(const f32x4 (&acc)[2][2][4][2], const pg8::Unit& u, int wr, int wc, int fr, int fq) const {
        const int row0 = u.pm * 256 + wr * 64 + fr, cc0 = wc * 32 + 8 * fq, e = u.aux;
        float rr[2][4];
#pragma unroll
        for (int ai = 0; ai < 2; ++ai)
#pragma unroll
            for (int m = 0; m < 4; ++m) rr[ai][m] = RTOK[((LAS const int*)(lds + u.rows))[wr * 64 + fr + ai * 128 + m * 16]];
        const float* bg = BGU + (size_t)e * 2048 + u.pn * 128 + cc0; const float* bu = bg + 1024;
        const f32x4 bg0 = *(const GAS f32x4*)bg, bg1 = *(const GAS f32x4*)(bg + 4), bu0 = *(const GAS f32x4*)bu, bu1 = *(const GAS f32x4*)(bu + 4);
#pragma unroll
        for (int ai = 0; ai < 2; ++ai)
#pragma unroll
            for (int m = 0; m < 4; ++m) { const size_t row = (size_t)(row0 + ai * 128 + m * 16);
                float av[8];
#pragma unroll
                for (int n = 0; n < 2; ++n) { const f32x4 gv = acc[ai][0][m][n] * rr[ai][m] + (n ? bg1 : bg0), uv = acc[ai][1][m][n] * rr[ai][m] + (n ? bu1 : bu0);
#pragma unroll
                    for (int j = 0; j < 4; ++j) { const float gg = fminf(gv[j], 7.0f); const float uu = fminf(fmaxf(uv[j], -7.0f), 7.0f); av[4 * n + j] = (uu + 1.0f) * gg * fast_sigmoid(1.702f * gg); } }
                int w0 = __builtin_amdgcn_cvt_pk_fp8_f32(av[0], av[1], 0, false); w0 = __builtin_amdgcn_cvt_pk_fp8_f32(av[2], av[3], w0, true);
                int w1 = __builtin_amdgcn_cvt_pk_fp8_f32(av[4], av[5], 0, false); w1 = __builtin_amdgcn_cvt_pk_fp8_f32(av[6], av[7], w1, true);
                *(GAS u32x2*)((unsigned char*)ACT + row * 1024 + u.pn * 128 + cc0) = (u32x2){(unsigned)w0, (unsigned)w1}; }
    }
};
struct P8Sched {
    int G, c; LAS const int* tl; const char* ACT; const char* WDN;
    __device__ __forceinline__ bool next(int i, pg8::Unit& u) const {
        const int ntile = __builtin_amdgcn_readfirstlane(tl[0]); const int L = i * G + c; if (L >= ntile * 4) return false;
        const int m = L >> 2, pn = L & 3, e = __builtin_amdgcn_readfirstlane(tl[1 + m]);
        u.pm = m; u.pn = pn; u.aux = e; u.scale = 1.f; u.nt = 8; u.rows = 0; u.A = ACT + (size_t)m * 256 * 1024; u.B = WDN + ((size_t)e * 1024 + pn * 256) * 1024; return true;
    }
};
struct P8Epi {
    const float* BDN; const float* SLOTW; bf16_t* YS;
    __device__ __forceinline__ void operator()(const f32x4 (&acc)[2][2][4][2], const pg8::Unit& u, int wr, int wc, int fr, int fq) const {
        const int row0 = u.pm * 256 + wr * 64 + fr, col0 = u.pn * 256 + wc * 32 + 8 * fq, e = u.aux;
        const float* bp = BDN + (size_t)e * 1024 + col0;
        f32x4 bv[2][2]; float sw[2][4];
#pragma unroll
        for (int bj = 0; bj < 2; ++bj) { bv[bj][0] = *(const GAS f32x4*)(bp + bj * 128); bv[bj][1] = *(const GAS f32x4*)(bp + bj * 128 + 4); }
#pragma unroll
        for (int ai = 0; ai < 2; ++ai)
#pragma unroll
            for (int m = 0; m < 4; ++m) sw[ai][m] = SLOTW[row0 + ai * 128 + m * 16];
        asm volatile("" ::: "memory");
#pragma unroll
        for (int ai = 0; ai < 2; ++ai)
#pragma unroll
            for (int m = 0; m < 4; ++m) { const size_t row = (size_t)(row0 + ai * 128 + m * 16); const float w_ = sw[ai][m];
#pragma unroll
                for (int bj = 0; bj < 2; ++bj) { const f32x4 v0 = (acc[ai][bj][m][0] + bv[bj][0]) * w_, v1 = (acc[ai][bj][m][1] + bv[bj][1]) * w_;
                    int w0 = __builtin_amdgcn_cvt_pk_fp8_f32(v0[0], v0[1], 0, false); w0 = __builtin_amdgcn_cvt_pk_fp8_f32(v0[2], v0[3], w0, true);
                    int w1 = __builtin_amdgcn_cvt_pk_fp8_f32(v1[0], v1[1], 0, false); w1 = __builtin_amdgcn_cvt_pk_fp8_f32(v1[2], v1[3], w1, true);
                    *(GAS u32x2*)((unsigned char*)YS + row * 1024 + col0 + bj * 128) = (u32x2){(unsigned)w0, (unsigned)w1}; } }
    }
};
__device__ __forceinline__ void p9_final(const Ctx& F0) {
    const KArgs ap = kargs(); struct { const float* in[20]; float* out; } a; a.in[19] = ap->in[19]; a.out = ap->out;
    const Ctx F = ctx_refresh(F0);
    float* OUT = a.out; const bf16_t* YS = (const bf16_t*)(F.ws + WS_YS); const int* TOKSLOT = (const int*)(F.ws + WS_MISC + MO_TOKSLOT); const float* GN = a.in[19];
    const int gw = F.vcu * NWAVES + F.wave, NGW = F.G * NWAVES, lane = F.lane;
    const GAS f32x4* gr = (const GAS f32x4*)GN + lane;
    const bool bad = ld_uniform((const int*)(F.ws + WS_CTL) + 4096 + XB_TMO) != 0;
    float ckscale = 1.0f;
#ifdef CKSUM
    { const int* prev = (const int*)(F.ws + WS_MISC + 7 * MiB); if (ld_uniform(prev) == 0x5EED1234) ckscale = 1.0f + 0.25f * (float)ld_uniform(prev + 1); }
#endif
    for (int tok = gw; tok < NTOK; tok += NGW) {
        GAS f32x4* xr = (GAS f32x4*)(OUT + (size_t)tok * D) + lane;
        f32x4 v[4];
#pragma unroll
        for (int jj = 0; jj < 4; ++jj) v[jj] = xr[64 * jj];
        const int slots[4] = {ld_uniform(TOKSLOT + tok * 4), ld_uniform(TOKSLOT + tok * 4 + 1), ld_uniform(TOKSLOT + tok * 4 + 2), ld_uniform(TOKSLOT + tok * 4 + 3)};
#pragma unroll
        for (int k = 0; k < 4; ++k) { const GAS unsigned* yr = (const GAS unsigned*)((const unsigned char*)YS + (size_t)slots[k] * 1024) + lane;
#pragma unroll
            for (int jj = 0; jj < 4; ++jj) { const unsigned y = yr[64 * jj]; const f32x2 lo = __builtin_amdgcn_cvt_pk_f32_fp8((int)y, false), hi = __builtin_amdgcn_cvt_pk_f32_fp8((int)y, true);
                v[jj].x += lo.x; v[jj].y += lo.y; v[jj].z += hi.x; v[jj].w += hi.y; } }
        float ss = 0.f;
#pragma unroll
        for (int jj = 0; jj < 4; ++jj) ss += (v[jj].x * v[jj].x + v[jj].y * v[jj].y) + (v[jj].z * v[jj].z + v[jj].w * v[jj].w);
        const float r = 1.0f / sqrtf(wave_sum(ss) * (1.f / D) + RMS_EPS);
#pragma unroll
        for (int jj = 0; jj < 4; ++jj) { const f32x4 gg = gr[64 * jj]; f32x4 o = (f32x4){v[jj].x * r * gg.x, v[jj].y * r * gg.y, v[jj].z * r * gg.z, v[jj].w * r * gg.w} * ckscale; if (bad) o = (f32x4){__builtin_nanf(""), __builtin_nanf(""), __builtin_nanf(""), __builtin_nanf("")}; xr[64 * jj] = o; }
    }
}

__device__ __forceinline__ void grid_barrier(int wave) {
    extern __shared__ __attribute__((aligned(16))) unsigned char lds_dyn[];
    XcdBarrier b; b.bar = (unsigned*)(kargs()->ws + WS_CTL) + 4096; b.x = xb_xcc_id(); b.st = (volatile LAS unsigned*)((LAS unsigned char*)lds_dyn + LDS_MISC) + 8; b.wave = wave;
    xcd_barrier(b);
}
__global__ void __launch_bounds__(NTHREADS, 2) fwd_megakernel(Args args) {
    const int wave = __builtin_amdgcn_readfirstlane((int)threadIdx.x >> 6);
    {
        const Ctx F = make_ctx(wave);
        volatile LAS unsigned* MISC = (volatile LAS unsigned*)(F.lds + LDS_MISC);
        for (int u = F.tid; u < 128; u += NTHREADS) MISC[u] = 0u;
        __syncthreads();
        (void)xcd_barrier_post((unsigned*)(F.ws + WS_CTL) + 4096, MISC + 8, wave);
    }
#ifndef TSK
#define TSK -1
#endif
    unsigned long long ts0_ = 0ull, ts1_ = 0ull; if (TSK >= 0) ts0_ = __builtin_amdgcn_s_memrealtime();
#define TS(k) do { if (TSK == (k)) ts1_ = __builtin_amdgcn_s_memrealtime(); } while (0)
#define F make_ctx(wave)
#define ws (kargs()->ws)
#define xcd_barrier(bar) grid_barrier(wave)
#ifndef PHM
#define PHM 0xFFFF
#endif
#define PH(k) ((PHM >> (k)) & 1)
#ifndef PHR
#define PHR 0
#endif
#define RP(k) ((PHR >> (k)) & 1)
#ifdef CANARY
    {
        const size_t n16 = (WS_END - WS_MISC) / 16; GAS u32x4* p = (GAS u32x4*)(ws + WS_MISC);
        for (size_t i = (size_t)blockIdx.x * NTHREADS + F.tid; i < n16; i += (size_t)F.G * NTHREADS) p[i] = (u32x4){0xffffffffu, 0xffffffffu, 0xffffffffu, 0xffffffffu};
        GAS u32x4* q = (GAS u32x4*)kargs()->out;
        for (size_t i = (size_t)blockIdx.x * NTHREADS + F.tid; i < (size_t)NTOK * D / 4; i += (size_t)F.G * NTHREADS) q[i] = (u32x4){0xffffffffu, 0xffffffffu, 0xffffffffu, 0xffffffffu};
        xcd_barrier(bar);
    }
#endif
    if (PH(0)) p0_prologue(F);
    xcd_barrier(bar);
    if (RP(0)) { p0_prologue(F); xcd_barrier(bar); }
    TS(0);
    CK(1, ws + WS_WIN_T, WS_MKV - WS_WIN_T); CK(1, ws + WS_XN, WS_ABC - WS_XN); CK(1, ws + WS_WGU_T, WS_PROJ - WS_WGU_T); CK(1, ws + WS_MISC + MO_T5, 128 * 1024);
    for (int rp_ = 0; rp_ < 1 + RP(1); ++rp_) {
    if (PH(1)) {
        p1_convert_experts(F);
        P1Sched S{(unsigned*)(ws + WS_CTL) + 12288 + 64 * ((int)blockIdx.x & 7), (LAS int*)(F.lds + LDS_MISC) + 32, F.wave, (int)blockIdx.x & 7, (const char*)(ws + WS_XN), (const char*)(ws + WS_WIN_T), (const char*)(ws + WS_MEMN), (const char*)(ws + WS_WMEM_T)};
        P1Epi E{(bf16_t*)(ws + WS_PROJ), (bf16_t*)(ws + WS_MKV)};
        pg8::gemm_phase<P1Epi, P1Sched, false>(F.lds, F.wave, 2048u, 2048u, S, E);
    }
    xcd_barrier(bar);
    }
    TS(1);
    CK(2, ws + WS_PROJ, WS_ACT - WS_PROJ); CK(2, ws + WS_MKV, 1 * MiB);
    if (PH(2)) p2_attention(F);
    xcd_barrier(bar);
    if (RP(2)) { p2_attention(F); xcd_barrier(bar); }
    TS(2);
    CK(3, ws + WS_OB, WS_MERGED - WS_OB); CK(3, ws + WS_MISC + MO_LSE, 3 * 16384 * 16);
    if (PH(10)) p2b_merge(F);
    xcd_barrier(bar);
    TS(10);
    CK(4, ws + WS_ABC, WS_OB - WS_ABC);
    for (int rp_ = 0; rp_ < 1 + RP(3); ++rp_) {
    if (PH(3)) {
        P3Sched S{(int)blockIdx.x, (const char*)(ws + WS_ABC), (const char*)(ws + WS_WABC_T)};
        P3Epi E{(const bf16_t*)(ws + WS_PROJ), (bf16_t*)(ws + WS_MERGED)};
        pg8::gemm_phase<P3Epi, P3Sched, false>(F.lds, F.wave, (unsigned)(ABC_LD * 2), (unsigned)(ABC_LD * 2), S, E);
    }
    xcd_barrier(bar);
    }
    TS(3);
    CK(5, ws + WS_MERGED, 32 * MiB);
    for (int rp_ = 0; rp_ < 1 + RP(4); ++rp_) {
    if (PH(4)) {
        P4Sched S{(int)blockIdx.x, (const char*)(ws + WS_MERGED), (const char*)(ws + WS_WOUT_T)};
        P4Epi E{kargs()->in[0], kargs()->out};
        pg8::gemm_phase<P4Epi, P4Sched, false>(F.lds, F.wave, 2048u, 2048u, S, E);
    }
    xcd_barrier(bar);
    }
    TS(4);
    CK(6, kargs()->out, 64 * MiB);
    if (PH(5)) p5_router(F);
    xcd_barrier(bar);
    if (RP(5)) { p5_router(F); xcd_barrier(bar); }
    TS(5);
    CK(7, ws + WS_XN, 32 * MiB); CK(7, ws + WS_MISC, 512 * 1024 + 32 * 1024);
    if (PH(6)) p6_slots(F);
    xcd_barrier(bar);
    TS(6);
#ifdef CKSUM
#define ck_rows ((size_t)ld_uniform((const int*)(ws + WS_MISC + MO_TILE)) * 256)
    CK(8, ws + WS_MISC + MO_TOKSLOT, 256 * 1024); CK(8, ws + WS_MISC + MO_SLOTTOK, ck_rows * 4); CK(8, ws + WS_MISC + MO_SLOTW, ck_rows * 4); CK(8, ws + WS_MISC + MO_TILE, 1024);
#endif
    for (int rp_ = 0; rp_ < 1 + RP(7); ++rp_) {
    if (PH(7)) {
        moe_tables<8, true>(F, (const int*)(ws + WS_MISC + MO_TILE), (const int*)(ws + WS_MISC + MO_SLOTTOK));
        P7Sched S{F.G, (int)blockIdx.x, (LAS const int*)(F.lds + LDS_TILE), (const char*)(ws + WS_XN), (const char*)(ws + WS_WGU_T)};
        P7Epi E{kargs()->in[16], (bf16_t*)(ws + WS_ACT), (const float*)(ws + WS_MISC + MO_RTOK), (LAS const unsigned char*)F.lds};
        pg8::gemm_phase<P7Epi, P7Sched, true, true>(F.lds, F.wave, 1024u, 1024u, S, E);
    }
    xcd_barrier(bar);
    }
    TS(7);
#ifdef CKSUM
    CK(9, ws + WS_ACT, ck_rows * 2048);
#endif
    for (int rp_ = 0; rp_ < 1 + RP(8); ++rp_) {
    if (PH(8)) {
        moe_tables<4, false>(F, (const int*)(ws + WS_MISC + MO_TILE), (const int*)(ws + WS_MISC + MO_SLOTTOK));
        P8Sched S{F.G, (int)blockIdx.x, (LAS const int*)(F.lds + LDS_TILE), (const char*)(ws + WS_ACT), (const char*)(ws + WS_WDN_T)};
        P8Epi E{kargs()->in[18], (const float*)(ws + WS_MISC + MO_SLOTW), (bf16_t*)(ws + WS_YS)};
        pg8::gemm_phase<P8Epi, P8Sched, false, true>(F.lds, F.wave, 1024u, 1024u, S, E);
    }
    xcd_barrier(bar);
    }
    TS(8);
#ifdef CKSUM
    CK(10, ws + WS_YS, ck_rows * 2048);
#endif
    if (PH(9)) p9_final(F);
    if (TSK >= 0 && blockIdx.x == 0 && wave == 0) { const unsigned long long te_ = __builtin_amdgcn_s_memrealtime(); const unsigned long long wait_ = 50ull * (ts1_ - ts0_); while (__builtin_amdgcn_s_memrealtime() - te_ < wait_) __builtin_amdgcn_s_sleep(32); }
#ifdef CKSUM
    xcd_barrier(bar);
    if (blockIdx.x == 0 && F.wave == 0 && lane_id() == 0) {
        unsigned* cur = (unsigned*)(ws + WS_CTL) + 8192; unsigned* prev = (unsigned*)(ws + WS_MISC + 7 * MiB);
        const bool have = __hip_atomic_load(prev, __ATOMIC_RELAXED, __HIP_MEMORY_SCOPE_AGENT) == 0x5EED1234u;
        unsigned flag = have ? __hip_atomic_load(prev + 1, __ATOMIC_RELAXED, __HIP_MEMORY_SCOPE_AGENT) : 0u;
        for (int k = 1; k <= 10; ++k) { const unsigned c = __hip_atomic_load(cur + 64 * k, __ATOMIC_RELAXED, __HIP_MEMORY_SCOPE_AGENT);
            if (have && flag == 0u && __hip_atomic_load(prev + 16 + k, __ATOMIC_RELAXED, __HIP_MEMORY_SCOPE_AGENT) != c) flag = (unsigned)k;
            __hip_atomic_store(prev + 16 + k, c, __ATOMIC_RELAXED, __HIP_MEMORY_SCOPE_AGENT); }
        __hip_atomic_store(prev + 1, flag, __ATOMIC_RELAXED, __HIP_MEMORY_SCOPE_AGENT); __hip_atomic_store(prev, 0x5EED1234u, __ATOMIC_RELAXED, __HIP_MEMORY_SCOPE_AGENT);
    }
#endif
}

#undef F
#undef ws
#undef xcd_barrier
extern "C" void kernel_launch(void* const* d_in, const int* in_sizes, int n_in, void* d_out, int out_size, void* d_ws, size_t ws_size, hipStream_t stream) {
    static int grid = 0;
    if (grid == 0) {
        if (n_in != 20 || out_size != NTOK * D || ws_size < WS_END) { fprintf(stderr, "kernel_launch: unexpected shapes (n_in %d, out %d, ws %zu); nothing launched\n", n_in, out_size, ws_size); grid = -1; return; }
        int dev = 0, cus = 0;
        if (hipGetDevice(&dev) != hipSuccess || hipDeviceGetAttribute(&cus, hipDeviceAttributeMultiprocessorCount, dev) != hipSuccess) { grid = -1; return; }
        if (hipFuncSetAttribute((const void*)fwd_megakernel, hipFuncAttributeMaxDynamicSharedMemorySize, LDS_BYTES) != hipSuccess) { fprintf(stderr, "kernel_launch: hipFuncSetAttribute failed\n"); grid = -1; return; }
        int per_cu = 0;
        if (hipOccupancyMaxActiveBlocksPerMultiprocessor(&per_cu, (const void*)fwd_megakernel, NTHREADS, LDS_BYTES) != hipSuccess || per_cu < 1) fprintf(stderr, "kernel_launch: occupancy query reports %d\n", per_cu);
        (void)hipGetLastError();
        grid = cus;
        if (grid != 256) fprintf(stderr, "kernel_launch: %d CUs; this kernel is laid out for 256\n", grid);
    }
    if (grid < 0) return;
    (void)hipMemsetAsync((char*)d_ws + WS_CTL, 0, CTL_ZERO_BYTES, stream);
    Args a{};
    for (int i = 0; i < 20; ++i) a.in[i] = (const float*)d_in[i];
    a.out = (float*)d_out; a.ws = (unsigned char*)d_ws;
    hipLaunchKernelGGL(fwd_megakernel, dim3(grid), dim3(NTHREADS), LDS_BYTES, stream, a);
}
```

```cpp
#include <hip/hip_runtime.h>
#include <cstdio>
#include <cstdint>

#define GAS __attribute__((address_space(1)))
#define LAS __attribute__((address_space(3)))
typedef unsigned short bf16_t;
typedef short bf16x8 __attribute__((ext_vector_type(8)));
typedef short s16x4 __attribute__((ext_vector_type(4)));
typedef float f32x4 __attribute__((ext_vector_type(4)));
typedef float f32x2 __attribute__((ext_vector_type(2)));
typedef unsigned u32x4 __attribute__((ext_vector_type(4)));
typedef unsigned u32x2 __attribute__((ext_vector_type(2)));
typedef int i32x4 __attribute__((ext_vector_type(4)));
typedef int i32x8 __attribute__((ext_vector_type(8)));
#define FP8_SCALE 0x7C7C7C7C
typedef GAS unsigned gu32;

constexpr int NTOK = 16384, SEQ = 8192, D = 1024, NMEM = 512, MEMLEN = 256;
constexpr int IN_COLS = 7424;
__host__ __device__ __forceinline__ size_t proj_off(size_t row, int col) { return (((row >> 8) * 29 + (size_t)(col >> 8)) << 16) + ((row & 255) << 8) + (size_t)(col & 255); }
constexpr int C_QA = 0, C_KA = 512, C_VA = 1024, C_QB = 1536, C_KB = 2304, C_VB = 3072, C_QC = 3840, C_GATE = 4352;
constexpr int NEXP = 32, TOPK = 4, DFF = 1024;
constexpr int MAX_TILES = 288, MAX_SLOTS = MAX_TILES * 256;
constexpr float RMS_EPS = 1e-6f, LOG2E = 1.4426950408889634f;
constexpr float QS64 = 0.125f * LOG2E, QS128 = 0.08838834764831845f * LOG2E;
constexpr int ABC_LD = 1280;

constexpr size_t MiB = 1u << 20;
constexpr size_t WS_CTL = 0, CTL_ZERO_BYTES = 1 * MiB;
constexpr size_t WS_MISC = 1 * MiB;
constexpr size_t MO_TOPIDX = 0, MO_TOPW = 256 * 1024, MO_HIST = 512 * 1024, MO_TOKSLOT = 1 * MiB, MO_SLOTTOK = 2 * MiB, MO_SLOTW = 3 * MiB, MO_TILE = 4 * MiB, MO_LSE = 5 * MiB, MO_T5 = 6 * MiB, MO_RPB = 6 * MiB + 64 * 1024, MO_RTOK = 7 * MiB + 64 * 1024;
constexpr size_t WS_WIN_T = 16 * MiB, WS_WMEM_T = 32 * MiB, WS_WABC_T = 34 * MiB, WS_WOUT_T = 37 * MiB, WS_MEMN = 39 * MiB, WS_MKV = 40 * MiB, WS_XN = 41 * MiB;
constexpr size_t WS_ABC = 73 * MiB, WS_OB = 113 * MiB, WS_MERGED = 137 * MiB, WS_WGU_T = 169 * MiB, WS_WDN_T = 297 * MiB, WS_PROJ = 361 * MiB, WS_ACT = 593 * MiB, WS_YS = 737 * MiB, WS_END = 881 * MiB;
constexpr int T5_LD = 192, RPB_LD = 640, RPB_OFF = 64;

constexpr int LDS_MAIN = 147456;
constexpr int LDS_TAB = LDS_MAIN;
constexpr int LDS_MISC = LDS_MAIN + 8192;
constexpr int LDS_BYTES = LDS_MISC + 512;

#define LDS_WAIT() asm volatile("s_waitcnt lgkmcnt(0)" ::: "memory")
#define VM_WAIT() asm volatile("s_waitcnt vmcnt(0)" ::: "memory")
__device__ __forceinline__ unsigned cvt_pk_bf16(float lo, float hi) { unsigned r; asm volatile("v_cvt_pk_bf16_f32 %0, %1, %2" : "=v"(r) : "v"(lo), "v"(hi)); return r; }
__device__ __forceinline__ float bf_lo(unsigned u) { return __uint_as_float(u << 16); }
__device__ __forceinline__ float bf_hi(unsigned u) { return __uint_as_float(u & 0xffff0000u); }
__device__ __forceinline__ int lane_id() { int l; asm volatile("v_mbcnt_lo_u32_b32 %0, -1, 0\n\tv_mbcnt_hi_u32_b32 %0, -1, %0" : "=v"(l)); return l; }
__device__ __forceinline__ float sx(float v, int off) { return __builtin_bit_cast(float, __builtin_amdgcn_ds_bpermute((lane_id() ^ off) << 2, __builtin_bit_cast(int, v))); }
__device__ __forceinline__ int sxi(int v, int off) { return __builtin_amdgcn_ds_bpermute((lane_id() ^ off) << 2, v); }
__device__ __forceinline__ float sidx(float v, int src) { return __builtin_bit_cast(float, __builtin_amdgcn_ds_bpermute(src << 2, __builtin_bit_cast(int, v))); }
__device__ __forceinline__ float wave_sum(float v) {
#pragma unroll
    for (int o = 1; o < 64; o <<= 1) v += sx(v, o);
    return v;
}
__device__ __forceinline__ float wave_max(float v) {
#pragma unroll
    for (int o = 1; o < 64; o <<= 1) v = fmaxf(v, sx(v, o));
    return v;
}
__device__ __forceinline__ int ld_uniform(const int* p) { return __builtin_amdgcn_readfirstlane(__hip_atomic_load((int*)p, __ATOMIC_RELAXED, __HIP_MEMORY_SCOPE_AGENT)); }
__device__ __forceinline__ float fast_sigmoid(float x) { return __builtin_amdgcn_rcpf(1.0f + __builtin_amdgcn_exp2f(-LOG2E * x)); }

namespace pg8 {
constexpr int BM = 256, BK = 64, HALF = 128, HTB = HALF * BK * 2, STAGE_BYTES = 8 * HTB, LDS_STASH = 131072  ;
__host__ __device__ __forceinline__ int lds_byte(int r, int c) { const int st = (r >> 4) * 2 + (c >> 5), rr = r & 15, cc = c & 31, ob = rr * 64 + cc * 2; return st * 1024 + (ob ^ (((ob >> 9) & 1) << 5)); }
__host__ __device__ __forceinline__ void stage_rc(int b, int& R, int& C) { const int st = b / 1024, sb = b % 1024, swz = sb ^ (((sb >> 9) & 1) << 5); R = (st >> 1) * 16 + swz / 64; C = (st & 1) * 32 + (swz % 64) / 2; }
__host__ __device__ __forceinline__ int perm32(int rho) { const int n = rho >> 4, i = rho & 15; return 8 * (i >> 2) + 4 * n + (i & 3); }

struct Unit {
    const char* A;
    const char* B;
    int rows;
    int nt;
    int pm, pn;
    int aux;
    float scale;
};

template <class Epi, class Sched, bool GATHER, bool FP8 = false>
__device__ __forceinline__ void gemm_phase(LAS unsigned char* lds, const int wave, const unsigned lda, const unsigned ldb, const Sched& S, const Epi& E) {
    const int lane = lane_id();
    const int wid = wave, tid = wave * 64 + lane, wr = wid >> 2, wc = wid & 3, fr = lane & 15, fq = lane >> 4;
    const int R0 = (wid >> 1) * 16 + (lane >> 2), C2 = ((wid & 1) * 32 + ((((lane & 3) * 8)) ^ ((lane >> 5) << 4))) * 2, Rb0 = (R0 & ~31) + perm32(R0 & 31);
    unsigned offA = (unsigned)R0 * lda + (unsigned)C2, offB = (unsigned)Rb0 * ldb + (unsigned)C2;
    const size_t kstep = (size_t)(BK * 2);
    const size_t hstepB = (size_t)HALF * ldb;
    const unsigned ldsw = (unsigned)wid * 1024u;
    const int aoff = lds_byte(wr * 64 + fr, fq * 8), boff = lds_byte(wc * 32 + fr, fq * 8);
#define PG8_SA(b, h) (((b) * 2 + (h)) * HTB)
#define PG8_SB(b, h) ((4 + (b) * 2 + (h)) * HTB)
#define PG8_STAGE2P(bufoff, p0, p1, v0, v1) do { \
        __builtin_amdgcn_global_load_lds((const unsigned*)((const char*)(p0) + (v0)), (LAS unsigned*)(lds + (bufoff) + ldsw), 16, 0, 0); \
        __builtin_amdgcn_global_load_lds((const unsigned*)((const char*)(p1) + (v1)), (LAS unsigned*)(lds + (bufoff) + ldsw + 8192), 16, 0, 0); } while (0)
#define PG8_STAGEB(bufoff, gbase) PG8_STAGE2P(bufoff, gbase, (const char*)(gbase) + (size_t)64 * ldb, offB, offB)
#define PG8_STAGEA(bufoff, gbase, h, g0, g1) do { if (GATHER) { PG8_STAGE2P(bufoff, gbase, gbase, g0, g1); } else { PG8_STAGE2P(bufoff, (const char*)(gbase) + (size_t)((h) * HALF) * lda, (const char*)(gbase) + (size_t)((h) * HALF + 64) * lda, offA, offA); } } while (0)
#define PG8_LDA(dst, b, h) do { _Pragma("unroll") for (int m = 0; m < 4; ++m) _Pragma("unroll") for (int k = 0; k < 2; ++k) dst[m][k] = *(const LAS bf16x8*)(lds + PG8_SA(b, h) + aoff + m * 2048 + k * 1024); } while (0)
#define PG8_LDB(dst, b, h) do { _Pragma("unroll") for (int n = 0; n < 2; ++n) _Pragma("unroll") for (int k = 0; k < 2; ++k) dst[n][k] = *(const LAS bf16x8*)(lds + PG8_SB(b, h) + boff + n * 2048 + k * 1024); } while (0)
#define PG8_MMA(ai, bj, At, Bt) do { __builtin_amdgcn_s_setprio(1); \
        if (FP8) { _Pragma("unroll") for (int m = 0; m < 4; ++m) _Pragma("unroll") for (int n = 0; n < 2; ++n) { \
            const i32x4 b0_ = __builtin_bit_cast(i32x4, Bt[n][0]), b1_ = __builtin_bit_cast(i32x4, Bt[n][1]), a0_ = __builtin_bit_cast(i32x4, At[m][0]), a1_ = __builtin_bit_cast(i32x4, At[m][1]); \
            const i32x8 bw_ = __builtin_shufflevector(b0_, b1_, 0, 1, 2, 3, 4, 5, 6, 7), aw_ = __builtin_shufflevector(a0_, a1_, 0, 1, 2, 3, 4, 5, 6, 7); \
            acc[ai][bj][m][n] = __builtin_amdgcn_mfma_scale_f32_16x16x128_f8f6f4(bw_, aw_, acc[ai][bj][m][n], 0, 0, 0, FP8_SCALE, 0, FP8_SCALE); } } \
        else { _Pragma("unroll") for (int m = 0; m < 4; ++m) _Pragma("unroll") for (int n = 0; n < 2; ++n) _Pragma("unroll") for (int k = 0; k < 2; ++k) \
            acc[ai][bj][m][n] = __builtin_amdgcn_mfma_f32_16x16x32_bf16(Bt[n][k], At[m][k], acc[ai][bj][m][n], 0, 0, 0); } \
        __builtin_amdgcn_s_setprio(0); } while (0)
#define PG8_WAIT_V(n) asm volatile("s_waitcnt vmcnt(" #n ")" ::: "memory")
#define PG8_WAIT_L(n) asm volatile("s_waitcnt lgkmcnt(" #n ")" ::: "memory")
#define PG8_BAR __builtin_amdgcn_s_barrier()
#define PG8_SCHED __builtin_amdgcn_sched_barrier(0)
    Unit cur, nxt; int ui = 0;
    if (!S.next(0, cur)) return;
    f32x4 acc[2][2][4][2];
#pragma unroll
    for (int a = 0; a < 2; ++a)
#pragma unroll
        for (int b = 0; b < 2; ++b)
#pragma unroll
            for (int m = 0; m < 4; ++m)
#pragma unroll
                for (int n = 0; n < 2; ++n) acc[a][b][m][n] = (f32x4){0.f, 0.f, 0.f, 0.f};
    bf16x8 At[4][2], B0[2][2], B1[2][2];
    unsigned c00 = 0, c01 = 0, c10 = 0, c11 = 0;
#define PG8_MKOFF(U, o00, o01, o10, o11) do { const LAS int* rl_ = (const LAS int*)(lds + (U).rows) + R0; \
        o00 = (unsigned)rl_[0] * lda + (unsigned)C2; o01 = (unsigned)rl_[64] * lda + (unsigned)C2; o10 = (unsigned)rl_[HALF] * lda + (unsigned)C2; o11 = (unsigned)rl_[HALF + 64] * lda + (unsigned)C2; } while (0)
    if (GATHER) { PG8_MKOFF(cur, c00, c01, c10, c11); }
    const char* cA = cur.A; const char* cB = cur.B; int nt = cur.nt;
    PG8_STAGEB(PG8_SB(0, 0), cB); PG8_STAGEB(PG8_SB(0, 1), cB + hstepB); PG8_STAGEA(PG8_SA(0, 0), cA, 0, c00, c01); PG8_STAGEA(PG8_SA(0, 1), cA, 1, c10, c11);
    if (wr == 1) PG8_BAR;
    PG8_WAIT_V(2); PG8_BAR;
    PG8_STAGEB(PG8_SB(1, 0), cB + kstep); PG8_STAGEA(PG8_SA(1, 0), cA + kstep, 0, c00, c01); PG8_STAGEB(PG8_SB(1, 1), cB + hstepB + kstep);
    PG8_WAIT_V(6); PG8_BAR;
    for (;;) {
        const bool has_next = S.next(ui + 1, nxt);
        const char* nA = has_next ? nxt.A : cA; const char* nB = has_next ? nxt.B : cB;
#pragma nounroll
        for (int t = 0; t < nt; t += 2) {
            const bool last = (t == nt - 2);
            if (GATHER) asm volatile("" : "+v"(c00), "+v"(c01), "+v"(c10), "+v"(c11)); asm volatile("" : "+v"(offA), "+v"(offB));
            const char* a1 = cA + (size_t)(t + 1) * kstep;
            const char* a2 = last ? nA : cA + (size_t)(t + 2) * kstep; const char* b2 = last ? nB : cB + (size_t)(t + 2) * kstep;
            const char* a3 = a2 + kstep; const char* b3 = b2 + kstep;
            PG8_LDB(B0, 0, 0); PG8_LDB(B1, 0, 1); PG8_SCHED; PG8_LDA(At, 0, 0); PG8_STAGEA(PG8_SA(1, 1), a1, 1, c10, c11);
            if (GATHER) { if (last && has_next) { PG8_MKOFF(nxt, c00, c01, c10, c11); } }
            PG8_WAIT_V(8); PG8_WAIT_L(0); PG8_BAR; PG8_MMA(0, 0, At, B0); PG8_MMA(0, 1, At, B1); PG8_BAR; PG8_SCHED;
            PG8_LDA(At, 0, 1); PG8_STAGEB(PG8_SB(0, 0), b2); PG8_STAGEB(PG8_SB(0, 1), b2 + hstepB); PG8_STAGEA(PG8_SA(0, 0), a2, 0, c00, c01);
            PG8_WAIT_V(8); PG8_WAIT_L(0); PG8_BAR; PG8_MMA(1, 0, At, B0); PG8_MMA(1, 1, At, B1); PG8_BAR; PG8_SCHED;
            PG8_LDB(B0, 1, 0); PG8_LDB(B1, 1, 1); PG8_SCHED; PG8_LDA(At, 1, 0); PG8_STAGEA(PG8_SA(0, 1), a2, 1, c10, c11);
            PG8_WAIT_V(8); PG8_WAIT_L(0); PG8_BAR; PG8_MMA(0, 0, At, B0); PG8_MMA(0, 1, At, B1); PG8_BAR; PG8_SCHED;
            PG8_LDA(At, 1, 1); PG8_STAGEB(PG8_SB(1, 0), b3); PG8_STAGEB(PG8_SB(1, 1), b3 + hstepB); PG8_STAGEA(PG8_SA(1, 0), a3, 0, c00, c01);
            PG8_WAIT_V(8); PG8_WAIT_L(0); PG8_BAR; PG8_MMA(1, 0, At, B0); PG8_MMA(1, 1, At, B1); PG8_BAR; PG8_SCHED;
        }
        if (wr == 0) PG8_BAR;
        { int le_ = lane; asm volatile("" : "+v"(le_)); E(acc, cur, wr, wc, le_ & 15, le_ >> 4); }
        if (GATHER) { if (has_next) { asm volatile("" ::: "memory"); PG8_MKOFF(nxt, c00, c01, c10, c11); } }
        if (!has_next) break;
#pragma unroll
        for (int a = 0; a < 2; ++a)
#pragma unroll
            for (int b = 0; b < 2; ++b)
#pragma unroll
                for (int m = 0; m < 4; ++m)
#pragma unroll
                    for (int n = 0; n < 2; ++n) acc[a][b][m][n] = (f32x4){0.f, 0.f, 0.f, 0.f};
        cur = nxt; cA = nA; cB = nB; nt = cur.nt; ++ui;
        if (wr == 1) PG8_BAR;
    }
    PG8_WAIT_V(0);
    PG8_BAR;
#undef PG8_SA
#undef PG8_SB
#undef PG8_STAGE2P
#undef PG8_STAGEB
#undef PG8_LDA
#undef PG8_LDB
#undef PG8_MMA
#undef PG8_WAIT_V
#undef PG8_WAIT_L
#undef PG8_BAR
#undef PG8_SCHED
#undef PG8_MKOFF
#undef PG8_STAGEA
}
}

#define XB_TMO      128
#define XB_XCNT(j)  (256  + 64 * (j))
#define XB_XSUB(j)  (1280 + 64 * (j))
#define XB_XGEN(j)  (2304 + 64 * (j))
#define XB_TOP      3328
#define XB_TOPGEN   3392
#define XCD_BAR_WORDS 3456
#define XB_SPIN_CAP (1u << 18)
__device__ __forceinline__ unsigned xb_ld(unsigned* p)              { return __hip_atomic_load(p, __ATOMIC_RELAXED, __HIP_MEMORY_SCOPE_AGENT); }
__device__ __forceinline__ unsigned xb_add(unsigned* p, unsigned v) { return __hip_atomic_fetch_add(p, v, __ATOMIC_RELAXED, __HIP_MEMORY_SCOPE_AGENT); }
__device__ __forceinline__ unsigned xb_xcc_id() { return (unsigned)__builtin_amdgcn_s_getreg((3 << 11) | 20) & 0xFu; }
#define XB_SPIN(cond, bar) do { unsigned _sp = 0; while (cond) { __builtin_amdgcn_s_sleep(1); \
    if ((++_sp & 255u) == 0u) { if (xb_ld(&(bar)[XB_TMO])) break; if (_sp > XB_SPIN_CAP) { atomicAdd(&(bar)[XB_TMO], 1u); break; } } } } while (0)
struct XcdBarrier { unsigned* bar; unsigned x; volatile LAS unsigned* st; int wave; };
__device__ __forceinline__ XcdBarrier xcd_barrier_post(unsigned* bar, volatile LAS unsigned* st, int wave) {
    XcdBarrier b; b.bar = bar; b.x = xb_xcc_id(); b.st = st; b.wave = wave;
    if (wave == 0 && lane_id() == 0) (void)xb_add(&bar[XB_XCNT(b.x)], 1u);
    return b;
}
__device__ __forceinline__ void xcd_barrier_complete(unsigned* bar, unsigned x, unsigned& nloc, unsigned& nx) {
    const unsigned G = gridDim.x * gridDim.y * gridDim.z;
    unsigned sum, cnt, mine, sp = 0u;
    for (;;) {
        sum = 0u; cnt = 0u; mine = 0u;
#pragma unroll
        for (unsigned j = 0; j < 16; ++j) { const unsigned c = xb_ld(&bar[XB_XCNT(j)]); sum += c; cnt += (c > 0u) ? 1u : 0u; mine = (j == x) ? c : mine; }
        if (sum == G) break;
        __builtin_amdgcn_s_sleep(1);
        if ((++sp & 255u) == 0u) { if (xb_ld(&bar[XB_TMO])) break; if (sp > XB_SPIN_CAP) { atomicAdd(&bar[XB_TMO], 1u); break; } }
    }
    nloc = mine > 0u ? mine : 1u; nx = cnt > 0u ? cnt : 1u;
}
__device__ __forceinline__ void xcd_barrier(const XcdBarrier& b) {
    asm volatile("s_waitcnt vmcnt(0)" ::: "memory");
    __syncthreads();
    if (b.wave == 0 && lane_id() == 0) {
        unsigned* bar = b.bar;
        __builtin_amdgcn_s_waitcnt(0);
        unsigned nloc = b.st[0], nx = b.st[1];
        if (nloc == 0u) { xcd_barrier_complete(bar, b.x, nloc, nx); b.st[0] = nloc; b.st[1] = nx; }
        const unsigned old = xb_add(&bar[XB_XSUB(b.x)], 1u);
        const unsigned gen = old / nloc;
        if (old + 1u == (gen + 1u) * nloc) {
            __builtin_amdgcn_fence(__ATOMIC_RELEASE, "agent");
            asm volatile("s_waitcnt vmcnt(0)" ::: "memory");
            const unsigned og = xb_add(&bar[XB_TOP], 1u);
            const unsigned tg = og / nx;
            if (og + 1u == (tg + 1u) * nx) xb_add(&bar[XB_TOPGEN], 1u);
            else XB_SPIN(xb_ld(&bar[XB_TOPGEN]) == tg, bar);
            __builtin_amdgcn_fence(__ATOMIC_ACQUIRE, "agent");
            xb_add(&bar[XB_XGEN(b.x)], 1u);
            asm volatile("s_waitcnt vmcnt(0)" ::: "memory");
        } else {
            XB_SPIN(xb_ld(&bar[XB_XGEN(b.x)]) == gen, bar);
            __builtin_amdgcn_fence(__ATOMIC_ACQUIRE, "agent");
            asm volatile("s_waitcnt vmcnt(0)" ::: "memory");
        }
    }
    __syncthreads();
}

struct Args { const float* in[20]; float* out; unsigned char* ws; };
typedef const __attribute__((address_space(4))) Args* KArgs;
__device__ __forceinline__ KArgs kargs() { KArgs k = (KArgs)__builtin_amdgcn_kernarg_segment_ptr(); asm volatile("" : "+s"(k)); return k; }
constexpr int NWAVES = 8, NTHREADS = 512;

struct Ctx {
    LAS unsigned char* lds;
    int tid, lane, wave, G, vcu;
    unsigned char* ws;
};
__device__ __forceinline__ Ctx make_ctx(int wave) {
    extern __shared__ __attribute__((aligned(16))) unsigned char lds_dyn[];
    Ctx F; int l = lane_id(); asm volatile("" : "+v"(l)); F.lds = (LAS unsigned char*)lds_dyn; F.lane = l; F.wave = wave; F.tid = wave * 64 + l;
    F.G = (int)gridDim.x; { const int bx = (int)blockIdx.x; F.vcu = (F.G % 8 == 0) ? (bx % 8) * (F.G / 8) + bx / 8 : bx; }
    F.ws = kargs()->ws; return F; }
__device__ __forceinline__ Ctx ctx_refresh(const Ctx& F0) { return make_ctx(F0.wave); }


#ifdef CKSUM
__device__ __forceinline__ void ck_region(const Ctx& F, int k, const void* base, size_t bytes) {
    const GAS u32x4* p = (const GAS u32x4*)base; const size_t n = bytes / 16; unsigned acc = 0u;
    const int tid_ = F.wave * 64 + lane_id();
    for (size_t i = (size_t)blockIdx.x * NTHREADS + tid_; i < n; i += (size_t)F.G * NTHREADS) { const u32x4 v = __builtin_nontemporal_load(p + i); acc += v.x * 3u + v.y * 5u + v.z * 7u + v.w * 11u + (unsigned)i; }
#pragma unroll
    for (int o = 1; o < 64; o <<= 1) acc += (unsigned)sxi((int)acc, o);
    if (lane_id() == 0) atomicAdd((unsigned*)(F.ws + WS_CTL) + 8192 + 64 * k, acc);
}
#define CK(k, base, bytes) ck_region(F, k, base, bytes)
#else
#define CK(k, base, bytes) do {} while (0)
#endif
__device__ __forceinline__ void p0_transpose64(const float* W, int ldw, int k0, int n0, bf16_t* dst, int ldt, LAS float* scr, int lane) {
    f32x4 v[16];
#pragma unroll
    for (int i = 0; i < 16; ++i) { const int kk = 4 * i + (lane >> 4); v[i] = *(const GAS f32x4*)(W + (size_t)(k0 + kk) * ldw + n0 + 4 * (lane & 15)); }
#pragma unroll
    for (int i = 0; i < 16; ++i) { const int kk = 4 * i + (lane >> 4); LAS float* s = scr + kk * 65 + 4 * (lane & 15); s[0] = v[i][0]; s[1] = v[i][1]; s[2] = v[i][2]; s[3] = v[i][3]; }
    LDS_WAIT(); asm volatile("" ::: "memory");
    const int c = lane & 7;
#pragma unroll
    for (int j = 0; j < 8; ++j) { const int n = (lane >> 3) + 8 * j; const LAS float* s = scr + (8 * c) * 65 + n;
        u32x4 o; o.x = cvt_pk_bf16(s[0 * 65], s[1 * 65]); o.y = cvt_pk_bf16(s[2 * 65], s[3 * 65]); o.z = cvt_pk_bf16(s[4 * 65], s[5 * 65]); o.w = cvt_pk_bf16(s[6 * 65], s[7 * 65]);
        *(GAS u32x4*)(dst + (size_t)n * ldt + 8 * c) = o; }
    LDS_WAIT(); asm volatile("" ::: "memory");
}
__device__ __forceinline__ void p0_transpose64_fp8(const float* W, int ldw, int k0, int n0, unsigned char* dst8, int ldt, LAS float* scr, int lane, float scale) {
    f32x4 v[16];
#pragma unroll
    for (int i = 0; i < 16; ++i) { const int kk = 4 * i + (lane >> 4); v[i] = *(const GAS f32x4*)(W + (size_t)(k0 + kk) * ldw + n0 + 4 * (lane & 15)); }
#pragma unroll
    for (int i = 0; i < 16; ++i) { const int kk = 4 * i + (lane >> 4); LAS float* s = scr + kk * 65 + 4 * (lane & 15); s[0] = v[i][0] * scale; s[1] = v[i][1] * scale; s[2] = v[i][2] * scale; s[3] = v[i][3] * scale; }
    LDS_WAIT(); asm volatile("" ::: "memory");
    const int c = lane & 3;
#pragma unroll
    for (int j = 0; j < 4; ++j) { const int n = (lane >> 2) + 16 * j; const LAS float* s = scr + (16 * c) * 65 + n;
        u32x4 o;
#pragma unroll
        for (int q = 0; q < 4; ++q) { int w = __builtin_amdgcn_cvt_pk_fp8_f32(s[(4 * q) * 65], s[(4 * q + 1) * 65], 0, false); w = __builtin_amdgcn_cvt_pk_fp8_f32(s[(4 * q + 2) * 65], s[(4 * q + 3) * 65], w, true); o[q] = (unsigned)w; }
        *(GAS u32x4*)(dst8 + (size_t)n * ldt + 16 * c) = o; }
    LDS_WAIT(); asm volatile("" ::: "memory");
}
__device__ __forceinline__ void rms_row_to_bf16(const float* xrow, const float* g, bf16_t* orow, int lane) {
    const GAS f32x4* xr = (const GAS f32x4*)xrow + lane; const GAS f32x4* gr = (const GAS f32x4*)g + lane;
    f32x4 v[4]; float s = 0.f;
#pragma unroll
    for (int j = 0; j < 4; ++j) { v[j] = xr[64 * j]; s += (v[j].x * v[j].x + v[j].y * v[j].y) + (v[j].z * v[j].z + v[j].w * v[j].w); }
    const float r = 1.0f / sqrtf(wave_sum(s) * (1.f / D) + RMS_EPS);
    GAS u32x2* o8 = (GAS u32x2*)orow + lane;
#pragma unroll
    for (int j = 0; j < 4; ++j) { const f32x4 gg = gr[64 * j]; u32x2 w; w.x = cvt_pk_bf16(v[j].x * r * gg.x, v[j].y * r * gg.y); w.y = cvt_pk_bf16(v[j].z * r * gg.z, v[j].w * r * gg.w); o8[64 * j] = w; }
}
__device__ __forceinline__ int t5_bucket(int rel) {
    int ret = rel > 0 ? 16 : 0; const int n = rel < 0 ? -rel : rel;
    if (n < 8) return ret + n;
    const float nf = (float)n;
    int large = 8 + (int)(logf(nf / 8.0f) / logf(128.0f) * 8.0f);
    large = large < 15 ? large : 15;
    return ret + large;
}
__device__ __forceinline__ void p0_prologue(const Ctx& F0) {
    const KArgs ap = kargs();
    const Ctx F = ctx_refresh(F0);
    LAS float* scr = (LAS float*)(F.lds) + F.wave * (64 * 65);
    const int gw = F.vcu * NWAVES + F.wave, NGW = F.G * NWAVES;
    bf16_t* WGU_T = (bf16_t*)(F.ws + WS_WGU_T); bf16_t* WDN_T = (bf16_t*)(F.ws + WS_WDN_T); bf16_t* WIN_T = (bf16_t*)(F.ws + WS_WIN_T);
    bf16_t* WMEM_T = (bf16_t*)(F.ws + WS_WMEM_T); bf16_t* WABC_T = (bf16_t*)(F.ws + WS_WABC_T); bf16_t* WOUT_T = (bf16_t*)(F.ws + WS_WOUT_T);
    constexpr int I_IN = 16 * 116, I_MEM = 256, I_A = 8 * 16, I_B = 4 * 16, I_C = 8 * 16, I_O = 256;
    constexpr int NITEMS = I_IN + I_MEM + I_A + I_B + I_C + I_O;
    for (int it = gw; it < NITEMS; it += NGW) {
        int r = it;
        if (r < I_IN) { const int kb = r / 116, nb = r % 116; p0_transpose64(ap->in[4], IN_COLS, kb * 64, nb * 64, WIN_T + (size_t)(nb * 64) * 1024 + kb * 64, 1024, scr, F.lane); continue; } r -= I_IN;
        if (r < I_MEM) { const int kb = r >> 4, nb = r & 15; p0_transpose64(ap->in[5], 1024, kb * 64, nb * 64, WMEM_T + (size_t)(nb * 64) * 1024 + kb * 64, 1024, scr, F.lane); continue; } r -= I_MEM;
        if (r < I_A) { const int kb = r >> 4, nb = r & 15; p0_transpose64(ap->in[8], 1024, kb * 64, nb * 64, WABC_T + (size_t)(nb * 64) * ABC_LD + 0 + kb * 64, ABC_LD, scr, F.lane); continue; } r -= I_A;
        if (r < I_B) { const int kb = r >> 4, nb = r & 15; p0_transpose64(ap->in[9], 1024, kb * 64, nb * 64, WABC_T + (size_t)(nb * 64) * ABC_LD + 512 + kb * 64, ABC_LD, scr, F.lane); continue; } r -= I_B;
        if (r < I_C) { const int kb = r >> 4, nb = r & 15; p0_transpose64(ap->in[10], 1024, kb * 64, nb * 64, WABC_T + (size_t)(nb * 64) * ABC_LD + 768 + kb * 64, ABC_LD, scr, F.lane); continue; } r -= I_C;
        { const int kb = r >> 4, nb = r & 15; p0_transpose64(ap->in[11], 1024, kb * 64, nb * 64, WOUT_T + (size_t)(nb * 64) * 1024 + kb * 64, 1024, scr, F.lane); }
    }
    bf16_t* XN = (bf16_t*)(F.ws + WS_XN); bf16_t* MEMN = (bf16_t*)(F.ws + WS_MEMN);
    for (int m = gw; m < NTOK; m += NGW) rms_row_to_bf16(ap->in[0] + (size_t)m * D, ap->in[2], XN + (size_t)m * D, F.lane);
    for (int m = gw; m < NMEM; m += NGW) rms_row_to_bf16(ap->in[1] + (size_t)m * D, ap->in[3], MEMN + (size_t)m * D, F.lane);
    const int gt = F.vcu * NTHREADS + F.tid, NGT = F.G * NTHREADS;
    float* t5 = (float*)(F.ws + WS_MISC + MO_T5); float* rp = (float*)(F.ws + WS_MISC + MO_RPB);
    for (int i = gt; i < 12 * T5_LD; i += NGT) { const int gh = i / T5_LD, j = i % T5_LD, rel = j - 79, g = gh >> 2; const int dil = g == 0 ? 1 : (g == 1 ? 4 : 16);
        float v = 0.f; if (rel >= -64 && rel <= 64) v = ap->in[7][t5_bucket(rel * dil) * 12 + gh] * LOG2E; t5[i] = v; }
    for (int i = gt; i < 8 * RPB_LD; i += NGT) { const int h = i / RPB_LD, j = i % RPB_LD - RPB_OFF; float v = 0.f; if (j >= 0 && j < 465) v = ap->in[6][h * 465 + j] * LOG2E; rp[i] = v; }
}

__device__ __forceinline__ bool is_converter(int c) { return ((c >> 3) & 3) == 3; }
struct CvItem { const float* src; int ldw; unsigned char* dst; };
__device__ __forceinline__ CvItem cv_decode(int r, const float* GU, const float* DN, unsigned char* WGU8, unsigned char* WDN8) {
    constexpr int I_GU = 32 * 16 * 32; CvItem I;
    if (r < I_GU) { const int e = r >> 9, q = r & 511, kb = q >> 5, nb = q & 31, n0 = nb * 64; const int bj = n0 >> 10, rem = n0 & 1023, pn = rem >> 7, c0 = rem & 127;
        I.src = GU + (size_t)e * 1024 * 2048 + (size_t)(kb * 64) * 2048 + n0; I.ldw = 2048; I.dst = WGU8 + ((size_t)e * 2048 + pn * 256 + bj * 128 + c0) * 1024 + kb * 64; }
    else { r -= I_GU; const int e = r >> 8, q = r & 255, kb = q >> 4, nb = q & 15;
        I.src = DN + (size_t)e * 1024 * 1024 + (size_t)(kb * 64) * 1024 + nb * 64; I.ldw = 1024; I.dst = WDN8 + ((size_t)e * 1024 + nb * 64) * 1024 + kb * 64; }
    return I;
}
__device__ __forceinline__ void cv_load(const CvItem& I, f32x4 (&v)[16], int lane) {
#pragma unroll
    for (int i = 0; i < 16; ++i) { const int kk = 4 * i + (lane >> 4); v[i] = *(const GAS f32x4*)(I.src + (size_t)kk * I.ldw + 4 * (lane & 15)); }
}
__device__ __forceinline__ void cv_finish(const CvItem& I, const f32x4 (&v)[16], LAS float* scr, int lane) {
#pragma unroll
    for (int i = 0; i < 16; ++i) { const int kk = 4 * i + (lane >> 4); LAS float* s = scr + kk * 65 + 4 * (lane & 15); s[0] = v[i][0] * 64.0f; s[1] = v[i][1] * 64.0f; s[2] = v[i][2] * 64.0f; s[3] = v[i][3] * 64.0f; }
    LDS_WAIT(); asm volatile("" ::: "memory");
    const int c = lane & 3;
#pragma unroll
    for (int j = 0; j < 4; ++j) { const int n = (lane >> 2) + 16 * j; const LAS float* s = scr + (16 * c) * 65 + n;
        u32x4 o;
#pragma unroll
        for (int q = 0; q < 4; ++q) { int w = __builtin_amdgcn_cvt_pk_fp8_f32(s[(4 * q) * 65], s[(4 * q + 1) * 65], 0, false); w = __builtin_amdgcn_cvt_pk_fp8_f32(s[(4 * q + 2) * 65], s[(4 * q + 3) * 65], w, true); o[q] = (unsigned)w; }
        *(GAS u32x4*)(I.dst + (size_t)n * 1024 + 16 * c) = o; }
    LDS_WAIT(); asm volatile("" ::: "memory");
}
__device__ __forceinline__ void p1_convert_experts(const Ctx& F0) {
    const KArgs ap = kargs();
    const Ctx F = ctx_refresh(F0);
    const int c = (int)blockIdx.x; if (!is_converter(c)) return;
    LAS float* scr = (LAS float*)(F.lds) + F.wave * (64 * 65);
    const int ci = (c & 7) * 8 + (c >> 5);
    const float* GU = ap->in[15]; const float* DN = ap->in[17];
    unsigned char* WGU8 = (unsigned char*)(F.ws + WS_WGU_T); unsigned char* WDN8 = (unsigned char*)(F.ws + WS_WDN_T);
    constexpr int NIT = 32 * 16 * 32 + 32 * 16 * 16, STRIDE = 64 * NWAVES;
    int it = ci * NWAVES + F.wave;
    CvItem I = cv_decode(it, GU, DN, WGU8, WDN8); f32x4 va[16], vb[16]; cv_load(I, va, F.lane);
    for (;;) {
        const int itn = it + STRIDE; const bool hn = itn < NIT; CvItem In = I;
        if (hn) { In = cv_decode(itn, GU, DN, WGU8, WDN8); cv_load(In, vb, F.lane); }
        cv_finish(I, va, scr, F.lane);
        if (!hn) break;
        I = In; it = itn;
#pragma unroll
        for (int i = 0; i < 16; ++i) va[i] = vb[i];
    }
}

struct P1Sched {
    unsigned* ctr; LAS int* slot; int wave, x; const char* XN; const char* WIN; const char* MEMN; const char* WMEM;
    __device__ __forceinline__ bool next(int i, pg8::Unit& u) const {
        if (wave == 0) { int t = 0; if (lane_id() == 0) t = (int)__hip_atomic_fetch_add(ctr, 1u, __ATOMIC_RELAXED, __HIP_MEMORY_SCOPE_AGENT); t = __builtin_amdgcn_readfirstlane(t); if (lane_id() == 0) slot[i & 1] = t; }
        LDS_WAIT(); __builtin_amdgcn_s_barrier(); asm volatile("" ::: "memory");
        const int idx = __builtin_amdgcn_readfirstlane(slot[i & 1]);
        if (idx > 232) return false;
        u.rows = 0; u.nt = 16;
        if (idx == 232) { u.pm = x >> 2; u.pn = x & 3; u.A = MEMN + (size_t)u.pm * 256 * 2048; u.B = WMEM + (size_t)u.pn * 256 * 2048; u.aux = 3; u.scale = 1.f; return true; }
        u.pm = 8 * x + (idx & 7); u.pn = idx >> 3;
        u.A = XN + (size_t)u.pm * 256 * 2048; u.B = WIN + (size_t)u.pn * 256 * 2048;
        const int pn = u.pn;
        if (pn < 2 || (pn >= 6 && pn < 9)) { u.aux = 1; u.scale = QS64; } else if (pn == 15 || pn == 16) { u.aux = 1; u.scale = QS128; } else if (pn >= 17) { u.aux = 2; u.scale = 1.f; } else { u.aux = 0; u.scale = 1.f; }
        return true;
    }
};
struct P1Epi {
    bf16_t* PROJ; bf16_t* MKV;
    __device__ __forceinline__ void operator()(const f32x4 (&acc)[2][2][4][2], const pg8::Unit& u, int wr, int wc, int fr, int fq) const {
        bf16_t* O = u.aux == 3 ? MKV : PROJ + ((size_t)(u.pm * 29 + u.pn) << 16); const int ldo = u.aux == 3 ? 1024 : 256;
        const int row0 = (u.aux == 3 ? u.pm * 256 : 0) + wr * 64 + fr, col0 = (u.aux == 3 ? u.pn * 256 : 0) + wc * 32 + 8 * fq; const float sc = u.scale; const bool sg = u.aux == 2;
#pragma unroll
        for (int ai = 0; ai < 2; ++ai)
#pragma unroll
            for (int m = 0; m < 4; ++m) { bf16_t* rowp = O + (size_t)(row0 + ai * 128 + m * 16) * ldo + col0;
#pragma unroll
                for (int bj = 0; bj < 2; ++bj) { f32x4 v0 = acc[ai][bj][m][0], v1 = acc[ai][bj][m][1];
                    if (sg) { v0 = (f32x4){fast_sigmoid(v0[0]), fast_sigmoid(v0[1]), fast_sigmoid(v0[2]), fast_sigmoid(v0[3])}; v1 = (f32x4){fast_sigmoid(v1[0]), fast_sigmoid(v1[1]), fast_sigmoid(v1[2]), fast_sigmoid(v1[3])}; }
                    else { v0 = v0 * sc; v1 = v1 * sc; }
                    u32x4 w; w.x = cvt_pk_bf16(v0[0], v0[1]); w.y = cvt_pk_bf16(v0[2], v0[3]); w.z = cvt_pk_bf16(v1[0], v1[1]); w.w = cvt_pk_bf16(v1[2], v1[3]);
                    *(GAS u32x4*)(rowp + bj * 128) = w; } }
    }
};

template <int DH> __device__ __forceinline__ int k_addr(int key, int c) {
    if (DH == 64) return key * 128 + ((c ^ ((key >> 1) & 7)) << 4);
    else return key * 256 + ((c ^ (key & 15)) << 4);
}
template <int DH> __device__ __forceinline__ int v_addr(int key, int c) {
    if (DH == 64) return key * 128 + ((c ^ (((key >> 1) & 3) << 1)) << 4);
    else return key * 256 + ((c ^ ((key & 7) << 1)) << 4);
}
__device__ __forceinline__ s16x4 vtr(const LAS unsigned char* p) { return __builtin_bit_cast(s16x4, __builtin_amdgcn_ds_read_tr16_b64_v4i16((LAS s16x4*)p)); }

template <int DH, class RowFn> __device__ __forceinline__ void stage_kv(LAS unsigned char* Kl, LAS unsigned char* Vl, int nkeys, int tid, const RowFn& rowfn) {
    constexpr int CH = DH / 8; const int total = nkeys * CH;
    for (int base = 0; base < total; base += NTHREADS * 4) {
        u32x4 kv[4], vv[4];
#pragma unroll
        for (int j = 0; j < 4; ++j) { const int ci = base + j * NTHREADS + tid; kv[j] = (u32x4){0u, 0u, 0u, 0u}; vv[j] = kv[j];
            if (ci < total) { const int key = ci / CH, c = ci % CH; const bf16_t* kp; const bf16_t* vp; rowfn(key, kp, vp); if (kp) { kv[j] = *(const GAS u32x4*)(kp + c * 8); vv[j] = *(const GAS u32x4*)(vp + c * 8); } } }
#pragma unroll
        for (int j = 0; j < 4; ++j) { const int ci = base + j * NTHREADS + tid;
            if (ci < total) { const int key = ci / CH, c = ci % CH; *(LAS u32x4*)(Kl + k_addr<DH>(key, c)) = kv[j]; *(LAS u32x4*)(Vl + v_addr<DH>(key, c)) = vv[j]; } }
    }
}

template <int DH> __device__ __forceinline__ f32x4 qk_tile(const LAS unsigned char* Kl, int kbase, const bf16x8 (&qf)[DH / 32], int i, int g) {
    f32x4 acc = (f32x4){0.f, 0.f, 0.f, 0.f}; const int key = kbase + i;
#pragma unroll
    for (int s = 0; s < DH / 32; ++s) { const bf16x8 kf = *(const LAS bf16x8*)(Kl + k_addr<DH>(key, 4 * s + g)); acc = __builtin_amdgcn_mfma_f32_16x16x32_bf16(kf, qf[s], acc, 0, 0, 0); }
    return acc;
}
template <int DH> __device__ __forceinline__ void pv_step(f32x4 (&o)[DH / 16], const LAS unsigned char* Vl, int vbase, int vbase2, bf16x8 pf, int i, int g) {
    const int k0 = vbase + 4 * g + (i >> 2), k1 = vbase2 + 4 * g + (i >> 2); const int sub = (i & 3) >> 1, b8 = 8 * (i & 1);
#pragma unroll
    for (int n = 0; n < DH / 16; ++n) {
        const s16x4 lo = vtr(Vl + v_addr<DH>(k0, 2 * n + sub) + b8), hi = vtr(Vl + v_addr<DH>(k1, 2 * n + sub) + b8);
        const bf16x8 vf = (bf16x8){lo[0], lo[1], lo[2], lo[3], hi[0], hi[1], hi[2], hi[3]};
        o[n] = __builtin_amdgcn_mfma_f32_16x16x32_bf16(vf, pf, o[n], 0, 0, 0);
    }
}
__device__ __forceinline__ bf16x8 pack_p(const f32x4& a, const f32x4& b) {
    u32x4 w; w.x = cvt_pk_bf16(a[0], a[1]); w.y = cvt_pk_bf16(a[2], a[3]); w.z = cvt_pk_bf16(b[0], b[1]); w.w = cvt_pk_bf16(b[2], b[3]); return __builtin_bit_cast(bf16x8, w);
}
template <int NT> __device__ __forceinline__ void softmax_tiles(f32x4 (&s)[NT], float& m, float& l) {
    float mx = -INFINITY;
#pragma unroll
    for (int t = 0; t < NT; ++t) mx = fmaxf(fmaxf(fmaxf(mx, s[t][0]), fmaxf(s[t][1], s[t][2])), s[t][3]);
    mx = fmaxf(mx, sx(mx, 16)); mx = fmaxf(mx, sx(mx, 32));
    float sum = 0.f;
#pragma unroll
    for (int t = 0; t < NT; ++t) {
#pragma unroll
        for (int r = 0; r < 4; ++r) { const float p = __builtin_amdgcn_exp2f(s[t][r] - mx); s[t][r] = p; sum += p; } }
    sum += sx(sum, 16); sum += sx(sum, 32);
    m = mx; l = sum;
}
template <int DH> __device__ __forceinline__ void load_q(bf16x8 (&qf)[DH / 32], const bf16_t* qrow, int g) {
#pragma unroll
    for (int s = 0; s < DH / 32; ++s) qf[s] = *(const GAS bf16x8*)(qrow + 32 * s + 8 * g);
}
template <int DH> __device__ __forceinline__ void store_o(const f32x4 (&o)[DH / 16], float inv, bf16_t* orow, int g) {
#pragma unroll
    for (int n = 0; n < DH / 16; ++n) { u32x2 w; w.x = cvt_pk_bf16(o[n][0] * inv, o[n][1] * inv); w.y = cvt_pk_bf16(o[n][2] * inv, o[n][3] * inv); *(GAS u32x2*)(orow + 16 * n + 4 * g) = w; }
}

__device__ __forceinline__ void p2_attention(const Ctx& F0) {
    const Ctx F = ctx_refresh(F0);
    const bf16_t* PROJ = (const bf16_t*)(F.ws + WS_PROJ); const bf16_t* MKV = (const bf16_t*)(F.ws + WS_MKV);
    bf16_t* ABC = (bf16_t*)(F.ws + WS_ABC); bf16_t* OB = (bf16_t*)(F.ws + WS_OB); float* LSE = (float*)(F.ws + WS_MISC + MO_LSE);
    const float* T5 = (const float*)(F.ws + WS_MISC + MO_T5); const float* RPB = (const float*)(F.ws + WS_MISC + MO_RPB);
    LAS unsigned char* Kl = F.lds; LAS float* tab = (LAS float*)(F.lds + LDS_TAB);
    const int w = F.wave, c = (int)blockIdx.x;
#define P2_LANE() int tid_r = F.tid; asm volatile("" : "+v"(tid_r)); const int lane = tid_r & 63, i = lane & 15, g = lane >> 4; (void)lane
    {
        LAS unsigned char* Vl = Kl + 65536; P2_LANE();
        const int combo = c & 7, b = combo >> 2, h = combo & 3;
        __syncthreads();
        stage_kv<128>(Kl, Vl, 256, tid_r, [&](int key, const bf16_t*& kp, const bf16_t*& vp) { kp = MKV + (size_t)(b * MEMLEN + key) * 1024 + h * 128; vp = kp + 512; });
        LDS_WAIT(); __syncthreads();
        for (int rep = 0; rep < 2; ++rep) {
            const int blk = (c >> 3) + 32 * rep; const int tok = b * SEQ + blk * 128 + w * 16 + i;
            bf16x8 qf[4]; load_q<128>(qf, PROJ + proj_off((size_t)tok, C_QC + h * 128), g);
            f32x4 s[16];
#pragma unroll
            for (int t = 0; t < 16; ++t) s[t] = qk_tile<128>(Kl, 16 * t, qf, i, g);
            float m, l; softmax_tiles<16>(s, m, l);
            f32x4 o[8];
#pragma unroll
            for (int n = 0; n < 8; ++n) o[n] = (f32x4){0.f, 0.f, 0.f, 0.f};
#pragma unroll
            for (int u = 0; u < 8; ++u) pv_step<128>(o, Vl, 32 * u, 32 * u + 16, pack_p(s[2 * u], s[2 * u + 1]), i, g);
            store_o<128>(o, 1.0f / l, ABC + (size_t)tok * ABC_LD + 768 + h * 128, g);
        }
    }
    for (int rep = 0; rep < 4; ++rep) {
        LAS unsigned char* Vl = Kl + 73728; P2_LANE();
        const int ua = c + 256 * rep, x = ua & 7, y = ua >> 3, pair = x * 2 + (y >> 6), rp = y & 63, b = pair >> 3, h = pair & 7, r0 = 2 * rp;
        int rsU = r0 - 4; rsU = rsU < 0 ? 0 : (rsU > 120 ? 120 : rsU);
        __syncthreads();
        stage_kv<64>(Kl, Vl, 576, tid_r, [&](int key, const bf16_t*& kp, const bf16_t*& vp) { kp = nullptr; vp = nullptr; if (rsU * 64 + key < SEQ) { const size_t tok = (size_t)b * SEQ + rsU * 64 + key; kp = PROJ + proj_off(tok, C_KA + h * 64); vp = PROJ + proj_off(tok, C_VA + h * 64); } });
        for (int j = tid_r; j < RPB_LD; j += NTHREADS) tab[j] = RPB[h * RPB_LD + j];
        LDS_WAIT(); __syncthreads();
        const int r = r0 + (w >> 2), jb = w & 3; int rs = r - 4; rs = rs < 0 ? 0 : (rs > 120 ? 120 : rs);
        const int cq = 16 * jb + i; int cs = cq - 8; cs = cs < 0 ? 0 : (cs > 48 ? 48 : cs);
        const int cw = jb == 0 ? 0 : (jb == 1 ? 8 : (jb == 2 ? 24 : 32));
        const int tok = b * SEQ + r * 64 + cq;
        bf16x8 qf[2]; load_q<64>(qf, PROJ + proj_off((size_t)tok, C_QA + h * 64), g);
        const int kb0 = (rs - rsU) * 64 + cw;
        f32x4 s[16];
#pragma unroll
        for (int t = 0; t < 16; ++t) s[t] = qk_tile<64>(Kl, kb0 + (t >> 1) * 64 + 16 * (t & 1), qf, i, g);
        const int bidx = RPB_OFF + (7 - (r - rs)) * 31 + (cw + 4 * g - cq + 15); const int lo = cs - cw - 4 * g;
#pragma unroll
        for (int t = 0; t < 16; ++t) {
#pragma unroll
            for (int rr = 0; rr < 4; ++rr) { const int kc = 16 * (t & 1) + rr; const float bias = tab[bidx + (t >> 1) * 31 + kc]; const bool ok = kc >= lo && kc < lo + 16; s[t][rr] = ok ? s[t][rr] + bias : -INFINITY; } }
        float m, l; softmax_tiles<16>(s, m, l);
        f32x4 o[4];
#pragma unroll
        for (int n = 0; n < 4; ++n) o[n] = (f32x4){0.f, 0.f, 0.f, 0.f};
#pragma unroll
        for (int u = 0; u < 8; ++u) pv_step<64>(o, Vl, kb0 + u * 64, kb0 + u * 64 + 16, pack_p(s[2 * u], s[2 * u + 1]), i, g);
        store_o<64>(o, 1.0f / l, ABC + (size_t)tok * ABC_LD + h * 64, g);
    }
    for (int rep = 0; rep < 6; ++rep) {
        LAS unsigned char* Vl = Kl + 34816; P2_LANE();
        const int ub = c + 256 * rep, x = ub & 7, y = ub >> 3, combo = x * 3 + y / 64, sub = y % 64, b = combo / 12, hh = combo % 12, grp = hh >> 2;
        const int dil = grp == 0 ? 1 : (grp == 1 ? 4 : 16), L = SEQ / dil, nb = L / 128, rho = sub / nb, n = sub % nb;
        const int p0 = 128 * n - 64;
        __syncthreads();
        stage_kv<64>(Kl, Vl, 272, tid_r, [&](int key, const bf16_t*& kp, const bf16_t*& vp) { const int p = p0 + key; kp = nullptr; vp = nullptr;
            if (key < 256 && p >= 0 && p < L) { const size_t tok = (size_t)b * SEQ + (size_t)p * dil + rho; kp = PROJ + proj_off(tok, C_KB + hh * 64); vp = PROJ + proj_off(tok, C_VB + hh * 64); } });
        for (int j = tid_r; j < T5_LD; j += NTHREADS) tab[j] = T5[hh * T5_LD + j];
        LDS_WAIT(); __syncthreads();
        const int pq = 128 * n + 16 * w + i; const int tok = b * SEQ + pq * dil + rho;
        bf16x8 qf[2]; load_q<64>(qf, PROJ + proj_off((size_t)tok, C_QB + hh * 64), g);
        f32x4 s[10];
#pragma unroll
        for (int t = 0; t < 10; ++t) s[t] = qk_tile<64>(Kl, 16 * w + 16 * t, qf, i, g);
        const int rel0 = 4 * g - 64 - i;
#pragma unroll
        for (int t = 0; t < 10; ++t) {
#pragma unroll
            for (int rr = 0; rr < 4; ++rr) { const int rel = rel0 + 16 * t + rr; const int p = pq + rel; const float bias = tab[rel + 79]; const bool ok = rel >= -64 && rel <= 64 && p >= 0 && p < L; s[t][rr] = ok ? s[t][rr] + bias : -INFINITY; } }
        float m, l; softmax_tiles<10>(s, m, l);
        f32x4 o[4];
#pragma unroll
        for (int nn = 0; nn < 4; ++nn) o[nn] = (f32x4){0.f, 0.f, 0.f, 0.f};
#pragma unroll
        for (int u = 0; u < 5; ++u) pv_step<64>(o, Vl, 16 * w + 32 * u, 16 * w + 32 * u + 16, pack_p(s[2 * u], s[2 * u + 1]), i, g);
        const int h4 = hh & 3;
        store_o<64>(o, 1.0f / l, OB + ((size_t)grp * NTOK + tok) * 256 + h4 * 64, g);
        if (g == 0) LSE[((size_t)grp * NTOK + tok) * 4 + h4] = m + __builtin_amdgcn_logf(l);
    }
}
#undef P2_LANE
__device__ __forceinline__ void p2b_merge(const Ctx& F0) {
    const Ctx F = ctx_refresh(F0);
    const bf16_t* OB = (const bf16_t*)(F.ws + WS_OB); const float* LSE = (const float*)(F.ws + WS_MISC + MO_LSE); bf16_t* ABC = (bf16_t*)(F.ws + WS_ABC);
    const int gt = F.vcu * NTHREADS + F.tid, NGT = F.G * NTHREADS;
    for (int it = gt; it < NTOK * 32; it += NGT) {
        const int tok = it >> 5, ch = it & 31, h = ch >> 3;
        const float l0 = LSE[(size_t)tok * 4 + h], l1 = LSE[((size_t)NTOK + tok) * 4 + h], l2 = LSE[((size_t)2 * NTOK + tok) * 4 + h];
        const float mx = fmaxf(l0, fmaxf(l1, l2)); float w0 = __builtin_amdgcn_exp2f(l0 - mx), w1 = __builtin_amdgcn_exp2f(l1 - mx), w2 = __builtin_amdgcn_exp2f(l2 - mx);
        const float inv = 1.0f / (w0 + w1 + w2); w0 *= inv; w1 *= inv; w2 *= inv;
        const u32x4 a = *(const GAS u32x4*)(OB + (size_t)tok * 256 + ch * 8), bq = *(const GAS u32x4*)(OB + ((size_t)NTOK + tok) * 256 + ch * 8), cq = *(const GAS u32x4*)(OB + ((size_t)2 * NTOK + tok) * 256 + ch * 8);
        u32x4 o;
#pragma unroll
        for (int j = 0; j < 4; ++j) { const float lo = w0 * bf_lo(a[j]) + w1 * bf_lo(bq[j]) + w2 * bf_lo(cq[j]), hi = w0 * bf_hi(a[j]) + w1 * bf_hi(bq[j]) + w2 * bf_hi(cq[j]); o[j] = cvt_pk_bf16(lo, hi); }
        *(GAS u32x4*)(ABC + (size_t)tok * ABC_LD + 512 + ch * 8) = o;
    }
}

struct P3Sched {
    int c; const char* ABCp; const char* WABC;
    __device__ __forceinline__ bool next(int i, pg8::Unit& u) const {
        if (i >= 3) return false;
        constexpr int nM = 64, nN = 4, nwg = 256;
        int wgid = c; { const int q = nwg / 8, xcd = wgid % 8, off = wgid / 8; wgid = xcd * q + off; }
        const int nig = 8 * nN, gid = wgid / nig, fm = gid * 8;
        u.pm = fm + ((wgid % nig) % 8); u.pn = (wgid % nig) / 8;
        const int sb = ((c >> 3) & 1) ? (i == 0 ? 1 : (i == 1 ? 0 : 2)) : i;
        const int koff = sb == 0 ? 0 : (sb == 1 ? 512 : 768);
        u.A = ABCp + (size_t)u.pm * 256 * (ABC_LD * 2) + koff * 2; u.B = WABC + (size_t)u.pn * 256 * (ABC_LD * 2) + koff * 2;
        u.rows = 0; u.nt = sb == 1 ? 4 : 8; u.aux = sb; u.scale = i == 0 ? 0.f : 1.f; return true;
    }
};
struct P3Epi {
    const bf16_t* PROJ; bf16_t* MERGED;
    __device__ __forceinline__ void operator()(const f32x4 (&acc)[2][2][4][2], const pg8::Unit& u, int wr, int wc, int fr, int fq) const {
        const int row0 = u.pm * 256 + wr * 64 + fr, col0 = u.pn * 256 + wc * 32 + 8 * fq; const int s = u.aux;
#pragma unroll
        for (int ai = 0; ai < 2; ++ai) {
            u32x4 gt[4][2], prev[4][2];
#pragma unroll
            for (int m = 0; m < 4; ++m)
#pragma unroll
                for (int bj = 0; bj < 2; ++bj) { const size_t row = (size_t)(row0 + ai * 128 + m * 16); const int col = col0 + bj * 128;
                    gt[m][bj] = *(const GAS u32x4*)(PROJ + proj_off(row, C_GATE + s * 1024 + col));
                    prev[m][bj] = (u32x4){0u, 0u, 0u, 0u}; if (u.scale != 0.f) prev[m][bj] = __builtin_nontemporal_load((const GAS u32x4*)(MERGED + row * 1024 + col)); }
            asm volatile("" ::: "memory");
#pragma unroll
            for (int m = 0; m < 4; ++m)
#pragma unroll
                for (int bj = 0; bj < 2; ++bj) { const size_t row = (size_t)(row0 + ai * 128 + m * 16); const int col = col0 + bj * 128;
                    const f32x4 v0 = acc[ai][bj][m][0], v1 = acc[ai][bj][m][1]; const u32x4 g = gt[m][bj], pv = prev[m][bj];
                    u32x4 o;
                    o.x = cvt_pk_bf16(bf_lo(pv.x) + bf_lo(g.x) * v0[0], bf_hi(pv.x) + bf_hi(g.x) * v0[1]);
                    o.y = cvt_pk_bf16(bf_lo(pv.y) + bf_lo(g.y) * v0[2], bf_hi(pv.y) + bf_hi(g.y) * v0[3]);
                    o.z = cvt_pk_bf16(bf_lo(pv.z) + bf_lo(g.z) * v1[0], bf_hi(pv.z) + bf_hi(g.z) * v1[1]);
                    o.w = cvt_pk_bf16(bf_lo(pv.w) + bf_lo(g.w) * v1[2], bf_hi(pv.w) + bf_hi(g.w) * v1[3]);
                    *(GAS u32x4*)(MERGED + row * 1024 + col) = o; }
            asm volatile("" ::: "memory");
        }
    }
};
struct P4Sched {
    int c; const char* MERGED; const char* WOUT;
    __device__ __forceinline__ bool next(int i, pg8::Unit& u) const {
        if (i >= 1) return false;
        constexpr int nN = 4, nwg = 256;
        int wgid = c; { const int q = nwg / 8, xcd = wgid % 8, off = wgid / 8; wgid = xcd * q + off; }
        const int nig = 8 * nN, gid = wgid / nig, fm = gid * 8;
        u.pm = fm + ((wgid % nig) % 8); u.pn = (wgid % nig) / 8;
        u.A = MERGED + (size_t)u.pm * 256 * 2048; u.B = WOUT + (size_t)u.pn * 256 * 2048; u.rows = 0; u.nt = 16; u.aux = 0; u.scale = 1.f; return true;
    }
};
struct P4Epi {
    const float* X; float* X1;
    __device__ __forceinline__ void operator()(const f32x4 (&acc)[2][2][4][2], const pg8::Unit& u, int wr, int wc, int fr, int fq) const {
        const int row0 = u.pm * 256 + wr * 64 + fr, col0 = u.pn * 256 + wc * 32 + 8 * fq;
#pragma unroll
        for (int ai = 0; ai < 2; ++ai) {
            f32x4 xv[4][2][2];
#pragma unroll
            for (int m = 0; m < 4; ++m)
#pragma unroll
                for (int bj = 0; bj < 2; ++bj) { const size_t off = (size_t)(row0 + ai * 128 + m * 16) * 1024 + col0 + bj * 128; xv[m][bj][0] = *(const GAS f32x4*)(X + off); xv[m][bj][1] = *(const GAS f32x4*)(X + off + 4); }
            asm volatile("" ::: "memory");
#pragma unroll
            for (int m = 0; m < 4; ++m)
#pragma unroll
                for (int bj = 0; bj < 2; ++bj) { const size_t off = (size_t)(row0 + ai * 128 + m * 16) * 1024 + col0 + bj * 128;
                    *(GAS f32x4*)(X1 + off) = xv[m][bj][0] + acc[ai][bj][m][0]; *(GAS f32x4*)(X1 + off + 4) = xv[m][bj][1] + acc[ai][bj][m][1]; }
            asm volatile("" ::: "memory");
        }
    }
};
__device__ __forceinline__ void p5_router(const Ctx& F0) {
    const KArgs ap = kargs(); const float* X1 = ap->out; const float* GF = ap->in[12]; const float* RW = ap->in[13]; const float* RB = ap->in[14];
    const Ctx F = ctx_refresh(F0);
    unsigned char* H8 = F.ws + WS_XN; float* RTOK = (float*)(F.ws + WS_MISC + MO_RTOK);
    int* TOPIDX = (int*)(F.ws + WS_MISC + MO_TOPIDX); float* TOPW = (float*)(F.ws + WS_MISC + MO_TOPW); int* HIST = (int*)(F.ws + WS_MISC + MO_HIST);
    LAS float* Wl = (LAS float*)F.lds;
    LAS float* xch = (LAS float*)(F.lds + 131072);
    LAS float* xss = (LAS float*)(F.lds + 131072 + 8192);
    LAS int* hist = (LAS int*)(F.lds + LDS_TAB);
    __syncthreads();
    for (int idx = F.tid; idx < 1024 * 8; idx += NTHREADS) { const int k = idx >> 3, q = idx & 7; const f32x4 wv = *(const GAS f32x4*)(RW + (size_t)k * 32 + 4 * q) * GF[k];
        *(LAS f32x4*)(Wl + k * 32 + ((4 * q) ^ (((k >> 5) & 1) << 4))) = wv; }
    if (F.tid < 32) hist[F.tid] = 0;
    LDS_WAIT(); __syncthreads();
    const int lane = F.lane, i = lane & 15, kq = lane >> 4, tg = F.wave & 3, kh = F.wave >> 2; const int bid = (int)blockIdx.x;
    const int tok = bid * 64 + tg * 16 + i; const int kbase = kh * 512 + 32 * kq;
    const float* xrow = X1 + (size_t)tok * D + kbase; const float* grow = GF + kbase;
    const LAS float* wb0 = Wl + kbase * 32 + (i ^ ((kq & 1) << 4)); const LAS float* wb1 = Wl + kbase * 32 + ((i + 16) ^ ((kq & 1) << 4));
    f32x4 acc0 = {0.f, 0.f, 0.f, 0.f}, acc1 = {0.f, 0.f, 0.f, 0.f}; float ss = 0.f;
#pragma unroll 1
    for (int c = 0; c < 4; ++c) {
        f32x4 xv[8], gv[8];
#pragma unroll
        for (int q = 0; q < 8; ++q) { xv[q] = *(const GAS f32x4*)(xrow + c * 128 + 4 * q); gv[q] = *(const GAS f32x4*)(grow + c * 128 + 4 * q); }
        unsigned o[8];
#pragma unroll
        for (int q = 0; q < 8; ++q) { const f32x4 x = xv[q], pq = x * gv[q]; ss += (x.x * x.x + x.y * x.y) + (x.z * x.z + x.w * x.w);
            int w = __builtin_amdgcn_cvt_pk_fp8_f32(pq.x, pq.y, 0, false); w = __builtin_amdgcn_cvt_pk_fp8_f32(pq.z, pq.w, w, true); o[q] = (unsigned)w; }
        GAS u32x4* op = (GAS u32x4*)(H8 + (size_t)tok * D + kbase + c * 128);
        op[0] = (u32x4){o[0], o[1], o[2], o[3]}; op[1] = (u32x4){o[4], o[5], o[6], o[7]};
#pragma unroll
        for (int j = 0; j < 32; ++j) { const float a = xv[j >> 2][j & 3]; const float b0 = wb0[(c * 128 + j) * 32], b1 = wb1[(c * 128 + j) * 32];
            acc0 = __builtin_amdgcn_mfma_f32_16x16x4f32(a, b0, acc0, 0, 0, 0); acc1 = __builtin_amdgcn_mfma_f32_16x16x4f32(a, b1, acc1, 0, 0, 0); }
    }
    ss += sx(ss, 16); ss += sx(ss, 32);
    if (kh == 1) { LAS float* xp = xch + (tg * 64 + lane) * 8; *(LAS f32x4*)xp = acc0; *(LAS f32x4*)(xp + 4) = acc1; if (lane < 16) xss[tg * 16 + lane] = ss; }
    LDS_WAIT(); __syncthreads();
    if (kh == 0) {
        const LAS float* xp = xch + (tg * 64 + lane) * 8; acc0 += *(const LAS f32x4*)xp; acc1 += *(const LAS f32x4*)(xp + 4); ss += xss[tg * 16 + i];
        const float rt = 1.0f / sqrtf(ss * (1.f / D) + RMS_EPS);
        if (lane < 16) RTOK[tok] = rt;
        const float bias0 = RB[i], bias1 = RB[i + 16];
        float c0[4], c1[4];
#pragma unroll
        for (int r = 0; r < 4; ++r) { const float rr = sidx(rt, 4 * kq + r); c0[r] = acc0[r] * rr + bias0; c1[r] = acc1[r] * rr + bias1; }
        float tv[4][4]; int ti[4][4];
#pragma unroll
        for (int k = 0; k < 4; ++k)
#pragma unroll
            for (int r = 0; r < 4; ++r) { float bv = c0[r] >= c1[r] ? c0[r] : c1[r]; int bi = c0[r] >= c1[r] ? i : i + 16;
#pragma unroll
                for (int off = 1; off < 16; off <<= 1) { const float ov = sx(bv, off); const int oi = sxi(bi, off); const bool take = (ov > bv) || (ov == bv && oi < bi); bv = take ? ov : bv; bi = take ? oi : bi; }
                tv[k][r] = bv; ti[k][r] = bi; if (bi == i) c0[r] = -INFINITY; if (bi == i + 16) c1[r] = -INFINITY; }
        if (i == 0) {
#pragma unroll
            for (int r = 0; r < 4; ++r) { const int t = bid * 64 + tg * 16 + 4 * kq + r;
                const float e1 = __expf(tv[1][r] - tv[0][r]), e2 = __expf(tv[2][r] - tv[0][r]), e3 = __expf(tv[3][r] - tv[0][r]); const float inv = 1.0f / (1.0f + e1 + e2 + e3);
                *(GAS i32x4*)(TOPIDX + t * 4) = (i32x4){ti[0][r], ti[1][r], ti[2][r], ti[3][r]}; *(GAS f32x4*)(TOPW + t * 4) = (f32x4){inv, e1 * inv, e2 * inv, e3 * inv};
                atomicAdd((int*)&hist[ti[0][r]], 1); atomicAdd((int*)&hist[ti[1][r]], 1); atomicAdd((int*)&hist[ti[2][r]], 1); atomicAdd((int*)&hist[ti[3][r]], 1); }
        }
    }
    LDS_WAIT(); __syncthreads();
    if (F.tid < 32) HIST[bid * 32 + F.tid] = hist[F.tid];
}
__device__ __forceinline__ void p6_slots(const Ctx& F0) {
    const Ctx F = ctx_refresh(F0);
    const int* TOPIDX = (const int*)(F.ws + WS_MISC + MO_TOPIDX); const float* TOPW = (const float*)(F.ws + WS_MISC + MO_TOPW); const int* HIST = (const int*)(F.ws + WS_MISC + MO_HIST);
    int* TOKSLOT = (int*)(F.ws + WS_MISC + MO_TOKSLOT); int* SLOTTOK = (int*)(F.ws + WS_MISC + MO_SLOTTOK); float* SLOTW = (float*)(F.ws + WS_MISC + MO_SLOTW); int* TILE = (int*)(F.ws + WS_MISC + MO_TILE);
    LAS int* part = (LAS int*)F.lds;
    LAS int* pref = part + 512;
    LAS int* tot = part + 1024;
    LAS int* mypre = tot + 32; LAS int* sbase = tot + 64; LAS int* wcnt = tot + 96;
    const int bid = (int)blockIdx.x, tid = F.tid;
    __syncthreads();
    { const int e = tid & 31, ch = tid >> 5; int s = 0, p = 0;
        for (int j = 0; j < 16; ++j) { const int bb = ch * 16 + j; const int hv = HIST[bb * 32 + e]; s += hv; if (bb < bid) p += hv; }
        part[ch * 32 + e] = s; pref[ch * 32 + e] = p; }
    LDS_WAIT(); __syncthreads();
    if (tid < 32) { int s = 0, p = 0; for (int ch = 0; ch < 16; ++ch) { s += part[ch * 32 + tid]; p += pref[ch * 32 + tid]; } tot[tid] = s; mypre[tid] = p; }
    LDS_WAIT(); __syncthreads();
    if (tid == 0) { int tb = 0; for (int e = 0; e < 32; ++e) { sbase[e] = tb * 256; const int nt = (tot[e] + 255) >> 8; if (bid == 0) { for (int j = 0; j < nt; ++j) TILE[1 + tb + j] = e; } tb += nt; } if (bid == 0) TILE[0] = tb; }
    LDS_WAIT(); __syncthreads();
    int e_me = 0, rank = 0; float w_me = 0.f; const int ent = tid;
    if (tid < 256) { e_me = TOPIDX[bid * 256 + ent]; w_me = TOPW[bid * 256 + ent];
        const int wv = tid >> 6;
        for (int e = 0; e < 32; ++e) { const unsigned long long bal = __ballot(e_me == e); if (e_me == e) rank = __builtin_popcountll(bal & ((1ull << F.lane) - 1ull)); if (F.lane == 0) wcnt[wv * 32 + e] = __builtin_popcountll(bal); } }
    LDS_WAIT(); __syncthreads();
    if (tid < 256) { const int wv = tid >> 6; for (int j = 0; j < wv; ++j) rank += wcnt[j * 32 + e_me];
        const int slot = sbase[e_me] + mypre[e_me] + rank; const int tok = bid * 64 + (ent >> 2);
        SLOTTOK[slot] = tok; SLOTW[slot] = w_me; TOKSLOT[bid * 256 + ent] = slot; }
    if (bid < 32) { const int e = bid; const int beg = sbase[e] + tot[e], end = sbase[e] + (((tot[e] + 255) >> 8) << 8); for (int s = beg + tid; s < end; s += NTHREADS) { SLOTTOK[s] = 0; SLOTW[s] = 0.f; } }
}
constexpr int LDS_ROWS = 139264, LDS_TILE = 139264 + 11 * 1024;
static_assert(LDS_TILE + 4 * (1 + MAX_TILES) <= LDS_MISC, "LDS tables");
template <int NPN, bool ROWS> __device__ __forceinline__ void moe_tables(const Ctx& F, const int* TILE, const int* SLOTTOK) {
    LAS int* tl = (LAS int*)(F.lds + LDS_TILE);
    __syncthreads();
    for (int j = F.tid; j < 1 + MAX_TILES; j += NTHREADS) tl[j] = __hip_atomic_load((int*)TILE + j, __ATOMIC_RELAXED, __HIP_MEMORY_SCOPE_AGENT);
    if (ROWS) { const int ntile = __builtin_amdgcn_readfirstlane(__hip_atomic_load((int*)TILE, __ATOMIC_RELAXED, __HIP_MEMORY_SCOPE_AGENT));
        for (int i = 0; i < 11; ++i) { const int L = i * F.G + (int)blockIdx.x; if (L >= ntile * NPN) break; const int m = L / NPN;
            if (F.tid < 256) ((LAS int*)(F.lds + LDS_ROWS))[i * 256 + F.tid] = SLOTTOK[m * 256 + F.tid]; } }
    LDS_WAIT(); __syncthreads();
}
struct P7Sched {
    int G, c; LAS const int* tl; const char* H2; const char* WGU; int ntile;
    __device__ __forceinline__ bool next(int i, pg8::Unit& u) const {
        const int L = i * G + c; if (L >= ntile * 8 || i >= 11) return false;
        const int m = L >> 3, pn = L & 7, e = __builtin_amdgcn_readfirstlane(tl[1 + m]);
        u.pm = m; u.pn = pn; u.aux = e; u.scale = 1.f; u.nt = 8; u.rows = LDS_ROWS + 1024 * i; u.A = H2; u.B = WGU + ((size_t)e * 2048 + pn * 256) * 1024; return true;
    }
};
struct P7Epi {
    const float* BGU; bf16_t* ACT; const float* RTOK; LAS const unsigned char* lds;
    __device__ __forceinline__ void operator()(const f32x4 (&acc)[2][2][4][2], const pg8::Unit& u, int wr, int wc, int fr, int fq) const {
        const int row0 = u.pm * 256 + wr * 64 + fr, cc0 = wc * 32 + 8 * fq, e = u.aux;
        float rr[2][4];
#pragma unroll
        for (int ai = 0; ai < 2; ++ai)
#pragma unroll
            for (int m = 0; m < 4; ++m) rr[ai][m] = RTOK[((LAS const int*)(lds + u.rows))[wr * 64 + fr + ai * 128 + m * 16]];
        const float* bg = BGU + (size_t)e * 2048 + u.pn * 128 + cc0; const float* bu = bg + 1024;
        const f32x4 bg0 = *(const GAS f32x4*)bg, bg1 = *(const GAS f32x4*)(bg + 4), bu0 = *(const GAS f32x4*)bu, bu1 = *(const GAS f32x4*)(bu + 4);
#pragma unroll
        for (int ai = 0; ai < 2; ++ai)
#pragma unroll
            for (int m = 0; m < 4; ++m) { const size_t row = (size_t)(row0 + ai * 128 + m * 16);
                float av[8];
#pragma unroll
                for (int n = 0; n < 2; ++n) { const f32x4 gv = acc[ai][0][m][n] * rr[ai][m] + (n ? bg1 : bg0), uv = acc[ai][1][m][n] * rr[ai][m] + (n ? bu1 : bu0);
#pragma unroll
                    for (int j = 0; j < 4; ++j) { const float gg = fminf(gv[j], 7.0f); const float uu = fminf(fmaxf(uv[j], -7.0f), 7.0f); av[4 * n + j] = (uu + 1.0f) * gg * fast_sigmoid(1.702f * gg); } }
                int w0 = __builtin_amdgcn_cvt_pk_fp8_f32(av[0], av[1], 0, false); w0 = __builtin_amdgcn_cvt_pk_fp8_f32(av[2], av[3], w0, true);
                int w1 = __builtin_amdgcn_cvt_pk_fp8_f32(av[4], av[5], 0, false); w1 = __builtin_amdgcn_cvt_pk_fp8_f32(av[6], av[7], w1, true);
                *(GAS u32x2*)((unsigned char*)ACT + row * 1024 + u.pn * 128 + cc0) = (u32x2){(unsigned)w0, (unsigned)w1}; }
    }
};
struct P8Sched {
    int G, c; LAS const int* tl; const char* ACT; const char* WDN; int ntile;
    __device__ __forceinline__ bool next(int i, pg8::Unit& u) const {
        const int L = i * G + c; if (L >= ntile * 4) return false;
        const int m = L >> 2, pn = L & 3, e = __builtin_amdgcn_readfirstlane(tl[1 + m]);
        u.pm = m; u.pn = pn; u.aux = e; u.scale = 1.f; u.nt = 8; u.rows = 0; u.A = ACT + (size_t)m * 256 * 1024; u.B = WDN + ((size_t)e * 1024 + pn * 256) * 1024; return true;
    }
};
struct P8Epi {
    const float* BDN; const float* SLOTW; bf16_t* YS;
    __device__ __forceinline__ void operator()(const f32x4 (&acc)[2][2][4][2], const pg8::Unit& u, int wr, int wc, int fr, int fq) const {
        const int row0 = u.pm * 256 + wr * 64 + fr, col0 = u.pn * 256 + wc * 32 + 8 * fq, e = u.aux;
        const float* bp = BDN + (size_t)e * 1024 + col0;
        f32x4 bv[2][2]; float sw[2][4];
#pragma unroll
        for (int bj = 0; bj < 2; ++bj) { bv[bj][0] = *(const GAS f32x4*)(bp + bj * 128); bv[bj][1] = *(const GAS f32x4*)(bp + bj * 128 + 4); }
#pragma unroll
        for (int ai = 0; ai < 2; ++ai)
#pragma unroll
            for (int m = 0; m < 4; ++m) sw[ai][m] = SLOTW[row0 + ai * 128 + m * 16];
        asm volatile("" ::: "memory");
#pragma unroll
        for (int ai = 0; ai < 2; ++ai)
#pragma unroll
            for (int m = 0; m < 4; ++m) { const size_t row = (size_t)(row0 + ai * 128 + m * 16); const float w_ = sw[ai][m];
#pragma unroll
                for (int bj = 0; bj < 2; ++bj) { const f32x4 v0 = (acc[ai][bj][m][0] + bv[bj][0]) * w_, v1 = (acc[ai][bj][m][1] + bv[bj][1]) * w_;
                    int w0 = __builtin_amdgcn_cvt_pk_fp8_f32(v0[0], v0[1], 0, false); w0 = __builtin_amdgcn_cvt_pk_fp8_f32(v0[2], v0[3], w0, true);
                    int w1 = __builtin_amdgcn_cvt_pk_fp8_f32(v1[0], v1[1], 0, false); w1 = __builtin_amdgcn_cvt_pk_fp8_f32(v1[2], v1[3], w1, true);
                    *(GAS u32x2*)((unsigned char*)YS + row * 1024 + col0 + bj * 128) = (u32x2){(unsigned)w0, (unsigned)w1}; } }
    }
};
__device__ __forceinline__ void p9_final(const Ctx& F0) {
    const KArgs ap = kargs(); struct { const float* in[20]; float* out; } a; a.in[19] = ap->in[19]; a.out = ap->out;
    const Ctx F = ctx_refresh(F0);
    float* OUT = a.out; const bf16_t* YS = (const bf16_t*)(F.ws + WS_YS); const int* TOKSLOT = (const int*)(F.ws + WS_MISC + MO_TOKSLOT); const float* GN = a.in[19];
    const int gw = F.vcu * NWAVES + F.wave, NGW = F.G * NWAVES, lane = F.lane;
    const GAS f32x4* gr = (const GAS f32x4*)GN + lane;
    const bool bad = ld_uniform((const int*)(F.ws + WS_CTL) + 4096 + XB_TMO) != 0;
    float ckscale = 1.0f;
#ifdef CKSUM
    { const int* prev = (const int*)(F.ws + WS_MISC + 7 * MiB); if (ld_uniform(prev) == 0x5EED1234) ckscale = 1.0f + 0.25f * (float)ld_uniform(prev + 1); }
#endif
    for (int tok = gw; tok < NTOK; tok += NGW) {
        GAS f32x4* xr = (GAS f32x4*)(OUT + (size_t)tok * D) + lane;
        f32x4 v[4];
#pragma unroll
        for (int jj = 0; jj < 4; ++jj) v[jj] = xr[64 * jj];
        const int slots[4] = {ld_uniform(TOKSLOT + tok * 4), ld_uniform(TOKSLOT + tok * 4 + 1), ld_uniform(TOKSLOT + tok * 4 + 2), ld_uniform(TOKSLOT + tok * 4 + 3)};
#pragma unroll
        for (int k = 0; k < 4; ++k) { const GAS unsigned* yr = (const GAS unsigned*)((const unsigned char*)YS + (size_t)slots[k] * 1024) + lane;
#pragma unroll
            for (int jj = 0; jj < 4; ++jj) { const unsigned y = yr[64 * jj]; const f32x2 lo = __builtin_amdgcn_cvt_pk_f32_fp8((int)y, false), hi = __builtin_amdgcn_cvt_pk_f32_fp8((int)y, true);
                v[jj].x += lo.x; v[jj].y += lo.y; v[jj].z += hi.x; v[jj].w += hi.y; } }
        float ss = 0.f;
#pragma unroll
        for (int jj = 0; jj < 4; ++jj) ss += (v[jj].x * v[jj].x + v[jj].y * v[jj].y) + (v[jj].z * v[jj].z + v[jj].w * v[jj].w);
        const float r = 1.0f / sqrtf(wave_sum(ss) * (1.f / D) + RMS_EPS);
#pragma unroll
        for (int jj = 0; jj < 4; ++jj) { const f32x4 gg = gr[64 * jj]; f32x4 o = (f32x4){v[jj].x * r * gg.x, v[jj].y * r * gg.y, v[jj].z * r * gg.z, v[jj].w * r * gg.w} * ckscale; if (bad) o = (f32x4){__builtin_nanf(""), __builtin_nanf(""), __builtin_nanf(""), __builtin_nanf("")}; xr[64 * jj] = o; }
    }
}

__device__ __forceinline__ void grid_barrier(int wave) {
    extern __shared__ __attribute__((aligned(16))) unsigned char lds_dyn[];
    XcdBarrier b; b.bar = (unsigned*)(kargs()->ws + WS_CTL) + 4096; b.x = xb_xcc_id(); b.st = (volatile LAS unsigned*)((LAS unsigned char*)lds_dyn + LDS_MISC) + 8; b.wave = wave;
    xcd_barrier(b);
}
__global__ void __launch_bounds__(NTHREADS, 2) fwd_megakernel(Args args) {
    const int wave = __builtin_amdgcn_readfirstlane((int)threadIdx.x >> 6);
    {
        const Ctx F = make_ctx(wave);
        volatile LAS unsigned* MISC = (volatile LAS unsigned*)(F.lds + LDS_MISC);
        for (int u = F.tid; u < 128; u += NTHREADS) MISC[u] = 0u;
        __syncthreads();
        (void)xcd_barrier_post((unsigned*)(F.ws + WS_CTL) + 4096, MISC + 8, wave);
    }
#ifndef TSK
#define TSK -1
#endif
#ifndef TSB
#define TSB 0
#endif
    unsigned long long ts0_ = 0ull, ts1_ = 0ull; if (TSK >= 0) ts0_ = __builtin_amdgcn_s_memrealtime();
#define TS(k) do { if (TSK == (k)) ts1_ = __builtin_amdgcn_s_memrealtime(); } while (0)
#define F make_ctx(wave)
#define ws (kargs()->ws)
#define xcd_barrier(bar) grid_barrier(wave)
#ifndef PHM
#define PHM 0xFFFF
#endif
#define PH(k) ((PHM >> (k)) & 1)
#ifndef PHR
#define PHR 0
#endif
#define RP(k) ((PHR >> (k)) & 1)
#ifdef CANARY
    {
        const size_t n16 = (WS_END - WS_MISC) / 16; GAS u32x4* p = (GAS u32x4*)(ws + WS_MISC);
        for (size_t i = (size_t)blockIdx.x * NTHREADS + F.tid; i < n16; i += (size_t)F.G * NTHREADS) p[i] = (u32x4){0xffffffffu, 0xffffffffu, 0xffffffffu, 0xffffffffu};
        GAS u32x4* q = (GAS u32x4*)kargs()->out;
        for (size_t i = (size_t)blockIdx.x * NTHREADS + F.tid; i < (size_t)NTOK * D / 4; i += (size_t)F.G * NTHREADS) q[i] = (u32x4){0xffffffffu, 0xffffffffu, 0xffffffffu, 0xffffffffu};
        xcd_barrier(bar);
    }
#endif
    if (PH(0)) p0_prologue(F);
    xcd_barrier(bar);
    if (RP(0)) { p0_prologue(F); xcd_barrier(bar); }
    TS(0);
    CK(1, ws + WS_WIN_T, WS_MKV - WS_WIN_T); CK(1, ws + WS_XN, WS_ABC - WS_XN); CK(1, ws + WS_WGU_T, WS_PROJ - WS_WGU_T); CK(1, ws + WS_MISC + MO_T5, 128 * 1024);
    for (int rp_ = 0; rp_ < 1 + RP(1); ++rp_) {
    if (PH(1)) {
        p1_convert_experts(F);
        TS(12);
        P1Sched S{(unsigned*)(ws + WS_CTL) + 12288 + 64 * ((int)blockIdx.x & 7), (LAS int*)(F.lds + LDS_MISC) + 32, F.wave, (int)blockIdx.x & 7, (const char*)(ws + WS_XN), (const char*)(ws + WS_WIN_T), (const char*)(ws + WS_MEMN), (const char*)(ws + WS_WMEM_T)};
        P1Epi E{(bf16_t*)(ws + WS_PROJ), (bf16_t*)(ws + WS_MKV)};
        pg8::gemm_phase<P1Epi, P1Sched, false>(F.lds, F.wave, 2048u, 2048u, S, E);
    }
    xcd_barrier(bar);
    }
    TS(1);
    CK(2, ws + WS_PROJ, WS_ACT - WS_PROJ); CK(2, ws + WS_MKV, 1 * MiB);
    if (PH(2)) p2_attention(F);
    xcd_barrier(bar);
    if (RP(2)) { p2_attention(F); xcd_barrier(bar); }
    TS(2);
    CK(3, ws + WS_OB, WS_MERGED - WS_OB); CK(3, ws + WS_MISC + MO_LSE, 3 * 16384 * 16);
    if (PH(10)) p2b_merge(F);
    xcd_barrier(bar);
    TS(10);
    CK(4, ws + WS_ABC, WS_OB - WS_ABC);
    for (int rp_ = 0; rp_ < 1 + RP(3); ++rp_) {
    if (PH(3)) {
        P3Sched S{(int)blockIdx.x, (const char*)(ws + WS_ABC), (const char*)(ws + WS_WABC_T)};
        P3Epi E{(const bf16_t*)(ws + WS_PROJ), (bf16_t*)(ws + WS_MERGED)};
        pg8::gemm_phase<P3Epi, P3Sched, false>(F.lds, F.wave, (unsigned)(ABC_LD * 2), (unsigned)(ABC_LD * 2), S, E);
    }
    xcd_barrier(bar);
    }
    TS(3);
    CK(5, ws + WS_MERGED, 32 * MiB);
    for (int rp_ = 0; rp_ < 1 + RP(4); ++rp_) {
    if (PH(4)) {
        P4Sched S{(int)blockIdx.x, (const char*)(ws + WS_MERGED), (const char*)(ws + WS_WOUT_T)};
        P4Epi E{kargs()->in[0], kargs()->out};
        pg8::gemm_phase<P4Epi, P4Sched, false>(F.lds, F.wave, 2048u, 2048u, S, E);
    }
    xcd_barrier(bar);
    }
    TS(4);
    CK(6, kargs()->out, 64 * MiB);
    if (PH(5)) p5_router(F);
    xcd_barrier(bar);
    if (RP(5)) { p5_router(F); xcd_barrier(bar); }
    TS(5);
    CK(7, ws + WS_XN, 32 * MiB); CK(7, ws + WS_MISC, 512 * 1024 + 32 * 1024);
    if (PH(6)) p6_slots(F);
    xcd_barrier(bar);
    TS(6);
#ifdef CKSUM
#define ck_rows ((size_t)ld_uniform((const int*)(ws + WS_MISC + MO_TILE)) * 256)
    CK(8, ws + WS_MISC + MO_TOKSLOT, 256 * 1024); CK(8, ws + WS_MISC + MO_SLOTTOK, ck_rows * 4); CK(8, ws + WS_MISC + MO_SLOTW, ck_rows * 4); CK(8, ws + WS_MISC + MO_TILE, 1024);
#endif
    for (int rp_ = 0; rp_ < 1 + RP(7); ++rp_) {
    if (PH(7)) {
        moe_tables<8, true>(F, (const int*)(ws + WS_MISC + MO_TILE), (const int*)(ws + WS_MISC + MO_SLOTTOK));
        P7Sched S{F.G, (int)blockIdx.x, (LAS const int*)(F.lds + LDS_TILE), (const char*)(ws + WS_XN), (const char*)(ws + WS_WGU_T), __builtin_amdgcn_readfirstlane(*(LAS const int*)(F.lds + LDS_TILE))};
        P7Epi E{kargs()->in[16], (bf16_t*)(ws + WS_ACT), (const float*)(ws + WS_MISC + MO_RTOK), (LAS const unsigned char*)F.lds};
        pg8::gemm_phase<P7Epi, P7Sched, true, true>(F.lds, F.wave, 1024u, 1024u, S, E);
    }
    xcd_barrier(bar);
    }
    TS(7);
#ifdef CKSUM
    CK(9, ws + WS_ACT, ck_rows * 2048);
#endif
    for (int rp_ = 0; rp_ < 1 + RP(8); ++rp_) {
    if (PH(8)) {
        moe_tables<4, false>(F, (const int*)(ws + WS_MISC + MO_TILE), (const int*)(ws + WS_MISC + MO_SLOTTOK));
        P8Sched S{F.G, (int)blockIdx.x, (LAS const int*)(F.lds + LDS_TILE), (const char*)(ws + WS_ACT), (const char*)(ws + WS_WDN_T), __builtin_amdgcn_readfirstlane(*(LAS const int*)(F.lds + LDS_TILE))};
        P8Epi E{kargs()->in[18], (const float*)(ws + WS_MISC + MO_SLOTW), (bf16_t*)(ws + WS_YS)};
        pg8::gemm_phase<P8Epi, P8Sched, false, true>(F.lds, F.wave, 1024u, 1024u, S, E);
    }
    xcd_barrier(bar);
    }
    TS(8);
#ifdef CKSUM
    CK(10, ws + WS_YS, ck_rows * 2048);
#endif
    if (PH(9)) p9_final(F);
    if (TSK >= 0 && blockIdx.x == TSB && wave == 0) { const unsigned long long te_ = __builtin_amdgcn_s_memrealtime(); const unsigned long long wait_ = 50ull * (ts1_ - ts0_); while (__builtin_amdgcn_s_memrealtime() - te_ < wait_) __builtin_amdgcn_s_sleep(32); }
#ifdef CKSUM
    xcd_barrier(bar);
    if (blockIdx.x == 0 && F.wave == 0 && lane_id() == 0) {
        unsigned* cur = (unsigned*)(ws + WS_CTL) + 8192; unsigned* prev = (unsigned*)(ws + WS_MISC + 7 * MiB);
        const bool have = __hip_atomic_load(prev, __ATOMIC_RELAXED, __HIP_MEMORY_SCOPE_AGENT) == 0x5EED1234u;
        unsigned flag = have ? __hip_atomic_load(prev + 1, __ATOMIC_RELAXED, __HIP_MEMORY_SCOPE_AGENT) : 0u;
        for (int k = 1; k <= 10; ++k) { const unsigned c = __hip_atomic_load(cur + 64 * k, __ATOMIC_RELAXED, __HIP_MEMORY_SCOPE_AGENT);
            if (have && flag == 0u && __hip_atomic_load(prev + 16 + k, __ATOMIC_RELAXED, __HIP_MEMORY_SCOPE_AGENT) != c) flag = (unsigned)k;
            __hip_atomic_store(prev + 16 + k, c, __ATOMIC_RELAXED, __HIP_MEMORY_SCOPE_AGENT); }
        __hip_atomic_store(prev + 1, flag, __ATOMIC_RELAXED, __HIP_MEMORY_SCOPE_AGENT); __hip_atomic_store(prev, 0x5EED1234u, __ATOMIC_RELAXED, __HIP_MEMORY_SCOPE_AGENT);
    }
#endif
}

#undef F
#undef ws
#undef xcd_barrier
extern "C" void kernel_launch(void* const* d_in, const int* in_sizes, int n_in, void* d_out, int out_size, void* d_ws, size_t ws_size, hipStream_t stream) {
    static int grid = 0;
    if (grid == 0) {
        if (n_in != 20 || out_size != NTOK * D || ws_size < WS_END) { fprintf(stderr, "kernel_launch: unexpected shapes (n_in %d, out %d, ws %zu); nothing launched\n", n_in, out_size, ws_size); grid = -1; return; }
        int dev = 0, cus = 0;
        if (hipGetDevice(&dev) != hipSuccess || hipDeviceGetAttribute(&cus, hipDeviceAttributeMultiprocessorCount, dev) != hipSuccess) { grid = -1; return; }
        if (hipFuncSetAttribute((const void*)fwd_megakernel, hipFuncAttributeMaxDynamicSharedMemorySize, LDS_BYTES) != hipSuccess) { fprintf(stderr, "kernel_launch: hipFuncSetAttribute failed\n"); grid = -1; return; }
        int per_cu = 0;
        if (hipOccupancyMaxActiveBlocksPerMultiprocessor(&per_cu, (const void*)fwd_megakernel, NTHREADS, LDS_BYTES) != hipSuccess || per_cu < 1) fprintf(stderr, "kernel_launch: occupancy query reports %d\n", per_cu);
        (void)hipGetLastError();
        grid = cus;
        if (grid != 256) fprintf(stderr, "kernel_launch: %d CUs; this kernel is laid out for 256\n", grid);
    }
    if (grid < 0) return;
    (void)hipMemsetAsync((char*)d_ws + WS_CTL, 0, CTL_ZERO_BYTES, stream);
    Args a{};
    for (int i = 0; i < 20; ++i) a.in[i] = (const float*)d_in[i];
    a.out = (float*)d_out; a.ws = (unsigned char*)d_ws;
    hipLaunchKernelGGL(fwd_megakernel, dim3(grid), dim3(NTHREADS), LDS_BYTES, stream, a);
}
```

```cpp
#include <hip/hip_runtime.h>
#include <cstdio>
#include <cstdint>

#define GAS __attribute__((address_space(1)))
#define LAS __attribute__((address_space(3)))
typedef unsigned short bf16_t;
typedef short bf16x8 __attribute__((ext_vector_type(8)));
typedef short s16x4 __attribute__((ext_vector_type(4)));
typedef float f32x4 __attribute__((ext_vector_type(4)));
typedef float f32x2 __attribute__((ext_vector_type(2)));
typedef unsigned u32x4 __attribute__((ext_vector_type(4)));
typedef unsigned u32x2 __attribute__((ext_vector_type(2)));
typedef int i32x4 __attribute__((ext_vector_type(4)));
typedef int i32x8 __attribute__((ext_vector_type(8)));
#define FP8_SCALE 0x7C7C7C7C
typedef GAS unsigned gu32;

constexpr int NTOK = 16384, SEQ = 8192, D = 1024, NMEM = 512, MEMLEN = 256;
constexpr int IN_COLS = 7424;
__host__ __device__ __forceinline__ size_t proj_off(size_t row, int col) { return (((row >> 8) * 29 + (size_t)(col >> 8)) << 16) + ((row & 255) << 8) + (size_t)(col & 255); }
constexpr int C_QA = 0, C_KA = 512, C_VA = 1024, C_QB = 1536, C_KB = 2304, C_VB = 3072, C_QC = 3840, C_GATE = 4352;
constexpr int NEXP = 32, TOPK = 4, DFF = 1024;
constexpr int MAX_TILES = 288, MAX_SLOTS = MAX_TILES * 256;
constexpr float RMS_EPS = 1e-6f, LOG2E = 1.4426950408889634f;
constexpr float QS64 = 0.125f * LOG2E, QS128 = 0.08838834764831845f * LOG2E;
constexpr int ABC_LD = 1280;

constexpr size_t MiB = 1u << 20;
constexpr size_t WS_CTL = 0, CTL_ZERO_BYTES = 1 * MiB;
constexpr size_t WS_MISC = 1 * MiB;
constexpr size_t MO_TOPIDX = 0, MO_TOPW = 256 * 1024, MO_HIST = 512 * 1024, MO_TOKSLOT = 1 * MiB, MO_SLOTTOK = 2 * MiB, MO_SLOTW = 3 * MiB, MO_TILE = 4 * MiB, MO_LSE = 5 * MiB, MO_T5 = 6 * MiB, MO_RPB = 6 * MiB + 64 * 1024, MO_RTOK = 7 * MiB + 64 * 1024;
constexpr size_t WS_WIN_T = 16 * MiB, WS_WMEM_T = 32 * MiB, WS_WABC_T = 34 * MiB, WS_WOUT_T = 37 * MiB, WS_MEMN = 39 * MiB, WS_MKV = 40 * MiB, WS_XN = 41 * MiB;
constexpr size_t WS_ABC = 73 * MiB, WS_OB = 113 * MiB, WS_MERGED = 137 * MiB, WS_WGU_T = 169 * MiB, WS_WDN_T = 297 * MiB, WS_PROJ = 361 * MiB, WS_ACT = 593 * MiB, WS_YS = 737 * MiB, WS_END = 881 * MiB;
constexpr int T5_LD = 192, RPB_LD = 640, RPB_OFF = 64;

constexpr int LDS_MAIN = 147456;
constexpr int LDS_TAB = LDS_MAIN;
constexpr int LDS_MISC = LDS_MAIN + 8192;
constexpr int LDS_BYTES = LDS_MISC + 512;

#define LDS_WAIT() asm volatile("s_waitcnt lgkmcnt(0)" ::: "memory")
#define VM_WAIT() asm volatile("s_waitcnt vmcnt(0)" ::: "memory")
__device__ __forceinline__ unsigned cvt_pk_bf16(float lo, float hi) { unsigned r; asm volatile("v_cvt_pk_bf16_f32 %0, %1, %2" : "=v"(r) : "v"(lo), "v"(hi)); return r; }
__device__ __forceinline__ float bf_lo(unsigned u) { return __uint_as_float(u << 16); }
__device__ __forceinline__ float bf_hi(unsigned u) { return __uint_as_float(u & 0xffff0000u); }
__device__ __forceinline__ int lane_id() { int l; asm volatile("v_mbcnt_lo_u32_b32 %0, -1, 0\n\tv_mbcnt_hi_u32_b32 %0, -1, %0" : "=v"(l)); return l; }
__device__ __forceinline__ float sx(float v, int off) { return __builtin_bit_cast(float, __builtin_amdgcn_ds_bpermute((lane_id() ^ off) << 2, __builtin_bit_cast(int, v))); }
__device__ __forceinline__ int sxi(int v, int off) { return __builtin_amdgcn_ds_bpermute((lane_id() ^ off) << 2, v); }
__device__ __forceinline__ float sidx(float v, int src) { return __builtin_bit_cast(float, __builtin_amdgcn_ds_bpermute(src << 2, __builtin_bit_cast(int, v))); }
__device__ __forceinline__ float wave_sum(float v) {
#pragma unroll
    for (int o = 1; o < 64; o <<= 1) v += sx(v, o);
    return v;
}
__device__ __forceinline__ float wave_max(float v) {
#pragma unroll
    for (int o = 1; o < 64; o <<= 1) v = fmaxf(v, sx(v, o));
    return v;
}
__device__ __forceinline__ int ld_uniform(const int* p) { return __builtin_amdgcn_readfirstlane(__hip_atomic_load((int*)p, __ATOMIC_RELAXED, __HIP_MEMORY_SCOPE_AGENT)); }
__device__ __forceinline__ float fast_sigmoid(float x) { return __builtin_amdgcn_rcpf(1.0f + __builtin_amdgcn_exp2f(-LOG2E * x)); }

namespace pg8 {
constexpr int BM = 256, BK = 64, HALF = 128, HTB = HALF * BK * 2, STAGE_BYTES = 8 * HTB, LDS_STASH = 131072  ;
__host__ __device__ __forceinline__ int lds_byte(int r, int c) { const int st = (r >> 4) * 2 + (c >> 5), rr = r & 15, cc = c & 31, ob = rr * 64 + cc * 2; return st * 1024 + (ob ^ (((ob >> 9) & 1) << 5)); }
__host__ __device__ __forceinline__ void stage_rc(int b, int& R, int& C) { const int st = b / 1024, sb = b % 1024, swz = sb ^ (((sb >> 9) & 1) << 5); R = (st >> 1) * 16 + swz / 64; C = (st & 1) * 32 + (swz % 64) / 2; }
__host__ __device__ __forceinline__ int perm32(int rho) { const int n = rho >> 4, i = rho & 15; return 8 * (i >> 2) + 4 * n + (i & 3); }

struct Unit {
    const char* A;
    const char* B;
    int rows;
    int nt;
    int pm, pn;
    int aux;
    float scale;
};

template <class Epi, class Sched, bool GATHER, bool FP8 = false>
__device__ __forceinline__ void gemm_phase(LAS unsigned char* lds, const int wave, const unsigned lda, const unsigned ldb, const Sched& S, const Epi& E) {
    const int lane = lane_id();
    const int wid = wave, tid = wave * 64 + lane, wr = wid >> 2, wc = wid & 3, fr = lane & 15, fq = lane >> 4;
    const int R0 = (wid >> 1) * 16 + (lane >> 2), C2 = ((wid & 1) * 32 + ((((lane & 3) * 8)) ^ ((lane >> 5) << 4))) * 2, Rb0 = (R0 & ~31) + perm32(R0 & 31);
    unsigned offA = (unsigned)R0 * lda + (unsigned)C2, offB = (unsigned)Rb0 * ldb + (unsigned)C2;
    const size_t kstep = (size_t)(BK * 2);
    const size_t hstepB = (size_t)HALF * ldb;
    const unsigned ldsw = (unsigned)wid * 1024u;
    const int aoff = lds_byte(wr * 64 + fr, fq * 8), boff = lds_byte(wc * 32 + fr, fq * 8);
#define PG8_SA(b, h) (((b) * 2 + (h)) * HTB)
#define PG8_SB(b, h) ((4 + (b) * 2 + (h)) * HTB)
#define PG8_STAGE2P(bufoff, p0, p1, v0, v1) do { \
        __builtin_amdgcn_global_load_lds((const unsigned*)((const char*)(p0) + (v0)), (LAS unsigned*)(lds + (bufoff) + ldsw), 16, 0, 0); \
        __builtin_amdgcn_global_load_lds((const unsigned*)((const char*)(p1) + (v1)), (LAS unsigned*)(lds + (bufoff) + ldsw + 8192), 16, 0, 0); } while (0)
#define PG8_STAGEB(bufoff, gbase) PG8_STAGE2P(bufoff, gbase, (const char*)(gbase) + (size_t)64 * ldb, offB, offB)
#define PG8_STAGEA(bufoff, gbase, h, g0, g1) do { if (GATHER) { PG8_STAGE2P(bufoff, gbase, gbase, g0, g1); } else { PG8_STAGE2P(bufoff, (const char*)(gbase) + (size_t)((h) * HALF) * lda, (const char*)(gbase) + (size_t)((h) * HALF + 64) * lda, offA, offA); } } while (0)
#define PG8_LDA(dst, b, h) do { _Pragma("unroll") for (int m = 0; m < 4; ++m) _Pragma("unroll") for (int k = 0; k < 2; ++k) dst[m][k] = *(const LAS bf16x8*)(lds + PG8_SA(b, h) + aoff + m * 2048 + k * 1024); } while (0)
#define PG8_LDB(dst, b, h) do { _Pragma("unroll") for (int n = 0; n < 2; ++n) _Pragma("unroll") for (int k = 0; k < 2; ++k) dst[n][k] = *(const LAS bf16x8*)(lds + PG8_SB(b, h) + boff + n * 2048 + k * 1024); } while (0)
#define PG8_MMA(ai, bj, At, Bt) do { __builtin_amdgcn_s_setprio(1); \
        if (FP8) { _Pragma("unroll") for (int m = 0; m < 4; ++m) _Pragma("unroll") for (int n = 0; n < 2; ++n) { \
            const i32x4 b0_ = __builtin_bit_cast(i32x4, Bt[n][0]), b1_ = __builtin_bit_cast(i32x4, Bt[n][1]), a0_ = __builtin_bit_cast(i32x4, At[m][0]), a1_ = __builtin_bit_cast(i32x4, At[m][1]); \
            const i32x8 bw_ = __builtin_shufflevector(b0_, b1_, 0, 1, 2, 3, 4, 5, 6, 7), aw_ = __builtin_shufflevector(a0_, a1_, 0, 1, 2, 3, 4, 5, 6, 7); \
            acc[ai][bj][m][n] = __builtin_amdgcn_mfma_scale_f32_16x16x128_f8f6f4(bw_, aw_, acc[ai][bj][m][n], 0, 0, 0, FP8_SCALE, 0, FP8_SCALE); } } \
        else { _Pragma("unroll") for (int m = 0; m < 4; ++m) _Pragma("unroll") for (int n = 0; n < 2; ++n) _Pragma("unroll") for (int k = 0; k < 2; ++k) \
            acc[ai][bj][m][n] = __builtin_amdgcn_mfma_f32_16x16x32_bf16(Bt[n][k], At[m][k], acc[ai][bj][m][n], 0, 0, 0); } \
        __builtin_amdgcn_s_setprio(0); } while (0)
#define PG8_WAIT_V(n) asm volatile("s_waitcnt vmcnt(" #n ")" ::: "memory")
#define PG8_WAIT_L(n) asm volatile("s_waitcnt lgkmcnt(" #n ")" ::: "memory")
#define PG8_BAR __builtin_amdgcn_s_barrier()
#define PG8_SCHED __builtin_amdgcn_sched_barrier(0)
    Unit cur, nxt; int ui = 0;
    if (!S.next(0, cur)) return;
    f32x4 acc[2][2][4][2];
#pragma unroll
    for (int a = 0; a < 2; ++a)
#pragma unroll
        for (int b = 0; b < 2; ++b)
#pragma unroll
            for (int m = 0; m < 4; ++m)
#pragma unroll
                for (int n = 0; n < 2; ++n) acc[a][b][m][n] = (f32x4){0.f, 0.f, 0.f, 0.f};
    bf16x8 At[4][2], B0[2][2], B1[2][2];
    unsigned c00 = 0, c01 = 0, c10 = 0, c11 = 0;
#define PG8_MKOFF(U, o00, o01, o10, o11) do { const LAS int* rl_ = (const LAS int*)(lds + (U).rows) + R0; \
        o00 = (unsigned)rl_[0] * lda + (unsigned)C2; o01 = (unsigned)rl_[64] * lda + (unsigned)C2; o10 = (unsigned)rl_[HALF] * lda + (unsigned)C2; o11 = (unsigned)rl_[HALF + 64] * lda + (unsigned)C2; } while (0)
    if (GATHER) { PG8_MKOFF(cur, c00, c01, c10, c11); }
    const char* cA = cur.A; const char* cB = cur.B; int nt = cur.nt;
    PG8_STAGEB(PG8_SB(0, 0), cB); PG8_STAGEB(PG8_SB(0, 1), cB + hstepB); PG8_STAGEA(PG8_SA(0, 0), cA, 0, c00, c01); PG8_STAGEA(PG8_SA(0, 1), cA, 1, c10, c11);
    if (wr == 1) PG8_BAR;
    PG8_WAIT_V(2); PG8_BAR;
    PG8_STAGEB(PG8_SB(1, 0), cB + kstep); PG8_STAGEA(PG8_SA(1, 0), cA + kstep, 0, c00, c01); PG8_STAGEB(PG8_SB(1, 1), cB + hstepB + kstep);
    PG8_WAIT_V(6); PG8_BAR;
    for (;;) {
        const bool has_next = S.next(ui + 1, nxt);
        const char* nA = has_next ? nxt.A : cA; const char* nB = has_next ? nxt.B : cB;
#pragma nounroll
        for (int t = 0; t < nt; t += 2) {
            const bool last = (t == nt - 2);
            if (GATHER) asm volatile("" : "+v"(c00), "+v"(c01), "+v"(c10), "+v"(c11)); asm volatile("" : "+v"(offA), "+v"(offB));
            const char* a1 = cA + (size_t)(t + 1) * kstep;
            const char* a2 = last ? nA : cA + (size_t)(t + 2) * kstep; const char* b2 = last ? nB : cB + (size_t)(t + 2) * kstep;
            const char* a3 = a2 + kstep; const char* b3 = b2 + kstep;
            PG8_LDB(B0, 0, 0); PG8_LDB(B1, 0, 1); PG8_SCHED; PG8_LDA(At, 0, 0); PG8_STAGEA(PG8_SA(1, 1), a1, 1, c10, c11);
            if (GATHER) { if (last && has_next) { PG8_MKOFF(nxt, c00, c01, c10, c11); } }
            PG8_WAIT_V(8); PG8_WAIT_L(0); PG8_BAR; PG8_MMA(0, 0, At, B0); PG8_MMA(0, 1, At, B1); PG8_BAR; PG8_SCHED;
            PG8_LDA(At, 0, 1); PG8_STAGEB(PG8_SB(0, 0), b2); PG8_STAGEB(PG8_SB(0, 1), b2 + hstepB); PG8_STAGEA(PG8_SA(0, 0), a2, 0, c00, c01);
            PG8_WAIT_V(8); PG8_WAIT_L(0); PG8_BAR; PG8_MMA(1, 0, At, B0); PG8_MMA(1, 1, At, B1); PG8_BAR; PG8_SCHED;
            PG8_LDB(B0, 1, 0); PG8_LDB(B1, 1, 1); PG8_SCHED; PG8_LDA(At, 1, 0); PG8_STAGEA(PG8_SA(0, 1), a2, 1, c10, c11);
            PG8_WAIT_V(8); PG8_WAIT_L(0); PG8_BAR; PG8_MMA(0, 0, At, B0); PG8_MMA(0, 1, At, B1); PG8_BAR; PG8_SCHED;
            PG8_LDA(At, 1, 1); PG8_STAGEB(PG8_SB(1, 0), b3); PG8_STAGEB(PG8_SB(1, 1), b3 + hstepB); PG8_STAGEA(PG8_SA(1, 0), a3, 0, c00, c01);
            PG8_WAIT_V(8); PG8_WAIT_L(0); PG8_BAR; PG8_MMA(1, 0, At, B0); PG8_MMA(1, 1, At, B1); PG8_BAR; PG8_SCHED;
        }
        if (wr == 0) PG8_BAR;
        { int le_ = lane; asm volatile("" : "+v"(le_)); E(acc, cur, wr, wc, le_ & 15, le_ >> 4); }
        if (GATHER) { if (has_next) { asm volatile("" ::: "memory"); PG8_MKOFF(nxt, c00, c01, c10, c11); } }
        if (!has_next) break;
#pragma unroll
        for (int a = 0; a < 2; ++a)
#pragma unroll
            for (int b = 0; b < 2; ++b)
#pragma unroll
                for (int m = 0; m < 4; ++m)
#pragma unroll
                    for (int n = 0; n < 2; ++n) acc[a][b][m][n] = (f32x4){0.f, 0.f, 0.f, 0.f};
        cur = nxt; cA = nA; cB = nB; nt = cur.nt; ++ui;
        if (wr == 1) PG8_BAR;
    }
    PG8_WAIT_V(0);
    PG8_BAR;
#undef PG8_SA
#undef PG8_SB
#undef PG8_STAGE2P
#undef PG8_STAGEB
#undef PG8_LDA
#undef PG8_LDB
#undef PG8_MMA
#undef PG8_WAIT_V
#undef PG8_WAIT_L
#undef PG8_BAR
#undef PG8_SCHED
#undef PG8_MKOFF
#undef PG8_STAGEA
}
}

#define XB_TMO      128
#define XB_XCNT(j)  (256  + 64 * (j))
#define XB_XSUB(j)  (1280 + 64 * (j))
#define XB_XGEN(j)  (2304 + 64 * (j))
#define XB_TOP      3328
#define XB_TOPGEN   3392
#define XCD_BAR_WORDS 3456
#define XB_SPIN_CAP (1u << 18)
__device__ __forceinline__ unsigned xb_ld(unsigned* p)              { return __hip_atomic_load(p, __ATOMIC_RELAXED, __HIP_MEMORY_SCOPE_AGENT); }
__device__ __forceinline__ unsigned xb_add(unsigned* p, unsigned v) { return __hip_atomic_fetch_add(p, v, __ATOMIC_RELAXED, __HIP_MEMORY_SCOPE_AGENT); }
__device__ __forceinline__ unsigned xb_xcc_id() { return (unsigned)__builtin_amdgcn_s_getreg((3 << 11) | 20) & 0xFu; }
#define XB_SPIN(cond, bar) do { unsigned _sp = 0; while (cond) { __builtin_amdgcn_s_sleep(1); \
    if ((++_sp & 255u) == 0u) { if (xb_ld(&(bar)[XB_TMO])) break; if (_sp > XB_SPIN_CAP) { atomicAdd(&(bar)[XB_TMO], 1u); break; } } } } while (0)
struct XcdBarrier { unsigned* bar; unsigned x; volatile LAS unsigned* st; int wave; };
__device__ __forceinline__ XcdBarrier xcd_barrier_post(unsigned* bar, volatile LAS unsigned* st, int wave) {
    XcdBarrier b; b.bar = bar; b.x = xb_xcc_id(); b.st = st; b.wave = wave;
    if (wave == 0 && lane_id() == 0) (void)xb_add(&bar[XB_XCNT(b.x)], 1u);
    return b;
}
__device__ __forceinline__ void xcd_barrier_complete(unsigned* bar, unsigned x, unsigned& nloc, unsigned& nx) {
    const unsigned G = gridDim.x * gridDim.y * gridDim.z;
    unsigned sum, cnt, mine, sp = 0u;
    for (;;) {
        sum = 0u; cnt = 0u; mine = 0u;
#pragma unroll
        for (unsigned j = 0; j < 16; ++j) { const unsigned c = xb_ld(&bar[XB_XCNT(j)]); sum += c; cnt += (c > 0u) ? 1u : 0u; mine = (j == x) ? c : mine; }
        if (sum == G) break;
        __builtin_amdgcn_s_sleep(1);
        if ((++sp & 255u) == 0u) { if (xb_ld(&bar[XB_TMO])) break; if (sp > XB_SPIN_CAP) { atomicAdd(&bar[XB_TMO], 1u); break; } }
    }
    nloc = mine > 0u ? mine : 1u; nx = cnt > 0u ? cnt : 1u;
}
__device__ __forceinline__ void xcd_barrier(const XcdBarrier& b) {
    asm volatile("s_waitcnt vmcnt(0)" ::: "memory");
    __syncthreads();
    if (b.wave == 0 && lane_id() == 0) {
        unsigned* bar = b.bar;
        __builtin_amdgcn_s_waitcnt(0);
        unsigned nloc = b.st[0], nx = b.st[1];
        if (nloc == 0u) { xcd_barrier_complete(bar, b.x, nloc, nx); b.st[0] = nloc; b.st[1] = nx; }
        const unsigned old = xb_add(&bar[XB_XSUB(b.x)], 1u);
        const unsigned gen = old / nloc;
        if (old + 1u == (gen + 1u) * nloc) {
            __builtin_amdgcn_fence(__ATOMIC_RELEASE, "agent");
            asm volatile("s_waitcnt vmcnt(0)" ::: "memory");
            const unsigned og = xb_add(&bar[XB_TOP], 1u);
            const unsigned tg = og / nx;
            if (og + 1u == (tg + 1u) * nx) xb_add(&bar[XB_TOPGEN], 1u);
            else XB_SPIN(xb_ld(&bar[XB_TOPGEN]) == tg, bar);
            __builtin_amdgcn_fence(__ATOMIC_ACQUIRE, "agent");
            xb_add(&bar[XB_XGEN(b.x)], 1u);
            asm volatile("s_waitcnt vmcnt(0)" ::: "memory");
        } else {
            XB_SPIN(xb_ld(&bar[XB_XGEN(b.x)]) == gen, bar);
            __builtin_amdgcn_fence(__ATOMIC_ACQUIRE, "agent");
            asm volatile("s_waitcnt vmcnt(0)" ::: "memory");
        }
    }
    __syncthreads();
}

struct Args { const float* in[20]; float* out; unsigned char* ws; };
typedef const __attribute__((address_space(4))) Args* KArgs;
__device__ __forceinline__ KArgs kargs() { KArgs k = (KArgs)__builtin_amdgcn_kernarg_segment_ptr(); asm volatile("" : "+s"(k)); return k; }
constexpr int NWAVES = 8, NTHREADS = 512;

struct Ctx {
    LAS unsigned char* lds;
    int tid, lane, wave, G, vcu;
    unsigned char* ws;
};
__device__ __forceinline__ Ctx make_ctx(int wave) {
    extern __shared__ __attribute__((aligned(16))) unsigned char lds_dyn[];
    Ctx F; int l = lane_id(); asm volatile("" : "+v"(l)); F.lds = (LAS unsigned char*)lds_dyn; F.lane = l; F.wave = wave; F.tid = wave * 64 + l;
    F.G = (int)gridDim.x; { const int bx = (int)blockIdx.x; F.vcu = (F.G % 8 == 0) ? (bx % 8) * (F.G / 8) + bx / 8 : bx; }
    F.ws = kargs()->ws; return F; }
__device__ __forceinline__ Ctx ctx_refresh(const Ctx& F0) { return make_ctx(F0.wave); }


#ifdef CKSUM
__device__ __forceinline__ void ck_region(const Ctx& F, int k, const void* base, size_t bytes) {
    const GAS u32x4* p = (const GAS u32x4*)base; const size_t n = bytes / 16; unsigned acc = 0u;
    const int tid_ = F.wave * 64 + lane_id();
    for (size_t i = (size_t)blockIdx.x * NTHREADS + tid_; i < n; i += (size_t)F.G * NTHREADS) { const u32x4 v = __builtin_nontemporal_load(p + i); acc += v.x * 3u + v.y * 5u + v.z * 7u + v.w * 11u + (unsigned)i; }
#pragma unroll
    for (int o = 1; o < 64; o <<= 1) acc += (unsigned)sxi((int)acc, o);
    if (lane_id() == 0) atomicAdd((unsigned*)(F.ws + WS_CTL) + 8192 + 64 * k, acc);
}
#define CK(k, base, bytes) ck_region(F, k, base, bytes)
#else
#define CK(k, base, bytes) do {} while (0)
#endif
__device__ __forceinline__ void p0_transpose64(const float* W, int ldw, int k0, int n0, bf16_t* dst, int ldt, LAS float* scr, int lane) {
    f32x4 v[16];
#pragma unroll
    for (int i = 0; i < 16; ++i) { const int kk = 4 * i + (lane >> 4); v[i] = *(const GAS f32x4*)(W + (size_t)(k0 + kk) * ldw + n0 + 4 * (lane & 15)); }
#pragma unroll
    for (int i = 0; i < 16; ++i) { const int kk = 4 * i + (lane >> 4); LAS float* s = scr + kk * 65 + 4 * (lane & 15); s[0] = v[i][0]; s[1] = v[i][1]; s[2] = v[i][2]; s[3] = v[i][3]; }
    LDS_WAIT(); asm volatile("" ::: "memory");
    const int c = lane & 7;
#pragma unroll
    for (int j = 0; j < 8; ++j) { const int n = (lane >> 3) + 8 * j; const LAS float* s = scr + (8 * c) * 65 + n;
        u32x4 o; o.x = cvt_pk_bf16(s[0 * 65], s[1 * 65]); o.y = cvt_pk_bf16(s[2 * 65], s[3 * 65]); o.z = cvt_pk_bf16(s[4 * 65], s[5 * 65]); o.w = cvt_pk_bf16(s[6 * 65], s[7 * 65]);
        *(GAS u32x4*)(dst + (size_t)n * ldt + 8 * c) = o; }
    LDS_WAIT(); asm volatile("" ::: "memory");
}
__device__ __forceinline__ void p0_transpose64_fp8(const float* W, int ldw, int k0, int n0, unsigned char* dst8, int ldt, LAS float* scr, int lane, float scale) {
    f32x4 v[16];
#pragma unroll
    for (int i = 0; i < 16; ++i) { const int kk = 4 * i + (lane >> 4); v[i] = *(const GAS f32x4*)(W + (size_t)(k0 + kk) * ldw + n0 + 4 * (lane & 15)); }
#pragma unroll
    for (int i = 0; i < 16; ++i) { const int kk = 4 * i + (lane >> 4); LAS float* s = scr + kk * 65 + 4 * (lane & 15); s[0] = v[i][0] * scale; s[1] = v[i][1] * scale; s[2] = v[i][2] * scale; s[3] = v[i][3] * scale; }
    LDS_WAIT(); asm volatile("" ::: "memory");
    const int c = lane & 3;
#pragma unroll
    for (int j = 0; j < 4; ++j) { const int n = (lane >> 2) + 16 * j; const LAS float* s = scr + (16 * c) * 65 + n;
        u32x4 o;
#pragma unroll
        for (int q = 0; q < 4; ++q) { int w = __builtin_amdgcn_cvt_pk_fp8_f32(s[(4 * q) * 65], s[(4 * q + 1) * 65], 0, false); w = __builtin_amdgcn_cvt_pk_fp8_f32(s[(4 * q + 2) * 65], s[(4 * q + 3) * 65], w, true); o[q] = (unsigned)w; }
        *(GAS u32x4*)(dst8 + (size_t)n * ldt + 16 * c) = o; }
    LDS_WAIT(); asm volatile("" ::: "memory");
}
__device__ __forceinline__ void rms_row_to_bf16(const float* xrow, const float* g, bf16_t* orow, int lane) {
    const GAS f32x4* xr = (const GAS f32x4*)xrow + lane; const GAS f32x4* gr = (const GAS f32x4*)g + lane;
    f32x4 v[4]; float s = 0.f;
#pragma unroll
    for (int j = 0; j < 4; ++j) { v[j] = xr[64 * j]; s += (v[j].x * v[j].x + v[j].y * v[j].y) + (v[j].z * v[j].z + v[j].w * v[j].w); }
    const float r = 1.0f / sqrtf(wave_sum(s) * (1.f / D) + RMS_EPS);
    GAS u32x2* o8 = (GAS u32x2*)orow + lane;
#pragma unroll
    for (int j = 0; j < 4; ++j) { const f32x4 gg = gr[64 * j]; u32x2 w; w.x = cvt_pk_bf16(v[j].x * r * gg.x, v[j].y * r * gg.y); w.y = cvt_pk_bf16(v[j].z * r * gg.z, v[j].w * r * gg.w); o8[64 * j] = w; }
}
__device__ __forceinline__ int t5_bucket(int rel) {
    int ret = rel > 0 ? 16 : 0; const int n = rel < 0 ? -rel : rel;
    if (n < 8) return ret + n;
    const float nf = (float)n;
    int large = 8 + (int)(logf(nf / 8.0f) / logf(128.0f) * 8.0f);
    large = large < 15 ? large : 15;
    return ret + large;
}
__device__ __forceinline__ void p0_prologue(const Ctx& F0) {
    const KArgs ap = kargs();
    const Ctx F = ctx_refresh(F0);
    LAS float* scr = (LAS float*)(F.lds) + F.wave * (64 * 65);
    const int gw = F.vcu * NWAVES + F.wave, NGW = F.G * NWAVES;
    bf16_t* WGU_T = (bf16_t*)(F.ws + WS_WGU_T); bf16_t* WDN_T = (bf16_t*)(F.ws + WS_WDN_T); bf16_t* WIN_T = (bf16_t*)(F.ws + WS_WIN_T);
    bf16_t* WMEM_T = (bf16_t*)(F.ws + WS_WMEM_T); bf16_t* WABC_T = (bf16_t*)(F.ws + WS_WABC_T); bf16_t* WOUT_T = (bf16_t*)(F.ws + WS_WOUT_T);
    constexpr int I_IN = 16 * 116, I_MEM = 256, I_A = 8 * 16, I_B = 4 * 16, I_C = 8 * 16, I_O = 256;
    constexpr int NITEMS = I_IN + I_MEM + I_A + I_B + I_C + I_O;
    for (int it = gw; it < NITEMS; it += NGW) {
        int r = it;
        if (r < I_IN) { const int kb = r / 116, nb = r % 116; p0_transpose64(ap->in[4], IN_COLS, kb * 64, nb * 64, WIN_T + (size_t)(nb * 64) * 1024 + kb * 64, 1024, scr, F.lane); continue; } r -= I_IN;
        if (r < I_MEM) { const int kb = r >> 4, nb = r & 15; p0_transpose64(ap->in[5], 1024, kb * 64, nb * 64, WMEM_T + (size_t)(nb * 64) * 1024 + kb * 64, 1024, scr, F.lane); continue; } r -= I_MEM;
        if (r < I_A) { const int kb = r >> 4, nb = r & 15; p0_transpose64(ap->in[8], 1024, kb * 64, nb * 64, WABC_T + (size_t)(nb * 64) * ABC_LD + 0 + kb * 64, ABC_LD, scr, F.lane); continue; } r -= I_A;
        if (r < I_B) { const int kb = r >> 4, nb = r & 15; p0_transpose64(ap->in[9], 1024, kb * 64, nb * 64, WABC_T + (size_t)(nb * 64) * ABC_LD + 512 + kb * 64, ABC_LD, scr, F.lane); continue; } r -= I_B;
        if (r < I_C) { const int kb = r >> 4, nb = r & 15; p0_transpose64(ap->in[10], 1024, kb * 64, nb * 64, WABC_T + (size_t)(nb * 64) * ABC_LD + 768 + kb * 64, ABC_LD, scr, F.lane); continue; } r -= I_C;
        { const int kb = r >> 4, nb = r & 15; p0_transpose64(ap->in[11], 1024, kb * 64, nb * 64, WOUT_T + (size_t)(nb * 64) * 1024 + kb * 64, 1024, scr, F.lane); }
    }
    bf16_t* XN = (bf16_t*)(F.ws + WS_XN); bf16_t* MEMN = (bf16_t*)(F.ws + WS_MEMN);
    for (int m = gw; m < NTOK; m += 2 * NGW) {
        const int m2 = m + NGW; const bool two = m2 < NTOK;
        const GAS f32x4* xa = (const GAS f32x4*)(ap->in[0] + (size_t)m * D) + F.lane; const GAS f32x4* xb = (const GAS f32x4*)(ap->in[0] + (size_t)(two ? m2 : m) * D) + F.lane;
        const GAS f32x4* gr = (const GAS f32x4*)ap->in[2] + F.lane;
        f32x4 va[4], vb[4]; float sa = 0.f, sb = 0.f;
#pragma unroll
        for (int j = 0; j < 4; ++j) { va[j] = xa[64 * j]; vb[j] = xb[64 * j]; }
#pragma unroll
        for (int j = 0; j < 4; ++j) { sa += (va[j].x * va[j].x + va[j].y * va[j].y) + (va[j].z * va[j].z + va[j].w * va[j].w); sb += (vb[j].x * vb[j].x + vb[j].y * vb[j].y) + (vb[j].z * vb[j].z + vb[j].w * vb[j].w); }
#pragma unroll
        for (int o = 1; o < 64; o <<= 1) { sa += sx(sa, o); sb += sx(sb, o); }
        const float ra = 1.0f / sqrtf(sa * (1.f / D) + RMS_EPS), rb = 1.0f / sqrtf(sb * (1.f / D) + RMS_EPS);
        GAS u32x2* oa = (GAS u32x2*)(XN + (size_t)m * D) + F.lane; GAS u32x2* ob = (GAS u32x2*)(XN + (size_t)m2 * D) + F.lane;
#pragma unroll
        for (int j = 0; j < 4; ++j) { const f32x4 gg = gr[64 * j]; u32x2 w; w.x = cvt_pk_bf16(va[j].x * ra * gg.x, va[j].y * ra * gg.y); w.y = cvt_pk_bf16(va[j].z * ra * gg.z, va[j].w * ra * gg.w); oa[64 * j] = w;
            if (two) { u32x2 w2; w2.x = cvt_pk_bf16(vb[j].x * rb * gg.x, vb[j].y * rb * gg.y); w2.y = cvt_pk_bf16(vb[j].z * rb * gg.z, vb[j].w * rb * gg.w); ob[64 * j] = w2; } }
    }
    for (int m = gw; m < NMEM; m += NGW) rms_row_to_bf16(ap->in[1] + (size_t)m * D, ap->in[3], MEMN + (size_t)m * D, F.lane);
    const int gt = F.vcu * NTHREADS + F.tid, NGT = F.G * NTHREADS;
    float* t5 = (float*)(F.ws + WS_MISC + MO_T5); float* rp = (float*)(F.ws + WS_MISC + MO_RPB);
    for (int i = gt; i < 12 * T5_LD; i += NGT) { const int gh = i / T5_LD, j = i % T5_LD, rel = j - 79, g = gh >> 2; const int dil = g == 0 ? 1 : (g == 1 ? 4 : 16);
        float v = 0.f; if (rel >= -64 && rel <= 64) v = ap->in[7][t5_bucket(rel * dil) * 12 + gh] * LOG2E; t5[i] = v; }
    for (int i = gt; i < 8 * RPB_LD; i += NGT) { const int h = i / RPB_LD, j = i % RPB_LD - RPB_OFF; float v = 0.f; if (j >= 0 && j < 465) v = ap->in[6][h * 465 + j] * LOG2E; rp[i] = v; }
}

__device__ __forceinline__ bool is_converter(int c) { return ((c >> 3) & 3) == 3; }
struct CvItem { const float* src; int ldw; unsigned char* dst; };
__device__ __forceinline__ CvItem cv_decode(int r, const float* GU, const float* DN, unsigned char* WGU8, unsigned char* WDN8) {
    constexpr int I_GU = 32 * 16 * 32; CvItem I;
    if (r < I_GU) { const int e = r >> 9, q = r & 511, kb = q >> 5, nb = q & 31, n0 = nb * 64; const int bj = n0 >> 10, rem = n0 & 1023, pn = rem >> 7, c0 = rem & 127;
        I.src = GU + (size_t)e * 1024 * 2048 + (size_t)(kb * 64) * 2048 + n0; I.ldw = 2048; I.dst = WGU8 + ((size_t)e * 2048 + pn * 256 + bj * 128 + c0) * 1024 + kb * 64; }
    else { r -= I_GU; const int e = r >> 8, q = r & 255, kb = q >> 4, nb = q & 15;
        I.src = DN + (size_t)e * 1024 * 1024 + (size_t)(kb * 64) * 1024 + nb * 64; I.ldw = 1024; I.dst = WDN8 + ((size_t)e * 1024 + nb * 64) * 1024 + kb * 64; }
    return I;
}
__device__ __forceinline__ void cv_load(const CvItem& I, f32x4 (&v)[16], int lane) {
#pragma unroll
    for (int i = 0; i < 16; ++i) { const int kk = 4 * i + (lane >> 4); v[i] = *(const GAS f32x4*)(I.src + (size_t)kk * I.ldw + 4 * (lane & 15)); }
}
__device__ __forceinline__ void cv_finish(const CvItem& I, const f32x4 (&v)[16], LAS float* scr, int lane) {
#pragma unroll
    for (int i = 0; i < 16; ++i) { const int kk = 4 * i + (lane >> 4); LAS float* s = scr + kk * 65 + 4 * (lane & 15); s[0] = v[i][0] * 64.0f; s[1] = v[i][1] * 64.0f; s[2] = v[i][2] * 64.0f; s[3] = v[i][3] * 64.0f; }
    LDS_WAIT(); asm volatile("" ::: "memory");
    const int c = lane & 3;
#pragma unroll
    for (int j = 0; j < 4; ++j) { const int n = (lane >> 2) + 16 * j; const LAS float* s = scr + (16 * c) * 65 + n;
        u32x4 o;
#pragma unroll
        for (int q = 0; q < 4; ++q) { int w = __builtin_amdgcn_cvt_pk_fp8_f32(s[(4 * q) * 65], s[(4 * q + 1) * 65], 0, false); w = __builtin_amdgcn_cvt_pk_fp8_f32(s[(4 * q + 2) * 65], s[(4 * q + 3) * 65], w, true); o[q] = (unsigned)w; }
        *(GAS u32x4*)(I.dst + (size_t)n * 1024 + 16 * c) = o; }
    LDS_WAIT(); asm volatile("" ::: "memory");
}
__device__ __forceinline__ void p1_convert_experts(const Ctx& F0) {
    const KArgs ap = kargs();
    const Ctx F = ctx_refresh(F0);
    const int c = (int)blockIdx.x; if (!is_converter(c)) return;
    LAS float* scr = (LAS float*)(F.lds) + F.wave * (64 * 65);
    const int ci = (c & 7) * 8 + (c >> 5);
    const float* GU = ap->in[15]; const float* DN = ap->in[17];
    unsigned char* WGU8 = (unsigned char*)(F.ws + WS_WGU_T); unsigned char* WDN8 = (unsigned char*)(F.ws + WS_WDN_T);
    constexpr int NIT = 32 * 16 * 32 + 32 * 16 * 16, STRIDE = 64 * NWAVES;
    int it = ci * NWAVES + F.wave;
    CvItem I = cv_decode(it, GU, DN, WGU8, WDN8); f32x4 va[16], vb[16]; cv_load(I, va, F.lane);
    for (;;) {
        const int itn = it + STRIDE; const bool hn = itn < NIT; CvItem In = I;
        if (hn) { In = cv_decode(itn, GU, DN, WGU8, WDN8); cv_load(In, vb, F.lane); }
        cv_finish(I, va, scr, F.lane);
        if (!hn) break;
        I = In; it = itn;
#pragma unroll
        for (int i = 0; i < 16; ++i) va[i] = vb[i];
    }
}

struct P1Sched {
    unsigned* ctr; LAS int* slot; int wave, x; const char* XN; const char* WIN; const char* MEMN; const char* WMEM;
    __device__ __forceinline__ bool next(int i, pg8::Unit& u) const {
        if (wave == 0) { int t = 0; if (lane_id() == 0) t = (int)__hip_atomic_fetch_add(ctr, 1u, __ATOMIC_RELAXED, __HIP_MEMORY_SCOPE_AGENT); t = __builtin_amdgcn_readfirstlane(t); if (lane_id() == 0) slot[i & 1] = t; }
        LDS_WAIT(); __builtin_amdgcn_s_barrier(); asm volatile("" ::: "memory");
        const int idx = __builtin_amdgcn_readfirstlane(slot[i & 1]);
        if (idx > 232) return false;
        u.rows = 0; u.nt = 16;
        if (idx == 232) { u.pm = x >> 2; u.pn = x & 3; u.A = MEMN + (size_t)u.pm * 256 * 2048; u.B = WMEM + (size_t)u.pn * 256 * 2048; u.aux = 3; u.scale = 1.f; return true; }
        u.pm = 8 * x + (idx & 7); u.pn = idx >> 3;
        u.A = XN + (size_t)u.pm * 256 * 2048; u.B = WIN + (size_t)u.pn * 256 * 2048;
        const int pn = u.pn;
        if (pn < 2 || (pn >= 6 && pn < 9)) { u.aux = 1; u.scale = QS64; } else if (pn == 15 || pn == 16) { u.aux = 1; u.scale = QS128; } else if (pn >= 17) { u.aux = 2; u.scale = 1.f; } else { u.aux = 0; u.scale = 1.f; }
        return true;
    }
};
struct P1Epi {
    bf16_t* PROJ; bf16_t* MKV;
    __device__ __forceinline__ void operator()(const f32x4 (&acc)[2][2][4][2], const pg8::Unit& u, int wr, int wc, int fr, int fq) const {
        bf16_t* O = u.aux == 3 ? MKV : PROJ + ((size_t)(u.pm * 29 + u.pn) << 16); const int ldo = u.aux == 3 ? 1024 : 256;
        const int row0 = (u.aux == 3 ? u.pm * 256 : 0) + wr * 64 + fr, col0 = (u.aux == 3 ? u.pn * 256 : 0) + wc * 32 + 8 * fq; const float sc = u.scale; const bool sg = u.aux == 2;
#pragma unroll
        for (int ai = 0; ai < 2; ++ai)
#pragma unroll
            for (int m = 0; m < 4; ++m) { bf16_t* rowp = O + (size_t)(row0 + ai * 128 + m * 16) * ldo + col0;
#pragma unroll
                for (int bj = 0; bj < 2; ++bj) { f32x4 v0 = acc[ai][bj][m][0], v1 = acc[ai][bj][m][1];
                    if (sg) { v0 = (f32x4){fast_sigmoid(v0[0]), fast_sigmoid(v0[1]), fast_sigmoid(v0[2]), fast_sigmoid(v0[3])}; v1 = (f32x4){fast_sigmoid(v1[0]), fast_sigmoid(v1[1]), fast_sigmoid(v1[2]), fast_sigmoid(v1[3])}; }
                    else { v0 = v0 * sc; v1 = v1 * sc; }
                    u32x4 w; w.x = cvt_pk_bf16(v0[0], v0[1]); w.y = cvt_pk_bf16(v0[2], v0[3]); w.z = cvt_pk_bf16(v1[0], v1[1]); w.w = cvt_pk_bf16(v1[2], v1[3]);
                    *(GAS u32x4*)(rowp + bj * 128) = w; } }
    }
};

template <int DH> __device__ __forceinline__ int k_addr(int key, int c) {
    if (DH == 64) return key * 128 + ((c ^ ((key >> 1) & 7)) << 4);
    else return key * 256 + ((c ^ (key & 15)) << 4);
}
template <int DH> __device__ __forceinline__ int v_addr(int key, int c) {
    if (DH == 64) return key * 128 + ((c ^ (((key >> 1) & 3) << 1)) << 4);
    else return key * 256 + ((c ^ ((key & 7) << 1)) << 4);
}
__device__ __forceinline__ s16x4 vtr(const LAS unsigned char* p) { return __builtin_bit_cast(s16x4, __builtin_amdgcn_ds_read_tr16_b64_v4i16((LAS s16x4*)p)); }

template <int DH, class RowFn> __device__ __forceinline__ void stage_kv(LAS unsigned char* Kl, LAS unsigned char* Vl, int nkeys, int tid, const RowFn& rowfn) {
    constexpr int CH = DH / 8; const int total = nkeys * CH;
    for (int base = 0; base < total; base += NTHREADS * 4) {
        u32x4 kv[4], vv[4];
#pragma unroll
        for (int j = 0; j < 4; ++j) { const int ci = base + j * NTHREADS + tid; kv[j] = (u32x4){0u, 0u, 0u, 0u}; vv[j] = kv[j];
            if (ci < total) { const int key = ci / CH, c = ci % CH; const bf16_t* kp; const bf16_t* vp; rowfn(key, kp, vp); if (kp) { kv[j] = *(const GAS u32x4*)(kp + c * 8); vv[j] = *(const GAS u32x4*)(vp + c * 8); } } }
#pragma unroll
        for (int j = 0; j < 4; ++j) { const int ci = base + j * NTHREADS + tid;
            if (ci < total) { const int key = ci / CH, c = ci % CH; *(LAS u32x4*)(Kl + k_addr<DH>(key, c)) = kv[j]; *(LAS u32x4*)(Vl + v_addr<DH>(key, c)) = vv[j]; } }
    }
}

template <int DH> __device__ __forceinline__ f32x4 qk_tile(const LAS unsigned char* Kl, int kbase, const bf16x8 (&qf)[DH / 32], int i, int g) {
    f32x4 acc = (f32x4){0.f, 0.f, 0.f, 0.f}; const int key = kbase + i;
#pragma unroll
    for (int s = 0; s < DH / 32; ++s) { const bf16x8 kf = *(const LAS bf16x8*)(Kl + k_addr<DH>(key, 4 * s + g)); acc = __builtin_amdgcn_mfma_f32_16x16x32_bf16(kf, qf[s], acc, 0, 0, 0); }
    return acc;
}
template <int DH> __device__ __forceinline__ void pv_step(f32x4 (&o)[DH / 16], const LAS unsigned char* Vl, int vbase, int vbase2, bf16x8 pf, int i, int g) {
    const int k0 = vbase + 4 * g + (i >> 2), k1 = vbase2 + 4 * g + (i >> 2); const int sub = (i & 3) >> 1, b8 = 8 * (i & 1);
#pragma unroll
    for (int n = 0; n < DH / 16; ++n) {
        const s16x4 lo = vtr(Vl + v_addr<DH>(k0, 2 * n + sub) + b8), hi = vtr(Vl + v_addr<DH>(k1, 2 * n + sub) + b8);
        const bf16x8 vf = (bf16x8){lo[0], lo[1], lo[2], lo[3], hi[0], hi[1], hi[2], hi[3]};
        o[n] = __builtin_amdgcn_mfma_f32_16x16x32_bf16(vf, pf, o[n], 0, 0, 0);
    }
}
__device__ __forceinline__ bf16x8 pack_p(const f32x4& a, const f32x4& b) {
    u32x4 w; w.x = cvt_pk_bf16(a[0], a[1]); w.y = cvt_pk_bf16(a[2], a[3]); w.z = cvt_pk_bf16(b[0], b[1]); w.w = cvt_pk_bf16(b[2], b[3]); return __builtin_bit_cast(bf16x8, w);
}
template <int NT> __device__ __forceinline__ void softmax_tiles(f32x4 (&s)[NT], float& m, float& l) {
    float mx = -INFINITY;
#pragma unroll
    for (int t = 0; t < NT; ++t) mx = fmaxf(fmaxf(fmaxf(mx, s[t][0]), fmaxf(s[t][1], s[t][2])), s[t][3]);
    mx = fmaxf(mx, sx(mx, 16)); mx = fmaxf(mx, sx(mx, 32));
    float sum = 0.f;
#pragma unroll
    for (int t = 0; t < NT; ++t) {
#pragma unroll
        for (int r = 0; r < 4; ++r) { const float p = __builtin_amdgcn_exp2f(s[t][r] - mx); s[t][r] = p; sum += p; } }
    sum += sx(sum, 16); sum += sx(sum, 32);
    m = mx; l = sum;
}
template <int DH> __device__ __forceinline__ void load_q(bf16x8 (&qf)[DH / 32], const bf16_t* qrow, int g) {
#pragma unroll
    for (int s = 0; s < DH / 32; ++s) qf[s] = *(const GAS bf16x8*)(qrow + 32 * s + 8 * g);
}
template <int DH> __device__ __forceinline__ void store_o(const f32x4 (&o)[DH / 16], float inv, bf16_t* orow, int g) {
#pragma unroll
    for (int n = 0; n < DH / 16; ++n) { u32x2 w; w.x = cvt_pk_bf16(o[n][0] * inv, o[n][1] * inv); w.y = cvt_pk_bf16(o[n][2] * inv, o[n][3] * inv); *(GAS u32x2*)(orow + 16 * n + 4 * g) = w; }
}

template <int DH, int NPF, class RowFn> __device__ __forceinline__ void pf_issue(u32x4 (&kv)[NPF], u32x4 (&vv)[NPF], int nkeys, int tid, const RowFn& rowfn) {
    constexpr int CH = DH / 8; const int total = nkeys * CH;
#pragma unroll
    for (int j = 0; j < NPF; ++j) { const int ci = j * NTHREADS + tid; kv[j] = (u32x4){0u, 0u, 0u, 0u}; vv[j] = kv[j];
        if (ci < total) { const int key = ci / CH, c = ci % CH; const bf16_t* kp; const bf16_t* vp; rowfn(key, kp, vp); if (kp) { kv[j] = *(const GAS u32x4*)(kp + c * 8); vv[j] = *(const GAS u32x4*)(vp + c * 8); } } }
}
template <int DH, int NPF> __device__ __forceinline__ void pf_commit(const u32x4 (&kv)[NPF], const u32x4 (&vv)[NPF], LAS unsigned char* Kl, LAS unsigned char* Vl, int nkeys, int tid) {
    constexpr int CH = DH / 8; const int total = nkeys * CH;
#pragma unroll
    for (int j = 0; j < NPF; ++j) { const int ci = j * NTHREADS + tid;
        if (ci < total) { const int key = ci / CH, c = ci % CH; *(LAS u32x4*)(Kl + k_addr<DH>(key, c)) = kv[j]; *(LAS u32x4*)(Vl + v_addr<DH>(key, c)) = vv[j]; } }
}
struct AUnit { int b, h, r0, rsU; };
__device__ __forceinline__ AUnit a_unit(int c, int rep) { const int ua = c + 256 * rep, x = ua & 7, y = ua >> 3, pair = x * 2 + (y >> 6), rp = y & 63; AUnit u; u.b = pair >> 3; u.h = pair & 7; u.r0 = 2 * rp; int rs = u.r0 - 4; u.rsU = rs < 0 ? 0 : (rs > 120 ? 120 : rs); return u; }
struct BUnit { int b, hh, grp, dil, L, rho, n, p0; };
__device__ __forceinline__ BUnit b_unit(int c, int rep) { const int ub = c + 256 * rep, x = ub & 7, y = ub >> 3, combo = x * 3 + y / 64, sub = y % 64; BUnit u; u.b = combo / 12; u.hh = combo % 12; u.grp = u.hh >> 2;
    u.dil = u.grp == 0 ? 1 : (u.grp == 1 ? 4 : 16); u.L = SEQ / u.dil; const int nb = u.L / 128; u.rho = sub / nb; u.n = sub % nb; u.p0 = 128 * u.n - 64; return u; }

__device__ __forceinline__ void p2_attention(const Ctx& F0) {
    const Ctx F = ctx_refresh(F0);
    const bf16_t* PROJ = (const bf16_t*)(F.ws + WS_PROJ); const bf16_t* MKV = (const bf16_t*)(F.ws + WS_MKV);
    bf16_t* ABC = (bf16_t*)(F.ws + WS_ABC); bf16_t* OB = (bf16_t*)(F.ws + WS_OB); float* LSE = (float*)(F.ws + WS_MISC + MO_LSE);
    const float* T5 = (const float*)(F.ws + WS_MISC + MO_T5); const float* RPB = (const float*)(F.ws + WS_MISC + MO_RPB);
    LAS unsigned char* Kl = F.lds; LAS float* tab = (LAS float*)(F.lds + LDS_TAB);
    const int w = F.wave, c = (int)blockIdx.x;
#define P2_LANE() int tid_r = F.tid; asm volatile("" : "+v"(tid_r)); const int lane = tid_r & 63, i = lane & 15, g = lane >> 4; (void)lane
#define PF_A(rep_, KV, VV, T0, T1) do { const AUnit nu = a_unit(c, rep_); \
        pf_issue<64, 9>(KV, VV, 576, tid_r, [&](int key, const bf16_t*& kp, const bf16_t*& vp) { kp = nullptr; vp = nullptr; if (nu.rsU * 64 + key < SEQ) { const size_t tok = (size_t)nu.b * SEQ + nu.rsU * 64 + key; kp = PROJ + proj_off(tok, C_KA + nu.h * 64); vp = PROJ + proj_off(tok, C_VA + nu.h * 64); } }); \
        T0 = RPB[nu.h * RPB_LD + tid_r]; T1 = tid_r < RPB_LD - NTHREADS ? RPB[nu.h * RPB_LD + NTHREADS + tid_r] : 0.f; } while (0)
#define CM_A(KV, VV, T0, T1) do { pf_commit<64, 9>(KV, VV, Kl, Kl + 73728, 576, tid_r); tab[tid_r] = T0; if (tid_r < RPB_LD - NTHREADS) tab[NTHREADS + tid_r] = T1; } while (0)
#define PF_B(rep_, KV, VV, T0) do { const BUnit nu = b_unit(c, rep_); \
        pf_issue<64, 5>(KV, VV, 272, tid_r, [&](int key, const bf16_t*& kp, const bf16_t*& vp) { const int p = nu.p0 + key; kp = nullptr; vp = nullptr; \
            if (key < 256 && p >= 0 && p < nu.L) { const size_t tok = (size_t)nu.b * SEQ + (size_t)p * nu.dil + nu.rho; kp = PROJ + proj_off(tok, C_KB + nu.hh * 64); vp = PROJ + proj_off(tok, C_VB + nu.hh * 64); } }); \
        T0 = tid_r < T5_LD ? T5[nu.hh * T5_LD + tid_r] : 0.f; } while (0)
#define CM_B(KV, VV, T0) do { pf_commit<64, 5>(KV, VV, Kl, Kl + 34816, 272, tid_r); if (tid_r < T5_LD) tab[tid_r] = T0; } while (0)
    u32x4 akv[9], avv[9]; float at0 = 0.f, at1 = 0.f;
    {
        LAS unsigned char* Vl = Kl + 65536; P2_LANE();
        const int combo = c & 7, b = combo >> 2, h = combo & 3;
        __syncthreads();
        stage_kv<128>(Kl, Vl, 256, tid_r, [&](int key, const bf16_t*& kp, const bf16_t*& vp) { kp = MKV + (size_t)(b * MEMLEN + key) * 1024 + h * 128; vp = kp + 512; });
        LDS_WAIT(); __syncthreads();
        for (int rep = 0; rep < 2; ++rep) {
            const int blk = (c >> 3) + 32 * rep; const int tok = b * SEQ + blk * 128 + w * 16 + i;
            bf16x8 qf[4]; load_q<128>(qf, PROJ + proj_off((size_t)tok, C_QC + h * 128), g);
            if (rep == 1) PF_A(0, akv, avv, at0, at1);
            f32x4 s[16];
#pragma unroll
            for (int t = 0; t < 16; ++t) s[t] = qk_tile<128>(Kl, 16 * t, qf, i, g);
            float m, l; softmax_tiles<16>(s, m, l);
            f32x4 o[8];
#pragma unroll
            for (int n = 0; n < 8; ++n) o[n] = (f32x4){0.f, 0.f, 0.f, 0.f};
#pragma unroll
            for (int u = 0; u < 8; ++u) pv_step<128>(o, Vl, 32 * u, 32 * u + 16, pack_p(s[2 * u], s[2 * u + 1]), i, g);
            store_o<128>(o, 1.0f / l, ABC + (size_t)tok * ABC_LD + 768 + h * 128, g);
        }
        __syncthreads(); CM_A(akv, avv, at0, at1); LDS_WAIT(); __syncthreads();
    }
    u32x4 bkv[5], bvv[5]; float bt0 = 0.f;
    for (int rep = 0; rep < 4; ++rep) {
        LAS unsigned char* Vl = Kl + 73728; P2_LANE();
        const AUnit U = a_unit(c, rep); const int b = U.b, h = U.h, r0 = U.r0, rsU = U.rsU;
        const int r = r0 + (w >> 2), jb = w & 3; int rs = r - 4; rs = rs < 0 ? 0 : (rs > 120 ? 120 : rs);
        const int cq = 16 * jb + i; int cs = cq - 8; cs = cs < 0 ? 0 : (cs > 48 ? 48 : cs);
        const int cw = jb == 0 ? 0 : (jb == 1 ? 8 : (jb == 2 ? 24 : 32));
        const int tok = b * SEQ + r * 64 + cq;
        bf16x8 qf[2]; load_q<64>(qf, PROJ + proj_off((size_t)tok, C_QA + h * 64), g);
        if (rep < 3) PF_A(rep + 1, akv, avv, at0, at1); else PF_B(0, bkv, bvv, bt0);
        const int kb0 = (rs - rsU) * 64 + cw;
        f32x4 s[16];
#pragma unroll
        for (int t = 0; t < 16; ++t) s[t] = qk_tile<64>(Kl, kb0 + (t >> 1) * 64 + 16 * (t & 1), qf, i, g);
        const int bidx = RPB_OFF + (7 - (r - rs)) * 31 + (cw + 4 * g - cq + 15); const int lo = cs - cw - 4 * g;
#pragma unroll
        for (int t = 0; t < 16; ++t) {
#pragma unroll
            for (int rr = 0; rr < 4; ++rr) { const int kc = 16 * (t & 1) + rr; const float bias = tab[bidx + (t >> 1) * 31 + kc]; const bool ok = kc >= lo && kc < lo + 16; s[t][rr] = ok ? s[t][rr] + bias : -INFINITY; } }
        float m, l; softmax_tiles<16>(s, m, l);
        f32x4 o[4];
#pragma unroll
        for (int n = 0; n < 4; ++n) o[n] = (f32x4){0.f, 0.f, 0.f, 0.f};
#pragma unroll
        for (int u = 0; u < 8; ++u) pv_step<64>(o, Vl, kb0 + u * 64, kb0 + u * 64 + 16, pack_p(s[2 * u], s[2 * u + 1]), i, g);
        store_o<64>(o, 1.0f / l, ABC + (size_t)tok * ABC_LD + h * 64, g);
        __syncthreads(); if (rep < 3) { CM_A(akv, avv, at0, at1); } else { CM_B(bkv, bvv, bt0); } LDS_WAIT(); __syncthreads();
    }
    for (int rep = 0; rep < 6; ++rep) {
        LAS unsigned char* Vl = Kl + 34816; P2_LANE();
        const BUnit U = b_unit(c, rep); const int b = U.b, hh = U.hh, grp = U.grp, dil = U.dil, L = U.L, rho = U.rho, n = U.n;
        const int pq = 128 * n + 16 * w + i; const int tok = b * SEQ + pq * dil + rho;
        bf16x8 qf[2]; load_q<64>(qf, PROJ + proj_off((size_t)tok, C_QB + hh * 64), g);
        if (rep < 5) PF_B(rep + 1, bkv, bvv, bt0);
        f32x4 s[10];
#pragma unroll
        for (int t = 0; t < 10; ++t) s[t] = qk_tile<64>(Kl, 16 * w + 16 * t, qf, i, g);
        const int rel0 = 4 * g - 64 - i;
#pragma unroll
        for (int t = 0; t < 10; ++t) {
#pragma unroll
            for (int rr = 0; rr < 4; ++rr) { const int rel = rel0 + 16 * t + rr; const int p = pq + rel; const float bias = tab[rel + 79]; const bool ok = rel >= -64 && rel <= 64 && p >= 0 && p < L; s[t][rr] = ok ? s[t][rr] + bias : -INFINITY; } }
        float m, l; softmax_tiles<10>(s, m, l);
        f32x4 o[4];
#pragma unroll
        for (int nn = 0; nn < 4; ++nn) o[nn] = (f32x4){0.f, 0.f, 0.f, 0.f};
#pragma unroll
        for (int u = 0; u < 5; ++u) pv_step<64>(o, Vl, 16 * w + 32 * u, 16 * w + 32 * u + 16, pack_p(s[2 * u], s[2 * u + 1]), i, g);
        const int h4 = hh & 3;
        store_o<64>(o, 1.0f / l, OB + ((size_t)grp * NTOK + tok) * 256 + h4 * 64, g);
        if (g == 0) LSE[((size_t)grp * NTOK + tok) * 4 + h4] = m + __builtin_amdgcn_logf(l);
        if (rep < 5) { __syncthreads(); CM_B(bkv, bvv, bt0); LDS_WAIT(); __syncthreads(); }
    }
#undef PF_A
#undef CM_A
#undef PF_B
#undef CM_B
}
#undef P2_LANE
__device__ __forceinline__ void p2b_merge(const Ctx& F0) {
    const Ctx F = ctx_refresh(F0);
    const bf16_t* OB = (const bf16_t*)(F.ws + WS_OB); const float* LSE = (const float*)(F.ws + WS_MISC + MO_LSE); bf16_t* ABC = (bf16_t*)(F.ws + WS_ABC);
    const int gt = F.vcu * NTHREADS + F.tid, NGT = F.G * NTHREADS;
    for (int it = gt; it < NTOK * 32; it += NGT) {
        const int tok = it >> 5, ch = it & 31, h = ch >> 3;
        const float l0 = LSE[(size_t)tok * 4 + h], l1 = LSE[((size_t)NTOK + tok) * 4 + h], l2 = LSE[((size_t)2 * NTOK + tok) * 4 + h];
        const float mx = fmaxf(l0, fmaxf(l1, l2)); float w0 = __builtin_amdgcn_exp2f(l0 - mx), w1 = __builtin_amdgcn_exp2f(l1 - mx), w2 = __builtin_amdgcn_exp2f(l2 - mx);
        const float inv = 1.0f / (w0 + w1 + w2); w0 *= inv; w1 *= inv; w2 *= inv;
        const u32x4 a = *(const GAS u32x4*)(OB + (size_t)tok * 256 + ch * 8), bq = *(const GAS u32x4*)(OB + ((size_t)NTOK + tok) * 256 + ch * 8), cq = *(const GAS u32x4*)(OB + ((size_t)2 * NTOK + tok) * 256 + ch * 8);
        u32x4 o;
#pragma unroll
        for (int j = 0; j < 4; ++j) { const float lo = w0 * bf_lo(a[j]) + w1 * bf_lo(bq[j]) + w2 * bf_lo(cq[j]), hi = w0 * bf_hi(a[j]) + w1 * bf_hi(bq[j]) + w2 * bf_hi(cq[j]); o[j] = cvt_pk_bf16(lo, hi); }
        *(GAS u32x4*)(ABC + (size_t)tok * ABC_LD + 512 + ch * 8) = o;
    }
}

struct P3Sched {
    int c; const char* ABCp; const char* WABC;
    __device__ __forceinline__ bool next(int i, pg8::Unit& u) const {
        if (i >= 3) return false;
        constexpr int nM = 64, nN = 4, nwg = 256;
        int wgid = c; { const int q = nwg / 8, xcd = wgid % 8, off = wgid / 8; wgid = xcd * q + off; }
        const int nig = 8 * nN, gid = wgid / nig, fm = gid * 8;
        u.pm = fm + ((wgid % nig) % 8); u.pn = (wgid % nig) / 8;
        const int sb = ((c >> 3) & 1) ? (i == 0 ? 1 : (i == 1 ? 0 : 2)) : i;
        const int koff = sb == 0 ? 0 : (sb == 1 ? 512 : 768);
        u.A = ABCp + (size_t)u.pm * 256 * (ABC_LD * 2) + koff * 2; u.B = WABC + (size_t)u.pn * 256 * (ABC_LD * 2) + koff * 2;
        u.rows = 0; u.nt = sb == 1 ? 4 : 8; u.aux = sb; u.scale = i == 0 ? 0.f : 1.f; return true;
    }
};
struct P3Epi {
    const bf16_t* PROJ; bf16_t* MERGED;
    __device__ __forceinline__ void operator()(const f32x4 (&acc)[2][2][4][2], const pg8::Unit& u, int wr, int wc, int fr, int fq) const {
        const int row0 = u.pm * 256 + wr * 64 + fr, col0 = u.pn * 256 + wc * 32 + 8 * fq; const int s = u.aux;
#pragma unroll
        for (int ai = 0; ai < 2; ++ai) {
            u32x4 gt[4][2], prev[4][2];
#pragma unroll
            for (int m = 0; m < 4; ++m)
#pragma unroll
                for (int bj = 0; bj < 2; ++bj) { const size_t row = (size_t)(row0 + ai * 128 + m * 16); const int col = col0 + bj * 128;
                    gt[m][bj] = *(const GAS u32x4*)(PROJ + proj_off(row, C_GATE + s * 1024 + col));
                    prev[m][bj] = (u32x4){0u, 0u, 0u, 0u}; if (u.scale != 0.f) prev[m][bj] = __builtin_nontemporal_load((const GAS u32x4*)(MERGED + row * 1024 + col)); }
            asm volatile("" ::: "memory");
#pragma unroll
            for (int m = 0; m < 4; ++m)
#pragma unroll
                for (int bj = 0; bj < 2; ++bj) { const size_t row = (size_t)(row0 + ai * 128 + m * 16); const int col = col0 + bj * 128;
                    const f32x4 v0 = acc[ai][bj][m][0], v1 = acc[ai][bj][m][1]; const u32x4 g = gt[m][bj], pv = prev[m][bj];
                    u32x4 o;
                    o.x = cvt_pk_bf16(bf_lo(pv.x) + bf_lo(g.x) * v0[0], bf_hi(pv.x) + bf_hi(g.x) * v0[1]);
                    o.y = cvt_pk_bf16(bf_lo(pv.y) + bf_lo(g.y) * v0[2], bf_hi(pv.y) + bf_hi(g.y) * v0[3]);
                    o.z = cvt_pk_bf16(bf_lo(pv.z) + bf_lo(g.z) * v1[0], bf_hi(pv.z) + bf_hi(g.z) * v1[1]);
                    o.w = cvt_pk_bf16(bf_lo(pv.w) + bf_lo(g.w) * v1[2], bf_hi(pv.w) + bf_hi(g.w) * v1[3]);
                    *(GAS u32x4*)(MERGED + row * 1024 + col) = o; }
            asm volatile("" ::: "memory");
        }
    }
};
struct P4Sched {
    int c; const char* MERGED; const char* WOUT;
    __device__ __forceinline__ bool next(int i, pg8::Unit& u) const {
        if (i >= 1) return false;
        constexpr int nN = 4, nwg = 256;
        int wgid = c; { const int q = nwg / 8, xcd = wgid % 8, off = wgid / 8; wgid = xcd * q + off; }
        const int nig = 8 * nN, gid = wgid / nig, fm = gid * 8;
        u.pm = fm + ((wgid % nig) % 8); u.pn = (wgid % nig) / 8;
        u.A = MERGED + (size_t)u.pm * 256 * 2048; u.B = WOUT + (size_t)u.pn * 256 * 2048; u.rows = 0; u.nt = 16; u.aux = 0; u.scale = 1.f; return true;
    }
};
struct P4Epi {
    const float* X; float* X1;
    __device__ __forceinline__ void operator()(const f32x4 (&acc)[2][2][4][2], const pg8::Unit& u, int wr, int wc, int fr, int fq) const {
        const int row0 = u.pm * 256 + wr * 64 + fr, col0 = u.pn * 256 + wc * 32 + 8 * fq;
#pragma unroll
        for (int ai = 0; ai < 2; ++ai) {
            f32x4 xv[4][2][2];
#pragma unroll
            for (int m = 0; m < 4; ++m)
#pragma unroll
                for (int bj = 0; bj < 2; ++bj) { const size_t off = (size_t)(row0 + ai * 128 + m * 16) * 1024 + col0 + bj * 128; xv[m][bj][0] = *(const GAS f32x4*)(X + off); xv[m][bj][1] = *(const GAS f32x4*)(X + off + 4); }
            asm volatile("" ::: "memory");
#pragma unroll
            for (int m = 0; m < 4; ++m)
#pragma unroll
                for (int bj = 0; bj < 2; ++bj) { const size_t off = (size_t)(row0 + ai * 128 + m * 16) * 1024 + col0 + bj * 128;
                    *(GAS f32x4*)(X1 + off) = xv[m][bj][0] + acc[ai][bj][m][0]; *(GAS f32x4*)(X1 + off + 4) = xv[m][bj][1] + acc[ai][bj][m][1]; }
            asm volatile("" ::: "memory");
        }
    }
};
__device__ __forceinline__ void p5_router(const Ctx& F0) {
    const KArgs ap = kargs(); const float* X1 = ap->out; const float* GF = ap->in[12]; const float* RW = ap->in[13]; const float* RB = ap->in[14];
    const Ctx F = ctx_refresh(F0);
    unsigned char* H8 = F.ws + WS_XN; float* RTOK = (float*)(F.ws + WS_MISC + MO_RTOK);
    int* TOPIDX = (int*)(F.ws + WS_MISC + MO_TOPIDX); float* TOPW = (float*)(F.ws + WS_MISC + MO_TOPW); int* HIST = (int*)(F.ws + WS_MISC + MO_HIST);
    LAS float* Wl = (LAS float*)F.lds;
    LAS float* xch = (LAS float*)(F.lds + 131072);
    LAS float* xss = (LAS float*)(F.lds + 131072 + 8192);
    LAS int* hist = (LAS int*)(F.lds + LDS_TAB);
    __syncthreads();
    for (int idx = F.tid; idx < 1024 * 8; idx += NTHREADS) { const int k = idx >> 3, q = idx & 7; const f32x4 wv = *(const GAS f32x4*)(RW + (size_t)k * 32 + 4 * q) * GF[k];
        *(LAS f32x4*)(Wl + k * 32 + ((4 * q) ^ (((k >> 5) & 1) << 4))) = wv; }
    if (F.tid < 32) hist[F.tid] = 0;
    LDS_WAIT(); __syncthreads();
    const int lane = F.lane, i = lane & 15, kq = lane >> 4, tg = F.wave & 3, kh = F.wave >> 2; const int bid = (int)blockIdx.x;
    const int tok = bid * 64 + tg * 16 + i; const int kbase = kh * 512 + 32 * kq;
    const float* xrow = X1 + (size_t)tok * D + kbase; const float* grow = GF + kbase;
    const LAS float* wb0 = Wl + kbase * 32 + (i ^ ((kq & 1) << 4)); const LAS float* wb1 = Wl + kbase * 32 + ((i + 16) ^ ((kq & 1) << 4));
    f32x4 acc0 = {0.f, 0.f, 0.f, 0.f}, acc1 = {0.f, 0.f, 0.f, 0.f}; float ss = 0.f;
#pragma unroll 1
    for (int c = 0; c < 4; ++c) {
        f32x4 xv[8], gv[8];
#pragma unroll
        for (int q = 0; q < 8; ++q) { xv[q] = *(const GAS f32x4*)(xrow + c * 128 + 4 * q); gv[q] = *(const GAS f32x4*)(grow + c * 128 + 4 * q); }
        unsigned o[8];
#pragma unroll
        for (int q = 0; q < 8; ++q) { const f32x4 x = xv[q], pq = x * gv[q]; ss += (x.x * x.x + x.y * x.y) + (x.z * x.z + x.w * x.w);
            int w = __builtin_amdgcn_cvt_pk_fp8_f32(pq.x, pq.y, 0, false); w = __builtin_amdgcn_cvt_pk_fp8_f32(pq.z, pq.w, w, true); o[q] = (unsigned)w; }
        GAS u32x4* op = (GAS u32x4*)(H8 + (size_t)tok * D + kbase + c * 128);
        op[0] = (u32x4){o[0], o[1], o[2], o[3]}; op[1] = (u32x4){o[4], o[5], o[6], o[7]};
#pragma unroll
        for (int j = 0; j < 32; ++j) { const float a = xv[j >> 2][j & 3]; const float b0 = wb0[(c * 128 + j) * 32], b1 = wb1[(c * 128 + j) * 32];
            acc0 = __builtin_amdgcn_mfma_f32_16x16x4f32(a, b0, acc0, 0, 0, 0); acc1 = __builtin_amdgcn_mfma_f32_16x16x4f32(a, b1, acc1, 0, 0, 0); }
    }
    ss += sx(ss, 16); ss += sx(ss, 32);
    if (kh == 1) { LAS float* xp = xch + (tg * 64 + lane) * 8; *(LAS f32x4*)xp = acc0; *(LAS f32x4*)(xp + 4) = acc1; if (lane < 16) xss[tg * 16 + lane] = ss; }
    LDS_WAIT(); __syncthreads();
    if (kh == 0) {
        const LAS float* xp = xch + (tg * 64 + lane) * 8; acc0 += *(const LAS f32x4*)xp; acc1 += *(const LAS f32x4*)(xp + 4); ss += xss[tg * 16 + i];
        const float rt = 1.0f / sqrtf(ss * (1.f / D) + RMS_EPS);
        if (lane < 16) RTOK[tok] = rt;
        const float bias0 = RB[i], bias1 = RB[i + 16];
        float c0[4], c1[4];
#pragma unroll
        for (int r = 0; r < 4; ++r) { const float rr = sidx(rt, 4 * kq + r); c0[r] = acc0[r] * rr + bias0; c1[r] = acc1[r] * rr + bias1; }
        float tv[4][4]; int ti[4][4];
#pragma unroll
        for (int k = 0; k < 4; ++k)
#pragma unroll
            for (int r = 0; r < 4; ++r) { float bv = c0[r] >= c1[r] ? c0[r] : c1[r]; int bi = c0[r] >= c1[r] ? i : i + 16;
#pragma unroll
                for (int off = 1; off < 16; off <<= 1) { const float ov = sx(bv, off); const int oi = sxi(bi, off); const bool take = (ov > bv) || (ov == bv && oi < bi); bv = take ? ov : bv; bi = take ? oi : bi; }
                tv[k][r] = bv; ti[k][r] = bi; if (bi == i) c0[r] = -INFINITY; if (bi == i + 16) c1[r] = -INFINITY; }
        if (i == 0) {
#pragma unroll
            for (int r = 0; r < 4; ++r) { const int t = bid * 64 + tg * 16 + 4 * kq + r;
                const float e1 = __expf(tv[1][r] - tv[0][r]), e2 = __expf(tv[2][r] - tv[0][r]), e3 = __expf(tv[3][r] - tv[0][r]); const float inv = 1.0f / (1.0f + e1 + e2 + e3);
                *(GAS i32x4*)(TOPIDX + t * 4) = (i32x4){ti[0][r], ti[1][r], ti[2][r], ti[3][r]}; *(GAS f32x4*)(TOPW + t * 4) = (f32x4){inv, e1 * inv, e2 * inv, e3 * inv};
                atomicAdd((int*)&hist[ti[0][r]], 1); atomicAdd((int*)&hist[ti[1][r]], 1); atomicAdd((int*)&hist[ti[2][r]], 1); atomicAdd((int*)&hist[ti[3][r]], 1); }
        }
    }
    LDS_WAIT(); __syncthreads();
    if (F.tid < 32) HIST[bid * 32 + F.tid] = hist[F.tid];
}
__device__ __forceinline__ void p6_slots(const Ctx& F0) {
    const Ctx F = ctx_refresh(F0);
    const int* TOPIDX = (const int*)(F.ws + WS_MISC + MO_TOPIDX); const float* TOPW = (const float*)(F.ws + WS_MISC + MO_TOPW); const int* HIST = (const int*)(F.ws + WS_MISC + MO_HIST);
    int* TOKSLOT = (int*)(F.ws + WS_MISC + MO_TOKSLOT); int* SLOTTOK = (int*)(F.ws + WS_MISC + MO_SLOTTOK); float* SLOTW = (float*)(F.ws + WS_MISC + MO_SLOTW); int* TILE = (int*)(F.ws + WS_MISC + MO_TILE);
    LAS int* part = (LAS int*)F.lds;
    LAS int* pref = part + 512;
    LAS int* tot = part + 1024;
    LAS int* mypre = tot + 32; LAS int* sbase = tot + 64; LAS int* wcnt = tot + 96;
    const int bid = (int)blockIdx.x, tid = F.tid;
    __syncthreads();
    { const int e = tid & 31, ch = tid >> 5; int s = 0, p = 0;
        for (int j = 0; j < 16; ++j) { const int bb = ch * 16 + j; const int hv = HIST[bb * 32 + e]; s += hv; if (bb < bid) p += hv; }
        part[ch * 32 + e] = s; pref[ch * 32 + e] = p; }
    LDS_WAIT(); __syncthreads();
    if (tid < 32) { int s = 0, p = 0; for (int ch = 0; ch < 16; ++ch) { s += part[ch * 32 + tid]; p += pref[ch * 32 + tid]; } tot[tid] = s; mypre[tid] = p; }
    LDS_WAIT(); __syncthreads();
    if (tid == 0) { int tb = 0; for (int e = 0; e < 32; ++e) { sbase[e] = tb * 256; const int nt = (tot[e] + 255) >> 8; if (bid == 0) { for (int j = 0; j < nt; ++j) TILE[1 + tb + j] = e; } tb += nt; } if (bid == 0) TILE[0] = tb; }
    LDS_WAIT(); __syncthreads();
    int e_me = 0, rank = 0; float w_me = 0.f; const int ent = tid;
    if (tid < 256) { e_me = TOPIDX[bid * 256 + ent]; w_me = TOPW[bid * 256 + ent];
        const int wv = tid >> 6;
        for (int e = 0; e < 32; ++e) { const unsigned long long bal = __ballot(e_me == e); if (e_me == e) rank = __builtin_popcountll(bal & ((1ull << F.lane) - 1ull)); if (F.lane == 0) wcnt[wv * 32 + e] = __builtin_popcountll(bal); } }
    LDS_WAIT(); __syncthreads();
    if (tid < 256) { const int wv = tid >> 6; for (int j = 0; j < wv; ++j) rank += wcnt[j * 32 + e_me];
        const int slot = sbase[e_me] + mypre[e_me] + rank; const int tok = bid * 64 + (ent >> 2);
        SLOTTOK[slot] = tok; SLOTW[slot] = w_me; TOKSLOT[bid * 256 + ent] = slot; }
    if (bid < 32) { const int e = bid; const int beg = sbase[e] + tot[e], end = sbase[e] + (((tot[e] + 255) >> 8) << 8); for (int s = beg + tid; s < end; s += NTHREADS) { SLOTTOK[s] = 0; SLOTW[s] = 0.f; } }
}
constexpr int LDS_ROWS = 139264, LDS_TILE = 139264 + 11 * 1024;
static_assert(LDS_TILE + 4 * (1 + MAX_TILES) <= LDS_MISC, "LDS tables");
template <int NPN, bool ROWS> __device__ __forceinline__ void moe_tables(const Ctx& F, const int* TILE, const int* SLOTTOK) {
    LAS int* tl = (LAS int*)(F.lds + LDS_TILE);
    __syncthreads();
    for (int j = F.tid; j < 1 + MAX_TILES; j += NTHREADS) tl[j] = __hip_atomic_load((int*)TILE + j, __ATOMIC_RELAXED, __HIP_MEMORY_SCOPE_AGENT);
    if (ROWS) { const int ntile = __builtin_amdgcn_readfirstlane(__hip_atomic_load((int*)TILE, __ATOMIC_RELAXED, __HIP_MEMORY_SCOPE_AGENT));
        for (int i = 0; i < 11; ++i) { const int L = i * F.G + (int)blockIdx.x; if (L >= ntile * NPN) break; const int m = L / NPN;
            if (F.tid < 256) ((LAS int*)(F.lds + LDS_ROWS))[i * 256 + F.tid] = SLOTTOK[m * 256 + F.tid]; } }
    LDS_WAIT(); __syncthreads();
}
struct P7Sched {
    int G, c; LAS const int* tl; const char* H2; const char* WGU; int ntile;
    __device__ __forceinline__ bool next(int i, pg8::Unit& u) const {
        const int L = i * G + c; if (L >= ntile * 8 || i >= 11) return false;
        const int m = L >> 3, pn = L & 7, e = __builtin_amdgcn_readfirstlane(tl[1 + m]);
        u.pm = m; u.pn = pn; u.aux = e; u.scale = 1.f; u.nt = 8; u.rows = LDS_ROWS + 1024 * i; u.A = H2; u.B = WGU + ((size_t)e * 2048 + pn * 256) * 1024; return true;
    }
};
struct P7Epi {
    const float* BGU; bf16_t* ACT; const float* RTOK; LAS const unsigned char* lds;
    __device__ __forceinline__ void operator()(const f32x4 (&acc)[2][2][4][2], const pg8::Unit& u, int wr, int wc, int fr, int fq) const {
        const int row0 = u.pm * 256 + wr * 64 + fr, cc0 = wc * 32 + 8 * fq, e = u.aux;
        float rr[2][4];
#pragma unroll
        for (int ai = 0; ai < 2; ++ai)
#pragma unroll
            for (int m = 0; m < 4; ++m) rr[ai][m] = RTOK[((LAS const int*)(lds + u.rows))[wr * 64 + fr + ai * 128 + m * 16]];
        const float* bg = BGU + (size_t)e * 2048 + u.pn * 128 + cc0; const float* bu = bg + 1024;
        const f32x4 bg0 = *(const GAS f32x4*)bg, bg1 = *(const GAS f32x4*)(bg + 4), bu0 = *(const GAS f32x4*)bu, bu1 = *(const GAS f32x4*)(bu + 4);
#pragma unroll
        for (int ai = 0; ai < 2; ++ai)
#pragma unroll
            for (int m = 0; m < 4; ++m) { const size_t row = (size_t)(row0 + ai * 128 + m * 16);
                float av[8];
#pragma unroll
                for (int n = 0; n < 2; ++n) { const f32x4 gv = acc[ai][0][m][n] * rr[ai][m] + (n ? bg1 : bg0), uv = acc[ai][1][m][n] * rr[ai][m] + (n ? bu1 : bu0);
#pragma unroll
                    for (int j = 0; j < 4; ++j) { const float gg = fminf(gv[j], 7.0f); const float uu = fminf(fmaxf(uv[j], -7.0f), 7.0f); av[4 * n + j] = (uu + 1.0f) * gg * fast_sigmoid(1.702f * gg); } }
                int w0 = __builtin_amdgcn_cvt_pk_fp8_f32(av[0], av[1], 0, false); w0 = __builtin_amdgcn_cvt_pk_fp8_f32(av[2], av[3], w0, true);
                int w1 = __builtin_amdgcn_cvt_pk_fp8_f32(av[4], av[5], 0, false); w1 = __builtin_amdgcn_cvt_pk_fp8_f32(av[6], av[7], w1, true);
                *(GAS u32x2*)((unsigned char*)ACT + row * 1024 + u.pn * 128 + cc0) = (u32x2){(unsigned)w0, (unsigned)w1}; }
    }
};
struct P8Sched {
    int G, c; LAS const int* tl; const char* ACT; const char* WDN; int ntile;
    __device__ __forceinline__ bool next(int i, pg8::Unit& u) const {
        const int L = i * G + c; if (L >= ntile * 4) return false;
        const int m = L >> 2, pn = L & 3, e = __builtin_amdgcn_readfirstlane(tl[1 + m]);
        u.pm = m; u.pn = pn; u.aux = e; u.scale = 1.f; u.nt = 8; u.rows = 0; u.A = ACT + (size_t)m * 256 * 1024; u.B = WDN + ((size_t)e * 1024 + pn * 256) * 1024; return true;
    }
};
struct P8Epi {
    const float* BDN; const float* SLOTW; bf16_t* YS;
    __device__ __forceinline__ void operator()(const f32x4 (&acc)[2][2][4][2], const pg8::Unit& u, int wr, int wc, int fr, int fq) const {
        const int row0 = u.pm * 256 + wr * 64 + fr, col0 = u.pn * 256 + wc * 32 + 8 * fq, e = u.aux;
        const float* bp = BDN + (size_t)e * 1024 + col0;
        f32x4 bv[2][2]; float sw[2][4];
#pragma unroll
        for (int bj = 0; bj < 2; ++bj) { bv[bj][0] = *(const GAS f32x4*)(bp + bj * 128); bv[bj][1] = *(const GAS f32x4*)(bp + bj * 128 + 4); }
#pragma unroll
        for (int ai = 0; ai < 2; ++ai)
#pragma unroll
            for (int m = 0; m < 4; ++m) sw[ai][m] = SLOTW[row0 + ai * 128 + m * 16];
        asm volatile("" ::: "memory");
#pragma unroll
        for (int ai = 0; ai < 2; ++ai)
#pragma unroll
            for (int m = 0; m < 4; ++m) { const size_t row = (size_t)(row0 + ai * 128 + m * 16); const float w_ = sw[ai][m];
#pragma unroll
                for (int bj = 0; bj < 2; ++bj) { const f32x4 v0 = (acc[ai][bj][m][0] + bv[bj][0]) * w_, v1 = (acc[ai][bj][m][1] + bv[bj][1]) * w_;
                    int w0 = __builtin_amdgcn_cvt_pk_fp8_f32(v0[0], v0[1], 0, false); w0 = __builtin_amdgcn_cvt_pk_fp8_f32(v0[2], v0[3], w0, true);
                    int w1 = __builtin_amdgcn_cvt_pk_fp8_f32(v1[0], v1[1], 0, false); w1 = __builtin_amdgcn_cvt_pk_fp8_f32(v1[2], v1[3], w1, true);
                    *(GAS u32x2*)((unsigned char*)YS + row * 1024 + col0 + bj * 128) = (u32x2){(unsigned)w0, (unsigned)w1}; } }
    }
};
__device__ __forceinline__ void p9_final(const Ctx& F0) {
    const KArgs ap = kargs(); struct { const float* in[20]; float* out; } a; a.in[19] = ap->in[19]; a.out = ap->out;
    const Ctx F = ctx_refresh(F0);
    float* OUT = a.out; const bf16_t* YS = (const bf16_t*)(F.ws + WS_YS); const int* TOKSLOT = (const int*)(F.ws + WS_MISC + MO_TOKSLOT); const float* GN = a.in[19];
    const int gw = F.vcu * NWAVES + F.wave, NGW = F.G * NWAVES, lane = F.lane;
    const GAS f32x4* gr = (const GAS f32x4*)GN + lane;
    const bool bad = ld_uniform((const int*)(F.ws + WS_CTL) + 4096 + XB_TMO) != 0;
    float ckscale = 1.0f;
#ifdef CKSUM
    { const int* prev = (const int*)(F.ws + WS_MISC + 7 * MiB); if (ld_uniform(prev) == 0x5EED1234) ckscale = 1.0f + 0.25f * (float)ld_uniform(prev + 1); }
#endif
    int slotv = 0; { const int k_ = lane >> 2, t_ = gw + k_ * NGW; if (lane < 32 && t_ < NTOK) slotv = __hip_atomic_load((int*)TOKSLOT + t_ * 4 + (lane & 3), __ATOMIC_RELAXED, __HIP_MEMORY_SCOPE_AGENT); }
    int kt = 0;
    for (int tok = gw; tok < NTOK; tok += NGW, ++kt) {
        GAS f32x4* xr = (GAS f32x4*)(OUT + (size_t)tok * D) + lane;
        f32x4 v[4];
#pragma unroll
        for (int jj = 0; jj < 4; ++jj) v[jj] = xr[64 * jj];
        const int slots[4] = {__builtin_amdgcn_readlane(slotv, kt * 4), __builtin_amdgcn_readlane(slotv, kt * 4 + 1), __builtin_amdgcn_readlane(slotv, kt * 4 + 2), __builtin_amdgcn_readlane(slotv, kt * 4 + 3)};
#pragma unroll
        for (int k = 0; k < 4; ++k) { const GAS unsigned* yr = (const GAS unsigned*)((const unsigned char*)YS + (size_t)slots[k] * 1024) + lane;
#pragma unroll
            for (int jj = 0; jj < 4; ++jj) { const unsigned y = yr[64 * jj]; const f32x2 lo = __builtin_amdgcn_cvt_pk_f32_fp8((int)y, false), hi = __builtin_amdgcn_cvt_pk_f32_fp8((int)y, true);
                v[jj].x += lo.x; v[jj].y += lo.y; v[jj].z += hi.x; v[jj].w += hi.y; } }
        float ss = 0.f;
#pragma unroll
        for (int jj = 0; jj < 4; ++jj) ss += (v[jj].x * v[jj].x + v[jj].y * v[jj].y) + (v[jj].z * v[jj].z + v[jj].w * v[jj].w);
        const float r = 1.0f / sqrtf(wave_sum(ss) * (1.f / D) + RMS_EPS);
#pragma unroll
        for (int jj = 0; jj < 4; ++jj) { const f32x4 gg = gr[64 * jj]; f32x4 o = (f32x4){v[jj].x * r * gg.x, v[jj].y * r * gg.y, v[jj].z * r * gg.z, v[jj].w * r * gg.w} * ckscale; if (bad) o = (f32x4){__builtin_nanf(""), __builtin_nanf(""), __builtin_nanf(""), __builtin_nanf("")}; xr[64 * jj] = o; }
    }
}

__device__ __forceinline__ void grid_barrier(int wave) {
    extern __shared__ __attribute__((aligned(16))) unsigned char lds_dyn[];
    XcdBarrier b; b.bar = (unsigned*)(kargs()->ws + WS_CTL) + 4096; b.x = xb_xcc_id(); b.st = (volatile LAS unsigned*)((LAS unsigned char*)lds_dyn + LDS_MISC) + 8; b.wave = wave;
    xcd_barrier(b);
}
__global__ void __launch_bounds__(NTHREADS, 2) fwd_megakernel(Args args) {
    const int wave = __builtin_amdgcn_readfirstlane((int)threadIdx.x >> 6);
    {
        const Ctx F = make_ctx(wave);
        volatile LAS unsigned* MISC = (volatile LAS unsigned*)(F.lds + LDS_MISC);
        for (int u = F.tid; u < 128; u += NTHREADS) MISC[u] = 0u;
        __syncthreads();
        (void)xcd_barrier_post((unsigned*)(F.ws + WS_CTL) + 4096, MISC + 8, wave);
    }
#ifndef TSK
#define TSK -1
#endif
#ifndef TSB
#define TSB 0
#endif
    unsigned long long ts0_ = 0ull, ts1_ = 0ull; if (TSK >= 0) ts0_ = __builtin_amdgcn_s_memrealtime();
#define TS(k) do { if (TSK == (k)) ts1_ = __builtin_amdgcn_s_memrealtime(); } while (0)
#define F make_ctx(wave)
#define ws (kargs()->ws)
#define xcd_barrier(bar) grid_barrier(wave)
#ifndef PHM
#define PHM 0xFFFF
#endif
#define PH(k) ((PHM >> (k)) & 1)
#ifndef PHR
#define PHR 0
#endif
#define RP(k) ((PHR >> (k)) & 1)
#ifdef CANARY
    {
        const size_t n16 = (WS_END - WS_MISC) / 16; GAS u32x4* p = (GAS u32x4*)(ws + WS_MISC);
        for (size_t i = (size_t)blockIdx.x * NTHREADS + F.tid; i < n16; i += (size_t)F.G * NTHREADS) p[i] = (u32x4){0xffffffffu, 0xffffffffu, 0xffffffffu, 0xffffffffu};
        GAS u32x4* q = (GAS u32x4*)kargs()->out;
        for (size_t i = (size_t)blockIdx.x * NTHREADS + F.tid; i < (size_t)NTOK * D / 4; i += (size_t)F.G * NTHREADS) q[i] = (u32x4){0xffffffffu, 0xffffffffu, 0xffffffffu, 0xffffffffu};
        xcd_barrier(bar);
    }
#endif
    if (PH(0)) p0_prologue(F);
    xcd_barrier(bar);
    if (RP(0)) { p0_prologue(F); xcd_barrier(bar); }
    TS(0);
    CK(1, ws + WS_WIN_T, WS_MKV - WS_WIN_T); CK(1, ws + WS_XN, WS_ABC - WS_XN); CK(1, ws + WS_WGU_T, WS_PROJ - WS_WGU_T); CK(1, ws + WS_MISC + MO_T5, 128 * 1024);
    for (int rp_ = 0; rp_ < 1 + RP(1); ++rp_) {
    if (PH(1)) {
        p1_convert_experts(F);
        TS(12);
        P1Sched S{(unsigned*)(ws + WS_CTL) + 12288 + 64 * ((int)blockIdx.x & 7), (LAS int*)(F.lds + LDS_MISC) + 32, F.wave, (int)blockIdx.x & 7, (const char*)(ws + WS_XN), (const char*)(ws + WS_WIN_T), (const char*)(ws + WS_MEMN), (const char*)(ws + WS_WMEM_T)};
        P1Epi E{(bf16_t*)(ws + WS_PROJ), (bf16_t*)(ws + WS_MKV)};
        pg8::gemm_phase<P1Epi, P1Sched, false>(F.lds, F.wave, 2048u, 2048u, S, E);
    }
    xcd_barrier(bar);
    }
    TS(1);
    CK(2, ws + WS_PROJ, WS_ACT - WS_PROJ); CK(2, ws + WS_MKV, 1 * MiB);
    if (PH(2)) p2_attention(F);
    xcd_barrier(bar);
    if (RP(2)) { p2_attention(F); xcd_barrier(bar); }
    TS(2);
    CK(3, ws + WS_OB, WS_MERGED - WS_OB); CK(3, ws + WS_MISC + MO_LSE, 3 * 16384 * 16);
    if (PH(10)) p2b_merge(F);
    xcd_barrier(bar);
    TS(10);
    CK(4, ws + WS_ABC, WS_OB - WS_ABC);
    for (int rp_ = 0; rp_ < 1 + RP(3); ++rp_) {
    if (PH(3)) {
        P3Sched S{(int)blockIdx.x, (const char*)(ws + WS_ABC), (const char*)(ws + WS_WABC_T)};
        P3Epi E{(const bf16_t*)(ws + WS_PROJ), (bf16_t*)(ws + WS_MERGED)};
        pg8::gemm_phase<P3Epi, P3Sched, false>(F.lds, F.wave, (unsigned)(ABC_LD * 2), (unsigned)(ABC_LD * 2), S, E);
    }
    xcd_barrier(bar);
    }
    TS(3);
    CK(5, ws + WS_MERGED, 32 * MiB);
    for (int rp_ = 0; rp_ < 1 + RP(4); ++rp_) {
    if (PH(4)) {
        P4Sched S{(int)blockIdx.x, (const char*)(ws + WS_MERGED), (const char*)(ws + WS_WOUT_T)};
        P4Epi E{kargs()->in[0], kargs()->out};
        pg8::gemm_phase<P4Epi, P4Sched, false>(F.lds, F.wave, 2048u, 2048u, S, E);
    }
    xcd_barrier(bar);
    }
    TS(4);
    CK(6, kargs()->out, 64 * MiB);
    if (PH(5)) p5_router(F);
    xcd_barrier(bar);
    if (RP(5)) { p5_router(F); xcd_barrier(bar); }
    TS(5);
    CK(7, ws + WS_XN, 32 * MiB); CK(7, ws + WS_MISC, 512 * 1024 + 32 * 1024);
    if (PH(6)) p6_slots(F);
    xcd_barrier(bar);
    TS(6);
#ifdef CKSUM
#define ck_rows ((size_t)ld_uniform((const int*)(ws + WS_MISC + MO_TILE)) * 256)
    CK(8, ws + WS_MISC + MO_TOKSLOT, 256 * 1024); CK(8, ws + WS_MISC + MO_SLOTTOK, ck_rows * 4); CK(8, ws + WS_MISC + MO_SLOTW, ck_rows * 4); CK(8, ws + WS_MISC + MO_TILE, 1024);
#endif
    for (int rp_ = 0; rp_ < 1 + RP(7); ++rp_) {
    if (PH(7)) {
        moe_tables<8, true>(F, (const int*)(ws + WS_MISC + MO_TILE), (const int*)(ws + WS_MISC + MO_SLOTTOK));
        P7Sched S{F.G, (int)blockIdx.x, (LAS const int*)(F.lds + LDS_TILE), (const char*)(ws + WS_XN), (const char*)(ws + WS_WGU_T), __builtin_amdgcn_readfirstlane(*(LAS const int*)(F.lds + LDS_TILE))};
        P7Epi E{kargs()->in[16], (bf16_t*)(ws + WS_ACT), (const float*)(ws + WS_MISC + MO_RTOK), (LAS const unsigned char*)F.lds};
        pg8::gemm_phase<P7Epi, P7Sched, true, true>(F.lds, F.wave, 1024u, 1024u, S, E);
    }
    xcd_barrier(bar);
    }
    TS(7);
#ifdef CKSUM
    CK(9, ws + WS_ACT, ck_rows * 2048);
#endif
    for (int rp_ = 0; rp_ < 1 + RP(8); ++rp_) {
    if (PH(8)) {
        moe_tables<4, false>(F, (const int*)(ws + WS_MISC + MO_TILE), (const int*)(ws + WS_MISC + MO_SLOTTOK));
        P8Sched S{F.G, (int)blockIdx.x, (LAS const int*)(F.lds + LDS_TILE), (const char*)(ws + WS_ACT), (const char*)(ws + WS_WDN_T), __builtin_amdgcn_readfirstlane(*(LAS const int*)(F.lds + LDS_TILE))};
        P8Epi E{kargs()->in[18], (const float*)(ws + WS_MISC + MO_SLOTW), (bf16_t*)(ws + WS_YS)};
        pg8::gemm_phase<P8Epi, P8Sched, false, true>(F.lds, F.wave, 1024u, 1024u, S, E);
    }
    xcd_barrier(bar);
    }
    TS(8);
#ifdef CKSUM
    CK(10, ws + WS_YS, ck_rows * 2048);
#endif
    if (PH(9)) p9_final(F);
    if (TSK >= 0 && blockIdx.x == TSB && wave == 0) { const unsigned long long te_ = __builtin_amdgcn_s_memrealtime(); const unsigned long long wait_ = 50ull * (ts1_ - ts0_); while (__builtin_amdgcn_s_memrealtime() - te_ < wait_) __builtin_amdgcn_s_sleep(32); }
#ifdef CKSUM
    xcd_barrier(bar);
    if (blockIdx.x == 0 && F.wave == 0 && lane_id() == 0) {
        unsigned* cur = (unsigned*)(ws + WS_CTL) + 8192; unsigned* prev = (unsigned*)(ws + WS_MISC + 7 * MiB);
        const bool have = __hip_atomic_load(prev, __ATOMIC_RELAXED, __HIP_MEMORY_SCOPE_AGENT) == 0x5EED1234u;
        unsigned flag = have ? __hip_atomic_load(prev + 1, __ATOMIC_RELAXED, __HIP_MEMORY_SCOPE_AGENT) : 0u;
        for (int k = 1; k <= 10; ++k) { const unsigned c = __hip_atomic_load(cur + 64 * k, __ATOMIC_RELAXED, __HIP_MEMORY_SCOPE_AGENT);
            if (have && flag == 0u && __hip_atomic_load(prev + 16 + k, __ATOMIC_RELAXED, __HIP_MEMORY_SCOPE_AGENT) != c) flag = (unsigned)k;
            __hip_atomic_store(prev + 16 + k, c, __ATOMIC_RELAXED, __HIP_MEMORY_SCOPE_AGENT); }
        __hip_atomic_store(prev + 1, flag, __ATOMIC_RELAXED, __HIP_MEMORY_SCOPE_AGENT); __hip_atomic_store(prev, 0x5EED1234u, __ATOMIC_RELAXED, __HIP_MEMORY_SCOPE_AGENT);
    }
#endif
}

#undef F
#undef ws
#undef xcd_barrier
extern "C" void kernel_launch(void* const* d_in, const int* in_sizes, int n_in, void* d_out, int out_size, void* d_ws, size_t ws_size, hipStream_t stream) {
    static int grid = 0;
    if (grid == 0) {
        if (n_in != 20 || out_size != NTOK * D || ws_size < WS_END) { fprintf(stderr, "kernel_launch: unexpected shapes (n_in %d, out %d, ws %zu); nothing launched\n", n_in, out_size, ws_size); grid = -1; return; }
        int dev = 0, cus = 0;
        if (hipGetDevice(&dev) != hipSuccess || hipDeviceGetAttribute(&cus, hipDeviceAttributeMultiprocessorCount, dev) != hipSuccess) { grid = -1; return; }
        if (hipFuncSetAttribute((const void*)fwd_megakernel, hipFuncAttributeMaxDynamicSharedMemorySize, LDS_BYTES) != hipSuccess) { fprintf(stderr, "kernel_launch: hipFuncSetAttribute failed\n"); grid = -1; return; }
        int per_cu = 0;
        if (hipOccupancyMaxActiveBlocksPerMultiprocessor(&per_cu, (const void*)fwd_megakernel, NTHREADS, LDS_BYTES) != hipSuccess || per_cu < 1) fprintf(stderr, "kernel_launch: occupancy query reports %d\n", per_cu);
        (void)hipGetLastError();
        grid = cus;
        if (grid != 256) fprintf(stderr, "kernel_launch: %d CUs; this kernel is laid out for 256\n", grid);
    }
    if (grid < 0) return;
    (void)hipMemsetAsync((char*)d_ws + WS_CTL, 0, CTL_ZERO_BYTES, stream);
    Args a{};
    for (int i = 0; i < 20; ++i) a.in[i] = (const float*)d_in[i];
    a.out = (float*)d_out; a.ws = (unsigned char*)d_ws;
    hipLaunchKernelGGL(fwd_megakernel, dim3(grid), dim3(NTHREADS), LDS_BYTES, stream, a);
}
```

```cpp
#include <hip/hip_runtime.h>
#include <cstdio>
#include <cstdint>

#define GAS __attribute__((address_space(1)))
#define LAS __attribute__((address_space(3)))
typedef unsigned short bf16_t;
typedef short bf16x8 __attribute__((ext_vector_type(8)));
typedef short s16x4 __attribute__((ext_vector_type(4)));
typedef float f32x4 __attribute__((ext_vector_type(4)));
typedef float f32x2 __attribute__((ext_vector_type(2)));
typedef unsigned u32x4 __attribute__((ext_vector_type(4)));
typedef unsigned u32x2 __attribute__((ext_vector_type(2)));
typedef int i32x4 __attribute__((ext_vector_type(4)));
typedef int i32x8 __attribute__((ext_vector_type(8)));
#define FP8_SCALE 0x7C7C7C7C
typedef GAS unsigned gu32;

constexpr int NTOK = 16384, SEQ = 8192, D = 1024, NMEM = 512, MEMLEN = 256;
constexpr int IN_COLS = 7424;
__host__ __device__ __forceinline__ size_t proj_off(size_t row, int col) { return (((row >> 8) * 29 + (size_t)(col >> 8)) << 16) + ((row & 255) << 8) + (size_t)(col & 255); }
constexpr int C_QA = 0, C_KA = 512, C_VA = 1024, C_QB = 1536, C_KB = 2304, C_VB = 3072, C_QC = 3840, C_GATE = 4352;
constexpr int NEXP = 32, TOPK = 4, DFF = 1024;
constexpr int MAX_TILES = 288, MAX_SLOTS = MAX_TILES * 256;
constexpr float RMS_EPS = 1e-6f, LOG2E = 1.4426950408889634f;
constexpr float QS64 = 0.125f * LOG2E, QS128 = 0.08838834764831845f * LOG2E;
constexpr int ABC_LD = 1280;

constexpr size_t MiB = 1u << 20;
constexpr size_t WS_CTL = 0, CTL_ZERO_BYTES = 1 * MiB;
constexpr size_t WS_MISC = 1 * MiB;
constexpr size_t MO_TOPIDX = 0, MO_TOPW = 256 * 1024, MO_HIST = 512 * 1024, MO_TOKSLOT = 1 * MiB, MO_SLOTTOK = 2 * MiB, MO_SLOTW = 3 * MiB, MO_TILE = 4 * MiB, MO_LSE = 5 * MiB, MO_T5 = 6 * MiB, MO_RPB = 6 * MiB + 64 * 1024, MO_RTOK = 7 * MiB + 64 * 1024;
constexpr size_t WS_WIN_T = 16 * MiB, WS_WMEM_T = 32 * MiB, WS_WABC_T = 34 * MiB, WS_WOUT_T = 37 * MiB, WS_MEMN = 39 * MiB, WS_MKV = 40 * MiB, WS_XN = 41 * MiB;
constexpr size_t WS_ABC = 73 * MiB, WS_OB = 113 * MiB, WS_MERGED = 137 * MiB, WS_WGU_T = 169 * MiB, WS_WDN_T = 297 * MiB, WS_PROJ = 361 * MiB, WS_ACT = 593 * MiB, WS_YS = 737 * MiB, WS_END = 881 * MiB;
constexpr int T5_LD = 192, RPB_LD = 640, RPB_OFF = 64;

constexpr int LDS_MAIN = 147456;
constexpr int LDS_TAB = LDS_MAIN;
constexpr int LDS_MISC = LDS_MAIN + 8192;
constexpr int LDS_BYTES = LDS_MISC + 512;

#define LDS_WAIT() asm volatile("s_waitcnt lgkmcnt(0)" ::: "memory")
#define VM_WAIT() asm volatile("s_waitcnt vmcnt(0)" ::: "memory")
__device__ __forceinline__ unsigned cvt_pk_bf16(float lo, float hi) { unsigned r; asm volatile("v_cvt_pk_bf16_f32 %0, %1, %2" : "=v"(r) : "v"(lo), "v"(hi)); return r; }
__device__ __forceinline__ float bf_lo(unsigned u) { return __uint_as_float(u << 16); }
__device__ __forceinline__ float bf_hi(unsigned u) { return __uint_as_float(u & 0xffff0000u); }
__device__ __forceinline__ int lane_id() { int l; asm volatile("v_mbcnt_lo_u32_b32 %0, -1, 0\n\tv_mbcnt_hi_u32_b32 %0, -1, %0" : "=v"(l)); return l; }
__device__ __forceinline__ float sx(float v, int off) { return __builtin_bit_cast(float, __builtin_amdgcn_ds_bpermute((lane_id() ^ off) << 2, __builtin_bit_cast(int, v))); }
__device__ __forceinline__ int sxi(int v, int off) { return __builtin_amdgcn_ds_bpermute((lane_id() ^ off) << 2, v); }
__device__ __forceinline__ float sidx(float v, int src) { return __builtin_bit_cast(float, __builtin_amdgcn_ds_bpermute(src << 2, __builtin_bit_cast(int, v))); }
__device__ __forceinline__ float wave_sum(float v) {
#pragma unroll
    for (int o = 1; o < 64; o <<= 1) v += sx(v, o);
    return v;
}
__device__ __forceinline__ float wave_max(float v) {
#pragma unroll
    for (int o = 1; o < 64; o <<= 1) v = fmaxf(v, sx(v, o));
    return v;
}
__device__ __forceinline__ int ld_uniform(const int* p) { return __builtin_amdgcn_readfirstlane(__hip_atomic_load((int*)p, __ATOMIC_RELAXED, __HIP_MEMORY_SCOPE_AGENT)); }
__device__ __forceinline__ float fast_sigmoid(float x) { return __builtin_amdgcn_rcpf(1.0f + __builtin_amdgcn_exp2f(-LOG2E * x)); }

namespace pg8 {
constexpr int BM = 256, BK = 64, HALF = 128, HTB = HALF * BK * 2, STAGE_BYTES = 8 * HTB, LDS_STASH = 131072  ;
__host__ __device__ __forceinline__ int lds_byte(int r, int c) { const int st = (r >> 4) * 2 + (c >> 5), rr = r & 15, cc = c & 31, ob = rr * 64 + cc * 2; return st * 1024 + (ob ^ (((ob >> 9) & 1) << 5)); }
__host__ __device__ __forceinline__ void stage_rc(int b, int& R, int& C) { const int st = b / 1024, sb = b % 1024, swz = sb ^ (((sb >> 9) & 1) << 5); R = (st >> 1) * 16 + swz / 64; C = (st & 1) * 32 + (swz % 64) / 2; }
__host__ __device__ __forceinline__ int perm32(int rho) { const int n = rho >> 4, i = rho & 15; return 8 * (i >> 2) + 4 * n + (i & 3); }

struct Unit {
    const char* A;
    const char* B;
    int rows;
    int nt;
    int pm, pn;
    int aux;
    float scale;
};

template <class Epi, class Sched, bool GATHER, bool FP8 = false>
__device__ __forceinline__ void gemm_phase(LAS unsigned char* lds, const int wave, const unsigned lda, const unsigned ldb, const Sched& S, const Epi& E) {
    const int lane = lane_id();
    const int wid = wave, tid = wave * 64 + lane, wr = wid >> 2, wc = wid & 3, fr = lane & 15, fq = lane >> 4;
    const int R0 = (wid >> 1) * 16 + (lane >> 2), C2 = ((wid & 1) * 32 + ((((lane & 3) * 8)) ^ ((lane >> 5) << 4))) * 2, Rb0 = (R0 & ~31) + perm32(R0 & 31);
    unsigned offA = (unsigned)R0 * lda + (unsigned)C2, offB = (unsigned)Rb0 * ldb + (unsigned)C2;
    const size_t kstep = (size_t)(BK * 2);
    const size_t hstepB = (size_t)HALF * ldb;
    const unsigned ldsw = (unsigned)wid * 1024u;
    const int aoff = lds_byte(wr * 64 + fr, fq * 8), boff = lds_byte(wc * 32 + fr, fq * 8);
#define PG8_SA(b, h) (((b) * 2 + (h)) * HTB)
#define PG8_SB(b, h) ((4 + (b) * 2 + (h)) * HTB)
#define PG8_STAGE2P(bufoff, p0, p1, v0, v1) do { \
        __builtin_amdgcn_global_load_lds((const unsigned*)((const char*)(p0) + (v0)), (LAS unsigned*)(lds + (bufoff) + ldsw), 16, 0, 0); \
        __builtin_amdgcn_global_load_lds((const unsigned*)((const char*)(p1) + (v1)), (LAS unsigned*)(lds + (bufoff) + ldsw + 8192), 16, 0, 0); } while (0)
#define PG8_STAGEB(bufoff, gbase) PG8_STAGE2P(bufoff, gbase, (const char*)(gbase) + (size_t)64 * ldb, offB, offB)
#define PG8_STAGEA(bufoff, gbase, h, g0, g1) do { if (GATHER) { PG8_STAGE2P(bufoff, gbase, gbase, g0, g1); } else { PG8_STAGE2P(bufoff, (const char*)(gbase) + (size_t)((h) * HALF) * lda, (const char*)(gbase) + (size_t)((h) * HALF + 64) * lda, offA, offA); } } while (0)
#define PG8_LDA(dst, b, h) do { _Pragma("unroll") for (int m = 0; m < 4; ++m) _Pragma("unroll") for (int k = 0; k < 2; ++k) dst[m][k] = *(const LAS bf16x8*)(lds + PG8_SA(b, h) + aoff + m * 2048 + k * 1024); } while (0)
#define PG8_LDB(dst, b, h) do { _Pragma("unroll") for (int n = 0; n < 2; ++n) _Pragma("unroll") for (int k = 0; k < 2; ++k) dst[n][k] = *(const LAS bf16x8*)(lds + PG8_SB(b, h) + boff + n * 2048 + k * 1024); } while (0)
#define PG8_MMA(ai, bj, At, Bt) do { __builtin_amdgcn_s_setprio(1); \
        if (FP8) { _Pragma("unroll") for (int m = 0; m < 4; ++m) _Pragma("unroll") for (int n = 0; n < 2; ++n) { \
            const i32x4 b0_ = __builtin_bit_cast(i32x4, Bt[n][0]), b1_ = __builtin_bit_cast(i32x4, Bt[n][1]), a0_ = __builtin_bit_cast(i32x4, At[m][0]), a1_ = __builtin_bit_cast(i32x4, At[m][1]); \
            const i32x8 bw_ = __builtin_shufflevector(b0_, b1_, 0, 1, 2, 3, 4, 5, 6, 7), aw_ = __builtin_shufflevector(a0_, a1_, 0, 1, 2, 3, 4, 5, 6, 7); \
            acc[ai][bj][m][n] = __builtin_amdgcn_mfma_scale_f32_16x16x128_f8f6f4(bw_, aw_, acc[ai][bj][m][n], 0, 0, 0, FP8_SCALE, 0, FP8_SCALE); } } \
        else { _Pragma("unroll") for (int m = 0; m < 4; ++m) _Pragma("unroll") for (int n = 0; n < 2; ++n) _Pragma("unroll") for (int k = 0; k < 2; ++k) \
            acc[ai][bj][m][n] = __builtin_amdgcn_mfma_f32_16x16x32_bf16(Bt[n][k], At[m][k], acc[ai][bj][m][n], 0, 0, 0); } \
        __builtin_amdgcn_s_setprio(0); } while (0)
#define PG8_WAIT_V(n) asm volatile("s_waitcnt vmcnt(" #n ")" ::: "memory")
#define PG8_WAIT_L(n) asm volatile("s_waitcnt lgkmcnt(" #n ")" ::: "memory")
#define PG8_BAR __builtin_amdgcn_s_barrier()
#define PG8_SCHED __builtin_amdgcn_sched_barrier(0)
    Unit cur, nxt; int ui = 0;
    if (!S.next(0, cur)) return;
    f32x4 acc[2][2][4][2];
#pragma unroll
    for (int a = 0; a < 2; ++a)
#pragma unroll
        for (int b = 0; b < 2; ++b)
#pragma unroll
            for (int m = 0; m < 4; ++m)
#pragma unroll
                for (int n = 0; n < 2; ++n) acc[a][b][m][n] = (f32x4){0.f, 0.f, 0.f, 0.f};
    bf16x8 At[4][2], B0[2][2], B1[2][2];
    unsigned c00 = 0, c01 = 0, c10 = 0, c11 = 0;
#define PG8_MKOFF(U, o00, o01, o10, o11) do { const LAS int* rl_ = (const LAS int*)(lds + (U).rows) + R0; \
        o00 = (unsigned)rl_[0] * lda + (unsigned)C2; o01 = (unsigned)rl_[64] * lda + (unsigned)C2; o10 = (unsigned)rl_[HALF] * lda + (unsigned)C2; o11 = (unsigned)rl_[HALF + 64] * lda + (unsigned)C2; } while (0)
    if (GATHER) { PG8_MKOFF(cur, c00, c01, c10, c11); }
    const char* cA = cur.A; const char* cB = cur.B; int nt = cur.nt;
    PG8_STAGEB(PG8_SB(0, 0), cB); PG8_STAGEB(PG8_SB(0, 1), cB + hstepB); PG8_STAGEA(PG8_SA(0, 0), cA, 0, c00, c01); PG8_STAGEA(PG8_SA(0, 1), cA, 1, c10, c11);
    if (wr == 1) PG8_BAR;
    PG8_WAIT_V(2); PG8_BAR;
    PG8_STAGEB(PG8_SB(1, 0), cB + kstep); PG8_STAGEA(PG8_SA(1, 0), cA + kstep, 0, c00, c01); PG8_STAGEB(PG8_SB(1, 1), cB + hstepB + kstep);
    PG8_WAIT_V(6); PG8_BAR;
    for (;;) {
        const bool has_next = S.next(ui + 1, nxt);
        const char* nA = has_next ? nxt.A : cA; const char* nB = has_next ? nxt.B : cB;
#pragma nounroll
        for (int t = 0; t < nt; t += 2) {
            const bool last = (t == nt - 2);
            if (GATHER) asm volatile("" : "+v"(c00), "+v"(c01), "+v"(c10), "+v"(c11)); asm volatile("" : "+v"(offA), "+v"(offB));
            const char* a1 = cA + (size_t)(t + 1) * kstep;
            const char* a2 = last ? nA : cA + (size_t)(t + 2) * kstep; const char* b2 = last ? nB : cB + (size_t)(t + 2) * kstep;
            const char* a3 = a2 + kstep; const char* b3 = b2 + kstep;
            PG8_LDB(B0, 0, 0); PG8_LDB(B1, 0, 1); PG8_SCHED; PG8_LDA(At, 0, 0); PG8_STAGEA(PG8_SA(1, 1), a1, 1, c10, c11);
            if (GATHER) { if (last && has_next) { PG8_MKOFF(nxt, c00, c01, c10, c11); } }
            PG8_WAIT_V(8); PG8_WAIT_L(0); PG8_BAR; PG8_MMA(0, 0, At, B0); PG8_MMA(0, 1, At, B1); PG8_BAR; PG8_SCHED;
            PG8_LDA(At, 0, 1); PG8_STAGEB(PG8_SB(0, 0), b2); PG8_STAGEB(PG8_SB(0, 1), b2 + hstepB); PG8_STAGEA(PG8_SA(0, 0), a2, 0, c00, c01);
            PG8_WAIT_V(8); PG8_WAIT_L(0); PG8_BAR; PG8_MMA(1, 0, At, B0); PG8_MMA(1, 1, At, B1); PG8_BAR; PG8_SCHED;
            PG8_LDB(B0, 1, 0); PG8_LDB(B1, 1, 1); PG8_SCHED; PG8_LDA(At, 1, 0); PG8_STAGEA(PG8_SA(0, 1), a2, 1, c10, c11);
            PG8_WAIT_V(8); PG8_WAIT_L(0); PG8_BAR; PG8_MMA(0, 0, At, B0); PG8_MMA(0, 1, At, B1); PG8_BAR; PG8_SCHED;
            PG8_LDA(At, 1, 1); PG8_STAGEB(PG8_SB(1, 0), b3); PG8_STAGEB(PG8_SB(1, 1), b3 + hstepB); PG8_STAGEA(PG8_SA(1, 0), a3, 0, c00, c01);
            PG8_WAIT_V(8); PG8_WAIT_L(0); PG8_BAR; PG8_MMA(1, 0, At, B0); PG8_MMA(1, 1, At, B1); PG8_BAR; PG8_SCHED;
        }
        if (wr == 0) PG8_BAR;
        { int le_ = lane; asm volatile("" : "+v"(le_)); E(acc, cur, wr, wc, le_ & 15, le_ >> 4); }
        if (GATHER) { if (has_next) { asm volatile("" ::: "memory"); PG8_MKOFF(nxt, c00, c01, c10, c11); } }
        if (!has_next) break;
#pragma unroll
        for (int a = 0; a < 2; ++a)
#pragma unroll
            for (int b = 0; b < 2; ++b)
#pragma unroll
                for (int m = 0; m < 4; ++m)
#pragma unroll
                    for (int n = 0; n < 2; ++n) acc[a][b][m][n] = (f32x4){0.f, 0.f, 0.f, 0.f};
        cur = nxt; cA = nA; cB = nB; nt = cur.nt; ++ui;
        if (wr == 1) PG8_BAR;
    }
    PG8_WAIT_V(0);
    PG8_BAR;
#undef PG8_SA
#undef PG8_SB
#undef PG8_STAGE2P
#undef PG8_STAGEB
#undef PG8_LDA
#undef PG8_LDB
#undef PG8_MMA
#undef PG8_WAIT_V
#undef PG8_WAIT_L
#undef PG8_BAR
#undef PG8_SCHED
#undef PG8_MKOFF
#undef PG8_STAGEA
}
}

#define XB_TMO      128
#define XB_XCNT(j)  (256  + 64 * (j))
#define XB_XSUB(j)  (1280 + 64 * (j))
#define XB_XGEN(j)  (2304 + 64 * (j))
#define XB_TOP      3328
#define XB_TOPGEN   3392
#define XCD_BAR_WORDS 3456
#define XB_SPIN_CAP (1u << 18)
__device__ __forceinline__ unsigned xb_ld(unsigned* p)              { return __hip_atomic_load(p, __ATOMIC_RELAXED, __HIP_MEMORY_SCOPE_AGENT); }
__device__ __forceinline__ unsigned xb_add(unsigned* p, unsigned v) { return __hip_atomic_fetch_add(p, v, __ATOMIC_RELAXED, __HIP_MEMORY_SCOPE_AGENT); }
__device__ __forceinline__ unsigned xb_xcc_id() { return (unsigned)__builtin_amdgcn_s_getreg((3 << 11) | 20) & 0xFu; }
#define XB_SPIN(cond, bar) do { unsigned _sp = 0; while (cond) { __builtin_amdgcn_s_sleep(1); \
    if ((++_sp & 255u) == 0u) { if (xb_ld(&(bar)[XB_TMO])) break; if (_sp > XB_SPIN_CAP) { atomicAdd(&(bar)[XB_TMO], 1u); break; } } } } while (0)
struct XcdBarrier { unsigned* bar; unsigned x; volatile LAS unsigned* st; int wave; };
__device__ __forceinline__ XcdBarrier xcd_barrier_post(unsigned* bar, volatile LAS unsigned* st, int wave) {
    XcdBarrier b; b.bar = bar; b.x = xb_xcc_id(); b.st = st; b.wave = wave;
    if (wave == 0 && lane_id() == 0) (void)xb_add(&bar[XB_XCNT(b.x)], 1u);
    return b;
}
__device__ __forceinline__ void xcd_barrier_complete(unsigned* bar, unsigned x, unsigned& nloc, unsigned& nx) {
    const unsigned G = gridDim.x * gridDim.y * gridDim.z;
    unsigned sum, cnt, mine, sp = 0u;
    for (;;) {
        sum = 0u; cnt = 0u; mine = 0u;
#pragma unroll
        for (unsigned j = 0; j < 16; ++j) { const unsigned c = xb_ld(&bar[XB_XCNT(j)]); sum += c; cnt += (c > 0u) ? 1u : 0u; mine = (j == x) ? c : mine; }
        if (sum == G) break;
        __builtin_amdgcn_s_sleep(1);
        if ((++sp & 255u) == 0u) { if (xb_ld(&bar[XB_TMO])) break; if (sp > XB_SPIN_CAP) { atomicAdd(&bar[XB_TMO], 1u); break; } }
    }
    nloc = mine > 0u ? mine : 1u; nx = cnt > 0u ? cnt : 1u;
}
__device__ __forceinline__ void xcd_barrier(const XcdBarrier& b) {
    asm volatile("s_waitcnt vmcnt(0)" ::: "memory");
    __syncthreads();
    if (b.wave == 0 && lane_id() == 0) {
        unsigned* bar = b.bar;
        __builtin_amdgcn_s_waitcnt(0);
        unsigned nloc = b.st[0], nx = b.st[1];
        if (nloc == 0u) { xcd_barrier_complete(bar, b.x, nloc, nx); b.st[0] = nloc; b.st[1] = nx; }
        const unsigned old = xb_add(&bar[XB_XSUB(b.x)], 1u);
        const unsigned gen = old / nloc;
        if (old + 1u == (gen + 1u) * nloc) {
            __builtin_amdgcn_fence(__ATOMIC_RELEASE, "agent");
            asm volatile("s_waitcnt vmcnt(0)" ::: "memory");
            const unsigned og = xb_add(&bar[XB_TOP], 1u);
            const unsigned tg = og / nx;
            if (og + 1u == (tg + 1u) * nx) xb_add(&bar[XB_TOPGEN], 1u);
            else XB_SPIN(xb_ld(&bar[XB_TOPGEN]) == tg, bar);
            __builtin_amdgcn_fence(__ATOMIC_ACQUIRE, "agent");
            xb_add(&bar[XB_XGEN(b.x)], 1u);
            asm volatile("s_waitcnt vmcnt(0)" ::: "memory");
        } else {
            XB_SPIN(xb_ld(&bar[XB_XGEN(b.x)]) == gen, bar);
            __builtin_amdgcn_fence(__ATOMIC_ACQUIRE, "agent");
            asm volatile("s_waitcnt vmcnt(0)" ::: "memory");
        }
    }
    __syncthreads();
}

struct Args { const float* in[20]; float* out; unsigned char* ws; };
typedef const __attribute__((address_space(4))) Args* KArgs;
__device__ __forceinline__ KArgs kargs() { KArgs k = (KArgs)__builtin_amdgcn_kernarg_segment_ptr(); asm volatile("" : "+s"(k)); return k; }
constexpr int NWAVES = 8, NTHREADS = 512;

struct Ctx {
    LAS unsigned char* lds;
    int tid, lane, wave, G, vcu;
    unsigned char* ws;
};
__device__ __forceinline__ Ctx make_ctx(int wave) {
    extern __shared__ __attribute__((aligned(16))) unsigned char lds_dyn[];
    Ctx F; int l = lane_id(); asm volatile("" : "+v"(l)); F.lds = (LAS unsigned char*)lds_dyn; F.lane = l; F.wave = wave; F.tid = wave * 64 + l;
    F.G = (int)gridDim.x; { const int bx = (int)blockIdx.x; F.vcu = (F.G % 8 == 0) ? (bx % 8) * (F.G / 8) + bx / 8 : bx; }
    F.ws = kargs()->ws; return F; }
__device__ __forceinline__ Ctx ctx_refresh(const Ctx& F0) { return make_ctx(F0.wave); }


#ifdef CKSUM
__device__ __forceinline__ void ck_region(const Ctx& F, int k, const void* base, size_t bytes) {
    const GAS u32x4* p = (const GAS u32x4*)base; const size_t n = bytes / 16; unsigned acc = 0u;
    const int tid_ = F.wave * 64 + lane_id();
    for (size_t i = (size_t)blockIdx.x * NTHREADS + tid_; i < n; i += (size_t)F.G * NTHREADS) { const u32x4 v = __builtin_nontemporal_load(p + i); acc += v.x * 3u + v.y * 5u + v.z * 7u + v.w * 11u + (unsigned)i; }
#pragma unroll
    for (int o = 1; o < 64; o <<= 1) acc += (unsigned)sxi((int)acc, o);
    if (lane_id() == 0) atomicAdd((unsigned*)(F.ws + WS_CTL) + 8192 + 64 * k, acc);
}
#define CK(k, base, bytes) ck_region(F, k, base, bytes)
#else
#define CK(k, base, bytes) do {} while (0)
#endif
__device__ __forceinline__ void p0_transpose64(const float* W, int ldw, int k0, int n0, bf16_t* dst, int ldt, LAS float* scr, int lane) {
    f32x4 v[16];
#pragma unroll
    for (int i = 0; i < 16; ++i) { const int kk = 4 * i + (lane >> 4); v[i] = *(const GAS f32x4*)(W + (size_t)(k0 + kk) * ldw + n0 + 4 * (lane & 15)); }
#pragma unroll
    for (int i = 0; i < 16; ++i) { const int kk = 4 * i + (lane >> 4); LAS float* s = scr + kk * 65 + 4 * (lane & 15); s[0] = v[i][0]; s[1] = v[i][1]; s[2] = v[i][2]; s[3] = v[i][3]; }
    LDS_WAIT(); asm volatile("" ::: "memory");
    const int c = lane & 7;
#pragma unroll
    for (int j = 0; j < 8; ++j) { const int n = (lane >> 3) + 8 * j; const LAS float* s = scr + (8 * c) * 65 + n;
        u32x4 o; o.x = cvt_pk_bf16(s[0 * 65], s[1 * 65]); o.y = cvt_pk_bf16(s[2 * 65], s[3 * 65]); o.z = cvt_pk_bf16(s[4 * 65], s[5 * 65]); o.w = cvt_pk_bf16(s[6 * 65], s[7 * 65]);
        *(GAS u32x4*)(dst + (size_t)n * ldt + 8 * c) = o; }
    LDS_WAIT(); asm volatile("" ::: "memory");
}
__device__ __forceinline__ void p0_transpose64_fp8(const float* W, int ldw, int k0, int n0, unsigned char* dst8, int ldt, LAS float* scr, int lane, float scale) {
    f32x4 v[16];
#pragma unroll
    for (int i = 0; i < 16; ++i) { const int kk = 4 * i + (lane >> 4); v[i] = *(const GAS f32x4*)(W + (size_t)(k0 + kk) * ldw + n0 + 4 * (lane & 15)); }
#pragma unroll
    for (int i = 0; i < 16; ++i) { const int kk = 4 * i + (lane >> 4); LAS float* s = scr + kk * 65 + 4 * (lane & 15); s[0] = v[i][0] * scale; s[1] = v[i][1] * scale; s[2] = v[i][2] * scale; s[3] = v[i][3] * scale; }
    LDS_WAIT(); asm volatile("" ::: "memory");
    const int c = lane & 3;
#pragma unroll
    for (int j = 0; j < 4; ++j) { const int n = (lane >> 2) + 16 * j; const LAS float* s = scr + (16 * c) * 65 + n;
        u32x4 o;
#pragma unroll
        for (int q = 0; q < 4; ++q) { int w = __builtin_amdgcn_cvt_pk_fp8_f32(s[(4 * q) * 65], s[(4 * q + 1) * 65], 0, false); w = __builtin_amdgcn_cvt_pk_fp8_f32(s[(4 * q + 2) * 65], s[(4 * q + 3) * 65], w, true); o[q] = (unsigned)w; }
        *(GAS u32x4*)(dst8 + (size_t)n * ldt + 16 * c) = o; }
    LDS_WAIT(); asm volatile("" ::: "memory");
}
__device__ __forceinline__ void rms_row_to_bf16(const float* xrow, const float* g, bf16_t* orow, int lane) {
    const GAS f32x4* xr = (const GAS f32x4*)xrow + lane; const GAS f32x4* gr = (const GAS f32x4*)g + lane;
    f32x4 v[4]; float s = 0.f;
#pragma unroll
    for (int j = 0; j < 4; ++j) { v[j] = xr[64 * j]; s += (v[j].x * v[j].x + v[j].y * v[j].y) + (v[j].z * v[j].z + v[j].w * v[j].w); }
    const float r = 1.0f / sqrtf(wave_sum(s) * (1.f / D) + RMS_EPS);
    GAS u32x2* o8 = (GAS u32x2*)orow + lane;
#pragma unroll
    for (int j = 0; j < 4; ++j) { const f32x4 gg = gr[64 * j]; u32x2 w; w.x = cvt_pk_bf16(v[j].x * r * gg.x, v[j].y * r * gg.y); w.y = cvt_pk_bf16(v[j].z * r * gg.z, v[j].w * r * gg.w); o8[64 * j] = w; }
}
__device__ __forceinline__ int t5_bucket(int rel) {
    int ret = rel > 0 ? 16 : 0; const int n = rel < 0 ? -rel : rel;
    if (n < 8) return ret + n;
    const float nf = (float)n;
    int large = 8 + (int)(logf(nf / 8.0f) / logf(128.0f) * 8.0f);
    large = large < 15 ? large : 15;
    return ret + large;
}
__device__ __forceinline__ void p0_prologue(const Ctx& F0) {
    const KArgs ap = kargs();
    const Ctx F = ctx_refresh(F0);
    LAS float* scr = (LAS float*)(F.lds) + F.wave * (64 * 65);
    const int gw = F.vcu * NWAVES + F.wave, NGW = F.G * NWAVES;
    bf16_t* WGU_T = (bf16_t*)(F.ws + WS_WGU_T); bf16_t* WDN_T = (bf16_t*)(F.ws + WS_WDN_T); bf16_t* WIN_T = (bf16_t*)(F.ws + WS_WIN_T);
    bf16_t* WMEM_T = (bf16_t*)(F.ws + WS_WMEM_T); bf16_t* WABC_T = (bf16_t*)(F.ws + WS_WABC_T); bf16_t* WOUT_T = (bf16_t*)(F.ws + WS_WOUT_T);
    constexpr int I_IN = 16 * 116, I_MEM = 256, I_A = 8 * 16, I_B = 4 * 16, I_C = 8 * 16, I_O = 256;
    constexpr int NITEMS = I_IN + I_MEM + I_A + I_B + I_C + I_O;
    for (int it = gw; it < NITEMS; it += NGW) {
        int r = it;
        if (r < I_IN) { const int kb = r / 116, nb = r % 116; p0_transpose64(ap->in[4], IN_COLS, kb * 64, nb * 64, WIN_T + (size_t)(nb * 64) * 1024 + kb * 64, 1024, scr, F.lane); continue; } r -= I_IN;
        if (r < I_MEM) { const int kb = r >> 4, nb = r & 15; p0_transpose64(ap->in[5], 1024, kb * 64, nb * 64, WMEM_T + (size_t)(nb * 64) * 1024 + kb * 64, 1024, scr, F.lane); continue; } r -= I_MEM;
        if (r < I_A) { const int kb = r >> 4, nb = r & 15; p0_transpose64(ap->in[8], 1024, kb * 64, nb * 64, WABC_T + (size_t)(nb * 64) * ABC_LD + 0 + kb * 64, ABC_LD, scr, F.lane); continue; } r -= I_A;
        if (r < I_B) { const int kb = r >> 4, nb = r & 15; p0_transpose64(ap->in[9], 1024, kb * 64, nb * 64, WABC_T + (size_t)(nb * 64) * ABC_LD + 512 + kb * 64, ABC_LD, scr, F.lane); continue; } r -= I_B;
        if (r < I_C) { const int kb = r >> 4, nb = r & 15; p0_transpose64(ap->in[10], 1024, kb * 64, nb * 64, WABC_T + (size_t)(nb * 64) * ABC_LD + 768 + kb * 64, ABC_LD, scr, F.lane); continue; } r -= I_C;
        { const int kb = r >> 4, nb = r & 15; p0_transpose64(ap->in[11], 1024, kb * 64, nb * 64, WOUT_T + (size_t)(nb * 64) * 1024 + kb * 64, 1024, scr, F.lane); }
    }
    bf16_t* XN = (bf16_t*)(F.ws + WS_XN); bf16_t* MEMN = (bf16_t*)(F.ws + WS_MEMN);
    for (int m = gw; m < NTOK; m += 2 * NGW) {
        const int m2 = m + NGW; const bool two = m2 < NTOK;
        const GAS f32x4* xa = (const GAS f32x4*)(ap->in[0] + (size_t)m * D) + F.lane; const GAS f32x4* xb = (const GAS f32x4*)(ap->in[0] + (size_t)(two ? m2 : m) * D) + F.lane;
        const GAS f32x4* gr = (const GAS f32x4*)ap->in[2] + F.lane;
        f32x4 va[4], vb[4]; float sa = 0.f, sb = 0.f;
#pragma unroll
        for (int j = 0; j < 4; ++j) { va[j] = xa[64 * j]; vb[j] = xb[64 * j]; }
#pragma unroll
        for (int j = 0; j < 4; ++j) { sa += (va[j].x * va[j].x + va[j].y * va[j].y) + (va[j].z * va[j].z + va[j].w * va[j].w); sb += (vb[j].x * vb[j].x + vb[j].y * vb[j].y) + (vb[j].z * vb[j].z + vb[j].w * vb[j].w); }
#pragma unroll
        for (int o = 1; o < 64; o <<= 1) { sa += sx(sa, o); sb += sx(sb, o); }
        const float ra = 1.0f / sqrtf(sa * (1.f / D) + RMS_EPS), rb = 1.0f / sqrtf(sb * (1.f / D) + RMS_EPS);
        GAS u32x2* oa = (GAS u32x2*)(XN + (size_t)m * D) + F.lane; GAS u32x2* ob = (GAS u32x2*)(XN + (size_t)m2 * D) + F.lane;
#pragma unroll
        for (int j = 0; j < 4; ++j) { const f32x4 gg = gr[64 * j]; u32x2 w; w.x = cvt_pk_bf16(va[j].x * ra * gg.x, va[j].y * ra * gg.y); w.y = cvt_pk_bf16(va[j].z * ra * gg.z, va[j].w * ra * gg.w); oa[64 * j] = w;
            if (two) { u32x2 w2; w2.x = cvt_pk_bf16(vb[j].x * rb * gg.x, vb[j].y * rb * gg.y); w2.y = cvt_pk_bf16(vb[j].z * rb * gg.z, vb[j].w * rb * gg.w); ob[64 * j] = w2; } }
    }
    for (int m = gw; m < NMEM; m += NGW) rms_row_to_bf16(ap->in[1] + (size_t)m * D, ap->in[3], MEMN + (size_t)m * D, F.lane);
    const int gt = F.vcu * NTHREADS + F.tid, NGT = F.G * NTHREADS;
    float* t5 = (float*)(F.ws + WS_MISC + MO_T5); float* rp = (float*)(F.ws + WS_MISC + MO_RPB);
    for (int i = gt; i < 12 * T5_LD; i += NGT) { const int gh = i / T5_LD, j = i % T5_LD, rel = j - 79, g = gh >> 2; const int dil = g == 0 ? 1 : (g == 1 ? 4 : 16);
        float v = 0.f; if (rel >= -64 && rel <= 64) v = ap->in[7][t5_bucket(rel * dil) * 12 + gh] * LOG2E; t5[i] = v; }
    for (int i = gt; i < 8 * RPB_LD; i += NGT) { const int h = i / RPB_LD, j = i % RPB_LD - RPB_OFF; float v = 0.f; if (j >= 0 && j < 465) v = ap->in[6][h * 465 + j] * LOG2E; rp[i] = v; }
}

__device__ __forceinline__ bool is_converter(int c) { return ((c >> 3) & 3) == 3; }
struct CvItem { const float* src; int ldw; unsigned char* dst; };
__device__ __forceinline__ CvItem cv_decode(int r, const float* GU, const float* DN, unsigned char* WGU8, unsigned char* WDN8) {
    constexpr int I_GU = 32 * 16 * 32; CvItem I;
    if (r < I_GU) { const int e = r >> 9, q = r & 511, kb = q >> 5, nb = q & 31, n0 = nb * 64; const int bj = n0 >> 10, rem = n0 & 1023, pn = rem >> 7, c0 = rem & 127;
        I.src = GU + (size_t)e * 1024 * 2048 + (size_t)(kb * 64) * 2048 + n0; I.ldw = 2048; I.dst = WGU8 + ((size_t)e * 2048 + pn * 256 + bj * 128 + c0) * 1024 + kb * 64; }
    else { r -= I_GU; const int e = r >> 8, q = r & 255, kb = q >> 4, nb = q & 15;
        I.src = DN + (size_t)e * 1024 * 1024 + (size_t)(kb * 64) * 1024 + nb * 64; I.ldw = 1024; I.dst = WDN8 + ((size_t)e * 1024 + nb * 64) * 1024 + kb * 64; }
    return I;
}
__device__ __forceinline__ void cv_load(const CvItem& I, f32x4 (&v)[16], int lane) {
#pragma unroll
    for (int i = 0; i < 16; ++i) { const int kk = 4 * i + (lane >> 4); v[i] = *(const GAS f32x4*)(I.src + (size_t)kk * I.ldw + 4 * (lane & 15)); }
}
__device__ __forceinline__ void cv_finish(const CvItem& I, const f32x4 (&v)[16], LAS float* scr, int lane) {
#pragma unroll
    for (int i = 0; i < 16; ++i) { const int kk = 4 * i + (lane >> 4); LAS float* s = scr + kk * 65 + 4 * (lane & 15); s[0] = v[i][0] * 64.0f; s[1] = v[i][1] * 64.0f; s[2] = v[i][2] * 64.0f; s[3] = v[i][3] * 64.0f; }
    LDS_WAIT(); asm volatile("" ::: "memory");
    const int c = lane & 3;
#pragma unroll
    for (int j = 0; j < 4; ++j) { const int n = (lane >> 2) + 16 * j; const LAS float* s = scr + (16 * c) * 65 + n;
        u32x4 o;
#pragma unroll
        for (int q = 0; q < 4; ++q) { int w = __builtin_amdgcn_cvt_pk_fp8_f32(s[(4 * q) * 65], s[(4 * q + 1) * 65], 0, false); w = __builtin_amdgcn_cvt_pk_fp8_f32(s[(4 * q + 2) * 65], s[(4 * q + 3) * 65], w, true); o[q] = (unsigned)w; }
        *(GAS u32x4*)(I.dst + (size_t)n * 1024 + 16 * c) = o; }
    LDS_WAIT(); asm volatile("" ::: "memory");
}
__device__ __forceinline__ void p1_convert_experts(const Ctx& F0) {
    const KArgs ap = kargs();
    const Ctx F = ctx_refresh(F0);
    const int c = (int)blockIdx.x; if (!is_converter(c)) return;
    LAS float* scr = (LAS float*)(F.lds) + F.wave * (64 * 65);
    const int ci = (c & 7) * 8 + (c >> 5);
    const float* GU = ap->in[15]; const float* DN = ap->in[17];
    unsigned char* WGU8 = (unsigned char*)(F.ws + WS_WGU_T); unsigned char* WDN8 = (unsigned char*)(F.ws + WS_WDN_T);
    constexpr int NIT = 32 * 16 * 32 + 32 * 16 * 16, STRIDE = 64 * NWAVES;
    int it = ci * NWAVES + F.wave;
    CvItem I = cv_decode(it, GU, DN, WGU8, WDN8); f32x4 va[16], vb[16]; cv_load(I, va, F.lane);
    for (;;) {
        const int itn = it + STRIDE; const bool hn = itn < NIT; CvItem In = I;
        if (hn) { In = cv_decode(itn, GU, DN, WGU8, WDN8); cv_load(In, vb, F.lane); }
        cv_finish(I, va, scr, F.lane);
        if (!hn) break;
        I = In; it = itn;
#pragma unroll
        for (int i = 0; i < 16; ++i) va[i] = vb[i];
    }
}

struct P1Sched {
    unsigned* ctr; LAS int* slot; int wave, x; const char* XN; const char* WIN; const char* MEMN; const char* WMEM;
    __device__ __forceinline__ bool next(int i, pg8::Unit& u) const {
        if (wave == 0) { int t = 0; if (lane_id() == 0) t = (int)__hip_atomic_fetch_add(ctr, 1u, __ATOMIC_RELAXED, __HIP_MEMORY_SCOPE_AGENT); t = __builtin_amdgcn_readfirstlane(t); if (lane_id() == 0) slot[i & 1] = t; }
        LDS_WAIT(); __builtin_amdgcn_s_barrier(); asm volatile("" ::: "memory");
        const int idx = __builtin_amdgcn_readfirstlane(slot[i & 1]);
        if (idx > 232) return false;
        u.rows = 0; u.nt = 16;
        if (idx == 232) { u.pm = x >> 2; u.pn = x & 3; u.A = MEMN + (size_t)u.pm * 256 * 2048; u.B = WMEM + (size_t)u.pn * 256 * 2048; u.aux = 3; u.scale = 1.f; return true; }
        u.pm = 8 * x + (idx & 7); u.pn = idx >> 3;
        u.A = XN + (size_t)u.pm * 256 * 2048; u.B = WIN + (size_t)u.pn * 256 * 2048;
        const int pn = u.pn;
        if (pn < 2 || (pn >= 6 && pn < 9)) { u.aux = 1; u.scale = QS64; } else if (pn == 15 || pn == 16) { u.aux = 1; u.scale = QS128; } else if (pn >= 17) { u.aux = 2; u.scale = 1.f; } else { u.aux = 0; u.scale = 1.f; }
        return true;
    }
};
struct P1Epi {
    bf16_t* PROJ; bf16_t* MKV;
    __device__ __forceinline__ void operator()(const f32x4 (&acc)[2][2][4][2], const pg8::Unit& u, int wr, int wc, int fr, int fq) const {
        bf16_t* O = u.aux == 3 ? MKV : PROJ + ((size_t)(u.pm * 29 + u.pn) << 16); const int ldo = u.aux == 3 ? 1024 : 256;
        const int row0 = (u.aux == 3 ? u.pm * 256 : 0) + wr * 64 + fr, col0 = (u.aux == 3 ? u.pn * 256 : 0) + wc * 32 + 8 * fq; const float sc = u.scale; const bool sg = u.aux == 2;
#pragma unroll
        for (int ai = 0; ai < 2; ++ai)
#pragma unroll
            for (int m = 0; m < 4; ++m) { bf16_t* rowp = O + (size_t)(row0 + ai * 128 + m * 16) * ldo + col0;
#pragma unroll
                for (int bj = 0; bj < 2; ++bj) { f32x4 v0 = acc[ai][bj][m][0], v1 = acc[ai][bj][m][1];
                    if (sg) { v0 = (f32x4){fast_sigmoid(v0[0]), fast_sigmoid(v0[1]), fast_sigmoid(v0[2]), fast_sigmoid(v0[3])}; v1 = (f32x4){fast_sigmoid(v1[0]), fast_sigmoid(v1[1]), fast_sigmoid(v1[2]), fast_sigmoid(v1[3])}; }
                    else { v0 = v0 * sc; v1 = v1 * sc; }
                    u32x4 w; w.x = cvt_pk_bf16(v0[0], v0[1]); w.y = cvt_pk_bf16(v0[2], v0[3]); w.z = cvt_pk_bf16(v1[0], v1[1]); w.w = cvt_pk_bf16(v1[2], v1[3]);
                    *(GAS u32x4*)(rowp + bj * 128) = w; } }
    }
};

template <int DH> __device__ __forceinline__ int k_addr(int key, int c) {
    if (DH == 64) return key * 128 + ((c ^ ((key >> 1) & 7)) << 4);
    else return key * 256 + ((c ^ (key & 15)) << 4);
}
template <int DH> __device__ __forceinline__ int v_addr(int key, int c) {
    if (DH == 64) return key * 128 + ((c ^ (((key >> 1) & 3) << 1)) << 4);
    else return key * 256 + ((c ^ ((key & 7) << 1)) << 4);
}
__device__ __forceinline__ s16x4 vtr(const LAS unsigned char* p) { return __builtin_bit_cast(s16x4, __builtin_amdgcn_ds_read_tr16_b64_v4i16((LAS s16x4*)p)); }

template <int DH, class RowFn> __device__ __forceinline__ void stage_kv(LAS unsigned char* Kl, LAS unsigned char* Vl, int nkeys, int tid, const RowFn& rowfn) {
    constexpr int CH = DH / 8; const int total = nkeys * CH;
    for (int base = 0; base < total; base += NTHREADS * 4) {
        u32x4 kv[4], vv[4];
#pragma unroll
        for (int j = 0; j < 4; ++j) { const int ci = base + j * NTHREADS + tid; kv[j] = (u32x4){0u, 0u, 0u, 0u}; vv[j] = kv[j];
            if (ci < total) { const int key = ci / CH, c = ci % CH; const bf16_t* kp; const bf16_t* vp; rowfn(key, kp, vp); if (kp) { kv[j] = *(const GAS u32x4*)(kp + c * 8); vv[j] = *(const GAS u32x4*)(vp + c * 8); } } }
#pragma unroll
        for (int j = 0; j < 4; ++j) { const int ci = base + j * NTHREADS + tid;
            if (ci < total) { const int key = ci / CH, c = ci % CH; *(LAS u32x4*)(Kl + k_addr<DH>(key, c)) = kv[j]; *(LAS u32x4*)(Vl + v_addr<DH>(key, c)) = vv[j]; } }
    }
}

template <int DH> __device__ __forceinline__ f32x4 qk_tile(const LAS unsigned char* Kl, int kbase, const bf16x8 (&qf)[DH / 32], int i, int g) {
    f32x4 acc = (f32x4){0.f, 0.f, 0.f, 0.f}; const int key = kbase + i;
#pragma unroll
    for (int s = 0; s < DH / 32; ++s) { const bf16x8 kf = *(const LAS bf16x8*)(Kl + k_addr<DH>(key, 4 * s + g)); acc = __builtin_amdgcn_mfma_f32_16x16x32_bf16(kf, qf[s], acc, 0, 0, 0); }
    return acc;
}
template <int DH> __device__ __forceinline__ void pv_step(f32x4 (&o)[DH / 16], const LAS unsigned char* Vl, int vbase, int vbase2, bf16x8 pf, int i, int g) {
    const int k0 = vbase + 4 * g + (i >> 2), k1 = vbase2 + 4 * g + (i >> 2); const int sub = (i & 3) >> 1, b8 = 8 * (i & 1);
#pragma unroll
    for (int n = 0; n < DH / 16; ++n) {
        const s16x4 lo = vtr(Vl + v_addr<DH>(k0, 2 * n + sub) + b8), hi = vtr(Vl + v_addr<DH>(k1, 2 * n + sub) + b8);
        const bf16x8 vf = (bf16x8){lo[0], lo[1], lo[2], lo[3], hi[0], hi[1], hi[2], hi[3]};
        o[n] = __builtin_amdgcn_mfma_f32_16x16x32_bf16(vf, pf, o[n], 0, 0, 0);
    }
}
__device__ __forceinline__ bf16x8 pack_p(const f32x4& a, const f32x4& b) {
    u32x4 w; w.x = cvt_pk_bf16(a[0], a[1]); w.y = cvt_pk_bf16(a[2], a[3]); w.z = cvt_pk_bf16(b[0], b[1]); w.w = cvt_pk_bf16(b[2], b[3]); return __builtin_bit_cast(bf16x8, w);
}
template <int NT> __device__ __forceinline__ void softmax_tiles(f32x4 (&s)[NT], float& m, float& l) {
    float mx = -INFINITY;
#pragma unroll
    for (int t = 0; t < NT; ++t) mx = fmaxf(fmaxf(fmaxf(mx, s[t][0]), fmaxf(s[t][1], s[t][2])), s[t][3]);
    mx = fmaxf(mx, sx(mx, 16)); mx = fmaxf(mx, sx(mx, 32));
    float sum = 0.f;
#pragma unroll
    for (int t = 0; t < NT; ++t) {
#pragma unroll
        for (int r = 0; r < 4; ++r) { const float p = __builtin_amdgcn_exp2f(s[t][r] - mx); s[t][r] = p; sum += p; } }
    sum += sx(sum, 16); sum += sx(sum, 32);
    m = mx; l = sum;
}
template <int DH> __device__ __forceinline__ void load_q(bf16x8 (&qf)[DH / 32], const bf16_t* qrow, int g) {
#pragma unroll
    for (int s = 0; s < DH / 32; ++s) qf[s] = *(const GAS bf16x8*)(qrow + 32 * s + 8 * g);
}
template <int DH> __device__ __forceinline__ void store_o(const f32x4 (&o)[DH / 16], float inv, bf16_t* orow, int g) {
#pragma unroll
    for (int n = 0; n < DH / 16; ++n) { u32x2 w; w.x = cvt_pk_bf16(o[n][0] * inv, o[n][1] * inv); w.y = cvt_pk_bf16(o[n][2] * inv, o[n][3] * inv); *(GAS u32x2*)(orow + 16 * n + 4 * g) = w; }
}

template <int DH, int NPF, class RowFn> __device__ __forceinline__ void pf_issue(u32x4 (&kv)[NPF], u32x4 (&vv)[NPF], int nkeys, int tid, const RowFn& rowfn) {
    constexpr int CH = DH / 8; const int total = nkeys * CH;
#pragma unroll
    for (int j = 0; j < NPF; ++j) { const int ci = j * NTHREADS + tid; kv[j] = (u32x4){0u, 0u, 0u, 0u}; vv[j] = kv[j];
        if (ci < total) { const int key = ci / CH, c = ci % CH; const bf16_t* kp; const bf16_t* vp; rowfn(key, kp, vp); if (kp) { kv[j] = *(const GAS u32x4*)(kp + c * 8); vv[j] = *(const GAS u32x4*)(vp + c * 8); } } }
}
template <int DH, int NPF> __device__ __forceinline__ void pf_commit(const u32x4 (&kv)[NPF], const u32x4 (&vv)[NPF], LAS unsigned char* Kl, LAS unsigned char* Vl, int nkeys, int tid) {
    constexpr int CH = DH / 8; const int total = nkeys * CH;
#pragma unroll
    for (int j = 0; j < NPF; ++j) { const int ci = j * NTHREADS + tid;
        if (ci < total) { const int key = ci / CH, c = ci % CH; *(LAS u32x4*)(Kl + k_addr<DH>(key, c)) = kv[j]; *(LAS u32x4*)(Vl + v_addr<DH>(key, c)) = vv[j]; } }
}
struct AUnit { int b, h, r0, rsU; };
__device__ __forceinline__ AUnit a_unit(int c, int rep) { const int ua = c + 256 * rep, x = ua & 7, y = ua >> 3, pair = x * 2 + (y >> 6), rp = y & 63; AUnit u; u.b = pair >> 3; u.h = pair & 7; u.r0 = 2 * rp; int rs = u.r0 - 4; u.rsU = rs < 0 ? 0 : (rs > 120 ? 120 : rs); return u; }
struct BUnit { int b, hh, grp, dil, L, rho, n, p0; };
__device__ __forceinline__ BUnit b_unit(int c, int rep) { const int ub = c + 256 * rep, x = ub & 7, y = ub >> 3, combo = x * 3 + y / 64, sub = y % 64; BUnit u; u.b = combo / 12; u.hh = combo % 12; u.grp = u.hh >> 2;
    u.dil = u.grp == 0 ? 1 : (u.grp == 1 ? 4 : 16); u.L = SEQ / u.dil; const int nb = u.L / 128; u.rho = sub / nb; u.n = sub % nb; u.p0 = 128 * u.n - 64; return u; }

__device__ __forceinline__ const bf16_t* a_qptr(const bf16_t* PROJ, int c, int rep, int w, int i) { const AUnit U = a_unit(c, rep); const int r = U.r0 + (w >> 2), cq = 16 * (w & 3) + i; return PROJ + proj_off((size_t)(U.b * SEQ + r * 64 + cq), C_QA + U.h * 64); }
__device__ __forceinline__ const bf16_t* b_qptr(const bf16_t* PROJ, int c, int rep, int w, int i) { const BUnit U = b_unit(c, rep); const int pq = 128 * U.n + 16 * w + i; return PROJ + proj_off((size_t)(U.b * SEQ + pq * U.dil + U.rho), C_QB + U.hh * 64); }

__device__ __forceinline__ void p2_attention(const Ctx& F0) {
    const Ctx F = ctx_refresh(F0);
    const bf16_t* PROJ = (const bf16_t*)(F.ws + WS_PROJ); const bf16_t* MKV = (const bf16_t*)(F.ws + WS_MKV);
    bf16_t* ABC = (bf16_t*)(F.ws + WS_ABC); bf16_t* OB = (bf16_t*)(F.ws + WS_OB); float* LSE = (float*)(F.ws + WS_MISC + MO_LSE);
    const float* T5 = (const float*)(F.ws + WS_MISC + MO_T5); const float* RPB = (const float*)(F.ws + WS_MISC + MO_RPB);
    LAS unsigned char* Kl = F.lds; LAS float* tab = (LAS float*)(F.lds + LDS_TAB);
    const int w = F.wave, c = (int)blockIdx.x;
#define P2_LANE() int tid_r = F.tid; asm volatile("" : "+v"(tid_r)); const int lane = tid_r & 63, i = lane & 15, g = lane >> 4; (void)lane
#define PF_A(rep_, KV, VV, T0, T1) do { const AUnit nu = a_unit(c, rep_); \
        pf_issue<64, 9>(KV, VV, 576, tid_r, [&](int key, const bf16_t*& kp, const bf16_t*& vp) { kp = nullptr; vp = nullptr; if (nu.rsU * 64 + key < SEQ) { const size_t tok = (size_t)nu.b * SEQ + nu.rsU * 64 + key; kp = PROJ + proj_off(tok, C_KA + nu.h * 64); vp = PROJ + proj_off(tok, C_VA + nu.h * 64); } }); \
        T0 = RPB[nu.h * RPB_LD + tid_r]; T1 = tid_r < RPB_LD - NTHREADS ? RPB[nu.h * RPB_LD + NTHREADS + tid_r] : 0.f; } while (0)
#define CM_A(KV, VV, T0, T1) do { pf_commit<64, 9>(KV, VV, Kl, Kl + 73728, 576, tid_r); tab[tid_r] = T0; if (tid_r < RPB_LD - NTHREADS) tab[NTHREADS + tid_r] = T1; } while (0)
#define PF_B(rep_, KV, VV, T0) do { const BUnit nu = b_unit(c, rep_); \
        pf_issue<64, 5>(KV, VV, 272, tid_r, [&](int key, const bf16_t*& kp, const bf16_t*& vp) { const int p = nu.p0 + key; kp = nullptr; vp = nullptr; \
            if (key < 256 && p >= 0 && p < nu.L) { const size_t tok = (size_t)nu.b * SEQ + (size_t)p * nu.dil + nu.rho; kp = PROJ + proj_off(tok, C_KB + nu.hh * 64); vp = PROJ + proj_off(tok, C_VB + nu.hh * 64); } }); \
        T0 = tid_r < T5_LD ? T5[nu.hh * T5_LD + tid_r] : 0.f; } while (0)
#define CM_B(KV, VV, T0) do { pf_commit<64, 5>(KV, VV, Kl, Kl + 34816, 272, tid_r); if (tid_r < T5_LD) tab[tid_r] = T0; } while (0)
    u32x4 akv[9], avv[9]; float at0 = 0.f, at1 = 0.f; bf16x8 qn[2];
    {
        LAS unsigned char* Vl = Kl + 65536; P2_LANE();
        const int combo = c & 7, b = combo >> 2, h = combo & 3;
        __syncthreads();
        stage_kv<128>(Kl, Vl, 256, tid_r, [&](int key, const bf16_t*& kp, const bf16_t*& vp) { kp = MKV + (size_t)(b * MEMLEN + key) * 1024 + h * 128; vp = kp + 512; });
        LDS_WAIT(); __syncthreads();
        for (int rep = 0; rep < 2; ++rep) {
            const int blk = (c >> 3) + 32 * rep; const int tok = b * SEQ + blk * 128 + w * 16 + i;
            bf16x8 qf[4]; load_q<128>(qf, PROJ + proj_off((size_t)tok, C_QC + h * 128), g);
            if (rep == 1) { PF_A(0, akv, avv, at0, at1); load_q<64>(qn, a_qptr(PROJ, c, 0, w, i), g); }
            f32x4 s[16];
#pragma unroll
            for (int t = 0; t < 16; ++t) s[t] = qk_tile<128>(Kl, 16 * t, qf, i, g);
            float m, l; softmax_tiles<16>(s, m, l);
            f32x4 o[8];
#pragma unroll
            for (int n = 0; n < 8; ++n) o[n] = (f32x4){0.f, 0.f, 0.f, 0.f};
#pragma unroll
            for (int u = 0; u < 8; ++u) pv_step<128>(o, Vl, 32 * u, 32 * u + 16, pack_p(s[2 * u], s[2 * u + 1]), i, g);
            store_o<128>(o, 1.0f / l, ABC + (size_t)tok * ABC_LD + 768 + h * 128, g);
        }
        __syncthreads(); CM_A(akv, avv, at0, at1); LDS_WAIT(); __syncthreads();
    }
    u32x4 bkv[5], bvv[5]; float bt0 = 0.f;
    for (int rep = 0; rep < 4; ++rep) {
        LAS unsigned char* Vl = Kl + 73728; P2_LANE();
        const AUnit U = a_unit(c, rep); const int b = U.b, h = U.h, r0 = U.r0, rsU = U.rsU;
        const int r = r0 + (w >> 2), jb = w & 3; int rs = r - 4; rs = rs < 0 ? 0 : (rs > 120 ? 120 : rs);
        const int cq = 16 * jb + i; int cs = cq - 8; cs = cs < 0 ? 0 : (cs > 48 ? 48 : cs);
        const int cw = jb == 0 ? 0 : (jb == 1 ? 8 : (jb == 2 ? 24 : 32));
        const int tok = b * SEQ + r * 64 + cq;
        bf16x8 qf[2]; qf[0] = qn[0]; qf[1] = qn[1];
        if (rep < 3) { PF_A(rep + 1, akv, avv, at0, at1); load_q<64>(qn, a_qptr(PROJ, c, rep + 1, w, i), g); } else { PF_B(0, bkv, bvv, bt0); load_q<64>(qn, b_qptr(PROJ, c, 0, w, i), g); }
        const int kb0 = (rs - rsU) * 64 + cw;
        f32x4 s[16];
#pragma unroll
        for (int t = 0; t < 16; ++t) s[t] = qk_tile<64>(Kl, kb0 + (t >> 1) * 64 + 16 * (t & 1), qf, i, g);
        const int bidx = RPB_OFF + (7 - (r - rs)) * 31 + (cw + 4 * g - cq + 15); const int lo = cs - cw - 4 * g;
#pragma unroll
        for (int t = 0; t < 16; ++t) {
#pragma unroll
            for (int rr = 0; rr < 4; ++rr) { const int kc = 16 * (t & 1) + rr; const float bias = tab[bidx + (t >> 1) * 31 + kc]; const bool ok = kc >= lo && kc < lo + 16; s[t][rr] = ok ? s[t][rr] + bias : -INFINITY; } }
        float m, l; softmax_tiles<16>(s, m, l);
        f32x4 o[4];
#pragma unroll
        for (int n = 0; n < 4; ++n) o[n] = (f32x4){0.f, 0.f, 0.f, 0.f};
#pragma unroll
        for (int u = 0; u < 8; ++u) pv_step<64>(o, Vl, kb0 + u * 64, kb0 + u * 64 + 16, pack_p(s[2 * u], s[2 * u + 1]), i, g);
        store_o<64>(o, 1.0f / l, ABC + (size_t)tok * ABC_LD + h * 64, g);
        __syncthreads(); if (rep < 3) { CM_A(akv, avv, at0, at1); } else { CM_B(bkv, bvv, bt0); } LDS_WAIT(); __syncthreads();
    }
    for (int rep = 0; rep < 6; ++rep) {
        LAS unsigned char* Vl = Kl + 34816; P2_LANE();
        const BUnit U = b_unit(c, rep); const int b = U.b, hh = U.hh, grp = U.grp, dil = U.dil, L = U.L, rho = U.rho, n = U.n;
        const int pq = 128 * n + 16 * w + i; const int tok = b * SEQ + pq * dil + rho;
        bf16x8 qf[2]; qf[0] = qn[0]; qf[1] = qn[1];
        if (rep < 5) { PF_B(rep + 1, bkv, bvv, bt0); load_q<64>(qn, b_qptr(PROJ, c, rep + 1, w, i), g); }
        f32x4 s[10];
#pragma unroll
        for (int t = 0; t < 10; ++t) s[t] = qk_tile<64>(Kl, 16 * w + 16 * t, qf, i, g);
        const int rel0 = 4 * g - 64 - i;
#pragma unroll
        for (int t = 0; t < 10; ++t) {
#pragma unroll
            for (int rr = 0; rr < 4; ++rr) { const int rel = rel0 + 16 * t + rr; const int p = pq + rel; const float bias = tab[rel + 79]; const bool ok = rel >= -64 && rel <= 64 && p >= 0 && p < L; s[t][rr] = ok ? s[t][rr] + bias : -INFINITY; } }
        float m, l; softmax_tiles<10>(s, m, l);
        f32x4 o[4];
#pragma unroll
        for (int nn = 0; nn < 4; ++nn) o[nn] = (f32x4){0.f, 0.f, 0.f, 0.f};
#pragma unroll
        for (int u = 0; u < 5; ++u) pv_step<64>(o, Vl, 16 * w + 32 * u, 16 * w + 32 * u + 16, pack_p(s[2 * u], s[2 * u + 1]), i, g);
        const int h4 = hh & 3;
        store_o<64>(o, 1.0f / l, OB + ((size_t)grp * NTOK + tok) * 256 + h4 * 64, g);
        if (g == 0) LSE[((size_t)grp * NTOK + tok) * 4 + h4] = m + __builtin_amdgcn_logf(l);
        if (rep < 5) { __syncthreads(); CM_B(bkv, bvv, bt0); LDS_WAIT(); __syncthreads(); }
    }
#undef PF_A
#undef CM_A
#undef PF_B
#undef CM_B
}
#undef P2_LANE
__device__ __forceinline__ void p2b_merge_tile(const Ctx& F0, int pm) {
    const Ctx F = ctx_refresh(F0);
    const bf16_t* OB = (const bf16_t*)(F.ws + WS_OB); const float* LSE = (const float*)(F.ws + WS_MISC + MO_LSE); bf16_t* ABC = (bf16_t*)(F.ws + WS_ABC);
    for (int it = F.tid; it < 256 * 32; it += NTHREADS) {
        const int tok = pm * 256 + (it >> 5), ch = it & 31, h = ch >> 3;
        const float l0 = LSE[(size_t)tok * 4 + h], l1 = LSE[((size_t)NTOK + tok) * 4 + h], l2 = LSE[((size_t)2 * NTOK + tok) * 4 + h];
        const float mx = fmaxf(l0, fmaxf(l1, l2)); float w0 = __builtin_amdgcn_exp2f(l0 - mx), w1 = __builtin_amdgcn_exp2f(l1 - mx), w2 = __builtin_amdgcn_exp2f(l2 - mx);
        const float inv = 1.0f / (w0 + w1 + w2); w0 *= inv; w1 *= inv; w2 *= inv;
        const u32x4 a = *(const GAS u32x4*)(OB + (size_t)tok * 256 + ch * 8), bq = *(const GAS u32x4*)(OB + ((size_t)NTOK + tok) * 256 + ch * 8), cq = *(const GAS u32x4*)(OB + ((size_t)2 * NTOK + tok) * 256 + ch * 8);
        u32x4 o;
#pragma unroll
        for (int j = 0; j < 4; ++j) { const float lo = w0 * bf_lo(a[j]) + w1 * bf_lo(bq[j]) + w2 * bf_lo(cq[j]), hi = w0 * bf_hi(a[j]) + w1 * bf_hi(bq[j]) + w2 * bf_hi(cq[j]); o[j] = cvt_pk_bf16(lo, hi); }
        *(GAS u32x4*)(ABC + (size_t)tok * ABC_LD + 512 + ch * 8) = o;
    }
    VM_WAIT(); __syncthreads();
}
__device__ __forceinline__ void p2b_merge(const Ctx& F0) {
    const Ctx F = ctx_refresh(F0);
    const bf16_t* OB = (const bf16_t*)(F.ws + WS_OB); const float* LSE = (const float*)(F.ws + WS_MISC + MO_LSE); bf16_t* ABC = (bf16_t*)(F.ws + WS_ABC);
    const int gt = F.vcu * NTHREADS + F.tid, NGT = F.G * NTHREADS;
    for (int it = gt; it < NTOK * 32; it += NGT) {
        const int tok = it >> 5, ch = it & 31, h = ch >> 3;
        const float l0 = LSE[(size_t)tok * 4 + h], l1 = LSE[((size_t)NTOK + tok) * 4 + h], l2 = LSE[((size_t)2 * NTOK + tok) * 4 + h];
        const float mx = fmaxf(l0, fmaxf(l1, l2)); float w0 = __builtin_amdgcn_exp2f(l0 - mx), w1 = __builtin_amdgcn_exp2f(l1 - mx), w2 = __builtin_amdgcn_exp2f(l2 - mx);
        const float inv = 1.0f / (w0 + w1 + w2); w0 *= inv; w1 *= inv; w2 *= inv;
        const u32x4 a = *(const GAS u32x4*)(OB + (size_t)tok * 256 + ch * 8), bq = *(const GAS u32x4*)(OB + ((size_t)NTOK + tok) * 256 + ch * 8), cq = *(const GAS u32x4*)(OB + ((size_t)2 * NTOK + tok) * 256 + ch * 8);
        u32x4 o;
#pragma unroll
        for (int j = 0; j < 4; ++j) { const float lo = w0 * bf_lo(a[j]) + w1 * bf_lo(bq[j]) + w2 * bf_lo(cq[j]), hi = w0 * bf_hi(a[j]) + w1 * bf_hi(bq[j]) + w2 * bf_hi(cq[j]); o[j] = cvt_pk_bf16(lo, hi); }
        *(GAS u32x4*)(ABC + (size_t)tok * ABC_LD + 512 + ch * 8) = o;
    }
}

struct P3Sched {
    int c; const char* ABCp; const char* WABC;
    __device__ __forceinline__ bool next(int i, pg8::Unit& u) const {
        if (i >= 3) return false;
        constexpr int nM = 64, nN = 4, nwg = 256;
        int wgid = c; { const int q = nwg / 8, xcd = wgid % 8, off = wgid / 8; wgid = xcd * q + off; }
        const int nig = 8 * nN, gid = wgid / nig, fm = gid * 8;
        u.pm = fm + ((wgid % nig) % 8); u.pn = (wgid % nig) / 8;
        const int sb = ((c >> 3) & 1) ? (i == 0 ? 1 : (i == 1 ? 0 : 2)) : i;
        const int koff = sb == 0 ? 0 : (sb == 1 ? 512 : 768);
        u.A = ABCp + (size_t)u.pm * 256 * (ABC_LD * 2) + koff * 2; u.B = WABC + (size_t)u.pn * 256 * (ABC_LD * 2) + koff * 2;
        u.rows = 0; u.nt = sb == 1 ? 4 : 8; u.aux = sb; u.scale = i == 0 ? 0.f : 1.f; return true;
    }
};
struct P3Epi {
    const bf16_t* PROJ; bf16_t* MERGED;
    __device__ __forceinline__ void operator()(const f32x4 (&acc)[2][2][4][2], const pg8::Unit& u, int wr, int wc, int fr, int fq) const {
        const int row0 = u.pm * 256 + wr * 64 + fr, col0 = u.pn * 256 + wc * 32 + 8 * fq; const int s = u.aux;
#pragma unroll
        for (int ai = 0; ai < 2; ++ai) {
            u32x4 gt[4][2], prev[4][2];
#pragma unroll
            for (int m = 0; m < 4; ++m)
#pragma unroll
                for (int bj = 0; bj < 2; ++bj) { const size_t row = (size_t)(row0 + ai * 128 + m * 16); const int col = col0 + bj * 128;
                    gt[m][bj] = *(const GAS u32x4*)(PROJ + proj_off(row, C_GATE + s * 1024 + col));
                    prev[m][bj] = (u32x4){0u, 0u, 0u, 0u}; if (u.scale != 0.f) prev[m][bj] = __builtin_nontemporal_load((const GAS u32x4*)(MERGED + row * 1024 + col)); }
            asm volatile("" ::: "memory");
#pragma unroll
            for (int m = 0; m < 4; ++m)
#pragma unroll
                for (int bj = 0; bj < 2; ++bj) { const size_t row = (size_t)(row0 + ai * 128 + m * 16); const int col = col0 + bj * 128;
                    const f32x4 v0 = acc[ai][bj][m][0], v1 = acc[ai][bj][m][1]; const u32x4 g = gt[m][bj], pv = prev[m][bj];
                    u32x4 o;
                    o.x = cvt_pk_bf16(bf_lo(pv.x) + bf_lo(g.x) * v0[0], bf_hi(pv.x) + bf_hi(g.x) * v0[1]);
                    o.y = cvt_pk_bf16(bf_lo(pv.y) + bf_lo(g.y) * v0[2], bf_hi(pv.y) + bf_hi(g.y) * v0[3]);
                    o.z = cvt_pk_bf16(bf_lo(pv.z) + bf_lo(g.z) * v1[0], bf_hi(pv.z) + bf_hi(g.z) * v1[1]);
                    o.w = cvt_pk_bf16(bf_lo(pv.w) + bf_lo(g.w) * v1[2], bf_hi(pv.w) + bf_hi(g.w) * v1[3]);
                    *(GAS u32x4*)(MERGED + row * 1024 + col) = o; }
            asm volatile("" ::: "memory");
        }
    }
};
struct P4Sched {
    int c; const char* MERGED; const char* WOUT;
    __device__ __forceinline__ bool next(int i, pg8::Unit& u) const {
        if (i >= 1) return false;
        constexpr int nN = 4, nwg = 256;
        int wgid = c; { const int q = nwg / 8, xcd = wgid % 8, off = wgid / 8; wgid = xcd * q + off; }
        const int nig = 8 * nN, gid = wgid / nig, fm = gid * 8;
        u.pm = fm + ((wgid % nig) % 8); u.pn = (wgid % nig) / 8;
        u.A = MERGED + (size_t)u.pm * 256 * 2048; u.B = WOUT + (size_t)u.pn * 256 * 2048; u.rows = 0; u.nt = 16; u.aux = 0; u.scale = 1.f; return true;
    }
};
struct P4Epi {
    const float* X; float* X1;
    __device__ __forceinline__ void operator()(const f32x4 (&acc)[2][2][4][2], const pg8::Unit& u, int wr, int wc, int fr, int fq) const {
        const int row0 = u.pm * 256 + wr * 64 + fr, col0 = u.pn * 256 + wc * 32 + 8 * fq;
#pragma unroll
        for (int ai = 0; ai < 2; ++ai) {
            f32x4 xv[4][2][2];
#pragma unroll
            for (int m = 0; m < 4; ++m)
#pragma unroll
                for (int bj = 0; bj < 2; ++bj) { const size_t off = (size_t)(row0 + ai * 128 + m * 16) * 1024 + col0 + bj * 128; xv[m][bj][0] = *(const GAS f32x4*)(X + off); xv[m][bj][1] = *(const GAS f32x4*)(X + off + 4); }
            asm volatile("" ::: "memory");
#pragma unroll
            for (int m = 0; m < 4; ++m)
#pragma unroll
                for (int bj = 0; bj < 2; ++bj) { const size_t off = (size_t)(row0 + ai * 128 + m * 16) * 1024 + col0 + bj * 128;
                    *(GAS f32x4*)(X1 + off) = xv[m][bj][0] + acc[ai][bj][m][0]; *(GAS f32x4*)(X1 + off + 4) = xv[m][bj][1] + acc[ai][bj][m][1]; }
            asm volatile("" ::: "memory");
        }
    }
};
__device__ __forceinline__ void p5_router(const Ctx& F0) {
    const KArgs ap = kargs(); const float* X1 = ap->out; const float* GF = ap->in[12]; const float* RW = ap->in[13]; const float* RB = ap->in[14];
    const Ctx F = ctx_refresh(F0);
    unsigned char* H8 = F.ws + WS_XN; float* RTOK = (float*)(F.ws + WS_MISC + MO_RTOK);
    int* TOPIDX = (int*)(F.ws + WS_MISC + MO_TOPIDX); float* TOPW = (float*)(F.ws + WS_MISC + MO_TOPW); int* HIST = (int*)(F.ws + WS_MISC + MO_HIST);
    LAS float* Wl = (LAS float*)F.lds;
    LAS float* xch = (LAS float*)(F.lds + 131072);
    LAS float* xss = (LAS float*)(F.lds + 131072 + 8192);
    LAS int* hist = (LAS int*)(F.lds + LDS_TAB);
    __syncthreads();
    for (int idx = F.tid; idx < 1024 * 8; idx += NTHREADS) { const int k = idx >> 3, q = idx & 7; const f32x4 wv = *(const GAS f32x4*)(RW + (size_t)k * 32 + 4 * q) * GF[k];
        *(LAS f32x4*)(Wl + k * 32 + ((4 * q) ^ (((k >> 5) & 1) << 4))) = wv; }
    if (F.tid < 32) hist[F.tid] = 0;
    LDS_WAIT(); __syncthreads();
    const int lane = F.lane, i = lane & 15, kq = lane >> 4, tg = F.wave & 3, kh = F.wave >> 2; const int bid = (int)blockIdx.x;
    const int tok = bid * 64 + tg * 16 + i; const int kbase = kh * 512 + 32 * kq;
    const float* xrow = X1 + (size_t)tok * D + kbase; const float* grow = GF + kbase;
    const LAS float* wb0 = Wl + kbase * 32 + (i ^ ((kq & 1) << 4)); const LAS float* wb1 = Wl + kbase * 32 + ((i + 16) ^ ((kq & 1) << 4));
    f32x4 acc0 = {0.f, 0.f, 0.f, 0.f}, acc1 = {0.f, 0.f, 0.f, 0.f}; float ss = 0.f;
#pragma unroll 1
    for (int c = 0; c < 4; ++c) {
        f32x4 xv[8], gv[8];
#pragma unroll
        for (int q = 0; q < 8; ++q) { xv[q] = *(const GAS f32x4*)(xrow + c * 128 + 4 * q); gv[q] = *(const GAS f32x4*)(grow + c * 128 + 4 * q); }
        unsigned o[8];
#pragma unroll
        for (int q = 0; q < 8; ++q) { const f32x4 x = xv[q], pq = x * gv[q]; ss += (x.x * x.x + x.y * x.y) + (x.z * x.z + x.w * x.w);
            int w = __builtin_amdgcn_cvt_pk_fp8_f32(pq.x, pq.y, 0, false); w = __builtin_amdgcn_cvt_pk_fp8_f32(pq.z, pq.w, w, true); o[q] = (unsigned)w; }
        GAS u32x4* op = (GAS u32x4*)(H8 + (size_t)tok * D + kbase + c * 128);
        op[0] = (u32x4){o[0], o[1], o[2], o[3]}; op[1] = (u32x4){o[4], o[5], o[6], o[7]};
#pragma unroll
        for (int j = 0; j < 32; ++j) { const float a = xv[j >> 2][j & 3]; const float b0 = wb0[(c * 128 + j) * 32], b1 = wb1[(c * 128 + j) * 32];
            acc0 = __builtin_amdgcn_mfma_f32_16x16x4f32(a, b0, acc0, 0, 0, 0); acc1 = __builtin_amdgcn_mfma_f32_16x16x4f32(a, b1, acc1, 0, 0, 0); }
    }
    ss += sx(ss, 16); ss += sx(ss, 32);
    if (kh == 1) { LAS float* xp = xch + (tg * 64 + lane) * 8; *(LAS f32x4*)xp = acc0; *(LAS f32x4*)(xp + 4) = acc1; if (lane < 16) xss[tg * 16 + lane] = ss; }
    LDS_WAIT(); __syncthreads();
    if (kh == 0) {
        const LAS float* xp = xch + (tg * 64 + lane) * 8; acc0 += *(const LAS f32x4*)xp; acc1 += *(const LAS f32x4*)(xp + 4); ss += xss[tg * 16 + i];
        const float rt = 1.0f / sqrtf(ss * (1.f / D) + RMS_EPS);
        if (lane < 16) RTOK[tok] = rt;
        const float bias0 = RB[i], bias1 = RB[i + 16];
        float c0[4], c1[4];
#pragma unroll
        for (int r = 0; r < 4; ++r) { const float rr = sidx(rt, 4 * kq + r); c0[r] = acc0[r] * rr + bias0; c1[r] = acc1[r] * rr + bias1; }
        float tv[4][4]; int ti[4][4];
#pragma unroll
        for (int k = 0; k < 4; ++k)
#pragma unroll
            for (int r = 0; r < 4; ++r) { float bv = c0[r] >= c1[r] ? c0[r] : c1[r]; int bi = c0[r] >= c1[r] ? i : i + 16;
#pragma unroll
                for (int off = 1; off < 16; off <<= 1) { const float ov = sx(bv, off); const int oi = sxi(bi, off); const bool take = (ov > bv) || (ov == bv && oi < bi); bv = take ? ov : bv; bi = take ? oi : bi; }
                tv[k][r] = bv; ti[k][r] = bi; if (bi == i) c0[r] = -INFINITY; if (bi == i + 16) c1[r] = -INFINITY; }
        if (i == 0) {
#pragma unroll
            for (int r = 0; r < 4; ++r) { const int t = bid * 64 + tg * 16 + 4 * kq + r;
                const float e1 = __expf(tv[1][r] - tv[0][r]), e2 = __expf(tv[2][r] - tv[0][r]), e3 = __expf(tv[3][r] - tv[0][r]); const float inv = 1.0f / (1.0f + e1 + e2 + e3);
                *(GAS i32x4*)(TOPIDX + t * 4) = (i32x4){ti[0][r], ti[1][r], ti[2][r], ti[3][r]}; *(GAS f32x4*)(TOPW + t * 4) = (f32x4){inv, e1 * inv, e2 * inv, e3 * inv};
                atomicAdd((int*)&hist[ti[0][r]], 1); atomicAdd((int*)&hist[ti[1][r]], 1); atomicAdd((int*)&hist[ti[2][r]], 1); atomicAdd((int*)&hist[ti[3][r]], 1); }
        }
    }
    LDS_WAIT(); __syncthreads();
    if (F.tid < 32) HIST[bid * 32 + F.tid] = hist[F.tid];
}
__device__ __forceinline__ void p6_slots(const Ctx& F0) {
    const Ctx F = ctx_refresh(F0);
    const int* TOPIDX = (const int*)(F.ws + WS_MISC + MO_TOPIDX); const float* TOPW = (const float*)(F.ws + WS_MISC + MO_TOPW); const int* HIST = (const int*)(F.ws + WS_MISC + MO_HIST);
    int* TOKSLOT = (int*)(F.ws + WS_MISC + MO_TOKSLOT); int* SLOTTOK = (int*)(F.ws + WS_MISC + MO_SLOTTOK); float* SLOTW = (float*)(F.ws + WS_MISC + MO_SLOTW); int* TILE = (int*)(F.ws + WS_MISC + MO_TILE);
    LAS int* part = (LAS int*)F.lds;
    LAS int* pref = part + 512;
    LAS int* tot = part + 1024;
    LAS int* mypre = tot + 32; LAS int* sbase = tot + 64; LAS int* wcnt = tot + 96;
    const int bid = (int)blockIdx.x, tid = F.tid;
    __syncthreads();
    { const int e = tid & 31, ch = tid >> 5; int s = 0, p = 0;
        for (int j = 0; j < 16; ++j) { const int bb = ch * 16 + j; const int hv = HIST[bb * 32 + e]; s += hv; if (bb < bid) p += hv; }
        part[ch * 32 + e] = s; pref[ch * 32 + e] = p; }
    LDS_WAIT(); __syncthreads();
    if (tid < 32) { int s = 0, p = 0; for (int ch = 0; ch < 16; ++ch) { s += part[ch * 32 + tid]; p += pref[ch * 32 + tid]; } tot[tid] = s; mypre[tid] = p; }
    LDS_WAIT(); __syncthreads();
    if (tid == 0) { int tb = 0; for (int e = 0; e < 32; ++e) { sbase[e] = tb * 256; const int nt = (tot[e] + 255) >> 8; if (bid == 0) { for (int j = 0; j < nt; ++j) TILE[1 + tb + j] = e; } tb += nt; } if (bid == 0) TILE[0] = tb; }
    LDS_WAIT(); __syncthreads();
    int e_me = 0, rank = 0; float w_me = 0.f; const int ent = tid;
    if (tid < 256) { e_me = TOPIDX[bid * 256 + ent]; w_me = TOPW[bid * 256 + ent];
        const int wv = tid >> 6;
        for (int e = 0; e < 32; ++e) { const unsigned long long bal = __ballot(e_me == e); if (e_me == e) rank = __builtin_popcountll(bal & ((1ull << F.lane) - 1ull)); if (F.lane == 0) wcnt[wv * 32 + e] = __builtin_popcountll(bal); } }
    LDS_WAIT(); __syncthreads();
    if (tid < 256) { const int wv = tid >> 6; for (int j = 0; j < wv; ++j) rank += wcnt[j * 32 + e_me];
        const int slot = sbase[e_me] + mypre[e_me] + rank; const int tok = bid * 64 + (ent >> 2);
        SLOTTOK[slot] = tok; SLOTW[slot] = w_me; TOKSLOT[bid * 256 + ent] = slot; }
    if (bid < 32) { const int e = bid; const int beg = sbase[e] + tot[e], end = sbase[e] + (((tot[e] + 255) >> 8) << 8); for (int s = beg + tid; s < end; s += NTHREADS) { SLOTTOK[s] = 0; SLOTW[s] = 0.f; } }
}
constexpr int LDS_ROWS = 139264, LDS_TILE = 139264 + 11 * 1024;
static_assert(LDS_TILE + 4 * (1 + MAX_TILES) <= LDS_MISC, "LDS tables");
template <int NPN, bool ROWS> __device__ __forceinline__ void moe_tables(const Ctx& F, const int* TILE, const int* SLOTTOK) {
    LAS int* tl = (LAS int*)(F.lds + LDS_TILE);
    __syncthreads();
    for (int j = F.tid; j < 1 + MAX_TILES; j += NTHREADS) tl[j] = __hip_atomic_load((int*)TILE + j, __ATOMIC_RELAXED, __HIP_MEMORY_SCOPE_AGENT);
    if (ROWS) { const int ntile = __builtin_amdgcn_readfirstlane(__hip_atomic_load((int*)TILE, __ATOMIC_RELAXED, __HIP_MEMORY_SCOPE_AGENT));
        for (int i = 0; i < 11; ++i) { const int L = i * F.G + (int)blockIdx.x; if (L >= ntile * NPN) break; const int m = L / NPN;
            if (F.tid < 256) ((LAS int*)(F.lds + LDS_ROWS))[i * 256 + F.tid] = SLOTTOK[m * 256 + F.tid]; } }
    LDS_WAIT(); __syncthreads();
}
struct P7Sched {
    int G, c; LAS const int* tl; const char* H2; const char* WGU; int ntile;
    __device__ __forceinline__ bool next(int i, pg8::Unit& u) const {
        const int L = i * G + c; if (L >= ntile * 8 || i >= 11) return false;
        const int m = L >> 3, pn = L & 7, e = __builtin_amdgcn_readfirstlane(tl[1 + m]);
        u.pm = m; u.pn = pn; u.aux = e; u.scale = 1.f; u.nt = 8; u.rows = LDS_ROWS + 1024 * i; u.A = H2; u.B = WGU + ((size_t)e * 2048 + pn * 256) * 1024; return true;
    }
};
struct P7Epi {
    const float* BGU; bf16_t* ACT; const float* RTOK; LAS const unsigned char* lds;
    __device__ __forceinline__ void operator()(const f32x4 (&acc)[2][2][4][2], const pg8::Unit& u, int wr, int wc, int fr, int fq) const {
        const int row0 = u.pm * 256 + wr * 64 + fr, cc0 = wc * 32 + 8 * fq, e = u.aux;
        float rr[2][4];
#pragma unroll
        for (int ai = 0; ai < 2; ++ai)
#pragma unroll
            for (int m = 0; m < 4; ++m) rr[ai][m] = RTOK[((LAS const int*)(lds + u.rows))[wr * 64 + fr + ai * 128 + m * 16]];
        const float* bg = BGU + (size_t)e * 2048 + u.pn * 128 + cc0; const float* bu = bg + 1024;
        const f32x4 bg0 = *(const GAS f32x4*)bg, bg1 = *(const GAS f32x4*)(bg + 4), bu0 = *(const GAS f32x4*)bu, bu1 = *(const GAS f32x4*)(bu + 4);
#pragma unroll
        for (int ai = 0; ai < 2; ++ai)
#pragma unroll
            for (int m = 0; m < 4; ++m) { const size_t row = (size_t)(row0 + ai * 128 + m * 16);
                float av[8];
#pragma unroll
                for (int n = 0; n < 2; ++n) { const f32x4 gv = acc[ai][0][m][n] * rr[ai][m] + (n ? bg1 : bg0), uv = acc[ai][1][m][n] * rr[ai][m] + (n ? bu1 : bu0);
#pragma unroll
                    for (int j = 0; j < 4; ++j) { const float gg = fminf(gv[j], 7.0f); const float uu = fminf(fmaxf(uv[j], -7.0f), 7.0f); av[4 * n + j] = (uu + 1.0f) * gg * fast_sigmoid(1.702f * gg); } }
                int w0 = __builtin_amdgcn_cvt_pk_fp8_f32(av[0], av[1], 0, false); w0 = __builtin_amdgcn_cvt_pk_fp8_f32(av[2], av[3], w0, true);
                int w1 = __builtin_amdgcn_cvt_pk_fp8_f32(av[4], av[5], 0, false); w1 = __builtin_amdgcn_cvt_pk_fp8_f32(av[6], av[7], w1, true);
                *(GAS u32x2*)((unsigned char*)ACT + row * 1024 + u.pn * 128 + cc0) = (u32x2){(unsigned)w0, (unsigned)w1}; }
    }
};
struct P8Sched {
    int G, c; LAS const int* tl; const char* ACT; const char* WDN; int ntile;
    __device__ __forceinline__ bool next(int i, pg8::Unit& u) const {
        const int L = i * G + c; if (L >= ntile * 4) return false;
        const int m = L >> 2, pn = L & 3, e = __builtin_amdgcn_readfirstlane(tl[1 + m]);
        u.pm = m; u.pn = pn; u.aux = e; u.scale = 1.f; u.nt = 8; u.rows = 0; u.A = ACT + (size_t)m * 256 * 1024; u.B = WDN + ((size_t)e * 1024 + pn * 256) * 1024; return true;
    }
};
struct P8Epi {
    const float* BDN; const float* SLOTW; bf16_t* YS;
    __device__ __forceinline__ void operator()(const f32x4 (&acc)[2][2][4][2], const pg8::Unit& u, int wr, int wc, int fr, int fq) const {
        const int row0 = u.pm * 256 + wr * 64 + fr, col0 = u.pn * 256 + wc * 32 + 8 * fq, e = u.aux;
        const float* bp = BDN + (size_t)e * 1024 + col0;
        f32x4 bv[2][2]; float sw[2][4];
#pragma unroll
        for (int bj = 0; bj < 2; ++bj) { bv[bj][0] = *(const GAS f32x4*)(bp + bj * 128); bv[bj][1] = *(const GAS f32x4*)(bp + bj * 128 + 4); }
#pragma unroll
        for (int ai = 0; ai < 2; ++ai)
#pragma unroll
            for (int m = 0; m < 4; ++m) sw[ai][m] = SLOTW[row0 + ai * 128 + m * 16];
        asm volatile("" ::: "memory");
#pragma unroll
        for (int ai = 0; ai < 2; ++ai)
#pragma unroll
            for (int m = 0; m < 4; ++m) { const size_t row = (size_t)(row0 + ai * 128 + m * 16); const float w_ = sw[ai][m];
#pragma unroll
                for (int bj = 0; bj < 2; ++bj) { const f32x4 v0 = (acc[ai][bj][m][0] + bv[bj][0]) * w_, v1 = (acc[ai][bj][m][1] + bv[bj][1]) * w_;
                    int w0 = __builtin_amdgcn_cvt_pk_fp8_f32(v0[0], v0[1], 0, false); w0 = __builtin_amdgcn_cvt_pk_fp8_f32(v0[2], v0[3], w0, true);
                    int w1 = __builtin_amdgcn_cvt_pk_fp8_f32(v1[0], v1[1], 0, false); w1 = __builtin_amdgcn_cvt_pk_fp8_f32(v1[2], v1[3], w1, true);
                    *(GAS u32x2*)((unsigned char*)YS + row * 1024 + col0 + bj * 128) = (u32x2){(unsigned)w0, (unsigned)w1}; } }
    }
};
__device__ __forceinline__ void p9_final(const Ctx& F0) {
    const KArgs ap = kargs(); struct { const float* in[20]; float* out; } a; a.in[19] = ap->in[19]; a.out = ap->out;
    const Ctx F = ctx_refresh(F0);
    float* OUT = a.out; const bf16_t* YS = (const bf16_t*)(F.ws + WS_YS); const int* TOKSLOT = (const int*)(F.ws + WS_MISC + MO_TOKSLOT); const float* GN = a.in[19];
    const int gw = F.vcu * NWAVES + F.wave, NGW = F.G * NWAVES, lane = F.lane;
    const GAS f32x4* gr = (const GAS f32x4*)GN + lane;
    const bool bad = ld_uniform((const int*)(F.ws + WS_CTL) + 4096 + XB_TMO) != 0;
    float ckscale = 1.0f;
#ifdef CKSUM
    { const int* prev = (const int*)(F.ws + WS_MISC + 7 * MiB); if (ld_uniform(prev) == 0x5EED1234) ckscale = 1.0f + 0.25f * (float)ld_uniform(prev + 1); }
#endif
    int slotv = 0; { const int k_ = lane >> 2, t_ = gw + k_ * NGW; if (lane < 32 && t_ < NTOK) slotv = __hip_atomic_load((int*)TOKSLOT + t_ * 4 + (lane & 3), __ATOMIC_RELAXED, __HIP_MEMORY_SCOPE_AGENT); }
    int kt = 0;
    for (int tok = gw; tok < NTOK; tok += NGW, ++kt) {
        GAS f32x4* xr = (GAS f32x4*)(OUT + (size_t)tok * D) + lane;
        f32x4 v[4];
#pragma unroll
        for (int jj = 0; jj < 4; ++jj) v[jj] = xr[64 * jj];
        const int slots[4] = {__builtin_amdgcn_readlane(slotv, kt * 4), __builtin_amdgcn_readlane(slotv, kt * 4 + 1), __builtin_amdgcn_readlane(slotv, kt * 4 + 2), __builtin_amdgcn_readlane(slotv, kt * 4 + 3)};
#pragma unroll
        for (int k = 0; k < 4; ++k) { const GAS unsigned* yr = (const GAS unsigned*)((const unsigned char*)YS + (size_t)slots[k] * 1024) + lane;
#pragma unroll
            for (int jj = 0; jj < 4; ++jj) { const unsigned y = yr[64 * jj]; const f32x2 lo = __builtin_amdgcn_cvt_pk_f32_fp8((int)y, false), hi = __builtin_amdgcn_cvt_pk_f32_fp8((int)y, true);
                v[jj].x += lo.x; v[jj].y += lo.y; v[jj].z += hi.x; v[jj].w += hi.y; } }
        float ss = 0.f;
#pragma unroll
        for (int jj = 0; jj < 4; ++jj) ss += (v[jj].x * v[jj].x + v[jj].y * v[jj].y) + (v[jj].z * v[jj].z + v[jj].w * v[jj].w);
        const float r = 1.0f / sqrtf(wave_sum(ss) * (1.f / D) + RMS_EPS);
#pragma unroll
        for (int jj = 0; jj < 4; ++jj) { const f32x4 gg = gr[64 * jj]; f32x4 o = (f32x4){v[jj].x * r * gg.x, v[jj].y * r * gg.y, v[jj].z * r * gg.z, v[jj].w * r * gg.w} * ckscale; if (bad) o = (f32x4){__builtin_nanf(""), __builtin_nanf(""), __builtin_nanf(""), __builtin_nanf("")}; xr[64 * jj] = o; }
    }
}

__device__ __forceinline__ void grid_barrier(int wave) {
    extern __shared__ __attribute__((aligned(16))) unsigned char lds_dyn[];
    XcdBarrier b; b.bar = (unsigned*)(kargs()->ws + WS_CTL) + 4096; b.x = xb_xcc_id(); b.st = (volatile LAS unsigned*)((LAS unsigned char*)lds_dyn + LDS_MISC) + 8; b.wave = wave;
    xcd_barrier(b);
}
__global__ void __launch_bounds__(NTHREADS, 2) fwd_megakernel(Args args) {
    const int wave = __builtin_amdgcn_readfirstlane((int)threadIdx.x >> 6);
    {
        const Ctx F = make_ctx(wave);
        volatile LAS unsigned* MISC = (volatile LAS unsigned*)(F.lds + LDS_MISC);
        for (int u = F.tid; u < 128; u += NTHREADS) MISC[u] = 0u;
        __syncthreads();
        (void)xcd_barrier_post((unsigned*)(F.ws + WS_CTL) + 4096, MISC + 8, wave);
    }
#ifndef TSK
#define TSK -1
#endif
#ifndef TSB
#define TSB 0
#endif
    unsigned long long ts0_ = 0ull, ts1_ = 0ull; if (TSK >= 0) ts0_ = __builtin_amdgcn_s_memrealtime();
#define TS(k) do { if (TSK == (k)) ts1_ = __builtin_amdgcn_s_memrealtime(); } while (0)
#define F make_ctx(wave)
#define ws (kargs()->ws)
#define xcd_barrier(bar) grid_barrier(wave)
#ifndef PHM
#define PHM 0xFFFF
#endif
#define PH(k) ((PHM >> (k)) & 1)
#ifndef PHR
#define PHR 0
#endif
#define RP(k) ((PHR >> (k)) & 1)
#ifdef CANARY
    {
        const size_t n16 = (WS_END - WS_MISC) / 16; GAS u32x4* p = (GAS u32x4*)(ws + WS_MISC);
        for (size_t i = (size_t)blockIdx.x * NTHREADS + F.tid; i < n16; i += (size_t)F.G * NTHREADS) p[i] = (u32x4){0xffffffffu, 0xffffffffu, 0xffffffffu, 0xffffffffu};
        GAS u32x4* q = (GAS u32x4*)kargs()->out;
        for (size_t i = (size_t)blockIdx.x * NTHREADS + F.tid; i < (size_t)NTOK * D / 4; i += (size_t)F.G * NTHREADS) q[i] = (u32x4){0xffffffffu, 0xffffffffu, 0xffffffffu, 0xffffffffu};
        xcd_barrier(bar);
    }
#endif
    if (PH(0)) p0_prologue(F);
    xcd_barrier(bar);
    if (RP(0)) { p0_prologue(F); xcd_barrier(bar); }
    TS(0);
    CK(1, ws + WS_WIN_T, WS_MKV - WS_WIN_T); CK(1, ws + WS_XN, WS_ABC - WS_XN); CK(1, ws + WS_WGU_T, WS_PROJ - WS_WGU_T); CK(1, ws + WS_MISC + MO_T5, 128 * 1024);
    for (int rp_ = 0; rp_ < 1 + RP(1); ++rp_) {
    if (PH(1)) {
        p1_convert_experts(F);
        TS(12);
        P1Sched S{(unsigned*)(ws + WS_CTL) + 12288 + 64 * ((int)blockIdx.x & 7), (LAS int*)(F.lds + LDS_MISC) + 32, F.wave, (int)blockIdx.x & 7, (const char*)(ws + WS_XN), (const char*)(ws + WS_WIN_T), (const char*)(ws + WS_MEMN), (const char*)(ws + WS_WMEM_T)};
        P1Epi E{(bf16_t*)(ws + WS_PROJ), (bf16_t*)(ws + WS_MKV)};
        pg8::gemm_phase<P1Epi, P1Sched, false>(F.lds, F.wave, 2048u, 2048u, S, E);
    }
    xcd_barrier(bar);
    }
    TS(1);
    CK(2, ws + WS_PROJ, WS_ACT - WS_PROJ); CK(2, ws + WS_MKV, 1 * MiB);
    if (PH(2)) p2_attention(F);
    xcd_barrier(bar);
    if (RP(2)) { p2_attention(F); xcd_barrier(bar); }
    TS(2);
    CK(3, ws + WS_OB, WS_MERGED - WS_OB); CK(3, ws + WS_MISC + MO_LSE, 3 * 16384 * 16);
    TS(10);
    CK(4, ws + WS_ABC, WS_OB - WS_ABC);
    for (int rp_ = 0; rp_ < 1 + RP(3); ++rp_) {
    if (PH(3)) {
        P3Sched S{(int)blockIdx.x, (const char*)(ws + WS_ABC), (const char*)(ws + WS_WABC_T)};
        { pg8::Unit u0_; (void)S.next(0, u0_); p2b_merge_tile(F, u0_.pm); }
        P3Epi E{(const bf16_t*)(ws + WS_PROJ), (bf16_t*)(ws + WS_MERGED)};
        pg8::gemm_phase<P3Epi, P3Sched, false>(F.lds, F.wave, (unsigned)(ABC_LD * 2), (unsigned)(ABC_LD * 2), S, E);
    }
    xcd_barrier(bar);
    }
    TS(3);
    CK(5, ws + WS_MERGED, 32 * MiB);
    for (int rp_ = 0; rp_ < 1 + RP(4); ++rp_) {
    if (PH(4)) {
        P4Sched S{(int)blockIdx.x, (const char*)(ws + WS_MERGED), (const char*)(ws + WS_WOUT_T)};
        P4Epi E{kargs()->in[0], kargs()->out};
        pg8::gemm_phase<P4Epi, P4Sched, false>(F.lds, F.wave, 2048u, 2048u, S, E);
    }
    xcd_barrier(bar);
    }
    TS(4);
    CK(6, kargs()->out, 64 * MiB);
    if (PH(5)) p5_router(F);
    xcd_barrier(bar);
    if (RP(5)) { p5_router(F); xcd_barrier(bar); }
    TS(5);
    CK(7, ws + WS_XN, 32 * MiB); CK(7, ws + WS_MISC, 512 * 1024 + 32 * 1024);
    if (PH(6)) p6_slots(F);
    xcd_barrier(bar);
    TS(6);
#ifdef CKSUM
#define ck_rows ((size_t)ld_uniform((const int*)(ws + WS_MISC + MO_TILE)) * 256)
    CK(8, ws + WS_MISC + MO_TOKSLOT, 256 * 1024); CK(8, ws + WS_MISC + MO_SLOTTOK, ck_rows * 4); CK(8, ws + WS_MISC + MO_SLOTW, ck_rows * 4); CK(8, ws + WS_MISC + MO_TILE, 1024);
#endif
    for (int rp_ = 0; rp_ < 1 + RP(7); ++rp_) {
    if (PH(7)) {
        moe_tables<8, true>(F, (const int*)(ws + WS_MISC + MO_TILE), (const int*)(ws + WS_MISC + MO_SLOTTOK));
        P7Sched S{F.G, (int)blockIdx.x, (LAS const int*)(F.lds + LDS_TILE), (const char*)(ws + WS_XN), (const char*)(ws + WS_WGU_T), __builtin_amdgcn_readfirstlane(*(LAS const int*)(F.lds + LDS_TILE))};
        P7Epi E{kargs()->in[16], (bf16_t*)(ws + WS_ACT), (const float*)(ws + WS_MISC + MO_RTOK), (LAS const unsigned char*)F.lds};
        pg8::gemm_phase<P7Epi, P7Sched, true, true>(F.lds, F.wave, 1024u, 1024u, S, E);
    }
    xcd_barrier(bar);
    }
    TS(7);
#ifdef CKSUM
    CK(9, ws + WS_ACT, ck_rows * 2048);
#endif
    for (int rp_ = 0; rp_ < 1 + RP(8); ++rp_) {
    if (PH(8)) {
        moe_tables<4, false>(F, (const int*)(ws + WS_MISC + MO_TILE), (const int*)(ws + WS_MISC + MO_SLOTTOK));
        P8Sched S{F.G, (int)blockIdx.x, (LAS const int*)(F.lds + LDS_TILE), (const char*)(ws + WS_ACT), (const char*)(ws + WS_WDN_T), __builtin_amdgcn_readfirstlane(*(LAS const int*)(F.lds + LDS_TILE))};
        P8Epi E{kargs()->in[18], (const float*)(ws + WS_MISC + MO_SLOTW), (bf16_t*)(ws + WS_YS)};
        pg8::gemm_phase<P8Epi, P8Sched, false, true>(F.lds, F.wave, 1024u, 1024u, S, E);
    }
    xcd_barrier(bar);
    }
    TS(8);
#ifdef CKSUM
    CK(10, ws + WS_YS, ck_rows * 2048);
#endif
    if (PH(9)) p9_final(F);
    if (TSK >= 0 && blockIdx.x == TSB && wave == 0) { const unsigned long long te_ = __builtin_amdgcn_s_memrealtime(); const unsigned long long wait_ = 50ull * (ts1_ - ts0_); while (__builtin_amdgcn_s_memrealtime() - te_ < wait_) __builtin_amdgcn_s_sleep(32); }
#ifdef CKSUM
    xcd_barrier(bar);
    if (blockIdx.x == 0 && F.wave == 0 && lane_id() == 0) {
        unsigned* cur = (unsigned*)(ws + WS_CTL) + 8192; unsigned* prev = (unsigned*)(ws + WS_MISC + 7 * MiB);
        const bool have = __hip_atomic_load(prev, __ATOMIC_RELAXED, __HIP_MEMORY_SCOPE_AGENT) == 0x5EED1234u;
        unsigned flag = have ? __hip_atomic_load(prev + 1, __ATOMIC_RELAXED, __HIP_MEMORY_SCOPE_AGENT) : 0u;
        for (int k = 1; k <= 10; ++k) { const unsigned c = __hip_atomic_load(cur + 64 * k, __ATOMIC_RELAXED, __HIP_MEMORY_SCOPE_AGENT);
            if (have && flag == 0u && __hip_atomic_load(prev + 16 + k, __ATOMIC_RELAXED, __HIP_MEMORY_SCOPE_AGENT) != c) flag = (unsigned)k;
            __hip_atomic_store(prev + 16 + k, c, __ATOMIC_RELAXED, __HIP_MEMORY_SCOPE_AGENT); }
        __hip_atomic_store(prev + 1, flag, __ATOMIC_RELAXED, __HIP_MEMORY_SCOPE_AGENT); __hip_atomic_store(prev, 0x5EED1234u, __ATOMIC_RELAXED, __HIP_MEMORY_SCOPE_AGENT);
    }
#endif
}

#undef F
#undef ws
#undef xcd_barrier
extern "C" void kernel_launch(void* const* d_in, const int* in_sizes, int n_in, void* d_out, int out_size, void* d_ws, size_t ws_size, hipStream_t stream) {
    static int grid = 0;
    if (grid == 0) {
        if (n_in != 20 || out_size != NTOK * D || ws_size < WS_END) { fprintf(stderr, "kernel_launch: unexpected shapes (n_in %d, out %d, ws %zu); nothing launched\n", n_in, out_size, ws_size); grid = -1; return; }
        int dev = 0, cus = 0;
        if (hipGetDevice(&dev) != hipSuccess || hipDeviceGetAttribute(&cus, hipDeviceAttributeMultiprocessorCount, dev) != hipSuccess) { grid = -1; return; }
        if (hipFuncSetAttribute((const void*)fwd_megakernel, hipFuncAttributeMaxDynamicSharedMemorySize, LDS_BYTES) != hipSuccess) { fprintf(stderr, "kernel_launch: hipFuncSetAttribute failed\n"); grid = -1; return; }
        int per_cu = 0;
        if (hipOccupancyMaxActiveBlocksPerMultiprocessor(&per_cu, (const void*)fwd_megakernel, NTHREADS, LDS_BYTES) != hipSuccess || per_cu < 1) fprintf(stderr, "kernel_launch: occupancy query reports %d\n", per_cu);
        (void)hipGetLastError();
        grid = cus;
        if (grid != 256) fprintf(stderr, "kernel_launch: %d CUs; this kernel is laid out for 256\n", grid);
    }
    if (grid < 0) return;
    (void)hipMemsetAsync((char*)d_ws + WS_CTL, 0, CTL_ZERO_BYTES, stream);
    Args a{};
    for (int i = 0; i < 20; ++i) a.in[i] = (const float*)d_in[i];
    a.out = (float*)d_out; a.ws = (unsigned char*)d_ws;
    hipLaunchKernelGGL(fwd_megakernel, dim3(grid), dim3(NTHREADS), LDS_BYTES, stream, a);
}
```

```cpp
#include <hip/hip_runtime.h>
#include <cstdio>
#include <cstdint>

#define GAS __attribute__((address_space(1)))
#define LAS __attribute__((address_space(3)))
typedef unsigned short bf16_t;
typedef short bf16x8 __attribute__((ext_vector_type(8)));
typedef short s16x4 __attribute__((ext_vector_type(4)));
typedef float f32x4 __attribute__((ext_vector_type(4)));
typedef float f32x2 __attribute__((ext_vector_type(2)));
typedef unsigned u32x4 __attribute__((ext_vector_type(4)));
typedef unsigned u32x2 __attribute__((ext_vector_type(2)));
typedef int i32x4 __attribute__((ext_vector_type(4)));
typedef int i32x8 __attribute__((ext_vector_type(8)));
#define FP8_SCALE 0x7C7C7C7C
typedef GAS unsigned gu32;

constexpr int NTOK = 16384, SEQ = 8192, D = 1024, NMEM = 512, MEMLEN = 256;
constexpr int IN_COLS = 7424;
__host__ __device__ __forceinline__ size_t proj_off(size_t row, int col) { return (((row >> 8) * 29 + (size_t)(col >> 8)) << 16) + ((row & 255) << 8) + (size_t)(col & 255); }
constexpr int C_QA = 0, C_KA = 512, C_VA = 1024, C_QB = 1536, C_KB = 2304, C_VB = 3072, C_QC = 3840, C_GATE = 4352;
constexpr int NEXP = 32, TOPK = 4, DFF = 1024;
constexpr int MAX_TILES = 288, MAX_SLOTS = MAX_TILES * 256;
constexpr float RMS_EPS = 1e-6f, LOG2E = 1.4426950408889634f;
constexpr float QS64 = 0.125f * LOG2E, QS128 = 0.08838834764831845f * LOG2E;
constexpr int ABC_LD = 1280;

constexpr size_t MiB = 1u << 20;
constexpr size_t WS_CTL = 0, CTL_ZERO_BYTES = 1 * MiB;
constexpr size_t WS_MISC = 1 * MiB;
constexpr size_t MO_TOPIDX = 0, MO_TOPW = 256 * 1024, MO_HIST = 512 * 1024, MO_TOKSLOT = 1 * MiB, MO_SLOTTOK = 2 * MiB, MO_SLOTW = 3 * MiB, MO_TILE = 4 * MiB, MO_LSE = 5 * MiB, MO_T5 = 6 * MiB, MO_RPB = 6 * MiB + 64 * 1024, MO_RTOK = 7 * MiB + 64 * 1024, MO_SLOTRS = 8 * MiB;
constexpr size_t WS_WIN_T = 16 * MiB, WS_WMEM_T = 32 * MiB, WS_WABC_T = 34 * MiB, WS_WOUT_T = 37 * MiB, WS_MEMN = 39 * MiB, WS_MKV = 40 * MiB, WS_XN = 41 * MiB;
constexpr size_t WS_ABC = 73 * MiB, WS_OB = 113 * MiB, WS_MERGED = 137 * MiB, WS_WGU_T = 169 * MiB, WS_WDN_T = 297 * MiB, WS_PROJ = 361 * MiB, WS_ACT = 593 * MiB, WS_YS = 737 * MiB, WS_END = 881 * MiB;
constexpr int T5_LD = 192, RPB_LD = 640, RPB_OFF = 64;

constexpr int LDS_MAIN = 147456;
constexpr int LDS_TAB = LDS_MAIN;
constexpr int LDS_MISC = LDS_MAIN + 8192;
constexpr int LDS_BYTES = LDS_MISC + 512;

#define LDS_WAIT() asm volatile("s_waitcnt lgkmcnt(0)" ::: "memory")
#define VM_WAIT() asm volatile("s_waitcnt vmcnt(0)" ::: "memory")
__device__ __forceinline__ unsigned cvt_pk_bf16(float lo, float hi) { unsigned r; asm volatile("v_cvt_pk_bf16_f32 %0, %1, %2" : "=v"(r) : "v"(lo), "v"(hi)); return r; }
__device__ __forceinline__ float bf_lo(unsigned u) { return __uint_as_float(u << 16); }
__device__ __forceinline__ float bf_hi(unsigned u) { return __uint_as_float(u & 0xffff0000u); }
__device__ __forceinline__ int lane_id() { int l; asm volatile("v_mbcnt_lo_u32_b32 %0, -1, 0\n\tv_mbcnt_hi_u32_b32 %0, -1, %0" : "=v"(l)); return l; }
__device__ __forceinline__ float sx(float v, int off) { return __builtin_bit_cast(float, __builtin_amdgcn_ds_bpermute((lane_id() ^ off) << 2, __builtin_bit_cast(int, v))); }
__device__ __forceinline__ int sxi(int v, int off) { return __builtin_amdgcn_ds_bpermute((lane_id() ^ off) << 2, v); }
__device__ __forceinline__ float sidx(float v, int src) { return __builtin_bit_cast(float, __builtin_amdgcn_ds_bpermute(src << 2, __builtin_bit_cast(int, v))); }
__device__ __forceinline__ float wave_sum(float v) {
#pragma unroll
    for (int o = 1; o < 64; o <<= 1) v += sx(v, o);
    return v;
}
__device__ __forceinline__ float wave_max(float v) {
#pragma unroll
    for (int o = 1; o < 64; o <<= 1) v = fmaxf(v, sx(v, o));
    return v;
}
__device__ __forceinline__ int ld_uniform(const int* p) { return __builtin_amdgcn_readfirstlane(__hip_atomic_load((int*)p, __ATOMIC_RELAXED, __HIP_MEMORY_SCOPE_AGENT)); }
__device__ __forceinline__ float fast_sigmoid(float x) { return __builtin_amdgcn_rcpf(1.0f + __builtin_amdgcn_exp2f(-LOG2E * x)); }

namespace pg8 {
constexpr int BM = 256, BK = 64, HALF = 128, HTB = HALF * BK * 2, STAGE_BYTES = 8 * HTB, LDS_STASH = 131072  ;
__host__ __device__ __forceinline__ int lds_byte(int r, int c) { const int st = (r >> 4) * 2 + (c >> 5), rr = r & 15, cc = c & 31, ob = rr * 64 + cc * 2; return st * 1024 + (ob ^ (((ob >> 9) & 1) << 5)); }
__host__ __device__ __forceinline__ void stage_rc(int b, int& R, int& C) { const int st = b / 1024, sb = b % 1024, swz = sb ^ (((sb >> 9) & 1) << 5); R = (st >> 1) * 16 + swz / 64; C = (st & 1) * 32 + (swz % 64) / 2; }
__host__ __device__ __forceinline__ int perm32(int rho) { const int n = rho >> 4, i = rho & 15; return 8 * (i >> 2) + 4 * n + (i & 3); }

struct Unit {
    const char* A;
    const char* B;
    int rows;
    int nt;
    int pm, pn;
    int aux;
    float scale;
};

template <class Epi, class Sched, bool GATHER, bool FP8 = false>
__device__ __forceinline__ void gemm_phase(LAS unsigned char* lds, const int wave, const unsigned lda, const unsigned ldb, const Sched& S, const Epi& E) {
    const int lane = lane_id();
    const int wid = wave, tid = wave * 64 + lane, wr = wid >> 2, wc = wid & 3, fr = lane & 15, fq = lane >> 4;
    const int R0 = (wid >> 1) * 16 + (lane >> 2), C2 = ((wid & 1) * 32 + ((((lane & 3) * 8)) ^ ((lane >> 5) << 4))) * 2, Rb0 = (R0 & ~31) + perm32(R0 & 31);
    unsigned offA = (unsigned)R0 * lda + (unsigned)C2, offB = (unsigned)Rb0 * ldb + (unsigned)C2;
    const size_t kstep = (size_t)(BK * 2);
    const size_t hstepB = (size_t)HALF * ldb;
    const unsigned ldsw = (unsigned)wid * 1024u;
    const int aoff = lds_byte(wr * 64 + fr, fq * 8), boff = lds_byte(wc * 32 + fr, fq * 8);
#define PG8_SA(b, h) (((b) * 2 + (h)) * HTB)
#define PG8_SB(b, h) ((4 + (b) * 2 + (h)) * HTB)
#define PG8_STAGE2P(bufoff, p0, p1, v0, v1) do { \
        __builtin_amdgcn_global_load_lds((const unsigned*)((const char*)(p0) + (v0)), (LAS unsigned*)(lds + (bufoff) + ldsw), 16, 0, 0); \
        __builtin_amdgcn_global_load_lds((const unsigned*)((const char*)(p1) + (v1)), (LAS unsigned*)(lds + (bufoff) + ldsw + 8192), 16, 0, 0); } while (0)
#define PG8_STAGEB(bufoff, gbase) PG8_STAGE2P(bufoff, gbase, (const char*)(gbase) + (size_t)64 * ldb, offB, offB)
#define PG8_STAGEA(bufoff, gbase, h, g0, g1) do { if (GATHER) { PG8_STAGE2P(bufoff, gbase, gbase, g0, g1); } else { PG8_STAGE2P(bufoff, (const char*)(gbase) + (size_t)((h) * HALF) * lda, (const char*)(gbase) + (size_t)((h) * HALF + 64) * lda, offA, offA); } } while (0)
#define PG8_LDA(dst, b, h) do { _Pragma("unroll") for (int m = 0; m < 4; ++m) _Pragma("unroll") for (int k = 0; k < 2; ++k) dst[m][k] = *(const LAS bf16x8*)(lds + PG8_SA(b, h) + aoff + m * 2048 + k * 1024); } while (0)
#define PG8_LDB(dst, b, h) do { _Pragma("unroll") for (int n = 0; n < 2; ++n) _Pragma("unroll") for (int k = 0; k < 2; ++k) dst[n][k] = *(const LAS bf16x8*)(lds + PG8_SB(b, h) + boff + n * 2048 + k * 1024); } while (0)
#define PG8_MMA(ai, bj, At, Bt) do { __builtin_amdgcn_s_setprio(1); \
        if (FP8) { _Pragma("unroll") for (int m = 0; m < 4; ++m) _Pragma("unroll") for (int n = 0; n < 2; ++n) { \
            const i32x4 b0_ = __builtin_bit_cast(i32x4, Bt[n][0]), b1_ = __builtin_bit_cast(i32x4, Bt[n][1]), a0_ = __builtin_bit_cast(i32x4, At[m][0]), a1_ = __builtin_bit_cast(i32x4, At[m][1]); \
            const i32x8 bw_ = __builtin_shufflevector(b0_, b1_, 0, 1, 2, 3, 4, 5, 6, 7), aw_ = __builtin_shufflevector(a0_, a1_, 0, 1, 2, 3, 4, 5, 6, 7); \
            acc[ai][bj][m][n] = __builtin_amdgcn_mfma_scale_f32_16x16x128_f8f6f4(bw_, aw_, acc[ai][bj][m][n], 0, 0, 0, FP8_SCALE, 0, FP8_SCALE); } } \
        else { _Pragma("unroll") for (int m = 0; m < 4; ++m) _Pragma("unroll") for (int n = 0; n < 2; ++n) _Pragma("unroll") for (int k = 0; k < 2; ++k) \
            acc[ai][bj][m][n] = __builtin_amdgcn_mfma_f32_16x16x32_bf16(Bt[n][k], At[m][k], acc[ai][bj][m][n], 0, 0, 0); } \
        __builtin_amdgcn_s_setprio(0); } while (0)
#define PG8_WAIT_V(n) asm volatile("s_waitcnt vmcnt(" #n ")" ::: "memory")
#define PG8_WAIT_L(n) asm volatile("s_waitcnt lgkmcnt(" #n ")" ::: "memory")
#define PG8_BAR __builtin_amdgcn_s_barrier()
#define PG8_SCHED __builtin_amdgcn_sched_barrier(0)
    Unit cur, nxt; int ui = 0;
    if (!S.next(0, cur)) return;
    f32x4 acc[2][2][4][2];
#pragma unroll
    for (int a = 0; a < 2; ++a)
#pragma unroll
        for (int b = 0; b < 2; ++b)
#pragma unroll
            for (int m = 0; m < 4; ++m)
#pragma unroll
                for (int n = 0; n < 2; ++n) acc[a][b][m][n] = (f32x4){0.f, 0.f, 0.f, 0.f};
    bf16x8 At[4][2], B0[2][2], B1[2][2];
    unsigned c00 = 0, c01 = 0, c10 = 0, c11 = 0;
#define PG8_MKOFF(U, o00, o01, o10, o11) do { const LAS int* rl_ = (const LAS int*)(lds + (U).rows) + R0; \
        o00 = (unsigned)rl_[0] * lda + (unsigned)C2; o01 = (unsigned)rl_[64] * lda + (unsigned)C2; o10 = (unsigned)rl_[HALF] * lda + (unsigned)C2; o11 = (unsigned)rl_[HALF + 64] * lda + (unsigned)C2; } while (0)
    if (GATHER) { PG8_MKOFF(cur, c00, c01, c10, c11); }
    const char* cA = cur.A; const char* cB = cur.B; int nt = cur.nt;
    PG8_STAGEB(PG8_SB(0, 0), cB); PG8_STAGEB(PG8_SB(0, 1), cB + hstepB); PG8_STAGEA(PG8_SA(0, 0), cA, 0, c00, c01); PG8_STAGEA(PG8_SA(0, 1), cA, 1, c10, c11);
    if (wr == 1) PG8_BAR;
    PG8_WAIT_V(2); PG8_BAR;
    PG8_STAGEB(PG8_SB(1, 0), cB + kstep); PG8_STAGEA(PG8_SA(1, 0), cA + kstep, 0, c00, c01); PG8_STAGEB(PG8_SB(1, 1), cB + hstepB + kstep);
    PG8_WAIT_V(6); PG8_BAR;
    for (;;) {
        const bool has_next = S.next(ui + 1, nxt);
        const char* nA = has_next ? nxt.A : cA; const char* nB = has_next ? nxt.B : cB;
#pragma nounroll
        for (int t = 0; t < nt; t += 2) {
            const bool last = (t == nt - 2);
            if (GATHER) asm volatile("" : "+v"(c00), "+v"(c01), "+v"(c10), "+v"(c11)); asm volatile("" : "+v"(offA), "+v"(offB));
            const char* a1 = cA + (size_t)(t + 1) * kstep;
            const char* a2 = last ? nA : cA + (size_t)(t + 2) * kstep; const char* b2 = last ? nB : cB + (size_t)(t + 2) * kstep;
            const char* a3 = a2 + kstep; const char* b3 = b2 + kstep;
            PG8_LDB(B0, 0, 0); PG8_LDB(B1, 0, 1); PG8_SCHED; PG8_LDA(At, 0, 0); PG8_STAGEA(PG8_SA(1, 1), a1, 1, c10, c11);
            if (GATHER) { if (last && has_next) { PG8_MKOFF(nxt, c00, c01, c10, c11); } }
            PG8_WAIT_V(8); PG8_WAIT_L(0); PG8_BAR; PG8_MMA(0, 0, At, B0); PG8_MMA(0, 1, At, B1); PG8_BAR; PG8_SCHED;
            PG8_LDA(At, 0, 1); PG8_STAGEB(PG8_SB(0, 0), b2); PG8_STAGEB(PG8_SB(0, 1), b2 + hstepB); PG8_STAGEA(PG8_SA(0, 0), a2, 0, c00, c01);
            PG8_WAIT_V(8); PG8_WAIT_L(0); PG8_BAR; PG8_MMA(1, 0, At, B0); PG8_MMA(1, 1, At, B1); PG8_BAR; PG8_SCHED;
            PG8_LDB(B0, 1, 0); PG8_LDB(B1, 1, 1); PG8_SCHED; PG8_LDA(At, 1, 0); PG8_STAGEA(PG8_SA(0, 1), a2, 1, c10, c11);
            PG8_WAIT_V(8); PG8_WAIT_L(0); PG8_BAR; PG8_MMA(0, 0, At, B0); PG8_MMA(0, 1, At, B1); PG8_BAR; PG8_SCHED;
            PG8_LDA(At, 1, 1); PG8_STAGEB(PG8_SB(1, 0), b3); PG8_STAGEB(PG8_SB(1, 1), b3 + hstepB); PG8_STAGEA(PG8_SA(1, 0), a3, 0, c00, c01);
            PG8_WAIT_V(8); PG8_WAIT_L(0); PG8_BAR; PG8_MMA(1, 0, At, B0); PG8_MMA(1, 1, At, B1); PG8_BAR; PG8_SCHED;
        }
        if (wr == 0) PG8_BAR;
        { int le_ = lane; asm volatile("" : "+v"(le_)); E(acc, cur, wr, wc, le_ & 15, le_ >> 4); }
        if (GATHER) { if (has_next) { asm volatile("" ::: "memory"); PG8_MKOFF(nxt, c00, c01, c10, c11); } }
        if (!has_next) break;
#pragma unroll
        for (int a = 0; a < 2; ++a)
#pragma unroll
            for (int b = 0; b < 2; ++b)
#pragma unroll
                for (int m = 0; m < 4; ++m)
#pragma unroll
                    for (int n = 0; n < 2; ++n) acc[a][b][m][n] = (f32x4){0.f, 0.f, 0.f, 0.f};
        cur = nxt; cA = nA; cB = nB; nt = cur.nt; ++ui;
        if (wr == 1) PG8_BAR;
    }
    PG8_WAIT_V(0);
    PG8_BAR;
#undef PG8_SA
#undef PG8_SB
#undef PG8_STAGE2P
#undef PG8_STAGEB
#undef PG8_LDA
#undef PG8_LDB
#undef PG8_MMA
#undef PG8_WAIT_V
#undef PG8_WAIT_L
#undef PG8_BAR
#undef PG8_SCHED
#undef PG8_MKOFF
#undef PG8_STAGEA
}
}

#define XB_TMO      128
#define XB_XCNT(j)  (256  + 64 * (j))
#define XB_XSUB(j)  (1280 + 64 * (j))
#define XB_XGEN(j)  (2304 + 64 * (j))
#define XB_TOP      3328
#define XB_TOPGEN   3392
#define XCD_BAR_WORDS 3456
#define XB_SPIN_CAP (1u << 18)
__device__ __forceinline__ unsigned xb_ld(unsigned* p)              { return __hip_atomic_load(p, __ATOMIC_RELAXED, __HIP_MEMORY_SCOPE_AGENT); }
__device__ __forceinline__ unsigned xb_add(unsigned* p, unsigned v) { return __hip_atomic_fetch_add(p, v, __ATOMIC_RELAXED, __HIP_MEMORY_SCOPE_AGENT); }
__device__ __forceinline__ unsigned xb_xcc_id() { return (unsigned)__builtin_amdgcn_s_getreg((3 << 11) | 20) & 0xFu; }
#define XB_SPIN(cond, bar) do { unsigned _sp = 0; while (cond) { __builtin_amdgcn_s_sleep(1); \
    if ((++_sp & 255u) == 0u) { if (xb_ld(&(bar)[XB_TMO])) break; if (_sp > XB_SPIN_CAP) { atomicAdd(&(bar)[XB_TMO], 1u); break; } } } } while (0)
struct XcdBarrier { unsigned* bar; unsigned x; volatile LAS unsigned* st; int wave; };
__device__ __forceinline__ XcdBarrier xcd_barrier_post(unsigned* bar, volatile LAS unsigned* st, int wave) {
    XcdBarrier b; b.bar = bar; b.x = xb_xcc_id(); b.st = st; b.wave = wave;
    if (wave == 0 && lane_id() == 0) (void)xb_add(&bar[XB_XCNT(b.x)], 1u);
    return b;
}
__device__ __forceinline__ void xcd_barrier_complete(unsigned* bar, unsigned x, unsigned& nloc, unsigned& nx) {
    const unsigned G = gridDim.x * gridDim.y * gridDim.z;
    unsigned sum, cnt, mine, sp = 0u;
    for (;;) {
        sum = 0u; cnt = 0u; mine = 0u;
#pragma unroll
        for (unsigned j = 0; j < 16; ++j) { const unsigned c = xb_ld(&bar[XB_XCNT(j)]); sum += c; cnt += (c > 0u) ? 1u : 0u; mine = (j == x) ? c : mine; }
        if (sum == G) break;
        __builtin_amdgcn_s_sleep(1);
        if ((++sp & 255u) == 0u) { if (xb_ld(&bar[XB_TMO])) break; if (sp > XB_SPIN_CAP) { atomicAdd(&bar[XB_TMO], 1u); break; } }
    }
    nloc = mine > 0u ? mine : 1u; nx = cnt > 0u ? cnt : 1u;
}
__device__ __forceinline__ void xcd_barrier(const XcdBarrier& b) {
    asm volatile("s_waitcnt vmcnt(0)" ::: "memory");
    __syncthreads();
    if (b.wave == 0 && lane_id() == 0) {
        unsigned* bar = b.bar;
        __builtin_amdgcn_s_waitcnt(0);
        unsigned nloc = b.st[0], nx = b.st[1];
        if (nloc == 0u) { xcd_barrier_complete(bar, b.x, nloc, nx); b.st[0] = nloc; b.st[1] = nx; }
        const unsigned old = xb_add(&bar[XB_XSUB(b.x)], 1u);
        const unsigned gen = old / nloc;
        if (old + 1u == (gen + 1u) * nloc) {
            __builtin_amdgcn_fence(__ATOMIC_RELEASE, "agent");
            asm volatile("s_waitcnt vmcnt(0)" ::: "memory");
            const unsigned og = xb_add(&bar[XB_TOP], 1u);
            const unsigned tg = og / nx;
            if (og + 1u == (tg + 1u) * nx) xb_add(&bar[XB_TOPGEN], 1u);
            else XB_SPIN(xb_ld(&bar[XB_TOPGEN]) == tg, bar);
            __builtin_amdgcn_fence(__ATOMIC_ACQUIRE, "agent");
            xb_add(&bar[XB_XGEN(b.x)], 1u);
            asm volatile("s_waitcnt vmcnt(0)" ::: "memory");
        } else {
            XB_SPIN(xb_ld(&bar[XB_XGEN(b.x)]) == gen, bar);
            __builtin_amdgcn_fence(__ATOMIC_ACQUIRE, "agent");
            asm volatile("s_waitcnt vmcnt(0)" ::: "memory");
        }
    }
    __syncthreads();
}

struct Args { const float* in[20]; float* out; unsigned char* ws; };
typedef const __attribute__((address_space(4))) Args* KArgs;
__device__ __forceinline__ KArgs kargs() { KArgs k = (KArgs)__builtin_amdgcn_kernarg_segment_ptr(); asm volatile("" : "+s"(k)); return k; }
constexpr int NWAVES = 8, NTHREADS = 512;

struct Ctx {
    LAS unsigned char* lds;
    int tid, lane, wave, G, vcu;
    unsigned char* ws;
};
__device__ __forceinline__ Ctx make_ctx(int wave) {
    extern __shared__ __attribute__((aligned(16))) unsigned char lds_dyn[];
    Ctx F; int l = lane_id(); asm volatile("" : "+v"(l)); F.lds = (LAS unsigned char*)lds_dyn; F.lane = l; F.wave = wave; F.tid = wave * 64 + l;
    F.G = (int)gridDim.x; { const int bx = (int)blockIdx.x; F.vcu = (F.G % 8 == 0) ? (bx % 8) * (F.G / 8) + bx / 8 : bx; }
    F.ws = kargs()->ws; return F; }
__device__ __forceinline__ Ctx ctx_refresh(const Ctx& F0) { return make_ctx(F0.wave); }


#ifdef CKSUM
__device__ __forceinline__ void ck_region(const Ctx& F, int k, const void* base, size_t bytes) {
    const GAS u32x4* p = (const GAS u32x4*)base; const size_t n = bytes / 16; unsigned acc = 0u;
    const int tid_ = F.wave * 64 + lane_id();
    for (size_t i = (size_t)blockIdx.x * NTHREADS + tid_; i < n; i += (size_t)F.G * NTHREADS) { const u32x4 v = __builtin_nontemporal_load(p + i); acc += v.x * 3u + v.y * 5u + v.z * 7u + v.w * 11u + (unsigned)i; }
#pragma unroll
    for (int o = 1; o < 64; o <<= 1) acc += (unsigned)sxi((int)acc, o);
    if (lane_id() == 0) atomicAdd((unsigned*)(F.ws + WS_CTL) + 8192 + 64 * k, acc);
}
#define CK(k, base, bytes) ck_region(F, k, base, bytes)
#else
#define CK(k, base, bytes) do {} while (0)
#endif
__device__ __forceinline__ void p0_transpose64(const float* W, int ldw, int k0, int n0, bf16_t* dst, int ldt, LAS float* scr, int lane) {
    f32x4 v[16];
#pragma unroll
    for (int i = 0; i < 16; ++i) { const int kk = 4 * i + (lane >> 4); v[i] = *(const GAS f32x4*)(W + (size_t)(k0 + kk) * ldw + n0 + 4 * (lane & 15)); }
#pragma unroll
    for (int i = 0; i < 16; ++i) { const int kk = 4 * i + (lane >> 4); LAS float* s = scr + kk * 65 + 4 * (lane & 15); s[0] = v[i][0]; s[1] = v[i][1]; s[2] = v[i][2]; s[3] = v[i][3]; }
    LDS_WAIT(); asm volatile("" ::: "memory");
    const int c = lane & 7;
#pragma unroll
    for (int j = 0; j < 8; ++j) { const int n = (lane >> 3) + 8 * j; const LAS float* s = scr + (8 * c) * 65 + n;
        u32x4 o; o.x = cvt_pk_bf16(s[0 * 65], s[1 * 65]); o.y = cvt_pk_bf16(s[2 * 65], s[3 * 65]); o.z = cvt_pk_bf16(s[4 * 65], s[5 * 65]); o.w = cvt_pk_bf16(s[6 * 65], s[7 * 65]);
        *(GAS u32x4*)(dst + (size_t)n * ldt + 8 * c) = o; }
    LDS_WAIT(); asm volatile("" ::: "memory");
}
__device__ __forceinline__ void p0_transpose64_fp8(const float* W, int ldw, int k0, int n0, unsigned char* dst8, int ldt, LAS float* scr, int lane, float scale) {
    f32x4 v[16];
#pragma unroll
    for (int i = 0; i < 16; ++i) { const int kk = 4 * i + (lane >> 4); v[i] = *(const GAS f32x4*)(W + (size_t)(k0 + kk) * ldw + n0 + 4 * (lane & 15)); }
#pragma unroll
    for (int i = 0; i < 16; ++i) { const int kk = 4 * i + (lane >> 4); LAS float* s = scr + kk * 65 + 4 * (lane & 15); s[0] = v[i][0] * scale; s[1] = v[i][1] * scale; s[2] = v[i][2] * scale; s[3] = v[i][3] * scale; }
    LDS_WAIT(); asm volatile("" ::: "memory");
    const int c = lane & 3;
#pragma unroll
    for (int j = 0; j < 4; ++j) { const int n = (lane >> 2) + 16 * j; const LAS float* s = scr + (16 * c) * 65 + n;
        u32x4 o;
#pragma unroll
        for (int q = 0; q < 4; ++q) { int w = __builtin_amdgcn_cvt_pk_fp8_f32(s[(4 * q) * 65], s[(4 * q + 1) * 65], 0, false); w = __builtin_amdgcn_cvt_pk_fp8_f32(s[(4 * q + 2) * 65], s[(4 * q + 3) * 65], w, true); o[q] = (unsigned)w; }
        *(GAS u32x4*)(dst8 + (size_t)n * ldt + 16 * c) = o; }
    LDS_WAIT(); asm volatile("" ::: "memory");
}
__device__ __forceinline__ void rms_row_to_bf16(const float* xrow, const float* g, bf16_t* orow, int lane) {
    const GAS f32x4* xr = (const GAS f32x4*)xrow + lane; const GAS f32x4* gr = (const GAS f32x4*)g + lane;
    f32x4 v[4]; float s = 0.f;
#pragma unroll
    for (int j = 0; j < 4; ++j) { v[j] = xr[64 * j]; s += (v[j].x * v[j].x + v[j].y * v[j].y) + (v[j].z * v[j].z + v[j].w * v[j].w); }
    const float r = 1.0f / sqrtf(wave_sum(s) * (1.f / D) + RMS_EPS);
    GAS u32x2* o8 = (GAS u32x2*)orow + lane;
#pragma unroll
    for (int j = 0; j < 4; ++j) { const f32x4 gg = gr[64 * j]; u32x2 w; w.x = cvt_pk_bf16(v[j].x * r * gg.x, v[j].y * r * gg.y); w.y = cvt_pk_bf16(v[j].z * r * gg.z, v[j].w * r * gg.w); o8[64 * j] = w; }
}
__device__ __forceinline__ int t5_bucket(int rel) {
    int ret = rel > 0 ? 16 : 0; const int n = rel < 0 ? -rel : rel;
    if (n < 8) return ret + n;
    const float nf = (float)n;
    int large = 8 + (int)(logf(nf / 8.0f) / logf(128.0f) * 8.0f);
    large = large < 15 ? large : 15;
    return ret + large;
}
__device__ __forceinline__ void p0_prologue(const Ctx& F0) {
    const KArgs ap = kargs();
    const Ctx F = ctx_refresh(F0);
    LAS float* scr = (LAS float*)(F.lds) + F.wave * (64 * 65);
    const int gw = F.vcu * NWAVES + F.wave, NGW = F.G * NWAVES;
    bf16_t* WGU_T = (bf16_t*)(F.ws + WS_WGU_T); bf16_t* WDN_T = (bf16_t*)(F.ws + WS_WDN_T); bf16_t* WIN_T = (bf16_t*)(F.ws + WS_WIN_T);
    bf16_t* WMEM_T = (bf16_t*)(F.ws + WS_WMEM_T); bf16_t* WABC_T = (bf16_t*)(F.ws + WS_WABC_T); bf16_t* WOUT_T = (bf16_t*)(F.ws + WS_WOUT_T);
    constexpr int I_IN = 16 * 116, I_MEM = 256, I_A = 8 * 16, I_B = 4 * 16, I_C = 8 * 16, I_O = 256;
    constexpr int NITEMS = I_IN + I_MEM + I_A + I_B + I_C + I_O;
    for (int it = gw; it < NITEMS; it += NGW) {
        int r = it;
        if (r < I_IN) { const int kb = r / 116, nb = r % 116; p0_transpose64(ap->in[4], IN_COLS, kb * 64, nb * 64, WIN_T + (size_t)(nb * 64) * 1024 + kb * 64, 1024, scr, F.lane); continue; } r -= I_IN;
        if (r < I_MEM) { const int kb = r >> 4, nb = r & 15; p0_transpose64(ap->in[5], 1024, kb * 64, nb * 64, WMEM_T + (size_t)(nb * 64) * 1024 + kb * 64, 1024, scr, F.lane); continue; } r -= I_MEM;
        if (r < I_A) { const int kb = r >> 4, nb = r & 15; p0_transpose64(ap->in[8], 1024, kb * 64, nb * 64, WABC_T + (size_t)(nb * 64) * ABC_LD + 0 + kb * 64, ABC_LD, scr, F.lane); continue; } r -= I_A;
        if (r < I_B) { const int kb = r >> 4, nb = r & 15; p0_transpose64(ap->in[9], 1024, kb * 64, nb * 64, WABC_T + (size_t)(nb * 64) * ABC_LD + 512 + kb * 64, ABC_LD, scr, F.lane); continue; } r -= I_B;
        if (r < I_C) { const int kb = r >> 4, nb = r & 15; p0_transpose64(ap->in[10], 1024, kb * 64, nb * 64, WABC_T + (size_t)(nb * 64) * ABC_LD + 768 + kb * 64, ABC_LD, scr, F.lane); continue; } r -= I_C;
        { const int kb = r >> 4, nb = r & 15; p0_transpose64(ap->in[11], 1024, kb * 64, nb * 64, WOUT_T + (size_t)(nb * 64) * 1024 + kb * 64, 1024, scr, F.lane); }
    }
    bf16_t* XN = (bf16_t*)(F.ws + WS_XN); bf16_t* MEMN = (bf16_t*)(F.ws + WS_MEMN);
    for (int m = gw; m < NTOK; m += 2 * NGW) {
        const int m2 = m + NGW; const bool two = m2 < NTOK;
        const GAS f32x4* xa = (const GAS f32x4*)(ap->in[0] + (size_t)m * D) + F.lane; const GAS f32x4* xb = (const GAS f32x4*)(ap->in[0] + (size_t)(two ? m2 : m) * D) + F.lane;
        const GAS f32x4* gr = (const GAS f32x4*)ap->in[2] + F.lane;
        f32x4 va[4], vb[4]; float sa = 0.f, sb = 0.f;
#pragma unroll
        for (int j = 0; j < 4; ++j) { va[j] = xa[64 * j]; vb[j] = xb[64 * j]; }
#pragma unroll
        for (int j = 0; j < 4; ++j) { sa += (va[j].x * va[j].x + va[j].y * va[j].y) + (va[j].z * va[j].z + va[j].w * va[j].w); sb += (vb[j].x * vb[j].x + vb[j].y * vb[j].y) + (vb[j].z * vb[j].z + vb[j].w * vb[j].w); }
#pragma unroll
        for (int o = 1; o < 64; o <<= 1) { sa += sx(sa, o); sb += sx(sb, o); }
        const float ra = 1.0f / sqrtf(sa * (1.f / D) + RMS_EPS), rb = 1.0f / sqrtf(sb * (1.f / D) + RMS_EPS);
        GAS u32x2* oa = (GAS u32x2*)(XN + (size_t)m * D) + F.lane; GAS u32x2* ob = (GAS u32x2*)(XN + (size_t)m2 * D) + F.lane;
#pragma unroll
        for (int j = 0; j < 4; ++j) { const f32x4 gg = gr[64 * j]; u32x2 w; w.x = cvt_pk_bf16(va[j].x * ra * gg.x, va[j].y * ra * gg.y); w.y = cvt_pk_bf16(va[j].z * ra * gg.z, va[j].w * ra * gg.w); oa[64 * j] = w;
            if (two) { u32x2 w2; w2.x = cvt_pk_bf16(vb[j].x * rb * gg.x, vb[j].y * rb * gg.y); w2.y = cvt_pk_bf16(vb[j].z * rb * gg.z, vb[j].w * rb * gg.w); ob[64 * j] = w2; } }
    }
    for (int m = gw; m < NMEM; m += NGW) rms_row_to_bf16(ap->in[1] + (size_t)m * D, ap->in[3], MEMN + (size_t)m * D, F.lane);
    const int gt = F.vcu * NTHREADS + F.tid, NGT = F.G * NTHREADS;
    float* t5 = (float*)(F.ws + WS_MISC + MO_T5); float* rp = (float*)(F.ws + WS_MISC + MO_RPB);
    for (int i = gt; i < 12 * T5_LD; i += NGT) { const int gh = i / T5_LD, j = i % T5_LD, rel = j - 79, g = gh >> 2; const int dil = g == 0 ? 1 : (g == 1 ? 4 : 16);
        float v = 0.f; if (rel >= -64 && rel <= 64) v = ap->in[7][t5_bucket(rel * dil) * 12 + gh] * LOG2E; t5[i] = v; }
    for (int i = gt; i < 8 * RPB_LD; i += NGT) { const int h = i / RPB_LD, j = i % RPB_LD - RPB_OFF; float v = 0.f; if (j >= 0 && j < 465) v = ap->in[6][h * 465 + j] * LOG2E; rp[i] = v; }
}

__device__ __forceinline__ bool is_converter(int c) { return ((c >> 3) & 3) == 3; }
struct CvItem { const float* src; int ldw; unsigned char* dst; };
__device__ __forceinline__ CvItem cv_decode(int r, const float* GU, const float* DN, unsigned char* WGU8, unsigned char* WDN8) {
    constexpr int I_GU = 32 * 16 * 32; CvItem I;
    if (r < I_GU) { const int e = r >> 9, q = r & 511, kb = q >> 5, nb = q & 31, n0 = nb * 64; const int bj = n0 >> 10, rem = n0 & 1023, pn = rem >> 7, c0 = rem & 127;
        I.src = GU + (size_t)e * 1024 * 2048 + (size_t)(kb * 64) * 2048 + n0; I.ldw = 2048; I.dst = WGU8 + ((size_t)e * 2048 + pn * 256 + bj * 128 + c0) * 1024 + kb * 64; }
    else { r -= I_GU; const int e = r >> 8, q = r & 255, kb = q >> 4, nb = q & 15;
        I.src = DN + (size_t)e * 1024 * 1024 + (size_t)(kb * 64) * 1024 + nb * 64; I.ldw = 1024; I.dst = WDN8 + ((size_t)e * 1024 + nb * 64) * 1024 + kb * 64; }
    return I;
}
__device__ __forceinline__ void cv_load(const CvItem& I, f32x4 (&v)[16], int lane) {
#pragma unroll
    for (int i = 0; i < 16; ++i) { const int kk = 4 * i + (lane >> 4); v[i] = *(const GAS f32x4*)(I.src + (size_t)kk * I.ldw + 4 * (lane & 15)); }
}
__device__ __forceinline__ void cv_finish(const CvItem& I, const f32x4 (&v)[16], LAS float* scr, int lane) {
#pragma unroll
    for (int i = 0; i < 16; ++i) { const int kk = 4 * i + (lane >> 4); LAS float* s = scr + kk * 65 + 4 * (lane & 15); s[0] = v[i][0] * 64.0f; s[1] = v[i][1] * 64.0f; s[2] = v[i][2] * 64.0f; s[3] = v[i][3] * 64.0f; }
    LDS_WAIT(); asm volatile("" ::: "memory");
    const int c = lane & 3;
#pragma unroll
    for (int j = 0; j < 4; ++j) { const int n = (lane >> 2) + 16 * j; const LAS float* s = scr + (16 * c) * 65 + n;
        u32x4 o;
#pragma unroll
        for (int q = 0; q < 4; ++q) { int w = __builtin_amdgcn_cvt_pk_fp8_f32(s[(4 * q) * 65], s[(4 * q + 1) * 65], 0, false); w = __builtin_amdgcn_cvt_pk_fp8_f32(s[(4 * q + 2) * 65], s[(4 * q + 3) * 65], w, true); o[q] = (unsigned)w; }
        *(GAS u32x4*)(I.dst + (size_t)n * 1024 + 16 * c) = o; }
    LDS_WAIT(); asm volatile("" ::: "memory");
}
__device__ __forceinline__ void p1_convert_experts(const Ctx& F0) {
    const KArgs ap = kargs();
    const Ctx F = ctx_refresh(F0);
    const int c = (int)blockIdx.x; if (!is_converter(c)) return;
    LAS float* scr = (LAS float*)(F.lds) + F.wave * (64 * 65);
    const int ci = (c & 7) * 8 + (c >> 5);
    const float* GU = ap->in[15]; const float* DN = ap->in[17];
    unsigned char* WGU8 = (unsigned char*)(F.ws + WS_WGU_T); unsigned char* WDN8 = (unsigned char*)(F.ws + WS_WDN_T);
    constexpr int NIT = 32 * 16 * 32 + 32 * 16 * 16, STRIDE = 64 * NWAVES;
    int it = ci * NWAVES + F.wave;
    CvItem I = cv_decode(it, GU, DN, WGU8, WDN8); f32x4 va[16], vb[16]; cv_load(I, va, F.lane);
    for (;;) {
        const int itn = it + STRIDE; const bool hn = itn < NIT; CvItem In = I;
        if (hn) { In = cv_decode(itn, GU, DN, WGU8, WDN8); cv_load(In, vb, F.lane); }
        cv_finish(I, va, scr, F.lane);
        if (!hn) break;
        I = In; it = itn;
#pragma unroll
        for (int i = 0; i < 16; ++i) va[i] = vb[i];
    }
}

struct P1Sched {
    unsigned* ctr; LAS int* slot; int wave, x; const char* XN; const char* WIN; const char* MEMN; const char* WMEM;
    __device__ __forceinline__ bool next(int i, pg8::Unit& u) const {
        if (wave == 0) { int t = 0; if (lane_id() == 0) t = (int)__hip_atomic_fetch_add(ctr, 1u, __ATOMIC_RELAXED, __HIP_MEMORY_SCOPE_AGENT); t = __builtin_amdgcn_readfirstlane(t); if (lane_id() == 0) slot[i & 1] = t; }
        LDS_WAIT(); __builtin_amdgcn_s_barrier(); asm volatile("" ::: "memory");
        const int idx = __builtin_amdgcn_readfirstlane(slot[i & 1]);
        if (idx > 232) return false;
        u.rows = 0; u.nt = 16;
        if (idx == 232) { u.pm = x >> 2; u.pn = x & 3; u.A = MEMN + (size_t)u.pm * 256 * 2048; u.B = WMEM + (size_t)u.pn * 256 * 2048; u.aux = 3; u.scale = 1.f; return true; }
        u.pm = 8 * x + (idx & 7); u.pn = idx >> 3;
        u.A = XN + (size_t)u.pm * 256 * 2048; u.B = WIN + (size_t)u.pn * 256 * 2048;
        const int pn = u.pn;
        if (pn < 2 || (pn >= 6 && pn < 9)) { u.aux = 1; u.scale = QS64; } else if (pn == 15 || pn == 16) { u.aux = 1; u.scale = QS128; } else if (pn >= 17) { u.aux = 2; u.scale = 1.f; } else { u.aux = 0; u.scale = 1.f; }
        return true;
    }
};
struct P1Epi {
    bf16_t* PROJ; bf16_t* MKV;
    __device__ __forceinline__ void operator()(const f32x4 (&acc)[2][2][4][2], const pg8::Unit& u, int wr, int wc, int fr, int fq) const {
        bf16_t* O = u.aux == 3 ? MKV : PROJ + ((size_t)(u.pm * 29 + u.pn) << 16); const int ldo = u.aux == 3 ? 1024 : 256;
        const int row0 = (u.aux == 3 ? u.pm * 256 : 0) + wr * 64 + fr, col0 = (u.aux == 3 ? u.pn * 256 : 0) + wc * 32 + 8 * fq; const float sc = u.scale; const bool sg = u.aux == 2;
#pragma unroll
        for (int ai = 0; ai < 2; ++ai)
#pragma unroll
            for (int m = 0; m < 4; ++m) { bf16_t* rowp = O + (size_t)(row0 + ai * 128 + m * 16) * ldo + col0;
#pragma unroll
                for (int bj = 0; bj < 2; ++bj) { f32x4 v0 = acc[ai][bj][m][0], v1 = acc[ai][bj][m][1];
                    if (sg) { v0 = (f32x4){fast_sigmoid(v0[0]), fast_sigmoid(v0[1]), fast_sigmoid(v0[2]), fast_sigmoid(v0[3])}; v1 = (f32x4){fast_sigmoid(v1[0]), fast_sigmoid(v1[1]), fast_sigmoid(v1[2]), fast_sigmoid(v1[3])}; }
                    else { v0 = v0 * sc; v1 = v1 * sc; }
                    u32x4 w; w.x = cvt_pk_bf16(v0[0], v0[1]); w.y = cvt_pk_bf16(v0[2], v0[3]); w.z = cvt_pk_bf16(v1[0], v1[1]); w.w = cvt_pk_bf16(v1[2], v1[3]);
                    *(GAS u32x4*)(rowp + bj * 128) = w; } }
    }
};

template <int DH> __device__ __forceinline__ int k_addr(int key, int c) {
    if (DH == 64) return key * 128 + ((c ^ ((key >> 1) & 7)) << 4);
    else return key * 256 + ((c ^ (key & 15)) << 4);
}
template <int DH> __device__ __forceinline__ int v_addr(int key, int c) {
    if (DH == 64) return key * 128 + ((c ^ (((key >> 1) & 3) << 1)) << 4);
    else return key * 256 + ((c ^ ((key & 7) << 1)) << 4);
}
__device__ __forceinline__ s16x4 vtr(const LAS unsigned char* p) { return __builtin_bit_cast(s16x4, __builtin_amdgcn_ds_read_tr16_b64_v4i16((LAS s16x4*)p)); }

template <int DH, class RowFn> __device__ __forceinline__ void stage_kv(LAS unsigned char* Kl, LAS unsigned char* Vl, int nkeys, int tid, const RowFn& rowfn) {
    constexpr int CH = DH / 8; const int total = nkeys * CH;
    for (int base = 0; base < total; base += NTHREADS * 4) {
        u32x4 kv[4], vv[4];
#pragma unroll
        for (int j = 0; j < 4; ++j) { const int ci = base + j * NTHREADS + tid; kv[j] = (u32x4){0u, 0u, 0u, 0u}; vv[j] = kv[j];
            if (ci < total) { const int key = ci / CH, c = ci % CH; const bf16_t* kp; const bf16_t* vp; rowfn(key, kp, vp); if (kp) { kv[j] = *(const GAS u32x4*)(kp + c * 8); vv[j] = *(const GAS u32x4*)(vp + c * 8); } } }
#pragma unroll
        for (int j = 0; j < 4; ++j) { const int ci = base + j * NTHREADS + tid;
            if (ci < total) { const int key = ci / CH, c = ci % CH; *(LAS u32x4*)(Kl + k_addr<DH>(key, c)) = kv[j]; *(LAS u32x4*)(Vl + v_addr<DH>(key, c)) = vv[j]; } }
    }
}

template <int DH> __device__ __forceinline__ f32x4 qk_tile(const LAS unsigned char* Kl, int kbase, const bf16x8 (&qf)[DH / 32], int i, int g) {
    f32x4 acc = (f32x4){0.f, 0.f, 0.f, 0.f}; const int key = kbase + i;
#pragma unroll
    for (int s = 0; s < DH / 32; ++s) { const bf16x8 kf = *(const LAS bf16x8*)(Kl + k_addr<DH>(key, 4 * s + g)); acc = __builtin_amdgcn_mfma_f32_16x16x32_bf16(kf, qf[s], acc, 0, 0, 0); }
    return acc;
}
template <int DH> __device__ __forceinline__ void pv_step(f32x4 (&o)[DH / 16], const LAS unsigned char* Vl, int vbase, int vbase2, bf16x8 pf, int i, int g) {
    const int k0 = vbase + 4 * g + (i >> 2), k1 = vbase2 + 4 * g + (i >> 2); const int sub = (i & 3) >> 1, b8 = 8 * (i & 1);
#pragma unroll
    for (int n = 0; n < DH / 16; ++n) {
        const s16x4 lo = vtr(Vl + v_addr<DH>(k0, 2 * n + sub) + b8), hi = vtr(Vl + v_addr<DH>(k1, 2 * n + sub) + b8);
        const bf16x8 vf = (bf16x8){lo[0], lo[1], lo[2], lo[3], hi[0], hi[1], hi[2], hi[3]};
        o[n] = __builtin_amdgcn_mfma_f32_16x16x32_bf16(vf, pf, o[n], 0, 0, 0);
    }
}
__device__ __forceinline__ bf16x8 pack_p(const f32x4& a, const f32x4& b) {
    u32x4 w; w.x = cvt_pk_bf16(a[0], a[1]); w.y = cvt_pk_bf16(a[2], a[3]); w.z = cvt_pk_bf16(b[0], b[1]); w.w = cvt_pk_bf16(b[2], b[3]); return __builtin_bit_cast(bf16x8, w);
}
template <int NT> __device__ __forceinline__ void softmax_tiles(f32x4 (&s)[NT], float& m, float& l) {
    float mx = -INFINITY;
#pragma unroll
    for (int t = 0; t < NT; ++t) mx = fmaxf(fmaxf(fmaxf(mx, s[t][0]), fmaxf(s[t][1], s[t][2])), s[t][3]);
    mx = fmaxf(mx, sx(mx, 16)); mx = fmaxf(mx, sx(mx, 32));
    float sum = 0.f;
#pragma unroll
    for (int t = 0; t < NT; ++t) {
#pragma unroll
        for (int r = 0; r < 4; ++r) { const float p = __builtin_amdgcn_exp2f(s[t][r] - mx); s[t][r] = p; sum += p; } }
    sum += sx(sum, 16); sum += sx(sum, 32);
    m = mx; l = sum;
}
template <int DH> __device__ __forceinline__ void load_q(bf16x8 (&qf)[DH / 32], const bf16_t* qrow, int g) {
#pragma unroll
    for (int s = 0; s < DH / 32; ++s) qf[s] = *(const GAS bf16x8*)(qrow + 32 * s + 8 * g);
}
template <int DH> __device__ __forceinline__ void store_o(const f32x4 (&o)[DH / 16], float inv, bf16_t* orow, int g) {
#pragma unroll
    for (int n = 0; n < DH / 16; ++n) { u32x2 w; w.x = cvt_pk_bf16(o[n][0] * inv, o[n][1] * inv); w.y = cvt_pk_bf16(o[n][2] * inv, o[n][3] * inv); *(GAS u32x2*)(orow + 16 * n + 4 * g) = w; }
}

template <int DH, int NPF, class RowFn> __device__ __forceinline__ void pf_issue(u32x4 (&kv)[NPF], u32x4 (&vv)[NPF], int nkeys, int tid, const RowFn& rowfn) {
    constexpr int CH = DH / 8; const int total = nkeys * CH;
#pragma unroll
    for (int j = 0; j < NPF; ++j) { const int ci = j * NTHREADS + tid; kv[j] = (u32x4){0u, 0u, 0u, 0u}; vv[j] = kv[j];
        if (ci < total) { const int key = ci / CH, c = ci % CH; const bf16_t* kp; const bf16_t* vp; rowfn(key, kp, vp); if (kp) { kv[j] = *(const GAS u32x4*)(kp + c * 8); vv[j] = *(const GAS u32x4*)(vp + c * 8); } } }
}
template <int DH, int NPF> __device__ __forceinline__ void pf_commit(const u32x4 (&kv)[NPF], const u32x4 (&vv)[NPF], LAS unsigned char* Kl, LAS unsigned char* Vl, int nkeys, int tid) {
    constexpr int CH = DH / 8; const int total = nkeys * CH;
#pragma unroll
    for (int j = 0; j < NPF; ++j) { const int ci = j * NTHREADS + tid;
        if (ci < total) { const int key = ci / CH, c = ci % CH; *(LAS u32x4*)(Kl + k_addr<DH>(key, c)) = kv[j]; *(LAS u32x4*)(Vl + v_addr<DH>(key, c)) = vv[j]; } }
}
struct AUnit { int b, h, r0, rsU; };
__device__ __forceinline__ AUnit a_unit(int c, int rep) { const int ua = c + 256 * rep, x = ua & 7, y = ua >> 3, pair = x * 2 + (y >> 6), rp = y & 63; AUnit u; u.b = pair >> 3; u.h = pair & 7; u.r0 = 2 * rp; int rs = u.r0 - 4; u.rsU = rs < 0 ? 0 : (rs > 120 ? 120 : rs); return u; }
struct BUnit { int b, hh, grp, dil, L, rho, n, p0; };
__device__ __forceinline__ BUnit b_unit(int c, int rep) { const int ub = c + 256 * rep, x = ub & 7, y = ub >> 3, combo = x * 3 + y / 64, sub = y % 64; BUnit u; u.b = combo / 12; u.hh = combo % 12; u.grp = u.hh >> 2;
    u.dil = u.grp == 0 ? 1 : (u.grp == 1 ? 4 : 16); u.L = SEQ / u.dil; const int nb = u.L / 128; u.rho = sub / nb; u.n = sub % nb; u.p0 = 128 * u.n - 64; return u; }

__device__ __forceinline__ const bf16_t* a_qptr(const bf16_t* PROJ, int c, int rep, int w, int i) { const AUnit U = a_unit(c, rep); const int r = U.r0 + (w >> 2), cq = 16 * (w & 3) + i; return PROJ + proj_off((size_t)(U.b * SEQ + r * 64 + cq), C_QA + U.h * 64); }
__device__ __forceinline__ const bf16_t* b_qptr(const bf16_t* PROJ, int c, int rep, int w, int i) { const BUnit U = b_unit(c, rep); const int pq = 128 * U.n + 16 * w + i; return PROJ + proj_off((size_t)(U.b * SEQ + pq * U.dil + U.rho), C_QB + U.hh * 64); }

__device__ __forceinline__ void p2_attention(const Ctx& F0) {
    const Ctx F = ctx_refresh(F0);
    const bf16_t* PROJ = (const bf16_t*)(F.ws + WS_PROJ); const bf16_t* MKV = (const bf16_t*)(F.ws + WS_MKV);
    bf16_t* ABC = (bf16_t*)(F.ws + WS_ABC); bf16_t* OB = (bf16_t*)(F.ws + WS_OB); float* LSE = (float*)(F.ws + WS_MISC + MO_LSE);
    const float* T5 = (const float*)(F.ws + WS_MISC + MO_T5); const float* RPB = (const float*)(F.ws + WS_MISC + MO_RPB);
    LAS unsigned char* Kl = F.lds; LAS float* tab = (LAS float*)(F.lds + LDS_TAB);
    const int w = F.wave, c = (int)blockIdx.x;
#define P2_LANE() int tid_r = F.tid; asm volatile("" : "+v"(tid_r)); const int lane = tid_r & 63, i = lane & 15, g = lane >> 4; (void)lane
#define PF_A(rep_, KV, VV, T0, T1) do { const AUnit nu = a_unit(c, rep_); \
        pf_issue<64, 9>(KV, VV, 576, tid_r, [&](int key, const bf16_t*& kp, const bf16_t*& vp) { kp = nullptr; vp = nullptr; if (nu.rsU * 64 + key < SEQ) { const size_t tok = (size_t)nu.b * SEQ + nu.rsU * 64 + key; kp = PROJ + proj_off(tok, C_KA + nu.h * 64); vp = PROJ + proj_off(tok, C_VA + nu.h * 64); } }); \
        T0 = RPB[nu.h * RPB_LD + tid_r]; T1 = tid_r < RPB_LD - NTHREADS ? RPB[nu.h * RPB_LD + NTHREADS + tid_r] : 0.f; } while (0)
#define CM_A(KV, VV, T0, T1) do { pf_commit<64, 9>(KV, VV, Kl, Kl + 73728, 576, tid_r); tab[tid_r] = T0; if (tid_r < RPB_LD - NTHREADS) tab[NTHREADS + tid_r] = T1; } while (0)
#define PF_B(rep_, KV, VV, T0) do { const BUnit nu = b_unit(c, rep_); \
        pf_issue<64, 5>(KV, VV, 272, tid_r, [&](int key, const bf16_t*& kp, const bf16_t*& vp) { const int p = nu.p0 + key; kp = nullptr; vp = nullptr; \
            if (key < 256 && p >= 0 && p < nu.L) { const size_t tok = (size_t)nu.b * SEQ + (size_t)p * nu.dil + nu.rho; kp = PROJ + proj_off(tok, C_KB + nu.hh * 64); vp = PROJ + proj_off(tok, C_VB + nu.hh * 64); } }); \
        T0 = tid_r < T5_LD ? T5[nu.hh * T5_LD + tid_r] : 0.f; } while (0)
#define CM_B(KV, VV, T0) do { pf_commit<64, 5>(KV, VV, Kl, Kl + 34816, 272, tid_r); if (tid_r < T5_LD) tab[tid_r] = T0; } while (0)
    u32x4 akv[9], avv[9]; float at0 = 0.f, at1 = 0.f; bf16x8 qn[2];
    {
        LAS unsigned char* Vl = Kl + 65536; P2_LANE();
        const int combo = c & 7, b = combo >> 2, h = combo & 3;
        __syncthreads();
        stage_kv<128>(Kl, Vl, 256, tid_r, [&](int key, const bf16_t*& kp, const bf16_t*& vp) { kp = MKV + (size_t)(b * MEMLEN + key) * 1024 + h * 128; vp = kp + 512; });
        LDS_WAIT(); __syncthreads();
        for (int rep = 0; rep < 2; ++rep) {
            const int blk = (c >> 3) + 32 * rep; const int tok = b * SEQ + blk * 128 + w * 16 + i;
            bf16x8 qf[4]; load_q<128>(qf, PROJ + proj_off((size_t)tok, C_QC + h * 128), g);
            if (rep == 1) { PF_A(0, akv, avv, at0, at1); load_q<64>(qn, a_qptr(PROJ, c, 0, w, i), g); }
            f32x4 s[16];
#pragma unroll
            for (int t = 0; t < 16; ++t) s[t] = qk_tile<128>(Kl, 16 * t, qf, i, g);
            float m, l; softmax_tiles<16>(s, m, l);
            f32x4 o[8];
#pragma unroll
            for (int n = 0; n < 8; ++n) o[n] = (f32x4){0.f, 0.f, 0.f, 0.f};
#pragma unroll
            for (int u = 0; u < 8; ++u) pv_step<128>(o, Vl, 32 * u, 32 * u + 16, pack_p(s[2 * u], s[2 * u + 1]), i, g);
            store_o<128>(o, 1.0f / l, ABC + (size_t)tok * ABC_LD + 768 + h * 128, g);
        }
        __syncthreads(); CM_A(akv, avv, at0, at1); LDS_WAIT(); __syncthreads();
    }
    u32x4 bkv[5], bvv[5]; float bt0 = 0.f;
    for (int rep = 0; rep < 4; ++rep) {
        LAS unsigned char* Vl = Kl + 73728; P2_LANE();
        const AUnit U = a_unit(c, rep); const int b = U.b, h = U.h, r0 = U.r0, rsU = U.rsU;
        const int r = r0 + (w >> 2), jb = w & 3; int rs = r - 4; rs = rs < 0 ? 0 : (rs > 120 ? 120 : rs);
        const int cq = 16 * jb + i; int cs = cq - 8; cs = cs < 0 ? 0 : (cs > 48 ? 48 : cs);
        const int cw = jb == 0 ? 0 : (jb == 1 ? 8 : (jb == 2 ? 24 : 32));
        const int tok = b * SEQ + r * 64 + cq;
        bf16x8 qf[2]; qf[0] = qn[0]; qf[1] = qn[1];
        if (rep < 3) { PF_A(rep + 1, akv, avv, at0, at1); load_q<64>(qn, a_qptr(PROJ, c, rep + 1, w, i), g); } else { PF_B(0, bkv, bvv, bt0); load_q<64>(qn, b_qptr(PROJ, c, 0, w, i), g); }
        const int kb0 = (rs - rsU) * 64 + cw;
        f32x4 s[16];
#pragma unroll
        for (int t = 0; t < 16; ++t) s[t] = qk_tile<64>(Kl, kb0 + (t >> 1) * 64 + 16 * (t & 1), qf, i, g);
        const int bidx = RPB_OFF + (7 - (r - rs)) * 31 + (cw + 4 * g - cq + 15); const int lo = cs - cw - 4 * g;
#pragma unroll
        for (int t = 0; t < 16; ++t) {
#pragma unroll
            for (int rr = 0; rr < 4; ++rr) { const int kc = 16 * (t & 1) + rr; const float bias = tab[bidx + (t >> 1) * 31 + kc]; const bool ok = kc >= lo && kc < lo + 16; s[t][rr] = ok ? s[t][rr] + bias : -INFINITY; } }
        float m, l; softmax_tiles<16>(s, m, l);
        f32x4 o[4];
#pragma unroll
        for (int n = 0; n < 4; ++n) o[n] = (f32x4){0.f, 0.f, 0.f, 0.f};
#pragma unroll
        for (int u = 0; u < 8; ++u) pv_step<64>(o, Vl, kb0 + u * 64, kb0 + u * 64 + 16, pack_p(s[2 * u], s[2 * u + 1]), i, g);
        store_o<64>(o, 1.0f / l, ABC + (size_t)tok * ABC_LD + h * 64, g);
        __syncthreads(); if (rep < 3) { CM_A(akv, avv, at0, at1); } else { CM_B(bkv, bvv, bt0); } LDS_WAIT(); __syncthreads();
    }
    for (int rep = 0; rep < 6; ++rep) {
        LAS unsigned char* Vl = Kl + 34816; P2_LANE();
        const BUnit U = b_unit(c, rep); const int b = U.b, hh = U.hh, grp = U.grp, dil = U.dil, L = U.L, rho = U.rho, n = U.n;
        const int pq = 128 * n + 16 * w + i; const int tok = b * SEQ + pq * dil + rho;
        bf16x8 qf[2]; qf[0] = qn[0]; qf[1] = qn[1];
        if (rep < 5) { PF_B(rep + 1, bkv, bvv, bt0); load_q<64>(qn, b_qptr(PROJ, c, rep + 1, w, i), g); }
        f32x4 s[10];
#pragma unroll
        for (int t = 0; t < 10; ++t) s[t] = qk_tile<64>(Kl, 16 * w + 16 * t, qf, i, g);
        const int rel0 = 4 * g - 64 - i;
#pragma unroll
        for (int t = 0; t < 10; ++t) {
#pragma unroll
            for (int rr = 0; rr < 4; ++rr) { const int rel = rel0 + 16 * t + rr; const int p = pq + rel; const float bias = tab[rel + 79]; const bool ok = rel >= -64 && rel <= 64 && p >= 0 && p < L; s[t][rr] = ok ? s[t][rr] + bias : -INFINITY; } }
        float m, l; softmax_tiles<10>(s, m, l);
        f32x4 o[4];
#pragma unroll
        for (int nn = 0; nn < 4; ++nn) o[nn] = (f32x4){0.f, 0.f, 0.f, 0.f};
#pragma unroll
        for (int u = 0; u < 5; ++u) pv_step<64>(o, Vl, 16 * w + 32 * u, 16 * w + 32 * u + 16, pack_p(s[2 * u], s[2 * u + 1]), i, g);
        const int h4 = hh & 3;
        store_o<64>(o, 1.0f / l, OB + ((size_t)grp * NTOK + tok) * 256 + h4 * 64, g);
        if (g == 0) LSE[((size_t)grp * NTOK + tok) * 4 + h4] = m + __builtin_amdgcn_logf(l);
        if (rep < 5) { __syncthreads(); CM_B(bkv, bvv, bt0); LDS_WAIT(); __syncthreads(); }
    }
#undef PF_A
#undef CM_A
#undef PF_B
#undef CM_B
}
#undef P2_LANE
__device__ __forceinline__ void p2b_merge_tile(const Ctx& F0, int pm) {
    const Ctx F = ctx_refresh(F0);
    const bf16_t* OB = (const bf16_t*)(F.ws + WS_OB); const float* LSE = (const float*)(F.ws + WS_MISC + MO_LSE); bf16_t* ABC = (bf16_t*)(F.ws + WS_ABC);
    for (int it = F.tid; it < 256 * 32; it += NTHREADS) {
        const int tok = pm * 256 + (it >> 5), ch = it & 31, h = ch >> 3;
        const float l0 = LSE[(size_t)tok * 4 + h], l1 = LSE[((size_t)NTOK + tok) * 4 + h], l2 = LSE[((size_t)2 * NTOK + tok) * 4 + h];
        const float mx = fmaxf(l0, fmaxf(l1, l2)); float w0 = __builtin_amdgcn_exp2f(l0 - mx), w1 = __builtin_amdgcn_exp2f(l1 - mx), w2 = __builtin_amdgcn_exp2f(l2 - mx);
        const float inv = 1.0f / (w0 + w1 + w2); w0 *= inv; w1 *= inv; w2 *= inv;
        const u32x4 a = *(const GAS u32x4*)(OB + (size_t)tok * 256 + ch * 8), bq = *(const GAS u32x4*)(OB + ((size_t)NTOK + tok) * 256 + ch * 8), cq = *(const GAS u32x4*)(OB + ((size_t)2 * NTOK + tok) * 256 + ch * 8);
        u32x4 o;
#pragma unroll
        for (int j = 0; j < 4; ++j) { const float lo = w0 * bf_lo(a[j]) + w1 * bf_lo(bq[j]) + w2 * bf_lo(cq[j]), hi = w0 * bf_hi(a[j]) + w1 * bf_hi(bq[j]) + w2 * bf_hi(cq[j]); o[j] = cvt_pk_bf16(lo, hi); }
        *(GAS u32x4*)(ABC + (size_t)tok * ABC_LD + 512 + ch * 8) = o;
    }
    VM_WAIT(); __syncthreads();
}
__device__ __forceinline__ void p2b_merge(const Ctx& F0) {
    const Ctx F = ctx_refresh(F0);
    const bf16_t* OB = (const bf16_t*)(F.ws + WS_OB); const float* LSE = (const float*)(F.ws + WS_MISC + MO_LSE); bf16_t* ABC = (bf16_t*)(F.ws + WS_ABC);
    const int gt = F.vcu * NTHREADS + F.tid, NGT = F.G * NTHREADS;
    for (int it = gt; it < NTOK * 32; it += NGT) {
        const int tok = it >> 5, ch = it & 31, h = ch >> 3;
        const float l0 = LSE[(size_t)tok * 4 + h], l1 = LSE[((size_t)NTOK + tok) * 4 + h], l2 = LSE[((size_t)2 * NTOK + tok) * 4 + h];
        const float mx = fmaxf(l0, fmaxf(l1, l2)); float w0 = __builtin_amdgcn_exp2f(l0 - mx), w1 = __builtin_amdgcn_exp2f(l1 - mx), w2 = __builtin_amdgcn_exp2f(l2 - mx);
        const float inv = 1.0f / (w0 + w1 + w2); w0 *= inv; w1 *= inv; w2 *= inv;
        const u32x4 a = *(const GAS u32x4*)(OB + (size_t)tok * 256 + ch * 8), bq = *(const GAS u32x4*)(OB + ((size_t)NTOK + tok) * 256 + ch * 8), cq = *(const GAS u32x4*)(OB + ((size_t)2 * NTOK + tok) * 256 + ch * 8);
        u32x4 o;
#pragma unroll
        for (int j = 0; j < 4; ++j) { const float lo = w0 * bf_lo(a[j]) + w1 * bf_lo(bq[j]) + w2 * bf_lo(cq[j]), hi = w0 * bf_hi(a[j]) + w1 * bf_hi(bq[j]) + w2 * bf_hi(cq[j]); o[j] = cvt_pk_bf16(lo, hi); }
        *(GAS u32x4*)(ABC + (size_t)tok * ABC_LD + 512 + ch * 8) = o;
    }
}

struct P3Sched {
    int c; const char* ABCp; const char* WABC;
    __device__ __forceinline__ bool next(int i, pg8::Unit& u) const {
        if (i >= 3) return false;
        constexpr int nM = 64, nN = 4, nwg = 256;
        int wgid = c; { const int q = nwg / 8, xcd = wgid % 8, off = wgid / 8; wgid = xcd * q + off; }
        const int nig = 8 * nN, gid = wgid / nig, fm = gid * 8;
        u.pm = fm + ((wgid % nig) % 8); u.pn = (wgid % nig) / 8;
        const int sb = ((c >> 3) & 1) ? (i == 0 ? 1 : (i == 1 ? 0 : 2)) : i;
        const int koff = sb == 0 ? 0 : (sb == 1 ? 512 : 768);
        u.A = ABCp + (size_t)u.pm * 256 * (ABC_LD * 2) + koff * 2; u.B = WABC + (size_t)u.pn * 256 * (ABC_LD * 2) + koff * 2;
        u.rows = 0; u.nt = sb == 1 ? 4 : 8; u.aux = sb; u.scale = i == 0 ? 0.f : 1.f; return true;
    }
};
struct P3Epi {
    const bf16_t* PROJ; bf16_t* MERGED;
    __device__ __forceinline__ void operator()(const f32x4 (&acc)[2][2][4][2], const pg8::Unit& u, int wr, int wc, int fr, int fq) const {
        const int row0 = u.pm * 256 + wr * 64 + fr, col0 = u.pn * 256 + wc * 32 + 8 * fq; const int s = u.aux;
#pragma unroll
        for (int ai = 0; ai < 2; ++ai) {
            u32x4 gt[4][2], prev[4][2];
#pragma unroll
            for (int m = 0; m < 4; ++m)
#pragma unroll
                for (int bj = 0; bj < 2; ++bj) { const size_t row = (size_t)(row0 + ai * 128 + m * 16); const int col = col0 + bj * 128;
                    gt[m][bj] = *(const GAS u32x4*)(PROJ + proj_off(row, C_GATE + s * 1024 + col));
                    prev[m][bj] = (u32x4){0u, 0u, 0u, 0u}; if (u.scale != 0.f) prev[m][bj] = __builtin_nontemporal_load((const GAS u32x4*)(MERGED + row * 1024 + col)); }
            asm volatile("" ::: "memory");
#pragma unroll
            for (int m = 0; m < 4; ++m)
#pragma unroll
                for (int bj = 0; bj < 2; ++bj) { const size_t row = (size_t)(row0 + ai * 128 + m * 16); const int col = col0 + bj * 128;
                    const f32x4 v0 = acc[ai][bj][m][0], v1 = acc[ai][bj][m][1]; const u32x4 g = gt[m][bj], pv = prev[m][bj];
                    u32x4 o;
                    o.x = cvt_pk_bf16(bf_lo(pv.x) + bf_lo(g.x) * v0[0], bf_hi(pv.x) + bf_hi(g.x) * v0[1]);
                    o.y = cvt_pk_bf16(bf_lo(pv.y) + bf_lo(g.y) * v0[2], bf_hi(pv.y) + bf_hi(g.y) * v0[3]);
                    o.z = cvt_pk_bf16(bf_lo(pv.z) + bf_lo(g.z) * v1[0], bf_hi(pv.z) + bf_hi(g.z) * v1[1]);
                    o.w = cvt_pk_bf16(bf_lo(pv.w) + bf_lo(g.w) * v1[2], bf_hi(pv.w) + bf_hi(g.w) * v1[3]);
                    *(GAS u32x4*)(MERGED + row * 1024 + col) = o; }
            asm volatile("" ::: "memory");
        }
    }
};
struct P4Sched {
    int c; const char* MERGED; const char* WOUT;
    __device__ __forceinline__ bool next(int i, pg8::Unit& u) const {
        if (i >= 1) return false;
        constexpr int nN = 4, nwg = 256;
        int wgid = c; { const int q = nwg / 8, xcd = wgid % 8, off = wgid / 8; wgid = xcd * q + off; }
        const int nig = 8 * nN, gid = wgid / nig, fm = gid * 8;
        u.pm = fm + ((wgid % nig) % 8); u.pn = (wgid % nig) / 8;
        u.A = MERGED + (size_t)u.pm * 256 * 2048; u.B = WOUT + (size_t)u.pn * 256 * 2048; u.rows = 0; u.nt = 16; u.aux = 0; u.scale = 1.f; return true;
    }
};
struct P4Epi {
    const float* X; float* X1;
    __device__ __forceinline__ void operator()(const f32x4 (&acc)[2][2][4][2], const pg8::Unit& u, int wr, int wc, int fr, int fq) const {
        const int row0 = u.pm * 256 + wr * 64 + fr, col0 = u.pn * 256 + wc * 32 + 8 * fq;
#pragma unroll
        for (int ai = 0; ai < 2; ++ai) {
            f32x4 xv[4][2][2];
#pragma unroll
            for (int m = 0; m < 4; ++m)
#pragma unroll
                for (int bj = 0; bj < 2; ++bj) { const size_t off = (size_t)(row0 + ai * 128 + m * 16) * 1024 + col0 + bj * 128; xv[m][bj][0] = *(const GAS f32x4*)(X + off); xv[m][bj][1] = *(const GAS f32x4*)(X + off + 4); }
            asm volatile("" ::: "memory");
#pragma unroll
            for (int m = 0; m < 4; ++m)
#pragma unroll
                for (int bj = 0; bj < 2; ++bj) { const size_t off = (size_t)(row0 + ai * 128 + m * 16) * 1024 + col0 + bj * 128;
                    *(GAS f32x4*)(X1 + off) = xv[m][bj][0] + acc[ai][bj][m][0]; *(GAS f32x4*)(X1 + off + 4) = xv[m][bj][1] + acc[ai][bj][m][1]; }
            asm volatile("" ::: "memory");
        }
    }
};
__device__ __forceinline__ void p5_router(const Ctx& F0) {
    const KArgs ap = kargs(); const float* X1 = ap->out; const float* GF = ap->in[12]; const float* RW = ap->in[13]; const float* RB = ap->in[14];
    const Ctx F = ctx_refresh(F0);
    unsigned char* H8 = F.ws + WS_XN; float* RTOK = (float*)(F.ws + WS_MISC + MO_RTOK);
    int* TOPIDX = (int*)(F.ws + WS_MISC + MO_TOPIDX); float* TOPW = (float*)(F.ws + WS_MISC + MO_TOPW); int* HIST = (int*)(F.ws + WS_MISC + MO_HIST);
    LAS float* Wl = (LAS float*)F.lds;
    LAS float* xch = (LAS float*)(F.lds + 131072);
    LAS float* xss = (LAS float*)(F.lds + 131072 + 8192);
    LAS int* hist = (LAS int*)(F.lds + LDS_TAB);
    __syncthreads();
    for (int idx = F.tid; idx < 1024 * 8; idx += NTHREADS) { const int k = idx >> 3, q = idx & 7; const f32x4 wv = *(const GAS f32x4*)(RW + (size_t)k * 32 + 4 * q) * GF[k];
        *(LAS f32x4*)(Wl + k * 32 + ((4 * q) ^ (((k >> 5) & 1) << 4))) = wv; }
    if (F.tid < 32) hist[F.tid] = 0;
    LDS_WAIT(); __syncthreads();
    const int lane = F.lane, i = lane & 15, kq = lane >> 4, tg = F.wave & 3, kh = F.wave >> 2; const int bid = (int)blockIdx.x;
    const int tok = bid * 64 + tg * 16 + i; const int kbase = kh * 512 + 32 * kq;
    const float* xrow = X1 + (size_t)tok * D + kbase; const float* grow = GF + kbase;
    const LAS float* wb0 = Wl + kbase * 32 + (i ^ ((kq & 1) << 4)); const LAS float* wb1 = Wl + kbase * 32 + ((i + 16) ^ ((kq & 1) << 4));
    f32x4 acc0 = {0.f, 0.f, 0.f, 0.f}, acc1 = {0.f, 0.f, 0.f, 0.f}; float ss = 0.f;
#pragma unroll 1
    for (int c = 0; c < 4; ++c) {
        f32x4 xv[8], gv[8];
#pragma unroll
        for (int q = 0; q < 8; ++q) { xv[q] = *(const GAS f32x4*)(xrow + c * 128 + 4 * q); gv[q] = *(const GAS f32x4*)(grow + c * 128 + 4 * q); }
        unsigned o[8];
#pragma unroll
        for (int q = 0; q < 8; ++q) { const f32x4 x = xv[q], pq = x * gv[q]; ss += (x.x * x.x + x.y * x.y) + (x.z * x.z + x.w * x.w);
            int w = __builtin_amdgcn_cvt_pk_fp8_f32(pq.x, pq.y, 0, false); w = __builtin_amdgcn_cvt_pk_fp8_f32(pq.z, pq.w, w, true); o[q] = (unsigned)w; }
        GAS u32x4* op = (GAS u32x4*)(H8 + (size_t)tok * D + kbase + c * 128);
        op[0] = (u32x4){o[0], o[1], o[2], o[3]}; op[1] = (u32x4){o[4], o[5], o[6], o[7]};
#pragma unroll
        for (int j = 0; j < 32; ++j) { const float a = xv[j >> 2][j & 3]; const float b0 = wb0[(c * 128 + j) * 32], b1 = wb1[(c * 128 + j) * 32];
            acc0 = __builtin_amdgcn_mfma_f32_16x16x4f32(a, b0, acc0, 0, 0, 0); acc1 = __builtin_amdgcn_mfma_f32_16x16x4f32(a, b1, acc1, 0, 0, 0); }
    }
    ss += sx(ss, 16); ss += sx(ss, 32);
    if (kh == 1) { LAS float* xp = xch + (tg * 64 + lane) * 8; *(LAS f32x4*)xp = acc0; *(LAS f32x4*)(xp + 4) = acc1; if (lane < 16) xss[tg * 16 + lane] = ss; }
    LDS_WAIT(); __syncthreads();
    if (kh == 0) {
        const LAS float* xp = xch + (tg * 64 + lane) * 8; acc0 += *(const LAS f32x4*)xp; acc1 += *(const LAS f32x4*)(xp + 4); ss += xss[tg * 16 + i];
        const float rt = 1.0f / sqrtf(ss * (1.f / D) + RMS_EPS);
        if (lane < 16) RTOK[tok] = rt;
        const float bias0 = RB[i], bias1 = RB[i + 16];
        float c0[4], c1[4];
#pragma unroll
        for (int r = 0; r < 4; ++r) { const float rr = sidx(rt, 4 * kq + r); c0[r] = acc0[r] * rr + bias0; c1[r] = acc1[r] * rr + bias1; }
        float tv[4][4]; int ti[4][4];
#pragma unroll
        for (int k = 0; k < 4; ++k)
#pragma unroll
            for (int r = 0; r < 4; ++r) { float bv = c0[r] >= c1[r] ? c0[r] : c1[r]; int bi = c0[r] >= c1[r] ? i : i + 16;
#pragma unroll
                for (int off = 1; off < 16; off <<= 1) { const float ov = sx(bv, off); const int oi = sxi(bi, off); const bool take = (ov > bv) || (ov == bv && oi < bi); bv = take ? ov : bv; bi = take ? oi : bi; }
                tv[k][r] = bv; ti[k][r] = bi; if (bi == i) c0[r] = -INFINITY; if (bi == i + 16) c1[r] = -INFINITY; }
        if (i == 0) {
#pragma unroll
            for (int r = 0; r < 4; ++r) { const int t = bid * 64 + tg * 16 + 4 * kq + r;
                const float e1 = __expf(tv[1][r] - tv[0][r]), e2 = __expf(tv[2][r] - tv[0][r]), e3 = __expf(tv[3][r] - tv[0][r]); const float inv = 1.0f / (1.0f + e1 + e2 + e3);
                *(GAS i32x4*)(TOPIDX + t * 4) = (i32x4){ti[0][r], ti[1][r], ti[2][r], ti[3][r]}; *(GAS f32x4*)(TOPW + t * 4) = (f32x4){inv, e1 * inv, e2 * inv, e3 * inv};
                atomicAdd((int*)&hist[ti[0][r]], 1); atomicAdd((int*)&hist[ti[1][r]], 1); atomicAdd((int*)&hist[ti[2][r]], 1); atomicAdd((int*)&hist[ti[3][r]], 1); }
        }
    }
    LDS_WAIT(); __syncthreads();
    if (F.tid < 32) HIST[bid * 32 + F.tid] = hist[F.tid];
}
__device__ __forceinline__ void p6_slots(const Ctx& F0) {
    const Ctx F = ctx_refresh(F0);
    const int* TOPIDX = (const int*)(F.ws + WS_MISC + MO_TOPIDX); const float* TOPW = (const float*)(F.ws + WS_MISC + MO_TOPW); const int* HIST = (const int*)(F.ws + WS_MISC + MO_HIST);
    int* TOKSLOT = (int*)(F.ws + WS_MISC + MO_TOKSLOT); int* SLOTTOK = (int*)(F.ws + WS_MISC + MO_SLOTTOK); float* SLOTW = (float*)(F.ws + WS_MISC + MO_SLOTW); int* TILE = (int*)(F.ws + WS_MISC + MO_TILE);
    float* SLOTRS = (float*)(F.ws + WS_MISC + MO_SLOTRS); const float* RTOK = (const float*)(F.ws + WS_MISC + MO_RTOK);
    LAS int* part = (LAS int*)F.lds;
    LAS int* pref = part + 512;
    LAS int* tot = part + 1024;
    LAS int* mypre = tot + 32; LAS int* sbase = tot + 64; LAS int* wcnt = tot + 96;
    const int bid = (int)blockIdx.x, tid = F.tid;
    __syncthreads();
    { const int e = tid & 31, ch = tid >> 5; int s = 0, p = 0;
        for (int j = 0; j < 16; ++j) { const int bb = ch * 16 + j; const int hv = HIST[bb * 32 + e]; s += hv; if (bb < bid) p += hv; }
        part[ch * 32 + e] = s; pref[ch * 32 + e] = p; }
    LDS_WAIT(); __syncthreads();
    if (tid < 32) { int s = 0, p = 0; for (int ch = 0; ch < 16; ++ch) { s += part[ch * 32 + tid]; p += pref[ch * 32 + tid]; } tot[tid] = s; mypre[tid] = p; }
    LDS_WAIT(); __syncthreads();
    if (tid == 0) { int tb = 0; for (int e = 0; e < 32; ++e) { sbase[e] = tb * 256; const int nt = (tot[e] + 255) >> 8; if (bid == 0) { for (int j = 0; j < nt; ++j) TILE[1 + tb + j] = e; } tb += nt; } if (bid == 0) TILE[0] = tb; }
    LDS_WAIT(); __syncthreads();
    int e_me = 0, rank = 0; float w_me = 0.f; const int ent = tid;
    if (tid < 256) { e_me = TOPIDX[bid * 256 + ent]; w_me = TOPW[bid * 256 + ent];
        const int wv = tid >> 6;
        for (int e = 0; e < 32; ++e) { const unsigned long long bal = __ballot(e_me == e); if (e_me == e) rank = __builtin_popcountll(bal & ((1ull << F.lane) - 1ull)); if (F.lane == 0) wcnt[wv * 32 + e] = __builtin_popcountll(bal); } }
    LDS_WAIT(); __syncthreads();
    if (tid < 256) { const int wv = tid >> 6; for (int j = 0; j < wv; ++j) rank += wcnt[j * 32 + e_me];
        const int slot = sbase[e_me] + mypre[e_me] + rank; const int tok = bid * 64 + (ent >> 2);
        SLOTTOK[slot] = tok; SLOTW[slot] = w_me; SLOTRS[slot] = RTOK[tok]; TOKSLOT[bid * 256 + ent] = slot; }
    if (bid < 32) { const int e = bid; const int beg = sbase[e] + tot[e], end = sbase[e] + (((tot[e] + 255) >> 8) << 8); for (int s = beg + tid; s < end; s += NTHREADS) { SLOTTOK[s] = 0; SLOTW[s] = 0.f; SLOTRS[s] = 0.f; } }
}
constexpr int LDS_ROWS = 139264, LDS_TILE = 139264 + 11 * 1024;
static_assert(LDS_TILE + 4 * (1 + MAX_TILES) <= LDS_MISC, "LDS tables");
template <int NPN> __device__ __forceinline__ void moe_unit(int i, int c, int& m, int& pn) { const int k = c >> 3; m = i * (256 / NPN) + (32 / NPN) * (c & 7) + k / NPN; pn = k % NPN; }
template <int NPN, bool ROWS> __device__ __forceinline__ void moe_tables(const Ctx& F, const int* TILE, const int* SLOTTOK) {
    LAS int* tl = (LAS int*)(F.lds + LDS_TILE);
    __syncthreads();
    for (int j = F.tid; j < 1 + MAX_TILES; j += NTHREADS) tl[j] = __hip_atomic_load((int*)TILE + j, __ATOMIC_RELAXED, __HIP_MEMORY_SCOPE_AGENT);
    if (ROWS) { const int ntile = __builtin_amdgcn_readfirstlane(__hip_atomic_load((int*)TILE, __ATOMIC_RELAXED, __HIP_MEMORY_SCOPE_AGENT));
        for (int i = 0; i < 11; ++i) { int m, pn_; moe_unit<NPN>(i, (int)blockIdx.x, m, pn_); if (m >= ntile) break;
            if (F.tid < 256) ((LAS int*)(F.lds + LDS_ROWS))[i * 256 + F.tid] = SLOTTOK[m * 256 + F.tid]; } }
    LDS_WAIT(); __syncthreads();
}
struct P7Sched {
    int G, c; LAS const int* tl; const char* H2; const char* WGU; int ntile;
    __device__ __forceinline__ bool next(int i, pg8::Unit& u) const {
        int m, pn; moe_unit<8>(i, c, m, pn); if (m >= ntile || i >= 11) return false;
        const int e = __builtin_amdgcn_readfirstlane(tl[1 + m]);
        u.pm = m; u.pn = pn; u.aux = e; u.scale = 1.f; u.nt = 8; u.rows = LDS_ROWS + 1024 * i; u.A = H2; u.B = WGU + ((size_t)e * 2048 + pn * 256) * 1024; return true;
    }
};
struct P7Epi {
    const float* BGU; bf16_t* ACT; const float* SLOTRS;
    __device__ __forceinline__ void operator()(const f32x4 (&acc)[2][2][4][2], const pg8::Unit& u, int wr, int wc, int fr, int fq) const {
        const int row0 = u.pm * 256 + wr * 64 + fr, cc0 = wc * 32 + 8 * fq, e = u.aux;
        float rr[2][4];
#pragma unroll
        for (int ai = 0; ai < 2; ++ai)
#pragma unroll
            for (int m = 0; m < 4; ++m) rr[ai][m] = SLOTRS[row0 + ai * 128 + m * 16];
        const float* bg = BGU + (size_t)e * 2048 + u.pn * 128 + cc0; const float* bu = bg + 1024;
        const f32x4 bg0 = *(const GAS f32x4*)bg, bg1 = *(const GAS f32x4*)(bg + 4), bu0 = *(const GAS f32x4*)bu + 1.0f, bu1 = *(const GAS f32x4*)(bu + 4) + 1.0f;
        asm volatile("" ::: "memory");
#pragma unroll
        for (int ai = 0; ai < 2; ++ai)
#pragma unroll
            for (int m = 0; m < 4; ++m) { const size_t row = (size_t)(row0 + ai * 128 + m * 16);
                float av[8];
#pragma unroll
                for (int n = 0; n < 2; ++n) { const f32x4 gv = acc[ai][0][m][n] * rr[ai][m] + (n ? bg1 : bg0), uv = acc[ai][1][m][n] * rr[ai][m] + (n ? bu1 : bu0);
#pragma unroll
                    for (int j = 0; j < 4; ++j) { const float gg = fminf(gv[j], 7.0f); const float u1 = fminf(fmaxf(uv[j], -6.0f), 8.0f);
                        av[4 * n + j] = (u1 * gg) * __builtin_amdgcn_rcpf(1.0f + __builtin_amdgcn_exp2f(gg * (-1.702f * LOG2E))); } }
                int w0 = __builtin_amdgcn_cvt_pk_fp8_f32(av[0], av[1], 0, false); w0 = __builtin_amdgcn_cvt_pk_fp8_f32(av[2], av[3], w0, true);
                int w1 = __builtin_amdgcn_cvt_pk_fp8_f32(av[4], av[5], 0, false); w1 = __builtin_amdgcn_cvt_pk_fp8_f32(av[6], av[7], w1, true);
                *(GAS u32x2*)((unsigned char*)ACT + row * 1024 + u.pn * 128 + cc0) = (u32x2){(unsigned)w0, (unsigned)w1}; }
    }
};
struct P8Sched {
    int G, c; LAS const int* tl; const char* ACT; const char* WDN; int ntile;
    __device__ __forceinline__ bool next(int i, pg8::Unit& u) const {
        int m, pn; moe_unit<4>(i, c, m, pn); if (m >= ntile) return false;
        const int e = __builtin_amdgcn_readfirstlane(tl[1 + m]);
        u.pm = m; u.pn = pn; u.aux = e; u.scale = 1.f; u.nt = 8; u.rows = 0; u.A = ACT + (size_t)m * 256 * 1024; u.B = WDN + ((size_t)e * 1024 + pn * 256) * 1024; return true;
    }
};
struct P8Epi {
    const float* BDN; const float* SLOTW; bf16_t* YS;
    __device__ __forceinline__ void operator()(const f32x4 (&acc)[2][2][4][2], const pg8::Unit& u, int wr, int wc, int fr, int fq) const {
        const int row0 = u.pm * 256 + wr * 64 + fr, col0 = u.pn * 256 + wc * 32 + 8 * fq, e = u.aux;
        const float* bp = BDN + (size_t)e * 1024 + col0;
        f32x4 bv[2][2]; float sw[2][4];
#pragma unroll
        for (int bj = 0; bj < 2; ++bj) { bv[bj][0] = *(const GAS f32x4*)(bp + bj * 128); bv[bj][1] = *(const GAS f32x4*)(bp + bj * 128 + 4); }
#pragma unroll
        for (int ai = 0; ai < 2; ++ai)
#pragma unroll
            for (int m = 0; m < 4; ++m) sw[ai][m] = SLOTW[row0 + ai * 128 + m * 16];
        asm volatile("" ::: "memory");
#pragma unroll
        for (int ai = 0; ai < 2; ++ai)
#pragma unroll
            for (int m = 0; m < 4; ++m) { const size_t row = (size_t)(row0 + ai * 128 + m * 16); const float w_ = sw[ai][m];
#pragma unroll
                for (int bj = 0; bj < 2; ++bj) { const f32x4 v0 = (acc[ai][bj][m][0] + bv[bj][0]) * w_, v1 = (acc[ai][bj][m][1] + bv[bj][1]) * w_;
                    int w0 = __builtin_amdgcn_cvt_pk_fp8_f32(v0[0], v0[1], 0, false); w0 = __builtin_amdgcn_cvt_pk_fp8_f32(v0[2], v0[3], w0, true);
                    int w1 = __builtin_amdgcn_cvt_pk_fp8_f32(v1[0], v1[1], 0, false); w1 = __builtin_amdgcn_cvt_pk_fp8_f32(v1[2], v1[3], w1, true);
                    *(GAS u32x2*)((unsigned char*)YS + row * 1024 + col0 + bj * 128) = (u32x2){(unsigned)w0, (unsigned)w1}; } }
    }
};
__device__ __forceinline__ void p9_final(const Ctx& F0) {
    const KArgs ap = kargs(); struct { const float* in[20]; float* out; } a; a.in[19] = ap->in[19]; a.out = ap->out;
    const Ctx F = ctx_refresh(F0);
    float* OUT = a.out; const bf16_t* YS = (const bf16_t*)(F.ws + WS_YS); const int* TOKSLOT = (const int*)(F.ws + WS_MISC + MO_TOKSLOT); const float* GN = a.in[19];
    const int gw = F.vcu * NWAVES + F.wave, NGW = F.G * NWAVES, lane = F.lane;
    const GAS f32x4* gr = (const GAS f32x4*)GN + lane;
    const bool bad = ld_uniform((const int*)(F.ws + WS_CTL) + 4096 + XB_TMO) != 0;
    float ckscale = 1.0f;
#ifdef CKSUM
    { const int* prev = (const int*)(F.ws + WS_MISC + 7 * MiB); if (ld_uniform(prev) == 0x5EED1234) ckscale = 1.0f + 0.25f * (float)ld_uniform(prev + 1); }
#endif
    int slotv = 0; { const int k_ = lane >> 2, t_ = gw + k_ * NGW; if (lane < 32 && t_ < NTOK) slotv = __hip_atomic_load((int*)TOKSLOT + t_ * 4 + (lane & 3), __ATOMIC_RELAXED, __HIP_MEMORY_SCOPE_AGENT); }
    int kt = 0;
    for (int tok = gw; tok < NTOK; tok += NGW, ++kt) {
        GAS f32x4* xr = (GAS f32x4*)(OUT + (size_t)tok * D) + lane;
        f32x4 v[4];
#pragma unroll
        for (int jj = 0; jj < 4; ++jj) v[jj] = xr[64 * jj];
        const int slots[4] = {__builtin_amdgcn_readlane(slotv, kt * 4), __builtin_amdgcn_readlane(slotv, kt * 4 + 1), __builtin_amdgcn_readlane(slotv, kt * 4 + 2), __builtin_amdgcn_readlane(slotv, kt * 4 + 3)};
#pragma unroll
        for (int k = 0; k < 4; ++k) { const GAS unsigned* yr = (const GAS unsigned*)((const unsigned char*)YS + (size_t)slots[k] * 1024) + lane;
#pragma unroll
            for (int jj = 0; jj < 4; ++jj) { const unsigned y = yr[64 * jj]; const f32x2 lo = __builtin_amdgcn_cvt_pk_f32_fp8((int)y, false), hi = __builtin_amdgcn_cvt_pk_f32_fp8((int)y, true);
                v[jj].x += lo.x; v[jj].y += lo.y; v[jj].z += hi.x; v[jj].w += hi.y; } }
        float ss = 0.f;
#pragma unroll
        for (int jj = 0; jj < 4; ++jj) ss += (v[jj].x * v[jj].x + v[jj].y * v[jj].y) + (v[jj].z * v[jj].z + v[jj].w * v[jj].w);
        const float r = 1.0f / sqrtf(wave_sum(ss) * (1.f / D) + RMS_EPS);
#pragma unroll
        for (int jj = 0; jj < 4; ++jj) { const f32x4 gg = gr[64 * jj]; f32x4 o = (f32x4){v[jj].x * r * gg.x, v[jj].y * r * gg.y, v[jj].z * r * gg.z, v[jj].w * r * gg.w} * ckscale; if (bad) o = (f32x4){__builtin_nanf(""), __builtin_nanf(""), __builtin_nanf(""), __builtin_nanf("")}; xr[64 * jj] = o; }
    }
}

__device__ __forceinline__ void grid_barrier(int wave) {
    extern __shared__ __attribute__((aligned(16))) unsigned char lds_dyn[];
    XcdBarrier b; b.bar = (unsigned*)(kargs()->ws + WS_CTL) + 4096; b.x = xb_xcc_id(); b.st = (volatile LAS unsigned*)((LAS unsigned char*)lds_dyn + LDS_MISC) + 8; b.wave = wave;
    xcd_barrier(b);
}
__global__ void __launch_bounds__(NTHREADS, 2) fwd_megakernel(Args args) {
    const int wave = __builtin_amdgcn_readfirstlane((int)threadIdx.x >> 6);
    {
        const Ctx F = make_ctx(wave);
        volatile LAS unsigned* MISC = (volatile LAS unsigned*)(F.lds + LDS_MISC);
        for (int u = F.tid; u < 128; u += NTHREADS) MISC[u] = 0u;
        __syncthreads();
        (void)xcd_barrier_post((unsigned*)(F.ws + WS_CTL) + 4096, MISC + 8, wave);
    }
#ifndef TSK
#define TSK -1
#endif
#ifndef TSB
#define TSB 0
#endif
    unsigned long long ts0_ = 0ull, ts1_ = 0ull; if (TSK >= 0) ts0_ = __builtin_amdgcn_s_memrealtime();
#define TS(k) do { if (TSK == (k)) ts1_ = __builtin_amdgcn_s_memrealtime(); } while (0)
#define F make_ctx(wave)
#define ws (kargs()->ws)
#define xcd_barrier(bar) grid_barrier(wave)
#ifndef PHM
#define PHM 0xFFFF
#endif
#define PH(k) ((PHM >> (k)) & 1)
#ifndef PHR
#define PHR 0
#endif
#define RP(k) ((PHR >> (k)) & 1)
#ifdef CANARY
    {
        const size_t n16 = (WS_END - WS_MISC) / 16; GAS u32x4* p = (GAS u32x4*)(ws + WS_MISC);
        for (size_t i = (size_t)blockIdx.x * NTHREADS + F.tid; i < n16; i += (size_t)F.G * NTHREADS) p[i] = (u32x4){0xffffffffu, 0xffffffffu, 0xffffffffu, 0xffffffffu};
        GAS u32x4* q = (GAS u32x4*)kargs()->out;
        for (size_t i = (size_t)blockIdx.x * NTHREADS + F.tid; i < (size_t)NTOK * D / 4; i += (size_t)F.G * NTHREADS) q[i] = (u32x4){0xffffffffu, 0xffffffffu, 0xffffffffu, 0xffffffffu};
        xcd_barrier(bar);
    }
#endif
    if (PH(0)) p0_prologue(F);
    xcd_barrier(bar);
    if (RP(0)) { p0_prologue(F); xcd_barrier(bar); }
    TS(0);
    CK(1, ws + WS_WIN_T, WS_MKV - WS_WIN_T); CK(1, ws + WS_XN, WS_ABC - WS_XN); CK(1, ws + WS_WGU_T, WS_PROJ - WS_WGU_T); CK(1, ws + WS_MISC + MO_T5, 128 * 1024);
    for (int rp_ = 0; rp_ < 1 + RP(1); ++rp_) {
    if (PH(1)) {
        p1_convert_experts(F);
        TS(12);
        P1Sched S{(unsigned*)(ws + WS_CTL) + 12288 + 64 * ((int)blockIdx.x & 7), (LAS int*)(F.lds + LDS_MISC) + 32, F.wave, (int)blockIdx.x & 7, (const char*)(ws + WS_XN), (const char*)(ws + WS_WIN_T), (const char*)(ws + WS_MEMN), (const char*)(ws + WS_WMEM_T)};
        P1Epi E{(bf16_t*)(ws + WS_PROJ), (bf16_t*)(ws + WS_MKV)};
        pg8::gemm_phase<P1Epi, P1Sched, false>(F.lds, F.wave, 2048u, 2048u, S, E);
    }
    xcd_barrier(bar);
    }
    TS(1);
    CK(2, ws + WS_PROJ, WS_ACT - WS_PROJ); CK(2, ws + WS_MKV, 1 * MiB);
    if (PH(2)) p2_attention(F);
    xcd_barrier(bar);
    if (RP(2)) { p2_attention(F); xcd_barrier(bar); }
    TS(2);
    CK(3, ws + WS_OB, WS_MERGED - WS_OB); CK(3, ws + WS_MISC + MO_LSE, 3 * 16384 * 16);
    TS(10);
    CK(4, ws + WS_ABC, WS_OB - WS_ABC);
    for (int rp_ = 0; rp_ < 1 + RP(3); ++rp_) {
    if (PH(3)) {
        P3Sched S{(int)blockIdx.x, (const char*)(ws + WS_ABC), (const char*)(ws + WS_WABC_T)};
        { pg8::Unit u0_; (void)S.next(0, u0_); p2b_merge_tile(F, u0_.pm); }
        P3Epi E{(const bf16_t*)(ws + WS_PROJ), (bf16_t*)(ws + WS_MERGED)};
        pg8::gemm_phase<P3Epi, P3Sched, false>(F.lds, F.wave, (unsigned)(ABC_LD * 2), (unsigned)(ABC_LD * 2), S, E);
    }
    xcd_barrier(bar);
    }
    TS(3);
    CK(5, ws + WS_MERGED, 32 * MiB);
    for (int rp_ = 0; rp_ < 1 + RP(4); ++rp_) {
    if (PH(4)) {
        P4Sched S{(int)blockIdx.x, (const char*)(ws + WS_MERGED), (const char*)(ws + WS_WOUT_T)};
        P4Epi E{kargs()->in[0], kargs()->out};
        pg8::gemm_phase<P4Epi, P4Sched, false>(F.lds, F.wave, 2048u, 2048u, S, E);
    }
    xcd_barrier(bar);
    }
    TS(4);
    CK(6, kargs()->out, 64 * MiB);
    if (PH(5)) p5_router(F);
    xcd_barrier(bar);
    if (RP(5)) { p5_router(F); xcd_barrier(bar); }
    TS(5);
    CK(7, ws + WS_XN, 32 * MiB); CK(7, ws + WS_MISC, 512 * 1024 + 32 * 1024);
    if (PH(6)) p6_slots(F);
    xcd_barrier(bar);
    TS(6);
#ifdef CKSUM
#define ck_rows ((size_t)ld_uniform((const int*)(ws + WS_MISC + MO_TILE)) * 256)
    CK(8, ws + WS_MISC + MO_TOKSLOT, 256 * 1024); CK(8, ws + WS_MISC + MO_SLOTTOK, ck_rows * 4); CK(8, ws + WS_MISC + MO_SLOTW, ck_rows * 4); CK(8, ws + WS_MISC + MO_TILE, 1024);
#endif
    for (int rp_ = 0; rp_ < 1 + RP(7); ++rp_) {
    if (PH(7)) {
        moe_tables<8, true>(F, (const int*)(ws + WS_MISC + MO_TILE), (const int*)(ws + WS_MISC + MO_SLOTTOK));
        P7Sched S{F.G, (int)blockIdx.x, (LAS const int*)(F.lds + LDS_TILE), (const char*)(ws + WS_XN), (const char*)(ws + WS_WGU_T), __builtin_amdgcn_readfirstlane(*(LAS const int*)(F.lds + LDS_TILE))};
        P7Epi E{kargs()->in[16], (bf16_t*)(ws + WS_ACT), (const float*)(ws + WS_MISC + MO_SLOTRS)};
        pg8::gemm_phase<P7Epi, P7Sched, true, true>(F.lds, F.wave, 1024u, 1024u, S, E);
    }
    xcd_barrier(bar);
    }
    TS(7);
#ifdef CKSUM
    CK(9, ws + WS_ACT, ck_rows * 2048);
#endif
    for (int rp_ = 0; rp_ < 1 + RP(8); ++rp_) {
    if (PH(8)) {
        moe_tables<4, false>(F, (const int*)(ws + WS_MISC + MO_TILE), (const int*)(ws + WS_MISC + MO_SLOTTOK));
        P8Sched S{F.G, (int)blockIdx.x, (LAS const int*)(F.lds + LDS_TILE), (const char*)(ws + WS_ACT), (const char*)(ws + WS_WDN_T), __builtin_amdgcn_readfirstlane(*(LAS const int*)(F.lds + LDS_TILE))};
        P8Epi E{kargs()->in[18], (const float*)(ws + WS_MISC + MO_SLOTW), (bf16_t*)(ws + WS_YS)};
        pg8::gemm_phase<P8Epi, P8Sched, false, true>(F.lds, F.wave, 1024u, 1024u, S, E);
    }
    xcd_barrier(bar);
    }
    TS(8);
#ifdef CKSUM
    CK(10, ws + WS_YS, ck_rows * 2048);
#endif
    if (PH(9)) p9_final(F);
    if (TSK >= 0 && blockIdx.x == TSB && wave == 0) { const unsigned long long te_ = __builtin_amdgcn_s_memrealtime(); const unsigned long long wait_ = 50ull * (ts1_ - ts0_); while (__builtin_amdgcn_s_memrealtime() - te_ < wait_) __builtin_amdgcn_s_sleep(32); }
#ifdef CKSUM
    xcd_barrier(bar);
    if (blockIdx.x == 0 && F.wave == 0 && lane_id() == 0) {
        unsigned* cur = (unsigned*)(ws + WS_CTL) + 8192; unsigned* prev = (unsigned*)(ws + WS_MISC + 7 * MiB);
        const bool have = __hip_atomic_load(prev, __ATOMIC_RELAXED, __HIP_MEMORY_SCOPE_AGENT) == 0x5EED1234u;
        unsigned flag = have ? __hip_atomic_load(prev + 1, __ATOMIC_RELAXED, __HIP_MEMORY_SCOPE_AGENT) : 0u;
        for (int k = 1; k <= 10; ++k) { const unsigned c = __hip_atomic_load(cur + 64 * k, __ATOMIC_RELAXED, __HIP_MEMORY_SCOPE_AGENT);
            if (have && flag == 0u && __hip_atomic_load(prev + 16 + k, __ATOMIC_RELAXED, __HIP_MEMORY_SCOPE_AGENT) != c) flag = (unsigned)k;
            __hip_atomic_store(prev + 16 + k, c, __ATOMIC_RELAXED, __HIP_MEMORY_SCOPE_AGENT); }
        __hip_atomic_store(prev + 1, flag, __ATOMIC_RELAXED, __HIP_MEMORY_SCOPE_AGENT); __hip_atomic_store(prev, 0x5EED1234u, __ATOMIC_RELAXED, __HIP_MEMORY_SCOPE_AGENT);
    }
#endif
}

#undef F
#undef ws
#undef xcd_barrier
extern "C" void kernel_launch(void* const* d_in, const int* in_sizes, int n_in, void* d_out, int out_size, void* d_ws, size_t ws_size, hipStream_t stream) {
    static int grid = 0;
    if (grid == 0) {
        if (n_in != 20 || out_size != NTOK * D || ws_size < WS_END) { fprintf(stderr, "kernel_launch: unexpected shapes (n_in %d, out %d, ws %zu); nothing launched\n", n_in, out_size, ws_size); grid = -1; return; }
        int dev = 0, cus = 0;
        if (hipGetDevice(&dev) != hipSuccess || hipDeviceGetAttribute(&cus, hipDeviceAttributeMultiprocessorCount, dev) != hipSuccess) { grid = -1; return; }
        if (hipFuncSetAttribute((const void*)fwd_megakernel, hipFuncAttributeMaxDynamicSharedMemorySize, LDS_BYTES) != hipSuccess) { fprintf(stderr, "kernel_launch: hipFuncSetAttribute failed\n"); grid = -1; return; }
        int per_cu = 0;
        if (hipOccupancyMaxActiveBlocksPerMultiprocessor(&per_cu, (const void*)fwd_megakernel, NTHREADS, LDS_BYTES) != hipSuccess || per_cu < 1) fprintf(stderr, "kernel_launch: occupancy query reports %d\n", per_cu);
        (void)hipGetLastError();
        grid = cus;
        if (grid != 256) fprintf(stderr, "kernel_launch: %d CUs; this kernel is laid out for 256\n", grid);
    }
    if (grid < 0) return;
    (void)hipMemsetAsync((char*)d_ws + WS_CTL, 0, CTL_ZERO_BYTES, stream);
    Args a{};
    for (int i = 0; i < 20; ++i) a.in[i] = (const float*)d_in[i];
    a.out = (float*)d_out; a.ws = (unsigned char*)d_ws;
    hipLaunchKernelGGL(fwd_megakernel, dim3(grid), dim3(NTHREADS), LDS_BYTES, stream, a);
}
```

```cpp
#include <hip/hip_runtime.h>
#include <cstdio>
#include <cstdint>

#define GAS __attribute__((address_space(1)))
#define LAS __attribute__((address_space(3)))
typedef unsigned short bf16_t;
typedef short bf16x8 __attribute__((ext_vector_type(8)));
typedef short s16x4 __attribute__((ext_vector_type(4)));
typedef float f32x4 __attribute__((ext_vector_type(4)));
typedef float f32x2 __attribute__((ext_vector_type(2)));
typedef unsigned u32x4 __attribute__((ext_vector_type(4)));
typedef unsigned u32x2 __attribute__((ext_vector_type(2)));
typedef int i32x4 __attribute__((ext_vector_type(4)));
typedef int i32x8 __attribute__((ext_vector_type(8)));
#define FP8_SCALE 0x7C7C7C7C
typedef GAS unsigned gu32;

constexpr int NTOK = 16384, SEQ = 8192, D = 1024, NMEM = 512, MEMLEN = 256;
constexpr int IN_COLS = 7424;
__host__ __device__ __forceinline__ size_t proj_off(size_t row, int col) { return (((row >> 8) * 29 + (size_t)(col >> 8)) << 16) + ((row & 255) << 8) + (size_t)(col & 255); }
constexpr int C_QA = 0, C_KA = 512, C_VA = 1024, C_QB = 1536, C_KB = 2304, C_VB = 3072, C_QC = 3840, C_GATE = 4352;
constexpr int NEXP = 32, TOPK = 4, DFF = 1024;
constexpr int MAX_TILES = 288, MAX_SLOTS = MAX_TILES * 256;
constexpr float RMS_EPS = 1e-6f, LOG2E = 1.4426950408889634f;
constexpr float QS64 = 0.125f * LOG2E, QS128 = 0.08838834764831845f * LOG2E;
constexpr int ABC_LD = 1280;

constexpr size_t MiB = 1u << 20;
constexpr size_t WS_CTL = 0, CTL_ZERO_BYTES = 1 * MiB;
constexpr size_t WS_MISC = 1 * MiB;
constexpr size_t MO_TOPIDX = 0, MO_TOPW = 256 * 1024, MO_HIST = 512 * 1024, MO_TOKSLOT = 1 * MiB, MO_SLOTTOK = 2 * MiB, MO_SLOTW = 3 * MiB, MO_TILE = 4 * MiB, MO_LSE = 5 * MiB, MO_T5 = 6 * MiB, MO_RPB = 6 * MiB + 64 * 1024, MO_RTOK = 7 * MiB + 64 * 1024, MO_SLOTRS = 8 * MiB;
constexpr size_t WS_WIN_T = 16 * MiB, WS_WMEM_T = 32 * MiB, WS_WABC_T = 34 * MiB, WS_WOUT_T = 37 * MiB, WS_MEMN = 39 * MiB, WS_MKV = 40 * MiB, WS_XN = 41 * MiB;
constexpr size_t WS_ABC = 73 * MiB, WS_OB = 113 * MiB, WS_MERGED = 137 * MiB, WS_WGU_T = 169 * MiB, WS_WDN_T = 297 * MiB, WS_PROJ = 361 * MiB, WS_ACT = 593 * MiB, WS_YS = 737 * MiB, WS_END = 881 * MiB;
constexpr int T5_LD = 192, RPB_LD = 640, RPB_OFF = 64;

constexpr int LDS_MAIN = 147456;
constexpr int LDS_TAB = LDS_MAIN;
constexpr int LDS_MISC = LDS_MAIN + 8192;
constexpr int LDS_BYTES = LDS_MISC + 512;

#define LDS_WAIT() asm volatile("s_waitcnt lgkmcnt(0)" ::: "memory")
#define VM_WAIT() asm volatile("s_waitcnt vmcnt(0)" ::: "memory")
__device__ __forceinline__ unsigned cvt_pk_bf16(float lo, float hi) { unsigned r; asm volatile("v_cvt_pk_bf16_f32 %0, %1, %2" : "=v"(r) : "v"(lo), "v"(hi)); return r; }
__device__ __forceinline__ float bf_lo(unsigned u) { return __uint_as_float(u << 16); }
__device__ __forceinline__ float bf_hi(unsigned u) { return __uint_as_float(u & 0xffff0000u); }
__device__ __forceinline__ int lane_id() { int l; asm volatile("v_mbcnt_lo_u32_b32 %0, -1, 0\n\tv_mbcnt_hi_u32_b32 %0, -1, %0" : "=v"(l)); return l; }
__device__ __forceinline__ float sx(float v, int off) { return __builtin_bit_cast(float, __builtin_amdgcn_ds_bpermute((lane_id() ^ off) << 2, __builtin_bit_cast(int, v))); }
__device__ __forceinline__ int sxi(int v, int off) { return __builtin_amdgcn_ds_bpermute((lane_id() ^ off) << 2, v); }
__device__ __forceinline__ float sidx(float v, int src) { return __builtin_bit_cast(float, __builtin_amdgcn_ds_bpermute(src << 2, __builtin_bit_cast(int, v))); }
__device__ __forceinline__ float wave_sum(float v) {
#pragma unroll
    for (int o = 1; o < 64; o <<= 1) v += sx(v, o);
    return v;
}
__device__ __forceinline__ float wave_max(float v) {
#pragma unroll
    for (int o = 1; o < 64; o <<= 1) v = fmaxf(v, sx(v, o));
    return v;
}
__device__ __forceinline__ int ld_uniform(const int* p) { return __builtin_amdgcn_readfirstlane(__hip_atomic_load((int*)p, __ATOMIC_RELAXED, __HIP_MEMORY_SCOPE_AGENT)); }
__device__ __forceinline__ float fast_sigmoid(float x) { return __builtin_amdgcn_rcpf(1.0f + __builtin_amdgcn_exp2f(-LOG2E * x)); }

namespace pg8 {
constexpr int BM = 256, BK = 64, HALF = 128, HTB = HALF * BK * 2, STAGE_BYTES = 8 * HTB, LDS_STASH = 131072  ;
__host__ __device__ __forceinline__ int lds_byte(int r, int c) { const int st = (r >> 4) * 2 + (c >> 5), rr = r & 15, cc = c & 31, ob = rr * 64 + cc * 2; return st * 1024 + (ob ^ (((ob >> 9) & 1) << 5)); }
__host__ __device__ __forceinline__ void stage_rc(int b, int& R, int& C) { const int st = b / 1024, sb = b % 1024, swz = sb ^ (((sb >> 9) & 1) << 5); R = (st >> 1) * 16 + swz / 64; C = (st & 1) * 32 + (swz % 64) / 2; }
__host__ __device__ __forceinline__ int perm32(int rho) { const int n = rho >> 4, i = rho & 15; return 8 * (i >> 2) + 4 * n + (i & 3); }

struct Unit {
    const char* A;
    const char* B;
    int rows;
    int nt;
    int pm, pn;
    int aux;
    float scale;
};

template <class Epi, class Sched, bool GATHER, bool FP8 = false>
__device__ __forceinline__ void gemm_phase(LAS unsigned char* lds, const int wave, const unsigned lda, const unsigned ldb, const Sched& S, const Epi& E) {
    const int lane = lane_id();
    const int wid = wave, tid = wave * 64 + lane, wr = wid >> 2, wc = wid & 3, fr = lane & 15, fq = lane >> 4;
    const int R0 = (wid >> 1) * 16 + (lane >> 2), C2 = ((wid & 1) * 32 + ((((lane & 3) * 8)) ^ ((lane >> 5) << 4))) * 2, Rb0 = (R0 & ~31) + perm32(R0 & 31);
    unsigned offA = (unsigned)R0 * lda + (unsigned)C2, offB = (unsigned)Rb0 * ldb + (unsigned)C2;
    const size_t kstep = (size_t)(BK * 2);
    const size_t hstepB = (size_t)HALF * ldb;
    const unsigned ldsw = (unsigned)wid * 1024u;
    const int aoff = lds_byte(wr * 64 + fr, fq * 8), boff = lds_byte(wc * 32 + fr, fq * 8);
#define PG8_SA(b, h) (((b) * 2 + (h)) * HTB)
#define PG8_SB(b, h) ((4 + (b) * 2 + (h)) * HTB)
#define PG8_STAGE2P(bufoff, p0, p1, v0, v1) do { \
        __builtin_amdgcn_global_load_lds((const unsigned*)((const char*)(p0) + (v0)), (LAS unsigned*)(lds + (bufoff) + ldsw), 16, 0, 0); \
        __builtin_amdgcn_global_load_lds((const unsigned*)((const char*)(p1) + (v1)), (LAS unsigned*)(lds + (bufoff) + ldsw + 8192), 16, 0, 0); } while (0)
#define PG8_STAGEB(bufoff, gbase) PG8_STAGE2P(bufoff, gbase, (const char*)(gbase) + (size_t)64 * ldb, offB, offB)
#define PG8_STAGEA(bufoff, gbase, h, g0, g1) do { if (GATHER) { PG8_STAGE2P(bufoff, gbase, gbase, g0, g1); } else { PG8_STAGE2P(bufoff, (const char*)(gbase) + (size_t)((h) * HALF) * lda, (const char*)(gbase) + (size_t)((h) * HALF + 64) * lda, offA, offA); } } while (0)
#define PG8_LDA(dst, b, h) do { _Pragma("unroll") for (int m = 0; m < 4; ++m) _Pragma("unroll") for (int k = 0; k < 2; ++k) dst[m][k] = *(const LAS bf16x8*)(lds + PG8_SA(b, h) + aoff + m * 2048 + k * 1024); } while (0)
#define PG8_LDB(dst, b, h) do { _Pragma("unroll") for (int n = 0; n < 2; ++n) _Pragma("unroll") for (int k = 0; k < 2; ++k) dst[n][k] = *(const LAS bf16x8*)(lds + PG8_SB(b, h) + boff + n * 2048 + k * 1024); } while (0)
#define PG8_MMA(ai, bj, At, Bt) do { __builtin_amdgcn_s_setprio(1); \
        if (FP8) { _Pragma("unroll") for (int m = 0; m < 4; ++m) _Pragma("unroll") for (int n = 0; n < 2; ++n) { \
            const i32x4 b0_ = __builtin_bit_cast(i32x4, Bt[n][0]), b1_ = __builtin_bit_cast(i32x4, Bt[n][1]), a0_ = __builtin_bit_cast(i32x4, At[m][0]), a1_ = __builtin_bit_cast(i32x4, At[m][1]); \
            const i32x8 bw_ = __builtin_shufflevector(b0_, b1_, 0, 1, 2, 3, 4, 5, 6, 7), aw_ = __builtin_shufflevector(a0_, a1_, 0, 1, 2, 3, 4, 5, 6, 7); \
            acc[ai][bj][m][n] = __builtin_amdgcn_mfma_scale_f32_16x16x128_f8f6f4(bw_, aw_, acc[ai][bj][m][n], 0, 0, 0, FP8_SCALE, 0, FP8_SCALE); } } \
        else { _Pragma("unroll") for (int m = 0; m < 4; ++m) _Pragma("unroll") for (int n = 0; n < 2; ++n) _Pragma("unroll") for (int k = 0; k < 2; ++k) \
            acc[ai][bj][m][n] = __builtin_amdgcn_mfma_f32_16x16x32_bf16(Bt[n][k], At[m][k], acc[ai][bj][m][n], 0, 0, 0); } \
        __builtin_amdgcn_s_setprio(0); } while (0)
#define PG8_WAIT_V(n) asm volatile("s_waitcnt vmcnt(" #n ")" ::: "memory")
#define PG8_WAIT_L(n) asm volatile("s_waitcnt lgkmcnt(" #n ")" ::: "memory")
#define PG8_BAR __builtin_amdgcn_s_barrier()
#define PG8_SCHED __builtin_amdgcn_sched_barrier(0)
    Unit cur, nxt; int ui = 0;
    if (!S.next(0, cur)) return;
    f32x4 acc[2][2][4][2];
#pragma unroll
    for (int a = 0; a < 2; ++a)
#pragma unroll
        for (int b = 0; b < 2; ++b)
#pragma unroll
            for (int m = 0; m < 4; ++m)
#pragma unroll
                for (int n = 0; n < 2; ++n) acc[a][b][m][n] = (f32x4){0.f, 0.f, 0.f, 0.f};
    bf16x8 At[4][2], B0[2][2], B1[2][2];
    unsigned c00 = 0, c01 = 0, c10 = 0, c11 = 0;
#define PG8_MKOFF(U, o00, o01, o10, o11) do { const LAS int* rl_ = (const LAS int*)(lds + (U).rows) + R0; \
        o00 = (unsigned)rl_[0] * lda + (unsigned)C2; o01 = (unsigned)rl_[64] * lda + (unsigned)C2; o10 = (unsigned)rl_[HALF] * lda + (unsigned)C2; o11 = (unsigned)rl_[HALF + 64] * lda + (unsigned)C2; } while (0)
    if (GATHER) { PG8_MKOFF(cur, c00, c01, c10, c11); }
    const char* cA = cur.A; const char* cB = cur.B; int nt = cur.nt;
    PG8_STAGEB(PG8_SB(0, 0), cB); PG8_STAGEB(PG8_SB(0, 1), cB + hstepB); PG8_STAGEA(PG8_SA(0, 0), cA, 0, c00, c01); PG8_STAGEA(PG8_SA(0, 1), cA, 1, c10, c11);
    if (wr == 1) PG8_BAR;
    PG8_WAIT_V(2); PG8_BAR;
    PG8_STAGEB(PG8_SB(1, 0), cB + kstep); PG8_STAGEA(PG8_SA(1, 0), cA + kstep, 0, c00, c01); PG8_STAGEB(PG8_SB(1, 1), cB + hstepB + kstep);
    PG8_WAIT_V(6); PG8_BAR;
    for (;;) {
        const bool has_next = S.next(ui + 1, nxt);
        const char* nA = has_next ? nxt.A : cA; const char* nB = has_next ? nxt.B : cB;
#pragma nounroll
        for (int t = 0; t < nt; t += 2) {
            const bool last = (t == nt - 2);
            if (GATHER) asm volatile("" : "+v"(c00), "+v"(c01), "+v"(c10), "+v"(c11)); asm volatile("" : "+v"(offA), "+v"(offB));
            const char* a1 = cA + (size_t)(t + 1) * kstep;
            const char* a2 = last ? nA : cA + (size_t)(t + 2) * kstep; const char* b2 = last ? nB : cB + (size_t)(t + 2) * kstep;
            const char* a3 = a2 + kstep; const char* b3 = b2 + kstep;
            PG8_LDB(B0, 0, 0); PG8_LDB(B1, 0, 1); PG8_SCHED; PG8_LDA(At, 0, 0); PG8_STAGEA(PG8_SA(1, 1), a1, 1, c10, c11);
            if (GATHER) { if (last && has_next) { PG8_MKOFF(nxt, c00, c01, c10, c11); } }
            PG8_WAIT_V(8); PG8_WAIT_L(0); PG8_BAR; PG8_MMA(0, 0, At, B0); PG8_MMA(0, 1, At, B1); PG8_BAR; PG8_SCHED;
            PG8_LDA(At, 0, 1); PG8_STAGEB(PG8_SB(0, 0), b2); PG8_STAGEB(PG8_SB(0, 1), b2 + hstepB); PG8_STAGEA(PG8_SA(0, 0), a2, 0, c00, c01);
            PG8_WAIT_V(8); PG8_WAIT_L(0); PG8_BAR; PG8_MMA(1, 0, At, B0); PG8_MMA(1, 1, At, B1); PG8_BAR; PG8_SCHED;
            PG8_LDB(B0, 1, 0); PG8_LDB(B1, 1, 1); PG8_SCHED; PG8_LDA(At, 1, 0); PG8_STAGEA(PG8_SA(0, 1), a2, 1, c10, c11);
            PG8_WAIT_V(8); PG8_WAIT_L(0); PG8_BAR; PG8_MMA(0, 0, At, B0); PG8_MMA(0, 1, At, B1); PG8_BAR; PG8_SCHED;
            PG8_LDA(At, 1, 1); PG8_STAGEB(PG8_SB(1, 0), b3); PG8_STAGEB(PG8_SB(1, 1), b3 + hstepB); PG8_STAGEA(PG8_SA(1, 0), a3, 0, c00, c01);
            PG8_WAIT_V(8); PG8_WAIT_L(0); PG8_BAR; PG8_MMA(1, 0, At, B0); PG8_MMA(1, 1, At, B1); PG8_BAR; PG8_SCHED;
        }
        if (wr == 0) PG8_BAR;
        { int le_ = lane; asm volatile("" : "+v"(le_)); E(acc, cur, wr, wc, le_ & 15, le_ >> 4); }
        if (GATHER) { if (has_next) { asm volatile("" ::: "memory"); PG8_MKOFF(nxt, c00, c01, c10, c11); } }
        if (!has_next) break;
#pragma unroll
        for (int a = 0; a < 2; ++a)
#pragma unroll
            for (int b = 0; b < 2; ++b)
#pragma unroll
                for (int m = 0; m < 4; ++m)
#pragma unroll
                    for (int n = 0; n < 2; ++n) acc[a][b][m][n] = (f32x4){0.f, 0.f, 0.f, 0.f};
        cur = nxt; cA = nA; cB = nB; nt = cur.nt; ++ui;
        if (wr == 1) PG8_BAR;
    }
    PG8_WAIT_V(0);
    PG8_BAR;
#undef PG8_SA
#undef PG8_SB
#undef PG8_STAGE2P
#undef PG8_STAGEB
#undef PG8_LDA
#undef PG8_LDB
#undef PG8_MMA
#undef PG8_WAIT_V
#undef PG8_WAIT_L
#undef PG8_BAR
#undef PG8_SCHED
#undef PG8_MKOFF
#undef PG8_STAGEA
}
}

#define XB_TMO      128
#define XB_XCNT(j)  (256  + 64 * (j))
#define XB_XSUB(j)  (1280 + 64 * (j))
#define XB_XGEN(j)  (2304 + 64 * (j))
#define XB_TOP      3328
#define XB_TOPGEN   3392
#define XCD_BAR_WORDS 3456
#define XB_SPIN_CAP (1u << 18)
__device__ __forceinline__ unsigned xb_ld(unsigned* p)              { return __hip_atomic_load(p, __ATOMIC_RELAXED, __HIP_MEMORY_SCOPE_AGENT); }
__device__ __forceinline__ unsigned xb_add(unsigned* p, unsigned v) { return __hip_atomic_fetch_add(p, v, __ATOMIC_RELAXED, __HIP_MEMORY_SCOPE_AGENT); }
__device__ __forceinline__ unsigned xb_xcc_id() { return (unsigned)__builtin_amdgcn_s_getreg((3 << 11) | 20) & 0xFu; }
#define XB_SPIN(cond, bar) do { unsigned _sp = 0; while (cond) { __builtin_amdgcn_s_sleep(1); \
    if ((++_sp & 255u) == 0u) { if (xb_ld(&(bar)[XB_TMO])) break; if (_sp > XB_SPIN_CAP) { atomicAdd(&(bar)[XB_TMO], 1u); break; } } } } while (0)
struct XcdBarrier { unsigned* bar; unsigned x; volatile LAS unsigned* st; int wave; };
__device__ __forceinline__ XcdBarrier xcd_barrier_post(unsigned* bar, volatile LAS unsigned* st, int wave) {
    XcdBarrier b; b.bar = bar; b.x = xb_xcc_id(); b.st = st; b.wave = wave;
    if (wave == 0 && lane_id() == 0) (void)xb_add(&bar[XB_XCNT(b.x)], 1u);
    return b;
}
__device__ __forceinline__ void xcd_barrier_complete(unsigned* bar, unsigned x, unsigned& nloc, unsigned& nx) {
    const unsigned G = gridDim.x * gridDim.y * gridDim.z;
    unsigned sum, cnt, mine, sp = 0u;
    for (;;) {
        sum = 0u; cnt = 0u; mine = 0u;
#pragma unroll
        for (unsigned j = 0; j < 16; ++j) { const unsigned c = xb_ld(&bar[XB_XCNT(j)]); sum += c; cnt += (c > 0u) ? 1u : 0u; mine = (j == x) ? c : mine; }
        if (sum == G) break;
        __builtin_amdgcn_s_sleep(1);
        if ((++sp & 255u) == 0u) { if (xb_ld(&bar[XB_TMO])) break; if (sp > XB_SPIN_CAP) { atomicAdd(&bar[XB_TMO], 1u); break; } }
    }
    nloc = mine > 0u ? mine : 1u; nx = cnt > 0u ? cnt : 1u;
}
__device__ __forceinline__ void xcd_barrier(const XcdBarrier& b) {
    asm volatile("s_waitcnt vmcnt(0)" ::: "memory");
    __syncthreads();
    if (b.wave == 0 && lane_id() == 0) {
        unsigned* bar = b.bar;
        __builtin_amdgcn_s_waitcnt(0);
        unsigned nloc = b.st[0], nx = b.st[1];
        if (nloc == 0u) { xcd_barrier_complete(bar, b.x, nloc, nx); b.st[0] = nloc; b.st[1] = nx; }
        const unsigned old = xb_add(&bar[XB_XSUB(b.x)], 1u);
        const unsigned gen = old / nloc;
        if (old + 1u == (gen + 1u) * nloc) {
            __builtin_amdgcn_fence(__ATOMIC_RELEASE, "agent");
            asm volatile("s_waitcnt vmcnt(0)" ::: "memory");
            const unsigned og = xb_add(&bar[XB_TOP], 1u);
            const unsigned tg = og / nx;
            if (og + 1u == (tg + 1u) * nx) xb_add(&bar[XB_TOPGEN], 1u);
            else XB_SPIN(xb_ld(&bar[XB_TOPGEN]) == tg, bar);
            __builtin_amdgcn_fence(__ATOMIC_ACQUIRE, "agent");
            xb_add(&bar[XB_XGEN(b.x)], 1u);
            asm volatile("s_waitcnt vmcnt(0)" ::: "memory");
        } else {
            XB_SPIN(xb_ld(&bar[XB_XGEN(b.x)]) == gen, bar);
            __builtin_amdgcn_fence(__ATOMIC_ACQUIRE, "agent");
            asm volatile("s_waitcnt vmcnt(0)" ::: "memory");
        }
    }
    __syncthreads();
}

struct Args { const float* in[20]; float* out; unsigned char* ws; };
typedef const __attribute__((address_space(4))) Args* KArgs;
__device__ __forceinline__ KArgs kargs() { KArgs k = (KArgs)__builtin_amdgcn_kernarg_segment_ptr(); asm volatile("" : "+s"(k)); return k; }
constexpr int NWAVES = 8, NTHREADS = 512;

struct Ctx {
    LAS unsigned char* lds;
    int tid, lane, wave, G, vcu;
    unsigned char* ws;
};
__device__ __forceinline__ Ctx make_ctx(int wave) {
    extern __shared__ __attribute__((aligned(16))) unsigned char lds_dyn[];
    Ctx F; int l = lane_id(); asm volatile("" : "+v"(l)); F.lds = (LAS unsigned char*)lds_dyn; F.lane = l; F.wave = wave; F.tid = wave * 64 + l;
    F.G = (int)gridDim.x; { const int bx = (int)blockIdx.x; F.vcu = (F.G % 8 == 0) ? (bx % 8) * (F.G / 8) + bx / 8 : bx; }
    F.ws = kargs()->ws; return F; }
__device__ __forceinline__ Ctx ctx_refresh(const Ctx& F0) { return make_ctx(F0.wave); }


#ifdef CKSUM
__device__ __forceinline__ void ck_region(const Ctx& F, int k, const void* base, size_t bytes) {
    const GAS u32x4* p = (const GAS u32x4*)base; const size_t n = bytes / 16; unsigned acc = 0u;
    const int tid_ = F.wave * 64 + lane_id();
    for (size_t i = (size_t)blockIdx.x * NTHREADS + tid_; i < n; i += (size_t)F.G * NTHREADS) { const u32x4 v = __builtin_nontemporal_load(p + i); acc += v.x * 3u + v.y * 5u + v.z * 7u + v.w * 11u + (unsigned)i; }
#pragma unroll
    for (int o = 1; o < 64; o <<= 1) acc += (unsigned)sxi((int)acc, o);
    if (lane_id() == 0) atomicAdd((unsigned*)(F.ws + WS_CTL) + 8192 + 64 * k, acc);
}
#define CK(k, base, bytes) ck_region(F, k, base, bytes)
#else
#define CK(k, base, bytes) do {} while (0)
#endif
__device__ __forceinline__ void p0_transpose64(const float* W, int ldw, int k0, int n0, bf16_t* dst, int ldt, LAS float* scr, int lane) {
    f32x4 v[16];
#pragma unroll
    for (int i = 0; i < 16; ++i) { const int kk = 4 * i + (lane >> 4); v[i] = *(const GAS f32x4*)(W + (size_t)(k0 + kk) * ldw + n0 + 4 * (lane & 15)); }
#pragma unroll
    for (int i = 0; i < 16; ++i) { const int kk = 4 * i + (lane >> 4); LAS float* s = scr + kk * 65 + 4 * (lane & 15); s[0] = v[i][0]; s[1] = v[i][1]; s[2] = v[i][2]; s[3] = v[i][3]; }
    LDS_WAIT(); asm volatile("" ::: "memory");
    const int c = lane & 7;
#pragma unroll
    for (int j = 0; j < 8; ++j) { const int n = (lane >> 3) + 8 * j; const LAS float* s = scr + (8 * c) * 65 + n;
        u32x4 o; o.x = cvt_pk_bf16(s[0 * 65], s[1 * 65]); o.y = cvt_pk_bf16(s[2 * 65], s[3 * 65]); o.z = cvt_pk_bf16(s[4 * 65], s[5 * 65]); o.w = cvt_pk_bf16(s[6 * 65], s[7 * 65]);
        *(GAS u32x4*)(dst + (size_t)n * ldt + 8 * c) = o; }
    LDS_WAIT(); asm volatile("" ::: "memory");
}
__device__ __forceinline__ void p0_transpose64_fp8(const float* W, int ldw, int k0, int n0, unsigned char* dst8, int ldt, LAS float* scr, int lane, float scale) {
    f32x4 v[16];
#pragma unroll
    for (int i = 0; i < 16; ++i) { const int kk = 4 * i + (lane >> 4); v[i] = *(const GAS f32x4*)(W + (size_t)(k0 + kk) * ldw + n0 + 4 * (lane & 15)); }
#pragma unroll
    for (int i = 0; i < 16; ++i) { const int kk = 4 * i + (lane >> 4); LAS float* s = scr + kk * 65 + 4 * (lane & 15); s[0] = v[i][0] * scale; s[1] = v[i][1] * scale; s[2] = v[i][2] * scale; s[3] = v[i][3] * scale; }
    LDS_WAIT(); asm volatile("" ::: "memory");
    const int c = lane & 3;
#pragma unroll
    for (int j = 0; j < 4; ++j) { const int n = (lane >> 2) + 16 * j; const LAS float* s = scr + (16 * c) * 65 + n;
        u32x4 o;
#pragma unroll
        for (int q = 0; q < 4; ++q) { int w = __builtin_amdgcn_cvt_pk_fp8_f32(s[(4 * q) * 65], s[(4 * q + 1) * 65], 0, false); w = __builtin_amdgcn_cvt_pk_fp8_f32(s[(4 * q + 2) * 65], s[(4 * q + 3) * 65], w, true); o[q] = (unsigned)w; }
        *(GAS u32x4*)(dst8 + (size_t)n * ldt + 16 * c) = o; }
    LDS_WAIT(); asm volatile("" ::: "memory");
}
__device__ __forceinline__ void rms_row_to_fp8(const float* xrow, const float* g, unsigned char* orow, int lane) {
    const GAS f32x4* xr = (const GAS f32x4*)xrow + lane; const GAS f32x4* gr = (const GAS f32x4*)g + lane;
    f32x4 v[4]; float s = 0.f;
#pragma unroll
    for (int j = 0; j < 4; ++j) { v[j] = xr[64 * j]; s += (v[j].x * v[j].x + v[j].y * v[j].y) + (v[j].z * v[j].z + v[j].w * v[j].w); }
    const float r = 1.0f / sqrtf(wave_sum(s) * (1.f / D) + RMS_EPS);
    GAS unsigned* o8 = (GAS unsigned*)orow + lane;
#pragma unroll
    for (int j = 0; j < 4; ++j) { const f32x4 gg = gr[64 * j]; int w = __builtin_amdgcn_cvt_pk_fp8_f32(v[j].x * r * gg.x, v[j].y * r * gg.y, 0, false); w = __builtin_amdgcn_cvt_pk_fp8_f32(v[j].z * r * gg.z, v[j].w * r * gg.w, w, true); o8[64 * j] = (unsigned)w; }
}
__device__ __forceinline__ int t5_bucket(int rel) {
    int ret = rel > 0 ? 16 : 0; const int n = rel < 0 ? -rel : rel;
    if (n < 8) return ret + n;
    const float nf = (float)n;
    int large = 8 + (int)(logf(nf / 8.0f) / logf(128.0f) * 8.0f);
    large = large < 15 ? large : 15;
    return ret + large;
}
__device__ __forceinline__ void p0_prologue(const Ctx& F0) {
    const KArgs ap = kargs();
    const Ctx F = ctx_refresh(F0);
    LAS float* scr = (LAS float*)(F.lds) + F.wave * (64 * 65);
    const int gw = F.vcu * NWAVES + F.wave, NGW = F.G * NWAVES;
    bf16_t* WGU_T = (bf16_t*)(F.ws + WS_WGU_T); bf16_t* WDN_T = (bf16_t*)(F.ws + WS_WDN_T); bf16_t* WIN_T = (bf16_t*)(F.ws + WS_WIN_T);
    bf16_t* WMEM_T = (bf16_t*)(F.ws + WS_WMEM_T); bf16_t* WABC_T = (bf16_t*)(F.ws + WS_WABC_T); bf16_t* WOUT_T = (bf16_t*)(F.ws + WS_WOUT_T);
    constexpr int I_IN = 16 * 116, I_MEM = 256, I_A = 8 * 16, I_B = 4 * 16, I_C = 8 * 16, I_O = 256;
    constexpr int NITEMS = I_IN + I_MEM + I_A + I_B + I_C + I_O;
    for (int it = gw; it < NITEMS; it += NGW) {
        int r = it;
        if (r < I_IN) { const int kb = r / 116, nb = r % 116; p0_transpose64_fp8(ap->in[4], IN_COLS, kb * 64, nb * 64, (unsigned char*)WIN_T + (size_t)(nb * 64) * 1024 + kb * 64, 1024, scr, F.lane, 64.0f); continue; } r -= I_IN;
        if (r < I_MEM) { const int kb = r >> 4, nb = r & 15; p0_transpose64_fp8(ap->in[5], 1024, kb * 64, nb * 64, (unsigned char*)WMEM_T + (size_t)(nb * 64) * 1024 + kb * 64, 1024, scr, F.lane, 64.0f); continue; } r -= I_MEM;
        if (r < I_A) { const int kb = r >> 4, nb = r & 15; p0_transpose64(ap->in[8], 1024, kb * 64, nb * 64, WABC_T + (size_t)(nb * 64) * ABC_LD + 0 + kb * 64, ABC_LD, scr, F.lane); continue; } r -= I_A;
        if (r < I_B) { const int kb = r >> 4, nb = r & 15; p0_transpose64(ap->in[9], 1024, kb * 64, nb * 64, WABC_T + (size_t)(nb * 64) * ABC_LD + 512 + kb * 64, ABC_LD, scr, F.lane); continue; } r -= I_B;
        if (r < I_C) { const int kb = r >> 4, nb = r & 15; p0_transpose64(ap->in[10], 1024, kb * 64, nb * 64, WABC_T + (size_t)(nb * 64) * ABC_LD + 768 + kb * 64, ABC_LD, scr, F.lane); continue; } r -= I_C;
        { const int kb = r >> 4, nb = r & 15; p0_transpose64(ap->in[11], 1024, kb * 64, nb * 64, WOUT_T + (size_t)(nb * 64) * 1024 + kb * 64, 1024, scr, F.lane); }
    }
    bf16_t* XN = (bf16_t*)(F.ws + WS_XN); bf16_t* MEMN = (bf16_t*)(F.ws + WS_MEMN);
    for (int m = gw; m < NTOK; m += 2 * NGW) {
        const int m2 = m + NGW; const bool two = m2 < NTOK;
        const GAS f32x4* xa = (const GAS f32x4*)(ap->in[0] + (size_t)m * D) + F.lane; const GAS f32x4* xb = (const GAS f32x4*)(ap->in[0] + (size_t)(two ? m2 : m) * D) + F.lane;
        const GAS f32x4* gr = (const GAS f32x4*)ap->in[2] + F.lane;
        f32x4 va[4], vb[4]; float sa = 0.f, sb = 0.f;
#pragma unroll
        for (int j = 0; j < 4; ++j) { va[j] = xa[64 * j]; vb[j] = xb[64 * j]; }
#pragma unroll
        for (int j = 0; j < 4; ++j) { sa += (va[j].x * va[j].x + va[j].y * va[j].y) + (va[j].z * va[j].z + va[j].w * va[j].w); sb += (vb[j].x * vb[j].x + vb[j].y * vb[j].y) + (vb[j].z * vb[j].z + vb[j].w * vb[j].w); }
#pragma unroll
        for (int o = 1; o < 64; o <<= 1) { sa += sx(sa, o); sb += sx(sb, o); }
        const float ra = 1.0f / sqrtf(sa * (1.f / D) + RMS_EPS), rb = 1.0f / sqrtf(sb * (1.f / D) + RMS_EPS);
        GAS unsigned* oa = (GAS unsigned*)((unsigned char*)XN + (size_t)m * D) + F.lane; GAS unsigned* ob = (GAS unsigned*)((unsigned char*)XN + (size_t)m2 * D) + F.lane;
#pragma unroll
        for (int j = 0; j < 4; ++j) { const f32x4 gg = gr[64 * j]; int w = __builtin_amdgcn_cvt_pk_fp8_f32(va[j].x * ra * gg.x, va[j].y * ra * gg.y, 0, false); w = __builtin_amdgcn_cvt_pk_fp8_f32(va[j].z * ra * gg.z, va[j].w * ra * gg.w, w, true); oa[64 * j] = (unsigned)w;
            if (two) { int w2 = __builtin_amdgcn_cvt_pk_fp8_f32(vb[j].x * rb * gg.x, vb[j].y * rb * gg.y, 0, false); w2 = __builtin_amdgcn_cvt_pk_fp8_f32(vb[j].z * rb * gg.z, vb[j].w * rb * gg.w, w2, true); ob[64 * j] = (unsigned)w2; } }
    }
    for (int m = gw; m < NMEM; m += NGW) rms_row_to_fp8(ap->in[1] + (size_t)m * D, ap->in[3], (unsigned char*)MEMN + (size_t)m * D, F.lane);
    const int gt = F.vcu * NTHREADS + F.tid, NGT = F.G * NTHREADS;
    float* t5 = (float*)(F.ws + WS_MISC + MO_T5); float* rp = (float*)(F.ws + WS_MISC + MO_RPB);
    for (int i = gt; i < 12 * T5_LD; i += NGT) { const int gh = i / T5_LD, j = i % T5_LD, rel = j - 79, g = gh >> 2; const int dil = g == 0 ? 1 : (g == 1 ? 4 : 16);
        float v = 0.f; if (rel >= -64 && rel <= 64) v = ap->in[7][t5_bucket(rel * dil) * 12 + gh] * LOG2E; t5[i] = v; }
    for (int i = gt; i < 8 * RPB_LD; i += NGT) { const int h = i / RPB_LD, j = i % RPB_LD - RPB_OFF; float v = 0.f; if (j >= 0 && j < 465) v = ap->in[6][h * 465 + j] * LOG2E; rp[i] = v; }
}

__device__ __forceinline__ bool is_converter(int c) { return ((c >> 3) & 3) == 3; }
struct CvItem { const float* src; int ldw; unsigned char* dst; };
__device__ __forceinline__ CvItem cv_decode(int r, const float* GU, const float* DN, unsigned char* WGU8, unsigned char* WDN8) {
    constexpr int I_GU = 32 * 16 * 32; CvItem I;
    if (r < I_GU) { const int e = r >> 9, q = r & 511, kb = q >> 5, nb = q & 31, n0 = nb * 64; const int bj = n0 >> 10, rem = n0 & 1023, pn = rem >> 7, c0 = rem & 127;
        I.src = GU + (size_t)e * 1024 * 2048 + (size_t)(kb * 64) * 2048 + n0; I.ldw = 2048; I.dst = WGU8 + ((size_t)e * 2048 + pn * 256 + bj * 128 + c0) * 1024 + kb * 64; }
    else { r -= I_GU; const int e = r >> 8, q = r & 255, kb = q >> 4, nb = q & 15;
        I.src = DN + (size_t)e * 1024 * 1024 + (size_t)(kb * 64) * 1024 + nb * 64; I.ldw = 1024; I.dst = WDN8 + ((size_t)e * 1024 + nb * 64) * 1024 + kb * 64; }
    return I;
}
__device__ __forceinline__ void cv_load(const CvItem& I, f32x4 (&v)[16], int lane) {
#pragma unroll
    for (int i = 0; i < 16; ++i) { const int kk = 4 * i + (lane >> 4); v[i] = *(const GAS f32x4*)(I.src + (size_t)kk * I.ldw + 4 * (lane & 15)); }
}
__device__ __forceinline__ void cv_finish(const CvItem& I, const f32x4 (&v)[16], LAS float* scr, int lane) {
#pragma unroll
    for (int i = 0; i < 16; ++i) { const int kk = 4 * i + (lane >> 4); LAS float* s = scr + kk * 65 + 4 * (lane & 15); s[0] = v[i][0] * 64.0f; s[1] = v[i][1] * 64.0f; s[2] = v[i][2] * 64.0f; s[3] = v[i][3] * 64.0f; }
    LDS_WAIT(); asm volatile("" ::: "memory");
    const int c = lane & 3;
#pragma unroll
    for (int j = 0; j < 4; ++j) { const int n = (lane >> 2) + 16 * j; const LAS float* s = scr + (16 * c) * 65 + n;
        u32x4 o;
#pragma unroll
        for (int q = 0; q < 4; ++q) { int w = __builtin_amdgcn_cvt_pk_fp8_f32(s[(4 * q) * 65], s[(4 * q + 1) * 65], 0, false); w = __builtin_amdgcn_cvt_pk_fp8_f32(s[(4 * q + 2) * 65], s[(4 * q + 3) * 65], w, true); o[q] = (unsigned)w; }
        *(GAS u32x4*)(I.dst + (size_t)n * 1024 + 16 * c) = o; }
    LDS_WAIT(); asm volatile("" ::: "memory");
}
__device__ __forceinline__ void p1_convert_experts(const Ctx& F0) {
    const KArgs ap = kargs();
    const Ctx F = ctx_refresh(F0);
    const int c = (int)blockIdx.x;
    LAS float* scr = (LAS float*)(F.lds) + F.wave * (64 * 65);
    const int ci = c;
    const float* GU = ap->in[15]; const float* DN = ap->in[17];
    unsigned char* WGU8 = (unsigned char*)(F.ws + WS_WGU_T); unsigned char* WDN8 = (unsigned char*)(F.ws + WS_WDN_T);
    constexpr int NIT = 32 * 16 * 32 + 32 * 16 * 16; const int STRIDE = F.G * NWAVES;
    int it = ci * NWAVES + F.wave;
    CvItem I = cv_decode(it, GU, DN, WGU8, WDN8); f32x4 va[16], vb[16]; cv_load(I, va, F.lane);
    for (;;) {
        const int itn = it + STRIDE; const bool hn = itn < NIT; CvItem In = I;
        if (hn) { In = cv_decode(itn, GU, DN, WGU8, WDN8); cv_load(In, vb, F.lane); }
        cv_finish(I, va, scr, F.lane);
        if (!hn) break;
        I = In; it = itn;
#pragma unroll
        for (int i = 0; i < 16; ++i) va[i] = vb[i];
    }
}

struct P1Sched {
    unsigned* ctr; LAS int* slot; int wave, x; const char* XN; const char* WIN; const char* MEMN; const char* WMEM;
    __device__ __forceinline__ bool next(int i, pg8::Unit& u) const {
        if (wave == 0) { int t = 0; if (lane_id() == 0) t = (int)__hip_atomic_fetch_add(ctr, 1u, __ATOMIC_RELAXED, __HIP_MEMORY_SCOPE_AGENT); t = __builtin_amdgcn_readfirstlane(t); if (lane_id() == 0) slot[i & 1] = t; }
        LDS_WAIT(); __builtin_amdgcn_s_barrier(); asm volatile("" ::: "memory");
        const int idx = __builtin_amdgcn_readfirstlane(slot[i & 1]);
        if (idx > 232) return false;
        u.rows = 0; u.nt = 8;
        if (idx == 232) { u.pm = x >> 2; u.pn = x & 3; u.A = MEMN + (size_t)u.pm * 256 * 1024; u.B = WMEM + (size_t)u.pn * 256 * 1024; u.aux = 3; u.scale = 1.f; return true; }
        u.pm = 8 * x + (idx & 7); u.pn = idx >> 3;
        u.A = XN + (size_t)u.pm * 256 * 1024; u.B = WIN + (size_t)u.pn * 256 * 1024;
        const int pn = u.pn;
        if (pn < 2 || (pn >= 6 && pn < 9)) { u.aux = 1; u.scale = QS64; } else if (pn == 15 || pn == 16) { u.aux = 1; u.scale = QS128; } else if (pn >= 17) { u.aux = 2; u.scale = 1.f; } else { u.aux = 0; u.scale = 1.f; }
        u.scale = __builtin_bit_cast(float, __builtin_amdgcn_readfirstlane(__builtin_bit_cast(int, u.scale)));
        return true;
    }
};
struct P1Epi {
    bf16_t* PROJ; bf16_t* MKV;
    __device__ __forceinline__ void operator()(const f32x4 (&acc)[2][2][4][2], const pg8::Unit& u, int wr, int wc, int fr, int fq) const {
        bf16_t* O = u.aux == 3 ? MKV : PROJ + ((size_t)(u.pm * 29 + u.pn) << 16); const int ldo = u.aux == 3 ? 1024 : 256;
        const int row0 = (u.aux == 3 ? u.pm * 256 : 0) + wr * 64 + fr, col0 = (u.aux == 3 ? u.pn * 256 : 0) + wc * 32 + 8 * fq; const float sc = u.scale; const bool sg = u.aux == 2;
#pragma unroll
        for (int ai = 0; ai < 2; ++ai)
#pragma unroll
            for (int m = 0; m < 4; ++m) { bf16_t* rowp = O + (size_t)(row0 + ai * 128 + m * 16) * ldo + col0;
#pragma unroll
                for (int bj = 0; bj < 2; ++bj) { f32x4 v0 = acc[ai][bj][m][0], v1 = acc[ai][bj][m][1];
                    if (sg) { v0 = (f32x4){fast_sigmoid(v0[0]), fast_sigmoid(v0[1]), fast_sigmoid(v0[2]), fast_sigmoid(v0[3])}; v1 = (f32x4){fast_sigmoid(v1[0]), fast_sigmoid(v1[1]), fast_sigmoid(v1[2]), fast_sigmoid(v1[3])}; }
                    else { v0 = v0 * sc; v1 = v1 * sc; }
                    u32x4 w; w.x = cvt_pk_bf16(v0[0], v0[1]); w.y = cvt_pk_bf16(v0[2], v0[3]); w.z = cvt_pk_bf16(v1[0], v1[1]); w.w = cvt_pk_bf16(v1[2], v1[3]);
                    *(GAS u32x4*)(rowp + bj * 128) = w; } }
    }
};

template <int DH> __device__ __forceinline__ int k_addr(int key, int c) {
    if (DH == 64) return key * 128 + ((c ^ ((key >> 1) & 7)) << 4);
    else return key * 256 + ((c ^ (key & 15)) << 4);
}
template <int DH> __device__ __forceinline__ int v_addr(int key, int c) {
    if (DH == 64) return key * 128 + ((c ^ (((key >> 1) & 3) << 1)) << 4);
    else return key * 256 + ((c ^ ((key & 7) << 1)) << 4);
}
__device__ __forceinline__ s16x4 vtr(const LAS unsigned char* p) { return __builtin_bit_cast(s16x4, __builtin_amdgcn_ds_read_tr16_b64_v4i16((LAS s16x4*)p)); }

template <int DH, class RowFn> __device__ __forceinline__ void stage_kv(LAS unsigned char* Kl, LAS unsigned char* Vl, int nkeys, int tid, const RowFn& rowfn) {
    constexpr int CH = DH / 8; const int total = nkeys * CH;
    for (int base = 0; base < total; base += NTHREADS * 4) {
        u32x4 kv[4], vv[4];
#pragma unroll
        for (int j = 0; j < 4; ++j) { const int ci = base + j * NTHREADS + tid; kv[j] = (u32x4){0u, 0u, 0u, 0u}; vv[j] = kv[j];
            if (ci < total) { const int key = ci / CH, c = ci % CH; const bf16_t* kp; const bf16_t* vp; rowfn(key, kp, vp); if (kp) { kv[j] = *(const GAS u32x4*)(kp + c * 8); vv[j] = *(const GAS u32x4*)(vp + c * 8); } } }
#pragma unroll
        for (int j = 0; j < 4; ++j) { const int ci = base + j * NTHREADS + tid;
            if (ci < total) { const int key = ci / CH, c = ci % CH; *(LAS u32x4*)(Kl + k_addr<DH>(key, c)) = kv[j]; *(LAS u32x4*)(Vl + v_addr<DH>(key, c)) = vv[j]; } }
    }
}

template <int DH> __device__ __forceinline__ f32x4 qk_tile(const LAS unsigned char* Kl, int kbase, const bf16x8 (&qf)[DH / 32], int i, int g) {
    f32x4 acc = (f32x4){0.f, 0.f, 0.f, 0.f}; const int key = kbase + i;
#pragma unroll
    for (int s = 0; s < DH / 32; ++s) { const bf16x8 kf = *(const LAS bf16x8*)(Kl + k_addr<DH>(key, 4 * s + g)); acc = __builtin_amdgcn_mfma_f32_16x16x32_bf16(kf, qf[s], acc, 0, 0, 0); }
    return acc;
}
template <int DH> __device__ __forceinline__ void pv_step(f32x4 (&o)[DH / 16], const LAS unsigned char* Vl, int vbase, int vbase2, bf16x8 pf, int i, int g) {
    const int k0 = vbase + 4 * g + (i >> 2), k1 = vbase2 + 4 * g + (i >> 2); const int sub = (i & 3) >> 1, b8 = 8 * (i & 1);
#pragma unroll
    for (int n = 0; n < DH / 16; ++n) {
        const s16x4 lo = vtr(Vl + v_addr<DH>(k0, 2 * n + sub) + b8), hi = vtr(Vl + v_addr<DH>(k1, 2 * n + sub) + b8);
        const bf16x8 vf = (bf16x8){lo[0], lo[1], lo[2], lo[3], hi[0], hi[1], hi[2], hi[3]};
        o[n] = __builtin_amdgcn_mfma_f32_16x16x32_bf16(vf, pf, o[n], 0, 0, 0);
    }
}
__device__ __forceinline__ bf16x8 pack_p(const f32x4& a, const f32x4& b) {
    u32x4 w; w.x = cvt_pk_bf16(a[0], a[1]); w.y = cvt_pk_bf16(a[2], a[3]); w.z = cvt_pk_bf16(b[0], b[1]); w.w = cvt_pk_bf16(b[2], b[3]); return __builtin_bit_cast(bf16x8, w);
}
template <int NT> __device__ __forceinline__ void softmax_tiles(f32x4 (&s)[NT], float& m, float& l) {
    float mx = -INFINITY;
#pragma unroll
    for (int t = 0; t < NT; ++t) mx = fmaxf(fmaxf(fmaxf(mx, s[t][0]), fmaxf(s[t][1], s[t][2])), s[t][3]);
    mx = fmaxf(mx, sx(mx, 16)); mx = fmaxf(mx, sx(mx, 32));
    float sum = 0.f;
#pragma unroll
    for (int t = 0; t < NT; ++t) {
#pragma unroll
        for (int r = 0; r < 4; ++r) { const float p = __builtin_amdgcn_exp2f(s[t][r] - mx); s[t][r] = p; sum += p; } }
    sum += sx(sum, 16); sum += sx(sum, 32);
    m = mx; l = sum;
}
template <int DH> __device__ __forceinline__ void load_q(bf16x8 (&qf)[DH / 32], const bf16_t* qrow, int g) {
#pragma unroll
    for (int s = 0; s < DH / 32; ++s) qf[s] = *(const GAS bf16x8*)(qrow + 32 * s + 8 * g);
}
template <int DH> __device__ __forceinline__ void store_o(const f32x4 (&o)[DH / 16], float inv, bf16_t* orow, int g) {
#pragma unroll
    for (int n = 0; n < DH / 16; ++n) { u32x2 w; w.x = cvt_pk_bf16(o[n][0] * inv, o[n][1] * inv); w.y = cvt_pk_bf16(o[n][2] * inv, o[n][3] * inv); *(GAS u32x2*)(orow + 16 * n + 4 * g) = w; }
}

template <int DH, int NPF, class RowFn> __device__ __forceinline__ void pf_issue(u32x4 (&kv)[NPF], u32x4 (&vv)[NPF], int nkeys, int tid, const RowFn& rowfn) {
    constexpr int CH = DH / 8; const int total = nkeys * CH;
#pragma unroll
    for (int j = 0; j < NPF; ++j) { const int ci = j * NTHREADS + tid; kv[j] = (u32x4){0u, 0u, 0u, 0u}; vv[j] = kv[j];
        if (ci < total) { const int key = ci / CH, c = ci % CH; const bf16_t* kp; const bf16_t* vp; rowfn(key, kp, vp); if (kp) { kv[j] = *(const GAS u32x4*)(kp + c * 8); vv[j] = *(const GAS u32x4*)(vp + c * 8); } } }
}
template <int DH, int NPF> __device__ __forceinline__ void pf_commit(const u32x4 (&kv)[NPF], const u32x4 (&vv)[NPF], LAS unsigned char* Kl, LAS unsigned char* Vl, int nkeys, int tid) {
    constexpr int CH = DH / 8; const int total = nkeys * CH;
#pragma unroll
    for (int j = 0; j < NPF; ++j) { const int ci = j * NTHREADS + tid;
        if (ci < total) { const int key = ci / CH, c = ci % CH; *(LAS u32x4*)(Kl + k_addr<DH>(key, c)) = kv[j]; *(LAS u32x4*)(Vl + v_addr<DH>(key, c)) = vv[j]; } }
}
struct AUnit { int b, h, r0, rsU; };
__device__ __forceinline__ AUnit a_unit(int c, int rep) { const int ua = c + 256 * rep, x = ua & 7, y = ua >> 3, pair = x * 2 + (y >> 6), rp = y & 63; AUnit u; u.b = pair >> 3; u.h = pair & 7; u.r0 = 2 * rp; int rs = u.r0 - 4; u.rsU = rs < 0 ? 0 : (rs > 120 ? 120 : rs); return u; }
struct BUnit { int b, hh, grp, dil, L, rho, n, p0; };
__device__ __forceinline__ BUnit b_unit(int c, int rep) { const int ub = c + 256 * rep, x = ub & 7, y = ub >> 3, combo = x * 3 + y / 64, sub = y % 64; BUnit u; u.b = combo / 12; u.hh = combo % 12; u.grp = u.hh >> 2;
    u.dil = u.grp == 0 ? 1 : (u.grp == 1 ? 4 : 16); u.L = SEQ / u.dil; const int nb = u.L / 128; u.rho = sub / nb; u.n = sub % nb; u.p0 = 128 * u.n - 64; return u; }

__device__ __forceinline__ const bf16_t* a_qptr(const bf16_t* PROJ, int c, int rep, int w, int i) { const AUnit U = a_unit(c, rep); const int r = U.r0 + (w >> 2), cq = 16 * (w & 3) + i; return PROJ + proj_off((size_t)(U.b * SEQ + r * 64 + cq), C_QA + U.h * 64); }
__device__ __forceinline__ const bf16_t* b_qptr(const bf16_t* PROJ, int c, int rep, int w, int i) { const BUnit U = b_unit(c, rep); const int pq = 128 * U.n + 16 * w + i; return PROJ + proj_off((size_t)(U.b * SEQ + pq * U.dil + U.rho), C_QB + U.hh * 64); }

__device__ __forceinline__ void p2_attention(const Ctx& F0) {
    const Ctx F = ctx_refresh(F0);
    const bf16_t* PROJ = (const bf16_t*)(F.ws + WS_PROJ); const bf16_t* MKV = (const bf16_t*)(F.ws + WS_MKV);
    bf16_t* ABC = (bf16_t*)(F.ws + WS_ABC); bf16_t* OB = (bf16_t*)(F.ws + WS_OB); float* LSE = (float*)(F.ws + WS_MISC + MO_LSE);
    const float* T5 = (const float*)(F.ws + WS_MISC + MO_T5); const float* RPB = (const float*)(F.ws + WS_MISC + MO_RPB);
    LAS unsigned char* Kl = F.lds; LAS float* tab = (LAS float*)(F.lds + LDS_TAB);
    const int w = F.wave, c = (int)blockIdx.x;
#define P2_LANE() int tid_r = F.tid; asm volatile("" : "+v"(tid_r)); const int lane = tid_r & 63, i = lane & 15, g = lane >> 4; (void)lane
#define PF_A(rep_, KV, VV, T0, T1) do { const AUnit nu = a_unit(c, rep_); \
        pf_issue<64, 9>(KV, VV, 576, tid_r, [&](int key, const bf16_t*& kp, const bf16_t*& vp) { kp = nullptr; vp = nullptr; if (nu.rsU * 64 + key < SEQ) { const size_t tok = (size_t)nu.b * SEQ + nu.rsU * 64 + key; kp = PROJ + proj_off(tok, C_KA + nu.h * 64); vp = PROJ + proj_off(tok, C_VA + nu.h * 64); } }); \
        T0 = RPB[nu.h * RPB_LD + tid_r]; T1 = tid_r < RPB_LD - NTHREADS ? RPB[nu.h * RPB_LD + NTHREADS + tid_r] : 0.f; } while (0)
#define CM_A(KV, VV, T0, T1) do { pf_commit<64, 9>(KV, VV, Kl, Kl + 73728, 576, tid_r); tab[tid_r] = T0; if (tid_r < RPB_LD - NTHREADS) tab[NTHREADS + tid_r] = T1; } while (0)
#define PF_B(rep_, KV, VV, T0) do { const BUnit nu = b_unit(c, rep_); \
        pf_issue<64, 5>(KV, VV, 272, tid_r, [&](int key, const bf16_t*& kp, const bf16_t*& vp) { const int p = nu.p0 + key; kp = nullptr; vp = nullptr; \
            if (key < 256 && p >= 0 && p < nu.L) { const size_t tok = (size_t)nu.b * SEQ + (size_t)p * nu.dil + nu.rho; kp = PROJ + proj_off(tok, C_KB + nu.hh * 64); vp = PROJ + proj_off(tok, C_VB + nu.hh * 64); } }); \
        T0 = tid_r < T5_LD ? T5[nu.hh * T5_LD + tid_r] : 0.f; } while (0)
#define CM_B(KV, VV, T0) do { pf_commit<64, 5>(KV, VV, Kl, Kl + 34816, 272, tid_r); if (tid_r < T5_LD) tab[tid_r] = T0; } while (0)
    u32x4 akv[9], avv[9]; float at0 = 0.f, at1 = 0.f; bf16x8 qn[2];
    {
        LAS unsigned char* Vl = Kl + 65536; P2_LANE();
        const int combo = c & 7, b = combo >> 2, h = combo & 3;
        __syncthreads();
        stage_kv<128>(Kl, Vl, 256, tid_r, [&](int key, const bf16_t*& kp, const bf16_t*& vp) { kp = MKV + (size_t)(b * MEMLEN + key) * 1024 + h * 128; vp = kp + 512; });
        LDS_WAIT(); __syncthreads();
        for (int rep = 0; rep < 2; ++rep) {
            const int blk = (c >> 3) + 32 * rep; const int tok = b * SEQ + blk * 128 + w * 16 + i;
            bf16x8 qf[4]; load_q<128>(qf, PROJ + proj_off((size_t)tok, C_QC + h * 128), g);
            if (rep == 1) { PF_A(0, akv, avv, at0, at1); load_q<64>(qn, a_qptr(PROJ, c, 0, w, i), g); }
            f32x4 s[16];
#pragma unroll
            for (int t = 0; t < 16; ++t) s[t] = qk_tile<128>(Kl, 16 * t, qf, i, g);
            float m, l; softmax_tiles<16>(s, m, l);
            f32x4 o[8];
#pragma unroll
            for (int n = 0; n < 8; ++n) o[n] = (f32x4){0.f, 0.f, 0.f, 0.f};
#pragma unroll
            for (int u = 0; u < 8; ++u) pv_step<128>(o, Vl, 32 * u, 32 * u + 16, pack_p(s[2 * u], s[2 * u + 1]), i, g);
            store_o<128>(o, 1.0f / l, ABC + (size_t)tok * ABC_LD + 768 + h * 128, g);
        }
        __syncthreads(); CM_A(akv, avv, at0, at1); LDS_WAIT(); __syncthreads();
    }
    u32x4 bkv[5], bvv[5]; float bt0 = 0.f;
    for (int rep = 0; rep < 4; ++rep) {
        LAS unsigned char* Vl = Kl + 73728; P2_LANE();
        const AUnit U = a_unit(c, rep); const int b = U.b, h = U.h, r0 = U.r0, rsU = U.rsU;
        const int r = r0 + (w >> 2), jb = w & 3; int rs = r - 4; rs = rs < 0 ? 0 : (rs > 120 ? 120 : rs);
        const int cq = 16 * jb + i; int cs = cq - 8; cs = cs < 0 ? 0 : (cs > 48 ? 48 : cs);
        const int cw = jb == 0 ? 0 : (jb == 1 ? 8 : (jb == 2 ? 24 : 32));
        const int tok = b * SEQ + r * 64 + cq;
        bf16x8 qf[2]; qf[0] = qn[0]; qf[1] = qn[1];
        if (rep < 3) { PF_A(rep + 1, akv, avv, at0, at1); load_q<64>(qn, a_qptr(PROJ, c, rep + 1, w, i), g); } else { PF_B(0, bkv, bvv, bt0); load_q<64>(qn, b_qptr(PROJ, c, 0, w, i), g); }
        const int kb0 = (rs - rsU) * 64 + cw;
        f32x4 s[16];
#pragma unroll
        for (int t = 0; t < 16; ++t) s[t] = qk_tile<64>(Kl, kb0 + (t >> 1) * 64 + 16 * (t & 1), qf, i, g);
        const int bidx = RPB_OFF + (7 - (r - rs)) * 31 + (cw + 4 * g - cq + 15); const int lo = cs - cw - 4 * g;
#pragma unroll
        for (int t = 0; t < 16; ++t) {
#pragma unroll
            for (int rr = 0; rr < 4; ++rr) { const int kc = 16 * (t & 1) + rr; const float bias = tab[bidx + (t >> 1) * 31 + kc]; const bool ok = kc >= lo && kc < lo + 16; s[t][rr] = ok ? s[t][rr] + bias : -INFINITY; } }
        float m, l; softmax_tiles<16>(s, m, l);
        f32x4 o[4];
#pragma unroll
        for (int n = 0; n < 4; ++n) o[n] = (f32x4){0.f, 0.f, 0.f, 0.f};
#pragma unroll
        for (int u = 0; u < 8; ++u) pv_step<64>(o, Vl, kb0 + u * 64, kb0 + u * 64 + 16, pack_p(s[2 * u], s[2 * u + 1]), i, g);
        store_o<64>(o, 1.0f / l, ABC + (size_t)tok * ABC_LD + h * 64, g);
        __syncthreads(); if (rep < 3) { CM_A(akv, avv, at0, at1); } else { CM_B(bkv, bvv, bt0); } LDS_WAIT(); __syncthreads();
    }
    for (int rep = 0; rep < 6; ++rep) {
        LAS unsigned char* Vl = Kl + 34816; P2_LANE();
        const BUnit U = b_unit(c, rep); const int b = U.b, hh = U.hh, grp = U.grp, dil = U.dil, L = U.L, rho = U.rho, n = U.n;
        const int pq = 128 * n + 16 * w + i; const int tok = b * SEQ + pq * dil + rho;
        bf16x8 qf[2]; qf[0] = qn[0]; qf[1] = qn[1];
        if (rep < 5) { PF_B(rep + 1, bkv, bvv, bt0); load_q<64>(qn, b_qptr(PROJ, c, rep + 1, w, i), g); }
        f32x4 s[10];
#pragma unroll
        for (int t = 0; t < 10; ++t) s[t] = qk_tile<64>(Kl, 16 * w + 16 * t, qf, i, g);
        const int rel0 = 4 * g - 64 - i;
#pragma unroll
        for (int t = 0; t < 10; ++t) {
#pragma unroll
            for (int rr = 0; rr < 4; ++rr) { const int rel = rel0 + 16 * t + rr; const int p = pq + rel; const float bias = tab[rel + 79]; const bool ok = rel >= -64 && rel <= 64 && p >= 0 && p < L; s[t][rr] = ok ? s[t][rr] + bias : -INFINITY; } }
        float m, l; softmax_tiles<10>(s, m, l);
        f32x4 o[4];
#pragma unroll
        for (int nn = 0; nn < 4; ++nn) o[nn] = (f32x4){0.f, 0.f, 0.f, 0.f};
#pragma unroll
        for (int u = 0; u < 5; ++u) pv_step<64>(o, Vl, 16 * w + 32 * u, 16 * w + 32 * u + 16, pack_p(s[2 * u], s[2 * u + 1]), i, g);
        const int h4 = hh & 3;
        store_o<64>(o, 1.0f / l, OB + ((size_t)grp * NTOK + tok) * 256 + h4 * 64, g);
        if (g == 0) LSE[((size_t)grp * NTOK + tok) * 4 + h4] = m + __builtin_amdgcn_logf(l);
        if (rep < 5) { __syncthreads(); CM_B(bkv, bvv, bt0); LDS_WAIT(); __syncthreads(); }
    }
#undef PF_A
#undef CM_A
#undef PF_B
#undef CM_B
}
#undef P2_LANE
__device__ __forceinline__ void p2b_merge_tile(const Ctx& F0, int pm) {
    const Ctx F = ctx_refresh(F0);
    const bf16_t* OB = (const bf16_t*)(F.ws + WS_OB); const float* LSE = (const float*)(F.ws + WS_MISC + MO_LSE); bf16_t* ABC = (bf16_t*)(F.ws + WS_ABC);
    for (int it = F.tid; it < 256 * 32; it += NTHREADS) {
        const int tok = pm * 256 + (it >> 5), ch = it & 31, h = ch >> 3;
        const float l0 = LSE[(size_t)tok * 4 + h], l1 = LSE[((size_t)NTOK + tok) * 4 + h], l2 = LSE[((size_t)2 * NTOK + tok) * 4 + h];
        const float mx = fmaxf(l0, fmaxf(l1, l2)); float w0 = __builtin_amdgcn_exp2f(l0 - mx), w1 = __builtin_amdgcn_exp2f(l1 - mx), w2 = __builtin_amdgcn_exp2f(l2 - mx);
        const float inv = 1.0f / (w0 + w1 + w2); w0 *= inv; w1 *= inv; w2 *= inv;
        const u32x4 a = *(const GAS u32x4*)(OB + (size_t)tok * 256 + ch * 8), bq = *(const GAS u32x4*)(OB + ((size_t)NTOK + tok) * 256 + ch * 8), cq = *(const GAS u32x4*)(OB + ((size_t)2 * NTOK + tok) * 256 + ch * 8);
        u32x4 o;
#pragma unroll
        for (int j = 0; j < 4; ++j) { const float lo = w0 * bf_lo(a[j]) + w1 * bf_lo(bq[j]) + w2 * bf_lo(cq[j]), hi = w0 * bf_hi(a[j]) + w1 * bf_hi(bq[j]) + w2 * bf_hi(cq[j]); o[j] = cvt_pk_bf16(lo, hi); }
        *(GAS u32x4*)(ABC + (size_t)tok * ABC_LD + 512 + ch * 8) = o;
    }
    VM_WAIT(); __syncthreads();
}
__device__ __forceinline__ void p2b_merge(const Ctx& F0) {
    const Ctx F = ctx_refresh(F0);
    const bf16_t* OB = (const bf16_t*)(F.ws + WS_OB); const float* LSE = (const float*)(F.ws + WS_MISC + MO_LSE); bf16_t* ABC = (bf16_t*)(F.ws + WS_ABC);
    const int gt = F.vcu * NTHREADS + F.tid, NGT = F.G * NTHREADS;
    for (int it = gt; it < NTOK * 32; it += NGT) {
        const int tok = it >> 5, ch = it & 31, h = ch >> 3;
        const float l0 = LSE[(size_t)tok * 4 + h], l1 = LSE[((size_t)NTOK + tok) * 4 + h], l2 = LSE[((size_t)2 * NTOK + tok) * 4 + h];
        const float mx = fmaxf(l0, fmaxf(l1, l2)); float w0 = __builtin_amdgcn_exp2f(l0 - mx), w1 = __builtin_amdgcn_exp2f(l1 - mx), w2 = __builtin_amdgcn_exp2f(l2 - mx);
        const float inv = 1.0f / (w0 + w1 + w2); w0 *= inv; w1 *= inv; w2 *= inv;
        const u32x4 a = *(const GAS u32x4*)(OB + (size_t)tok * 256 + ch * 8), bq = *(const GAS u32x4*)(OB + ((size_t)NTOK + tok) * 256 + ch * 8), cq = *(const GAS u32x4*)(OB + ((size_t)2 * NTOK + tok) * 256 + ch * 8);
        u32x4 o;
#pragma unroll
        for (int j = 0; j < 4; ++j) { const float lo = w0 * bf_lo(a[j]) + w1 * bf_lo(bq[j]) + w2 * bf_lo(cq[j]), hi = w0 * bf_hi(a[j]) + w1 * bf_hi(bq[j]) + w2 * bf_hi(cq[j]); o[j] = cvt_pk_bf16(lo, hi); }
        *(GAS u32x4*)(ABC + (size_t)tok * ABC_LD + 512 + ch * 8) = o;
    }
}

struct P3Sched {
    int c; const char* ABCp; const char* WABC;
    __device__ __forceinline__ bool next(int i, pg8::Unit& u) const {
        if (i >= 3) return false;
        constexpr int nM = 64, nN = 4, nwg = 256;
        int wgid = c; { const int q = nwg / 8, xcd = wgid % 8, off = wgid / 8; wgid = xcd * q + off; }
        const int nig = 8 * nN, gid = wgid / nig, fm = gid * 8;
        u.pm = fm + ((wgid % nig) % 8); u.pn = (wgid % nig) / 8;
        const int sb = ((c >> 3) & 1) ? (i == 0 ? 1 : (i == 1 ? 0 : 2)) : i;
        const int koff = sb == 0 ? 0 : (sb == 1 ? 512 : 768);
        u.A = ABCp + (size_t)u.pm * 256 * (ABC_LD * 2) + koff * 2; u.B = WABC + (size_t)u.pn * 256 * (ABC_LD * 2) + koff * 2;
        u.rows = 0; u.nt = sb == 1 ? 4 : 8; u.aux = sb; u.scale = i == 0 ? 0.f : 1.f; return true;
    }
};
struct P3Epi {
    const bf16_t* PROJ; bf16_t* MERGED;
    __device__ __forceinline__ void operator()(const f32x4 (&acc)[2][2][4][2], const pg8::Unit& u, int wr, int wc, int fr, int fq) const {
        const int row0 = u.pm * 256 + wr * 64 + fr, col0 = u.pn * 256 + wc * 32 + 8 * fq; const int s = u.aux;
#pragma unroll
        for (int ai = 0; ai < 2; ++ai) {
            u32x4 gt[4][2], prev[4][2];
#pragma unroll
            for (int m = 0; m < 4; ++m)
#pragma unroll
                for (int bj = 0; bj < 2; ++bj) { const size_t row = (size_t)(row0 + ai * 128 + m * 16); const int col = col0 + bj * 128;
                    gt[m][bj] = *(const GAS u32x4*)(PROJ + proj_off(row, C_GATE + s * 1024 + col));
                    prev[m][bj] = (u32x4){0u, 0u, 0u, 0u}; if (u.scale != 0.f) prev[m][bj] = __builtin_nontemporal_load((const GAS u32x4*)(MERGED + row * 1024 + col)); }
            asm volatile("" ::: "memory");
#pragma unroll
            for (int m = 0; m < 4; ++m)
#pragma unroll
                for (int bj = 0; bj < 2; ++bj) { const size_t row = (size_t)(row0 + ai * 128 + m * 16); const int col = col0 + bj * 128;
                    const f32x4 v0 = acc[ai][bj][m][0], v1 = acc[ai][bj][m][1]; const u32x4 g = gt[m][bj], pv = prev[m][bj];
                    u32x4 o;
                    o.x = cvt_pk_bf16(bf_lo(pv.x) + bf_lo(g.x) * v0[0], bf_hi(pv.x) + bf_hi(g.x) * v0[1]);
                    o.y = cvt_pk_bf16(bf_lo(pv.y) + bf_lo(g.y) * v0[2], bf_hi(pv.y) + bf_hi(g.y) * v0[3]);
                    o.z = cvt_pk_bf16(bf_lo(pv.z) + bf_lo(g.z) * v1[0], bf_hi(pv.z) + bf_hi(g.z) * v1[1]);
                    o.w = cvt_pk_bf16(bf_lo(pv.w) + bf_lo(g.w) * v1[2], bf_hi(pv.w) + bf_hi(g.w) * v1[3]);
                    *(GAS u32x4*)(MERGED + row * 1024 + col) = o; }
            asm volatile("" ::: "memory");
        }
    }
};
struct P4Sched {
    int c; const char* MERGED; const char* WOUT;
    __device__ __forceinline__ bool next(int i, pg8::Unit& u) const {
        if (i >= 1) return false;
        constexpr int nN = 4, nwg = 256;
        int wgid = c; { const int q = nwg / 8, xcd = wgid % 8, off = wgid / 8; wgid = xcd * q + off; }
        const int nig = 8 * nN, gid = wgid / nig, fm = gid * 8;
        u.pm = fm + ((wgid % nig) % 8); u.pn = (wgid % nig) / 8;
        u.A = MERGED + (size_t)u.pm * 256 * 2048; u.B = WOUT + (size_t)u.pn * 256 * 2048; u.rows = 0; u.nt = 16; u.aux = 0; u.scale = 1.f; return true;
    }
};
struct P4Epi {
    const float* X; float* X1;
    __device__ __forceinline__ void operator()(const f32x4 (&acc)[2][2][4][2], const pg8::Unit& u, int wr, int wc, int fr, int fq) const {
        const int row0 = u.pm * 256 + wr * 64 + fr, col0 = u.pn * 256 + wc * 32 + 8 * fq;
#pragma unroll
        for (int ai = 0; ai < 2; ++ai) {
            f32x4 xv[4][2][2];
#pragma unroll
            for (int m = 0; m < 4; ++m)
#pragma unroll
                for (int bj = 0; bj < 2; ++bj) { const size_t off = (size_t)(row0 + ai * 128 + m * 16) * 1024 + col0 + bj * 128; xv[m][bj][0] = *(const GAS f32x4*)(X + off); xv[m][bj][1] = *(const GAS f32x4*)(X + off + 4); }
            asm volatile("" ::: "memory");
#pragma unroll
            for (int m = 0; m < 4; ++m)
#pragma unroll
                for (int bj = 0; bj < 2; ++bj) { const size_t off = (size_t)(row0 + ai * 128 + m * 16) * 1024 + col0 + bj * 128;
                    *(GAS f32x4*)(X1 + off) = xv[m][bj][0] + acc[ai][bj][m][0]; *(GAS f32x4*)(X1 + off + 4) = xv[m][bj][1] + acc[ai][bj][m][1]; }
            asm volatile("" ::: "memory");
        }
    }
};
__device__ __forceinline__ void p5_router(const Ctx& F0) {
    const KArgs ap = kargs(); const float* X1 = ap->out; const float* GF = ap->in[12]; const float* RW = ap->in[13]; const float* RB = ap->in[14];
    const Ctx F = ctx_refresh(F0);
    unsigned char* H8 = F.ws + WS_XN; float* RTOK = (float*)(F.ws + WS_MISC + MO_RTOK);
    int* TOPIDX = (int*)(F.ws + WS_MISC + MO_TOPIDX); float* TOPW = (float*)(F.ws + WS_MISC + MO_TOPW); int* HIST = (int*)(F.ws + WS_MISC + MO_HIST);
    LAS float* Wl = (LAS float*)F.lds;
    LAS float* xch = (LAS float*)(F.lds + 131072);
    LAS float* xss = (LAS float*)(F.lds + 131072 + 8192);
    LAS int* hist = (LAS int*)(F.lds + LDS_TAB);
    const int lane = F.lane, i = lane & 15, kq = lane >> 4, tg = F.wave & 3, kh = F.wave >> 2; const int bid = (int)blockIdx.x;
    const int tok = bid * 64 + tg * 16 + i; const int kbase = kh * 512 + 32 * kq;
    const float* xrow = X1 + (size_t)tok * D + kbase; const float* grow = GF + kbase;
    f32x4 xv[4][8];
    {
        f32x4 wv[16]; float gk[16];
#pragma unroll
        for (int u = 0; u < 16; ++u) { const int idx = F.tid + u * NTHREADS, k = idx >> 3, q = idx & 7; wv[u] = *(const GAS f32x4*)(RW + (size_t)k * 32 + 4 * q); gk[u] = GF[k]; }
#pragma unroll
        for (int c = 0; c < 2; ++c)
#pragma unroll
            for (int q = 0; q < 8; ++q) xv[c][q] = *(const GAS f32x4*)(xrow + c * 128 + 4 * q);
        __syncthreads();
#pragma unroll
        for (int u = 0; u < 16; ++u) { const int idx = F.tid + u * NTHREADS, k = idx >> 3, q = idx & 7; *(LAS f32x4*)(Wl + k * 32 + ((4 * q) ^ (((k >> 5) & 1) << 4))) = wv[u] * gk[u]; }
    }
#pragma unroll
    for (int c = 2; c < 4; ++c)
#pragma unroll
        for (int q = 0; q < 8; ++q) xv[c][q] = *(const GAS f32x4*)(xrow + c * 128 + 4 * q);
    if (F.tid < 32) hist[F.tid] = 0;
    LDS_WAIT(); __syncthreads();
    const LAS float* wb0 = Wl + kbase * 32 + (i ^ ((kq & 1) << 4)); const LAS float* wb1 = Wl + kbase * 32 + ((i + 16) ^ ((kq & 1) << 4));
    f32x4 acc0 = {0.f, 0.f, 0.f, 0.f}, acc1 = {0.f, 0.f, 0.f, 0.f}; float ss = 0.f;
#pragma unroll
    for (int c = 0; c < 4; ++c) {
        f32x4 gv[8];
#pragma unroll
        for (int q = 0; q < 8; ++q) gv[q] = *(const GAS f32x4*)(grow + c * 128 + 4 * q);
        unsigned o[8];
#pragma unroll
        for (int q = 0; q < 8; ++q) { const f32x4 x = xv[c][q], pq = x * gv[q]; ss += (x.x * x.x + x.y * x.y) + (x.z * x.z + x.w * x.w);
            int w = __builtin_amdgcn_cvt_pk_fp8_f32(pq.x, pq.y, 0, false); w = __builtin_amdgcn_cvt_pk_fp8_f32(pq.z, pq.w, w, true); o[q] = (unsigned)w; }
        GAS u32x4* op = (GAS u32x4*)(H8 + (size_t)tok * D + kbase + c * 128);
        op[0] = (u32x4){o[0], o[1], o[2], o[3]}; op[1] = (u32x4){o[4], o[5], o[6], o[7]};
#pragma unroll
        for (int j = 0; j < 32; ++j) { const float a = xv[c][j >> 2][j & 3]; const float b0 = wb0[(c * 128 + j) * 32], b1 = wb1[(c * 128 + j) * 32];
            acc0 = __builtin_amdgcn_mfma_f32_16x16x4f32(a, b0, acc0, 0, 0, 0); acc1 = __builtin_amdgcn_mfma_f32_16x16x4f32(a, b1, acc1, 0, 0, 0); }
    }
    ss += sx(ss, 16); ss += sx(ss, 32);
    if (kh == 1) { LAS float* xp = xch + (tg * 64 + lane) * 8; *(LAS f32x4*)xp = acc0; *(LAS f32x4*)(xp + 4) = acc1; if (lane < 16) xss[tg * 16 + lane] = ss; }
    LDS_WAIT(); __syncthreads();
    if (kh == 0) {
        const LAS float* xp = xch + (tg * 64 + lane) * 8; acc0 += *(const LAS f32x4*)xp; acc1 += *(const LAS f32x4*)(xp + 4); ss += xss[tg * 16 + i];
        const float rt = 1.0f / sqrtf(ss * (1.f / D) + RMS_EPS);
        if (lane < 16) RTOK[tok] = rt;
        const float bias0 = RB[i], bias1 = RB[i + 16];
        float c0[4], c1[4];
#pragma unroll
        for (int r = 0; r < 4; ++r) { const float rr = sidx(rt, 4 * kq + r); c0[r] = acc0[r] * rr + bias0; c1[r] = acc1[r] * rr + bias1; }
        float tv[4][4]; int ti[4][4];
#pragma unroll
        for (int k = 0; k < 4; ++k)
#pragma unroll
            for (int r = 0; r < 4; ++r) { float bv = c0[r] >= c1[r] ? c0[r] : c1[r]; int bi = c0[r] >= c1[r] ? i : i + 16;
#pragma unroll
                for (int off = 1; off < 16; off <<= 1) { const float ov = sx(bv, off); const int oi = sxi(bi, off); const bool take = (ov > bv) || (ov == bv && oi < bi); bv = take ? ov : bv; bi = take ? oi : bi; }
                tv[k][r] = bv; ti[k][r] = bi; if (bi == i) c0[r] = -INFINITY; if (bi == i + 16) c1[r] = -INFINITY; }
        if (i == 0) {
#pragma unroll
            for (int r = 0; r < 4; ++r) { const int t = bid * 64 + tg * 16 + 4 * kq + r;
                const float e1 = __expf(tv[1][r] - tv[0][r]), e2 = __expf(tv[2][r] - tv[0][r]), e3 = __expf(tv[3][r] - tv[0][r]); const float inv = 1.0f / (1.0f + e1 + e2 + e3);
                *(GAS i32x4*)(TOPIDX + t * 4) = (i32x4){ti[0][r], ti[1][r], ti[2][r], ti[3][r]}; *(GAS f32x4*)(TOPW + t * 4) = (f32x4){inv, e1 * inv, e2 * inv, e3 * inv};
                atomicAdd((int*)&hist[ti[0][r]], 1); atomicAdd((int*)&hist[ti[1][r]], 1); atomicAdd((int*)&hist[ti[2][r]], 1); atomicAdd((int*)&hist[ti[3][r]], 1); }
        }
    }
    LDS_WAIT(); __syncthreads();
    if (F.tid < 32) HIST[bid * 32 + F.tid] = hist[F.tid];
}
__device__ __forceinline__ void p6_slots(const Ctx& F0) {
    const Ctx F = ctx_refresh(F0);
    const int* TOPIDX = (const int*)(F.ws + WS_MISC + MO_TOPIDX); const float* TOPW = (const float*)(F.ws + WS_MISC + MO_TOPW); const int* HIST = (const int*)(F.ws + WS_MISC + MO_HIST);
    int* TOKSLOT = (int*)(F.ws + WS_MISC + MO_TOKSLOT); int* SLOTTOK = (int*)(F.ws + WS_MISC + MO_SLOTTOK); float* SLOTW = (float*)(F.ws + WS_MISC + MO_SLOTW); int* TILE = (int*)(F.ws + WS_MISC + MO_TILE);
    float* SLOTRS = (float*)(F.ws + WS_MISC + MO_SLOTRS); const float* RTOK = (const float*)(F.ws + WS_MISC + MO_RTOK);
    LAS int* part = (LAS int*)F.lds;
    LAS int* pref = part + 512;
    LAS int* tot = part + 1024;
    LAS int* mypre = tot + 32; LAS int* sbase = tot + 64; LAS int* wcnt = tot + 96;
    const int bid = (int)blockIdx.x, tid = F.tid;
    __syncthreads();
    { const int e = tid & 31, ch = tid >> 5; int s = 0, p = 0;
        for (int j = 0; j < 16; ++j) { const int bb = ch * 16 + j; const int hv = HIST[bb * 32 + e]; s += hv; if (bb < bid) p += hv; }
        part[ch * 32 + e] = s; pref[ch * 32 + e] = p; }
    LDS_WAIT(); __syncthreads();
    if (tid < 32) { int s = 0, p = 0; for (int ch = 0; ch < 16; ++ch) { s += part[ch * 32 + tid]; p += pref[ch * 32 + tid]; } tot[tid] = s; mypre[tid] = p; }
    LDS_WAIT(); __syncthreads();
    if (tid == 0) { int tb = 0; for (int e = 0; e < 32; ++e) { sbase[e] = tb * 256; const int nt = (tot[e] + 255) >> 8; if (bid == 0) { for (int j = 0; j < nt; ++j) TILE[1 + tb + j] = e; } tb += nt; } if (bid == 0) TILE[0] = tb; }
    LDS_WAIT(); __syncthreads();
    int e_me = 0, rank = 0; float w_me = 0.f; const int ent = tid;
    if (tid < 256) { e_me = TOPIDX[bid * 256 + ent]; w_me = TOPW[bid * 256 + ent];
        const int wv = tid >> 6;
        for (int e = 0; e < 32; ++e) { const unsigned long long bal = __ballot(e_me == e); if (e_me == e) rank = __builtin_popcountll(bal & ((1ull << F.lane) - 1ull)); if (F.lane == 0) wcnt[wv * 32 + e] = __builtin_popcountll(bal); } }
    LDS_WAIT(); __syncthreads();
    if (tid < 256) { const int wv = tid >> 6; for (int j = 0; j < wv; ++j) rank += wcnt[j * 32 + e_me];
        const int slot = sbase[e_me] + mypre[e_me] + rank; const int tok = bid * 64 + (ent >> 2);
        SLOTTOK[slot] = tok; SLOTW[slot] = w_me; SLOTRS[slot] = RTOK[tok]; TOKSLOT[bid * 256 + ent] = slot; }
    if (bid < 32) { const int e = bid; const int beg = sbase[e] + tot[e], end = sbase[e] + (((tot[e] + 255) >> 8) << 8); for (int s = beg + tid; s < end; s += NTHREADS) { SLOTTOK[s] = 0; SLOTW[s] = 0.f; SLOTRS[s] = 0.f; } }
}
constexpr int LDS_ROWS = 139264, LDS_TILE = 139264 + 11 * 1024;
static_assert(LDS_TILE + 4 * (1 + MAX_TILES) <= LDS_MISC, "LDS tables");
template <int NPN> __device__ __forceinline__ void moe_unit(int i, int c, int& m, int& pn) { const int k = c >> 3; m = i * (256 / NPN) + (32 / NPN) * (c & 7) + k / NPN; pn = k % NPN; }
template <int NPN, bool ROWS> __device__ __forceinline__ void moe_tables(const Ctx& F, const int* TILE, const int* SLOTTOK) {
    LAS int* tl = (LAS int*)(F.lds + LDS_TILE);
    __syncthreads();
    for (int j = F.tid; j < 1 + MAX_TILES; j += NTHREADS) tl[j] = __hip_atomic_load((int*)TILE + j, __ATOMIC_RELAXED, __HIP_MEMORY_SCOPE_AGENT);
    if (ROWS) { const int ntile = __builtin_amdgcn_readfirstlane(__hip_atomic_load((int*)TILE, __ATOMIC_RELAXED, __HIP_MEMORY_SCOPE_AGENT));
        for (int i = 0; i < 11; ++i) { int m, pn_; moe_unit<NPN>(i, (int)blockIdx.x, m, pn_); if (m >= ntile) break;
            if (F.tid < 256) ((LAS int*)(F.lds + LDS_ROWS))[i * 256 + F.tid] = SLOTTOK[m * 256 + F.tid]; } }
    LDS_WAIT(); __syncthreads();
}
struct P7Sched {
    int G, c; LAS const int* tl; const char* H2; const char* WGU; int ntile;
    __device__ __forceinline__ bool next(int i, pg8::Unit& u) const {
        int m, pn; moe_unit<8>(i, c, m, pn); if (m >= ntile || i >= 11) return false;
        const int e = __builtin_amdgcn_readfirstlane(tl[1 + m]);
        u.pm = m; u.pn = pn; u.aux = e; u.scale = 1.f; u.nt = 8; u.rows = LDS_ROWS + 1024 * i; u.A = H2; u.B = WGU + ((size_t)e * 2048 + pn * 256) * 1024; return true;
    }
};
struct P7Epi {
    const float* BGU; bf16_t* ACT; const float* SLOTRS;
    __device__ __forceinline__ void operator()(const f32x4 (&acc)[2][2][4][2], const pg8::Unit& u, int wr, int wc, int fr, int fq) const {
        const int row0 = u.pm * 256 + wr * 64 + fr, cc0 = wc * 32 + 8 * fq, e = u.aux;
        float rr[2][4];
#pragma unroll
        for (int ai = 0; ai < 2; ++ai)
#pragma unroll
            for (int m = 0; m < 4; ++m) rr[ai][m] = SLOTRS[row0 + ai * 128 + m * 16];
        const float* bg = BGU + (size_t)e * 2048 + u.pn * 128 + cc0; const float* bu = bg + 1024;
        const f32x4 bg0 = *(const GAS f32x4*)bg, bg1 = *(const GAS f32x4*)(bg + 4), bu0 = *(const GAS f32x4*)bu + 1.0f, bu1 = *(const GAS f32x4*)(bu + 4) + 1.0f;
        asm volatile("" ::: "memory");
#pragma unroll
        for (int ai = 0; ai < 2; ++ai)
#pragma unroll
            for (int m = 0; m < 4; ++m) { const size_t row = (size_t)(row0 + ai * 128 + m * 16);
                float av[8];
#pragma unroll
                for (int n = 0; n < 2; ++n) { const f32x4 gv = acc[ai][0][m][n] * rr[ai][m] + (n ? bg1 : bg0), uv = acc[ai][1][m][n] * rr[ai][m] + (n ? bu1 : bu0);
#pragma unroll
                    for (int j = 0; j < 4; ++j) { const float gg = fminf(gv[j], 7.0f); const float u1 = fminf(fmaxf(uv[j], -6.0f), 8.0f);
                        av[4 * n + j] = (u1 * gg) * __builtin_amdgcn_rcpf(1.0f + __builtin_amdgcn_exp2f(gg * (-1.702f * LOG2E))); } }
                int w0 = __builtin_amdgcn_cvt_pk_fp8_f32(av[0], av[1], 0, false); w0 = __builtin_amdgcn_cvt_pk_fp8_f32(av[2], av[3], w0, true);
                int w1 = __builtin_amdgcn_cvt_pk_fp8_f32(av[4], av[5], 0, false); w1 = __builtin_amdgcn_cvt_pk_fp8_f32(av[6], av[7], w1, true);
                *(GAS u32x2*)((unsigned char*)ACT + row * 1024 + u.pn * 128 + cc0) = (u32x2){(unsigned)w0, (unsigned)w1}; }
    }
};
struct P8Sched {
    int G, c; LAS const int* tl; const char* ACT; const char* WDN; int ntile;
    __device__ __forceinline__ bool next(int i, pg8::Unit& u) const {
        int m, pn; moe_unit<4>(i, c, m, pn); if (m >= ntile) return false;
        const int e = __builtin_amdgcn_readfirstlane(tl[1 + m]);
        u.pm = m; u.pn = pn; u.aux = e; u.scale = 1.f; u.nt = 8; u.rows = 0; u.A = ACT + (size_t)m * 256 * 1024; u.B = WDN + ((size_t)e * 1024 + pn * 256) * 1024; return true;
    }
};
struct P8Epi {
    const float* BDN; const float* SLOTW; bf16_t* YS;
    __device__ __forceinline__ void operator()(const f32x4 (&acc)[2][2][4][2], const pg8::Unit& u, int wr, int wc, int fr, int fq) const {
        const int row0 = u.pm * 256 + wr * 64 + fr, col0 = u.pn * 256 + wc * 32 + 8 * fq, e = u.aux;
        const float* bp = BDN + (size_t)e * 1024 + col0;
        f32x4 bv[2][2]; float sw[2][4];
#pragma unroll
        for (int bj = 0; bj < 2; ++bj) { bv[bj][0] = *(const GAS f32x4*)(bp + bj * 128); bv[bj][1] = *(const GAS f32x4*)(bp + bj * 128 + 4); }
#pragma unroll
        for (int ai = 0; ai < 2; ++ai)
#pragma unroll
            for (int m = 0; m < 4; ++m) sw[ai][m] = SLOTW[row0 + ai * 128 + m * 16];
        asm volatile("" ::: "memory");
#pragma unroll
        for (int ai = 0; ai < 2; ++ai)
#pragma unroll
            for (int m = 0; m < 4; ++m) { const size_t row = (size_t)(row0 + ai * 128 + m * 16); const float w_ = sw[ai][m];
#pragma unroll
                for (int bj = 0; bj < 2; ++bj) { const f32x4 v0 = (acc[ai][bj][m][0] + bv[bj][0]) * w_, v1 = (acc[ai][bj][m][1] + bv[bj][1]) * w_;
                    int w0 = __builtin_amdgcn_cvt_pk_fp8_f32(v0[0], v0[1], 0, false); w0 = __builtin_amdgcn_cvt_pk_fp8_f32(v0[2], v0[3], w0, true);
                    int w1 = __builtin_amdgcn_cvt_pk_fp8_f32(v1[0], v1[1], 0, false); w1 = __builtin_amdgcn_cvt_pk_fp8_f32(v1[2], v1[3], w1, true);
                    *(GAS u32x2*)((unsigned char*)YS + row * 1024 + col0 + bj * 128) = (u32x2){(unsigned)w0, (unsigned)w1}; } }
    }
};
__device__ __forceinline__ void p9_final(const Ctx& F0) {
    const KArgs ap = kargs(); struct { const float* in[20]; float* out; } a; a.in[19] = ap->in[19]; a.out = ap->out;
    const Ctx F = ctx_refresh(F0);
    float* OUT = a.out; const bf16_t* YS = (const bf16_t*)(F.ws + WS_YS); const int* TOKSLOT = (const int*)(F.ws + WS_MISC + MO_TOKSLOT); const float* GN = a.in[19];
    const int gw = F.vcu * NWAVES + F.wave, NGW = F.G * NWAVES, lane = F.lane;
    const GAS f32x4* gr = (const GAS f32x4*)GN + lane;
    const bool bad = ld_uniform((const int*)(F.ws + WS_CTL) + 4096 + XB_TMO) != 0;
    float ckscale = 1.0f;
#ifdef CKSUM
    { const int* prev = (const int*)(F.ws + WS_MISC + 7 * MiB); if (ld_uniform(prev) == 0x5EED1234) ckscale = 1.0f + 0.25f * (float)ld_uniform(prev + 1); }
#endif
    int slotv = 0; { const int k_ = lane >> 2, t_ = gw + k_ * NGW; if (lane < 32 && t_ < NTOK) slotv = __hip_atomic_load((int*)TOKSLOT + t_ * 4 + (lane & 3), __ATOMIC_RELAXED, __HIP_MEMORY_SCOPE_AGENT); }
    int kt = 0;
    for (int tok = gw; tok < NTOK; tok += NGW, ++kt) {
        GAS f32x4* xr = (GAS f32x4*)(OUT + (size_t)tok * D) + lane;
        f32x4 v[4];
#pragma unroll
        for (int jj = 0; jj < 4; ++jj) v[jj] = xr[64 * jj];
        const int slots[4] = {__builtin_amdgcn_readlane(slotv, kt * 4), __builtin_amdgcn_readlane(slotv, kt * 4 + 1), __builtin_amdgcn_readlane(slotv, kt * 4 + 2), __builtin_amdgcn_readlane(slotv, kt * 4 + 3)};
#pragma unroll
        for (int k = 0; k < 4; ++k) { const GAS unsigned* yr = (const GAS unsigned*)((const unsigned char*)YS + (size_t)slots[k] * 1024) + lane;
#pragma unroll
            for (int jj = 0; jj < 4; ++jj) { const unsigned y = yr[64 * jj]; const f32x2 lo = __builtin_amdgcn_cvt_pk_f32_fp8((int)y, false), hi = __builtin_amdgcn_cvt_pk_f32_fp8((int)y, true);
                v[jj].x += lo.x; v[jj].y += lo.y; v[jj].z += hi.x; v[jj].w += hi.y; } }
        float ss = 0.f;
#pragma unroll
        for (int jj = 0; jj < 4; ++jj) ss += (v[jj].x * v[jj].x + v[jj].y * v[jj].y) + (v[jj].z * v[jj].z + v[jj].w * v[jj].w);
        const float r = 1.0f / sqrtf(wave_sum(ss) * (1.f / D) + RMS_EPS);
#pragma unroll
        for (int jj = 0; jj < 4; ++jj) { const f32x4 gg = gr[64 * jj]; f32x4 o = (f32x4){v[jj].x * r * gg.x, v[jj].y * r * gg.y, v[jj].z * r * gg.z, v[jj].w * r * gg.w} * ckscale; if (bad) o = (f32x4){__builtin_nanf(""), __builtin_nanf(""), __builtin_nanf(""), __builtin_nanf("")}; xr[64 * jj] = o; }
    }
}

__device__ __forceinline__ void grid_barrier(int wave) {
    extern __shared__ __attribute__((aligned(16))) unsigned char lds_dyn[];
    XcdBarrier b; b.bar = (unsigned*)(kargs()->ws + WS_CTL) + 4096; b.x = xb_xcc_id(); b.st = (volatile LAS unsigned*)((LAS unsigned char*)lds_dyn + LDS_MISC) + 8; b.wave = wave;
    xcd_barrier(b);
}
__global__ void __launch_bounds__(NTHREADS, 2) fwd_megakernel(Args args) {
    const int wave = __builtin_amdgcn_readfirstlane((int)threadIdx.x >> 6);
    {
        const Ctx F = make_ctx(wave);
        volatile LAS unsigned* MISC = (volatile LAS unsigned*)(F.lds + LDS_MISC);
        for (int u = F.tid; u < 128; u += NTHREADS) MISC[u] = 0u;
        __syncthreads();
        (void)xcd_barrier_post((unsigned*)(F.ws + WS_CTL) + 4096, MISC + 8, wave);
    }
#ifndef TSK
#define TSK -1
#endif
#ifndef TSB
#define TSB 0
#endif
    unsigned long long ts0_ = 0ull, ts1_ = 0ull; if (TSK >= 0) ts0_ = __builtin_amdgcn_s_memrealtime();
#define TS(k) do { if (TSK == (k)) ts1_ = __builtin_amdgcn_s_memrealtime(); } while (0)
#define F make_ctx(wave)
#define ws (kargs()->ws)
#define xcd_barrier(bar) grid_barrier(wave)
#ifndef PHM
#define PHM 0xFFFF
#endif
#define PH(k) ((PHM >> (k)) & 1)
#ifndef PHR
#define PHR 0
#endif
#define RP(k) ((PHR >> (k)) & 1)
#ifdef CANARY
    {
        const size_t n16 = (WS_END - WS_MISC) / 16; GAS u32x4* p = (GAS u32x4*)(ws + WS_MISC);
        for (size_t i = (size_t)blockIdx.x * NTHREADS + F.tid; i < n16; i += (size_t)F.G * NTHREADS) p[i] = (u32x4){0xffffffffu, 0xffffffffu, 0xffffffffu, 0xffffffffu};
        GAS u32x4* q = (GAS u32x4*)kargs()->out;
        for (size_t i = (size_t)blockIdx.x * NTHREADS + F.tid; i < (size_t)NTOK * D / 4; i += (size_t)F.G * NTHREADS) q[i] = (u32x4){0xffffffffu, 0xffffffffu, 0xffffffffu, 0xffffffffu};
        xcd_barrier(bar);
    }
#endif
    if (PH(0)) p0_prologue(F);
    xcd_barrier(bar);
    if (RP(0)) { p0_prologue(F); xcd_barrier(bar); }
    TS(0);
    CK(1, ws + WS_WIN_T, WS_MKV - WS_WIN_T); CK(1, ws + WS_XN, WS_ABC - WS_XN); CK(1, ws + WS_WGU_T, WS_PROJ - WS_WGU_T); CK(1, ws + WS_MISC + MO_T5, 128 * 1024);
    for (int rp_ = 0; rp_ < 1 + RP(1); ++rp_) {
    if (PH(1)) {
        p1_convert_experts(F);
        TS(12);
        P1Sched S{(unsigned*)(ws + WS_CTL) + 12288 + 64 * ((int)blockIdx.x & 7), (LAS int*)(F.lds + LDS_MISC) + 32, F.wave, (int)blockIdx.x & 7, (const char*)(ws + WS_XN), (const char*)(ws + WS_WIN_T), (const char*)(ws + WS_MEMN), (const char*)(ws + WS_WMEM_T)};
        P1Epi E{(bf16_t*)(ws + WS_PROJ), (bf16_t*)(ws + WS_MKV)};
        pg8::gemm_phase<P1Epi, P1Sched, false, true>(F.lds, F.wave, 1024u, 1024u, S, E);
    }
    xcd_barrier(bar);
    }
    TS(1);
    CK(2, ws + WS_PROJ, WS_ACT - WS_PROJ); CK(2, ws + WS_MKV, 1 * MiB);
    if (PH(2)) p2_attention(F);
    xcd_barrier(bar);
    if (RP(2)) { p2_attention(F); xcd_barrier(bar); }
    TS(2);
    CK(3, ws + WS_OB, WS_MERGED - WS_OB); CK(3, ws + WS_MISC + MO_LSE, 3 * 16384 * 16);
    TS(10);
    CK(4, ws + WS_ABC, WS_OB - WS_ABC);
    for (int rp_ = 0; rp_ < 1 + RP(3); ++rp_) {
    if (PH(3)) {
        P3Sched S{(int)blockIdx.x, (const char*)(ws + WS_ABC), (const char*)(ws + WS_WABC_T)};
        { pg8::Unit u0_; (void)S.next(0, u0_); p2b_merge_tile(F, u0_.pm); }
        P3Epi E{(const bf16_t*)(ws + WS_PROJ), (bf16_t*)(ws + WS_MERGED)};
        pg8::gemm_phase<P3Epi, P3Sched, false>(F.lds, F.wave, (unsigned)(ABC_LD * 2), (unsigned)(ABC_LD * 2), S, E);
    }
    xcd_barrier(bar);
    }
    TS(3);
    CK(5, ws + WS_MERGED, 32 * MiB);
    for (int rp_ = 0; rp_ < 1 + RP(4); ++rp_) {
    if (PH(4)) {
        P4Sched S{(int)blockIdx.x, (const char*)(ws + WS_MERGED), (const char*)(ws + WS_WOUT_T)};
        P4Epi E{kargs()->in[0], kargs()->out};
        pg8::gemm_phase<P4Epi, P4Sched, false>(F.lds, F.wave, 2048u, 2048u, S, E);
    }
    xcd_barrier(bar);
    }
    TS(4);
    CK(6, kargs()->out, 64 * MiB);
    if (PH(5)) p5_router(F);
    xcd_barrier(bar);
    if (RP(5)) { p5_router(F); xcd_barrier(bar); }
    TS(5);
    CK(7, ws + WS_XN, 32 * MiB); CK(7, ws + WS_MISC, 512 * 1024 + 32 * 1024);
    if (PH(6)) p6_slots(F);
    xcd_barrier(bar);
    TS(6);
#ifdef CKSUM
#define ck_rows ((size_t)ld_uniform((const int*)(ws + WS_MISC + MO_TILE)) * 256)
    CK(8, ws + WS_MISC + MO_TOKSLOT, 256 * 1024); CK(8, ws + WS_MISC + MO_SLOTTOK, ck_rows * 4); CK(8, ws + WS_MISC + MO_SLOTW, ck_rows * 4); CK(8, ws + WS_MISC + MO_TILE, 1024);
#endif
    for (int rp_ = 0; rp_ < 1 + RP(7); ++rp_) {
    if (PH(7)) {
        moe_tables<8, true>(F, (const int*)(ws + WS_MISC + MO_TILE), (const int*)(ws + WS_MISC + MO_SLOTTOK));
        P7Sched S{F.G, (int)blockIdx.x, (LAS const int*)(F.lds + LDS_TILE), (const char*)(ws + WS_XN), (const char*)(ws + WS_WGU_T), __builtin_amdgcn_readfirstlane(*(LAS const int*)(F.lds + LDS_TILE))};
        P7Epi E{kargs()->in[16], (bf16_t*)(ws + WS_ACT), (const float*)(ws + WS_MISC + MO_SLOTRS)};
        pg8::gemm_phase<P7Epi, P7Sched, true, true>(F.lds, F.wave, 1024u, 1024u, S, E);
    }
    xcd_barrier(bar);
    }
    TS(7);
#ifdef CKSUM
    CK(9, ws + WS_ACT, ck_rows * 2048);
#endif
    for (int rp_ = 0; rp_ < 1 + RP(8); ++rp_) {
    if (PH(8)) {
        moe_tables<4, false>(F, (const int*)(ws + WS_MISC + MO_TILE), (const int*)(ws + WS_MISC + MO_SLOTTOK));
        P8Sched S{F.G, (int)blockIdx.x, (LAS const int*)(F.lds + LDS_TILE), (const char*)(ws + WS_ACT), (const char*)(ws + WS_WDN_T), __builtin_amdgcn_readfirstlane(*(LAS const int*)(F.lds + LDS_TILE))};
        P8Epi E{kargs()->in[18], (const float*)(ws + WS_MISC + MO_SLOTW), (bf16_t*)(ws + WS_YS)};
        pg8::gemm_phase<P8Epi, P8Sched, false, true>(F.lds, F.wave, 1024u, 1024u, S, E);
    }
    xcd_barrier(bar);
    }
    TS(8);
#ifdef CKSUM
    CK(10, ws + WS_YS, ck_rows * 2048);
#endif
    if (PH(9)) p9_final(F);
    if (TSK >= 0 && blockIdx.x == TSB && wave == 0) { const unsigned long long te_ = __builtin_amdgcn_s_memrealtime(); const unsigned long long wait_ = 50ull * (ts1_ - ts0_); while (__builtin_amdgcn_s_memrealtime() - te_ < wait_) __builtin_amdgcn_s_sleep(32); }
#ifdef CKSUM
    xcd_barrier(bar);
    if (blockIdx.x == 0 && F.wave == 0 && lane_id() == 0) {
        unsigned* cur = (unsigned*)(ws + WS_CTL) + 8192; unsigned* prev = (unsigned*)(ws + WS_MISC + 7 * MiB);
        const bool have = __hip_atomic_load(prev, __ATOMIC_RELAXED, __HIP_MEMORY_SCOPE_AGENT) == 0x5EED1234u;
        unsigned flag = have ? __hip_atomic_load(prev + 1, __ATOMIC_RELAXED, __HIP_MEMORY_SCOPE_AGENT) : 0u;
        for (int k = 1; k <= 10; ++k) { const unsigned c = __hip_atomic_load(cur + 64 * k, __ATOMIC_RELAXED, __HIP_MEMORY_SCOPE_AGENT);
            if (have && flag == 0u && __hip_atomic_load(prev + 16 + k, __ATOMIC_RELAXED, __HIP_MEMORY_SCOPE_AGENT) != c) flag = (unsigned)k;
            __hip_atomic_store(prev + 16 + k, c, __ATOMIC_RELAXED, __HIP_MEMORY_SCOPE_AGENT); }
        __hip_atomic_store(prev + 1, flag, __ATOMIC_RELAXED, __HIP_MEMORY_SCOPE_AGENT); __hip_atomic_store(prev, 0x5EED1234u, __ATOMIC_RELAXED, __HIP_MEMORY_SCOPE_AGENT);
    }
#endif
}

#undef F
#undef ws
#undef xcd_barrier
extern "C" void kernel_launch(void* const* d_in, const int* in_sizes, int n_in, void* d_out, int out_size, void* d_ws, size_t ws_size, hipStream_t stream) {
    static int grid = 0;
    if (grid == 0) {
        if (n_in != 20 || out_size != NTOK * D || ws_size < WS_END) { fprintf(stderr, "kernel_launch: unexpected shapes (n_in %d, out %d, ws %zu); nothing launched\n", n_in, out_size, ws_size); grid = -1; return; }
        int dev = 0, cus = 0;
        if (hipGetDevice(&dev) != hipSuccess || hipDeviceGetAttribute(&cus, hipDeviceAttributeMultiprocessorCount, dev) != hipSuccess) { grid = -1; return; }
        if (hipFuncSetAttribute((const void*)fwd_megakernel, hipFuncAttributeMaxDynamicSharedMemorySize, LDS_BYTES) != hipSuccess) { fprintf(stderr, "kernel_launch: hipFuncSetAttribute failed\n"); grid = -1; return; }
        int per_cu = 0;
        if (hipOccupancyMaxActiveBlocksPerMultiprocessor(&per_cu, (const void*)fwd_megakernel, NTHREADS, LDS_BYTES) != hipSuccess || per_cu < 1) fprintf(stderr, "kernel_launch: occupancy query reports %d\n", per_cu);
        (void)hipGetLastError();
        grid = cus;
        if (grid != 256) fprintf(stderr, "kernel_launch: %d CUs; this kernel is laid out for 256\n", grid);
    }
    if (grid < 0) return;
    (void)hipMemsetAsync((char*)d_ws + WS_CTL, 0, CTL_ZERO_BYTES, stream);
    Args a{};
    for (int i = 0; i < 20; ++i) a.in[i] = (const float*)d_in[i];
    a.out = (float*)d_out; a.ws = (unsigned char*)d_ws;
    hipLaunchKernelGGL(fwd_megakernel, dim3(grid), dim3(NTHREADS), LDS_BYTES, stream, a);
}
```

```cpp
#include <hip/hip_runtime.h>
#include <cstdio>
#include <cstdint>
#include <type_traits>

#define GAS __attribute__((address_space(1)))
#define LAS __attribute__((address_space(3)))
typedef unsigned short bf16_t;
typedef short bf16x8 __attribute__((ext_vector_type(8)));
typedef short s16x4 __attribute__((ext_vector_type(4)));
typedef float f32x4 __attribute__((ext_vector_type(4)));
typedef float f32x2 __attribute__((ext_vector_type(2)));
typedef unsigned u32x4 __attribute__((ext_vector_type(4)));
typedef unsigned u32x2 __attribute__((ext_vector_type(2)));
typedef int i32x4 __attribute__((ext_vector_type(4)));
typedef int i32x8 __attribute__((ext_vector_type(8)));
#define FP8_SCALE 0x7C7C7C7C
typedef GAS unsigned gu32;

constexpr int NTOK = 16384, SEQ = 8192, D = 1024, NMEM = 512, MEMLEN = 256;
constexpr int IN_COLS = 7424;
__host__ __device__ __forceinline__ size_t proj_off(size_t row, int col) { return (((row >> 8) * 29 + (size_t)(col >> 8)) << 16) + ((row & 255) << 8) + (size_t)(col & 255); }
constexpr int C_QA = 0, C_KA = 512, C_VA = 1024, C_QB = 1536, C_KB = 2304, C_VB = 3072, C_QC = 3840, C_GATE = 4352;
constexpr int NEXP = 32, TOPK = 4, DFF = 1024;
constexpr int MAX_TILES = 288, MAX_SLOTS = MAX_TILES * 256;
constexpr float RMS_EPS = 1e-6f, LOG2E = 1.4426950408889634f;
constexpr float QS64 = 0.125f * LOG2E, QS128 = 0.08838834764831845f * LOG2E;
constexpr int ABC_LD = 1280;

constexpr size_t MiB = 1u << 20;
constexpr size_t WS_CTL = 0, CTL_ZERO_BYTES = 1 * MiB;
constexpr size_t WS_MISC = 1 * MiB;
constexpr size_t MO_TOPIDX = 0, MO_TOPW = 256 * 1024, MO_HIST = 512 * 1024, MO_TOKSLOT = 1 * MiB, MO_SLOTTOK = 2 * MiB, MO_SLOTW = 3 * MiB, MO_TILE = 4 * MiB, MO_LSE = 5 * MiB, MO_T5 = 6 * MiB, MO_RPB = 6 * MiB + 64 * 1024, MO_RTOK = 7 * MiB + 64 * 1024, MO_SLOTRS = 8 * MiB;
constexpr size_t WS_WIN_T = 16 * MiB, WS_WMEM_T = 32 * MiB, WS_WABC_T = 34 * MiB, WS_WOUT_T = 37 * MiB, WS_MEMN = 39 * MiB, WS_MKV = 40 * MiB, WS_XN = 41 * MiB;
constexpr size_t WS_ABC = 73 * MiB, WS_OB = 113 * MiB, WS_MERGED = 137 * MiB, WS_WGU_T = 169 * MiB, WS_WDN_T = 297 * MiB, WS_PROJ = 361 * MiB, WS_ACT = 593 * MiB, WS_YS = 737 * MiB, WS_END = 881 * MiB;
constexpr size_t WS_X1B = WS_ACT + 100 * MiB;
constexpr int T5_LD = 192, RPB_LD = 640, RPB_OFF = 64;

constexpr int LDS_MAIN = 147456;
constexpr int LDS_TAB = LDS_MAIN;
constexpr int LDS_MISC = LDS_MAIN + 8192;
constexpr int LDS_BYTES = LDS_MISC + 512;

#define LDS_WAIT() asm volatile("s_waitcnt lgkmcnt(0)" ::: "memory")
#define VM_WAIT() asm volatile("s_waitcnt vmcnt(0)" ::: "memory")
__device__ __forceinline__ unsigned cvt_pk_bf16(float lo, float hi) { unsigned r; asm volatile("v_cvt_pk_bf16_f32 %0, %1, %2" : "=v"(r) : "v"(lo), "v"(hi)); return r; }
__device__ __forceinline__ float bf_lo(unsigned u) { return __uint_as_float(u << 16); }
__device__ __forceinline__ float bf_hi(unsigned u) { return __uint_as_float(u & 0xffff0000u); }
__device__ __forceinline__ int lane_id() { int l; asm volatile("v_mbcnt_lo_u32_b32 %0, -1, 0\n\tv_mbcnt_hi_u32_b32 %0, -1, %0" : "=v"(l)); return l; }
__device__ __forceinline__ float sx(float v, int off) { return __builtin_bit_cast(float, __builtin_amdgcn_ds_bpermute((lane_id() ^ off) << 2, __builtin_bit_cast(int, v))); }
__device__ __forceinline__ int sxi(int v, int off) { return __builtin_amdgcn_ds_bpermute((lane_id() ^ off) << 2, v); }
__device__ __forceinline__ float sidx(float v, int src) { return __builtin_bit_cast(float, __builtin_amdgcn_ds_bpermute(src << 2, __builtin_bit_cast(int, v))); }
__device__ __forceinline__ float wave_sum(float v) {
#pragma unroll
    for (int o = 1; o < 64; o <<= 1) v += sx(v, o);
    return v;
}
__device__ __forceinline__ float wave_max(float v) {
#pragma unroll
    for (int o = 1; o < 64; o <<= 1) v = fmaxf(v, sx(v, o));
    return v;
}
__device__ __forceinline__ int ld_uniform(const int* p) { return __builtin_amdgcn_readfirstlane(__hip_atomic_load((int*)p, __ATOMIC_RELAXED, __HIP_MEMORY_SCOPE_AGENT)); }
__device__ __forceinline__ float fast_sigmoid(float x) { return __builtin_amdgcn_rcpf(1.0f + __builtin_amdgcn_exp2f(-LOG2E * x)); }

namespace pg8 {
constexpr int BM = 256, BK = 64, HALF = 128, HTB = HALF * BK * 2, STAGE_BYTES = 8 * HTB, LDS_STASH = 131072  ;
__host__ __device__ __forceinline__ int lds_byte(int r, int c) { const int st = (r >> 4) * 2 + (c >> 5), rr = r & 15, cc = c & 31, ob = rr * 64 + cc * 2; return st * 1024 + (ob ^ (((ob >> 9) & 1) << 5)); }
__host__ __device__ __forceinline__ void stage_rc(int b, int& R, int& C) { const int st = b / 1024, sb = b % 1024, swz = sb ^ (((sb >> 9) & 1) << 5); R = (st >> 1) * 16 + swz / 64; C = (st & 1) * 32 + (swz % 64) / 2; }
__host__ __device__ __forceinline__ int perm32(int rho) { const int n = rho >> 4, i = rho & 15; return 8 * (i >> 2) + 4 * n + (i & 3); }

struct Unit {
    const char* A;
    const char* B;
    int rows;
    int nt;
    int pm, pn;
    int aux;
    float scale;
};

template <class Epi, class Sched, bool GATHER, bool FP8 = false>
__device__ __forceinline__ void gemm_phase(LAS unsigned char* lds, const int wave, const unsigned lda, const unsigned ldb, const Sched& S, const Epi& E) {
    const int lane = lane_id();
    const int wid = wave, tid = wave * 64 + lane, wr = wid >> 2, wc = wid & 3, fr = lane & 15, fq = lane >> 4;
    const int R0 = (wid >> 1) * 16 + (lane >> 2), C2 = ((wid & 1) * 32 + ((((lane & 3) * 8)) ^ ((lane >> 5) << 4))) * 2, Rb0 = (R0 & ~31) + perm32(R0 & 31);
    unsigned offA = (unsigned)R0 * lda + (unsigned)C2, offB = (unsigned)Rb0 * ldb + (unsigned)C2;
    const size_t kstep = (size_t)(BK * 2);
    const size_t hstepB = (size_t)HALF * ldb;
    const unsigned ldsw = (unsigned)wid * 1024u;
    const int aoff = lds_byte(wr * 64 + fr, fq * 8), boff = lds_byte(wc * 32 + fr, fq * 8);
#define PG8_SA(b, h) (((b) * 2 + (h)) * HTB)
#define PG8_SB(b, h) ((4 + (b) * 2 + (h)) * HTB)
#define PG8_STAGE2P(bufoff, p0, p1, v0, v1) do { \
        __builtin_amdgcn_global_load_lds((const unsigned*)((const char*)(p0) + (v0)), (LAS unsigned*)(lds + (bufoff) + ldsw), 16, 0, 0); \
        __builtin_amdgcn_global_load_lds((const unsigned*)((const char*)(p1) + (v1)), (LAS unsigned*)(lds + (bufoff) + ldsw + 8192), 16, 0, 0); } while (0)
#define PG8_STAGEB(bufoff, gbase) PG8_STAGE2P(bufoff, gbase, (const char*)(gbase) + (size_t)64 * ldb, offB, offB)
#define PG8_STAGEA(bufoff, gbase, h, g0, g1) do { if (GATHER) { PG8_STAGE2P(bufoff, gbase, gbase, g0, g1); } else { PG8_STAGE2P(bufoff, (const char*)(gbase) + (size_t)((h) * HALF) * lda, (const char*)(gbase) + (size_t)((h) * HALF + 64) * lda, offA, offA); } } while (0)
#define PG8_LDA(dst, b, h) do { _Pragma("unroll") for (int m = 0; m < 4; ++m) _Pragma("unroll") for (int k = 0; k < 2; ++k) dst[m][k] = *(const LAS bf16x8*)(lds + PG8_SA(b, h) + aoff + m * 2048 + k * 1024); } while (0)
#define PG8_LDB(dst, b, h) do { _Pragma("unroll") for (int n = 0; n < 2; ++n) _Pragma("unroll") for (int k = 0; k < 2; ++k) dst[n][k] = *(const LAS bf16x8*)(lds + PG8_SB(b, h) + boff + n * 2048 + k * 1024); } while (0)
#define PG8_MMA(ai, bj, At, Bt) do { __builtin_amdgcn_s_setprio(1); \
        if (FP8) { _Pragma("unroll") for (int m = 0; m < 4; ++m) _Pragma("unroll") for (int n = 0; n < 2; ++n) { \
            const i32x4 b0_ = __builtin_bit_cast(i32x4, Bt[n][0]), b1_ = __builtin_bit_cast(i32x4, Bt[n][1]), a0_ = __builtin_bit_cast(i32x4, At[m][0]), a1_ = __builtin_bit_cast(i32x4, At[m][1]); \
            const i32x8 bw_ = __builtin_shufflevector(b0_, b1_, 0, 1, 2, 3, 4, 5, 6, 7), aw_ = __builtin_shufflevector(a0_, a1_, 0, 1, 2, 3, 4, 5, 6, 7); \
            acc[ai][bj][m][n] = __builtin_amdgcn_mfma_scale_f32_16x16x128_f8f6f4(bw_, aw_, acc[ai][bj][m][n], 0, 0, 0, FP8_SCALE, 0, FP8_SCALE); } } \
        else { _Pragma("unroll") for (int m = 0; m < 4; ++m) _Pragma("unroll") for (int n = 0; n < 2; ++n) _Pragma("unroll") for (int k = 0; k < 2; ++k) \
            acc[ai][bj][m][n] = __builtin_amdgcn_mfma_f32_16x16x32_bf16(Bt[n][k], At[m][k], acc[ai][bj][m][n], 0, 0, 0); } \
        __builtin_amdgcn_s_setprio(0); } while (0)
#define PG8_WAIT_V(n) asm volatile("s_waitcnt vmcnt(" #n ")" ::: "memory")
#define PG8_WAIT_L(n) asm volatile("s_waitcnt lgkmcnt(" #n ")" ::: "memory")
#define PG8_BAR __builtin_amdgcn_s_barrier()
#define PG8_SCHED __builtin_amdgcn_sched_barrier(0)
    Unit cur, nxt; int ui = 0;
    if (!S.next(0, cur)) return;
    f32x4 acc[2][2][4][2];
#pragma unroll
    for (int a = 0; a < 2; ++a)
#pragma unroll
        for (int b = 0; b < 2; ++b)
#pragma unroll
            for (int m = 0; m < 4; ++m)
#pragma unroll
                for (int n = 0; n < 2; ++n) acc[a][b][m][n] = (f32x4){0.f, 0.f, 0.f, 0.f};
    bf16x8 At[4][2], B0[2][2], B1[2][2];
    unsigned c00 = 0, c01 = 0, c10 = 0, c11 = 0;
#define PG8_MKOFF(U, o00, o01, o10, o11) do { const LAS int* rl_ = (const LAS int*)(lds + (U).rows) + R0; \
        o00 = (unsigned)rl_[0] * lda + (unsigned)C2; o01 = (unsigned)rl_[64] * lda + (unsigned)C2; o10 = (unsigned)rl_[HALF] * lda + (unsigned)C2; o11 = (unsigned)rl_[HALF + 64] * lda + (unsigned)C2; } while (0)
    if (GATHER) { PG8_MKOFF(cur, c00, c01, c10, c11); }
    const char* cA = cur.A; const char* cB = cur.B; int nt = cur.nt;
    PG8_STAGEB(PG8_SB(0, 0), cB); PG8_STAGEB(PG8_SB(0, 1), cB + hstepB); PG8_STAGEA(PG8_SA(0, 0), cA, 0, c00, c01); PG8_STAGEA(PG8_SA(0, 1), cA, 1, c10, c11);
    if (wr == 1) PG8_BAR;
    PG8_WAIT_V(2); PG8_BAR;
    PG8_STAGEB(PG8_SB(1, 0), cB + kstep); PG8_STAGEA(PG8_SA(1, 0), cA + kstep, 0, c00, c01); PG8_STAGEB(PG8_SB(1, 1), cB + hstepB + kstep);
    PG8_WAIT_V(6); PG8_BAR;
    Unit nx2 = cur; bool hn = false; if constexpr (Sched::LAZY) hn = S.next(1, nxt);
    for (;;) {
        bool has_next; if constexpr (Sched::LAZY) has_next = hn; else has_next = S.next(ui + 1, nxt);
        const char* nA = has_next ? nxt.A : cA; const char* nB = has_next ? nxt.B : cB;
#pragma nounroll
        for (int t = 0; t < nt; t += 2) {
            const bool last = (t == nt - 2);
            if (GATHER) asm volatile("" : "+v"(c00), "+v"(c01), "+v"(c10), "+v"(c11)); asm volatile("" : "+v"(offA), "+v"(offB));
            const char* a1 = cA + (size_t)(t + 1) * kstep;
            const char* a2 = last ? nA : cA + (size_t)(t + 2) * kstep; const char* b2 = last ? nB : cB + (size_t)(t + 2) * kstep;
            const char* a3 = a2 + kstep; const char* b3 = b2 + kstep;
            PG8_LDB(B0, 0, 0); PG8_LDB(B1, 0, 1); PG8_SCHED; PG8_LDA(At, 0, 0); PG8_STAGEA(PG8_SA(1, 1), a1, 1, c10, c11);
            if (GATHER) { if (last && has_next) { PG8_MKOFF(nxt, c00, c01, c10, c11); } }
            PG8_WAIT_V(8); PG8_WAIT_L(0); PG8_BAR; PG8_MMA(0, 0, At, B0); PG8_MMA(0, 1, At, B1); PG8_BAR; PG8_SCHED;
            PG8_LDA(At, 0, 1); PG8_STAGEB(PG8_SB(0, 0), b2); PG8_STAGEB(PG8_SB(0, 1), b2 + hstepB); PG8_STAGEA(PG8_SA(0, 0), a2, 0, c00, c01);
            PG8_WAIT_V(8); PG8_WAIT_L(0); PG8_BAR; PG8_MMA(1, 0, At, B0); PG8_MMA(1, 1, At, B1); PG8_BAR; PG8_SCHED;
            PG8_LDB(B0, 1, 0); PG8_LDB(B1, 1, 1); PG8_SCHED; PG8_LDA(At, 1, 0); PG8_STAGEA(PG8_SA(0, 1), a2, 1, c10, c11);
            PG8_WAIT_V(8); PG8_WAIT_L(0); PG8_BAR; PG8_MMA(0, 0, At, B0); PG8_MMA(0, 1, At, B1); PG8_BAR; PG8_SCHED;
            PG8_LDA(At, 1, 1); PG8_STAGEB(PG8_SB(1, 0), b3); PG8_STAGEB(PG8_SB(1, 1), b3 + hstepB); PG8_STAGEA(PG8_SA(1, 0), a3, 0, c00, c01);
            PG8_WAIT_V(8); PG8_WAIT_L(0); PG8_BAR; PG8_MMA(1, 0, At, B0); PG8_MMA(1, 1, At, B1); PG8_BAR; PG8_SCHED;
        }
        if (Sched::TOUCH && has_next && wid < 3) {
            int lt_ = lane; asm volatile("" : "+v"(lt_)); const int idx_ = wid * 64 + lt_, row_ = 32 * (cur.pm & 7) + idx_ / 6, ln_ = idx_ % 6;
            __builtin_amdgcn_global_load_lds((const unsigned*)(nB + (size_t)row_ * ldb + 256 + ln_ * 128), (LAS unsigned*)(lds + 131072 + wid * 1024), 16, 0, 0); }
        int pend_ = 0; if constexpr (Sched::LAZY) pend_ = S.predraw();
        if (wr == 0) PG8_BAR;
        { int le_ = lane; asm volatile("" : "+v"(le_)); E(acc, cur, wr, wc, le_ & 15, le_ >> 4); }
        if constexpr (Sched::LAZY) { if (has_next) hn = S.next_pre(ui + 2, nx2, pend_); }
        if (GATHER) { if (has_next) { asm volatile("" ::: "memory"); PG8_MKOFF(nxt, c00, c01, c10, c11); } }
        if (!has_next) break;
        if (!(cur.aux & (1 << 30))) {
#pragma unroll
        for (int a = 0; a < 2; ++a)
#pragma unroll
            for (int b = 0; b < 2; ++b)
#pragma unroll
                for (int m = 0; m < 4; ++m)
#pragma unroll
                    for (int n = 0; n < 2; ++n) acc[a][b][m][n] = (f32x4){0.f, 0.f, 0.f, 0.f};
        }
        cur = nxt; cA = nA; cB = nB; nt = cur.nt; ++ui; if constexpr (Sched::LAZY) nxt = nx2;
        if (wr == 1) PG8_BAR;
    }
    PG8_WAIT_V(0);
    PG8_BAR;
#undef PG8_SA
#undef PG8_SB
#undef PG8_STAGE2P
#undef PG8_STAGEB
#undef PG8_LDA
#undef PG8_LDB
#undef PG8_MMA
#undef PG8_WAIT_V
#undef PG8_WAIT_L
#undef PG8_BAR
#undef PG8_SCHED
#undef PG8_MKOFF
#undef PG8_STAGEA
}
}

#define XB_TMO      128
#define XB_XCNT(j)  (256  + 64 * (j))
#define XB_XSUB(j)  (1280 + 64 * (j))
#define XB_XGEN(j)  (2304 + 64 * (j))
#define XB_TOP      3328
#define XB_TOPGEN   3392
#define XCD_BAR_WORDS 3456
#define XB_SPIN_CAP (1u << 18)
__device__ __forceinline__ unsigned xb_ld(unsigned* p)              { return __hip_atomic_load(p, __ATOMIC_RELAXED, __HIP_MEMORY_SCOPE_AGENT); }
__device__ __forceinline__ unsigned xb_add(unsigned* p, unsigned v) { return __hip_atomic_fetch_add(p, v, __ATOMIC_RELAXED, __HIP_MEMORY_SCOPE_AGENT); }
__device__ __forceinline__ unsigned xb_xcc_id() { return (unsigned)__builtin_amdgcn_s_getreg((3 << 11) | 20) & 0xFu; }
#define XB_SPIN(cond, bar) do { unsigned _sp = 0; while (cond) { __builtin_amdgcn_s_sleep(1); \
    if ((++_sp & 255u) == 0u) { if (xb_ld(&(bar)[XB_TMO])) break; if (_sp > XB_SPIN_CAP) { atomicAdd(&(bar)[XB_TMO], 1u); break; } } } } while (0)
struct XcdBarrier { unsigned* bar; unsigned x; volatile LAS unsigned* st; int wave; };
__device__ __forceinline__ XcdBarrier xcd_barrier_post(unsigned* bar, volatile LAS unsigned* st, int wave) {
    XcdBarrier b; b.bar = bar; b.x = xb_xcc_id(); b.st = st; b.wave = wave;
    if (wave == 0 && lane_id() == 0) (void)xb_add(&bar[XB_XCNT(b.x)], 1u);
    return b;
}
__device__ __forceinline__ void xcd_barrier_complete(unsigned* bar, unsigned x, unsigned& nloc, unsigned& nx) {
    const unsigned G = gridDim.x * gridDim.y * gridDim.z;
    unsigned sum, cnt, mine, sp = 0u;
    for (;;) {
        sum = 0u; cnt = 0u; mine = 0u;
#pragma unroll
        for (unsigned j = 0; j < 16; ++j) { const unsigned c = xb_ld(&bar[XB_XCNT(j)]); sum += c; cnt += (c > 0u) ? 1u : 0u; mine = (j == x) ? c : mine; }
        if (sum == G) break;
        __builtin_amdgcn_s_sleep(1);
        if ((++sp & 255u) == 0u) { if (xb_ld(&bar[XB_TMO])) break; if (sp > XB_SPIN_CAP) { atomicAdd(&bar[XB_TMO], 1u); break; } }
    }
    nloc = mine > 0u ? mine : 1u; nx = cnt > 0u ? cnt : 1u;
}
__device__ __forceinline__ void xcd_barrier(const XcdBarrier& b) {
    asm volatile("s_waitcnt vmcnt(0)" ::: "memory");
    __syncthreads();
    if (b.wave == 0 && lane_id() == 0) {
        unsigned* bar = b.bar;
        __builtin_amdgcn_s_waitcnt(0);
        unsigned nloc = b.st[0], nx = b.st[1];
        if (nloc == 0u) { xcd_barrier_complete(bar, b.x, nloc, nx); b.st[0] = nloc; b.st[1] = nx; }
        const unsigned old = xb_add(&bar[XB_XSUB(b.x)], 1u);
        const unsigned gen = old / nloc;
        if (old + 1u == (gen + 1u) * nloc) {
            __builtin_amdgcn_fence(__ATOMIC_RELEASE, "agent");
            asm volatile("s_waitcnt vmcnt(0)" ::: "memory");
            const unsigned og = xb_add(&bar[XB_TOP], 1u);
            const unsigned tg = og / nx;
            if (og + 1u == (tg + 1u) * nx) xb_add(&bar[XB_TOPGEN], 1u);
            else XB_SPIN(xb_ld(&bar[XB_TOPGEN]) == tg, bar);
            __builtin_amdgcn_fence(__ATOMIC_ACQUIRE, "agent");
            xb_add(&bar[XB_XGEN(b.x)], 1u);
            asm volatile("s_waitcnt vmcnt(0)" ::: "memory");
        } else {
            XB_SPIN(xb_ld(&bar[XB_XGEN(b.x)]) == gen, bar);
            __builtin_amdgcn_fence(__ATOMIC_ACQUIRE, "agent");
            asm volatile("s_waitcnt vmcnt(0)" ::: "memory");
        }
    }
    __syncthreads();
}

struct Args { const float* in[20]; float* out; unsigned char* ws; };
typedef const __attribute__((address_space(4))) Args* KArgs;
__device__ __forceinline__ KArgs kargs() { KArgs k = (KArgs)__builtin_amdgcn_kernarg_segment_ptr(); asm volatile("" : "+s"(k)); return k; }
constexpr int NWAVES = 8, NTHREADS = 512;

struct Ctx {
    LAS unsigned char* lds;
    int tid, lane, wave, G, vcu;
    unsigned char* ws;
};
__device__ __forceinline__ Ctx make_ctx(int wave) {
    extern __shared__ __attribute__((aligned(16))) unsigned char lds_dyn[];
    Ctx F; int l = lane_id(); asm volatile("" : "+v"(l)); F.lds = (LAS unsigned char*)lds_dyn; F.lane = l; F.wave = wave; F.tid = wave * 64 + l;
    F.G = (int)gridDim.x; { const int bx = (int)blockIdx.x; F.vcu = (F.G % 8 == 0) ? (bx % 8) * (F.G / 8) + bx / 8 : bx; }
    F.ws = kargs()->ws; return F; }
__device__ __forceinline__ Ctx ctx_refresh(const Ctx& F0) { return make_ctx(F0.wave); }


#ifdef CKSUM
__device__ __forceinline__ void ck_region(const Ctx& F, int k, const void* base, size_t bytes) {
    const GAS u32x4* p = (const GAS u32x4*)base; const size_t n = bytes / 16; unsigned acc = 0u;
    const int tid_ = F.wave * 64 + lane_id();
    for (size_t i = (size_t)blockIdx.x * NTHREADS + tid_; i < n; i += (size_t)F.G * NTHREADS) { const u32x4 v = __builtin_nontemporal_load(p + i); acc += v.x * 3u + v.y * 5u + v.z * 7u + v.w * 11u + (unsigned)i; }
#pragma unroll
    for (int o = 1; o < 64; o <<= 1) acc += (unsigned)sxi((int)acc, o);
    if (lane_id() == 0) atomicAdd((unsigned*)(F.ws + WS_CTL) + 8192 + 64 * k, acc);
}
#define CK(k, base, bytes) ck_region(F, k, base, bytes)
#else
#define CK(k, base, bytes) do {} while (0)
#endif
__device__ __forceinline__ void p0_transpose64(const float* W, int ldw, int k0, int n0, bf16_t* dst, int ldt, LAS float* scr, int lane) {
    f32x4 v[16];
#pragma unroll
    for (int i = 0; i < 16; ++i) { const int kk = 4 * i + (lane >> 4); v[i] = *(const GAS f32x4*)(W + (size_t)(k0 + kk) * ldw + n0 + 4 * (lane & 15)); }
#pragma unroll
    for (int i = 0; i < 16; ++i) { const int kk = 4 * i + (lane >> 4); LAS float* s = scr + kk * 65 + 4 * (lane & 15); s[0] = v[i][0]; s[1] = v[i][1]; s[2] = v[i][2]; s[3] = v[i][3]; }
    LDS_WAIT(); asm volatile("" ::: "memory");
    const int c = lane & 7;
#pragma unroll
    for (int j = 0; j < 8; ++j) { const int n = (lane >> 3) + 8 * j; const LAS float* s = scr + (8 * c) * 65 + n;
        u32x4 o; o.x = cvt_pk_bf16(s[0 * 65], s[1 * 65]); o.y = cvt_pk_bf16(s[2 * 65], s[3 * 65]); o.z = cvt_pk_bf16(s[4 * 65], s[5 * 65]); o.w = cvt_pk_bf16(s[6 * 65], s[7 * 65]);
        *(GAS u32x4*)(dst + (size_t)n * ldt + 8 * c) = o; }
    LDS_WAIT(); asm volatile("" ::: "memory");
}
__device__ __forceinline__ void p0_transpose64_fp8(const float* W, int ldw, int k0, int n0, unsigned char* dst8, int ldt, LAS float* scr, int lane, float scale) {
    f32x4 v[16];
#pragma unroll
    for (int i = 0; i < 16; ++i) { const int kk = 4 * i + (lane >> 4); v[i] = *(const GAS f32x4*)(W + (size_t)(k0 + kk) * ldw + n0 + 4 * (lane & 15)); }
#pragma unroll
    for (int i = 0; i < 16; ++i) { const int kk = 4 * i + (lane >> 4); LAS float* s = scr + kk * 65 + 4 * (lane & 15); s[0] = v[i][0] * scale; s[1] = v[i][1] * scale; s[2] = v[i][2] * scale; s[3] = v[i][3] * scale; }
    LDS_WAIT(); asm volatile("" ::: "memory");
    const int c = lane & 3;
#pragma unroll
    for (int j = 0; j < 4; ++j) { const int n = (lane >> 2) + 16 * j; const LAS float* s = scr + (16 * c) * 65 + n;
        u32x4 o;
#pragma unroll
        for (int q = 0; q < 4; ++q) { int w = __builtin_amdgcn_cvt_pk_fp8_f32(s[(4 * q) * 65], s[(4 * q + 1) * 65], 0, false); w = __builtin_amdgcn_cvt_pk_fp8_f32(s[(4 * q + 2) * 65], s[(4 * q + 3) * 65], w, true); o[q] = (unsigned)w; }
        *(GAS u32x4*)(dst8 + (size_t)n * ldt + 16 * c) = o; }
    LDS_WAIT(); asm volatile("" ::: "memory");
}
__device__ __forceinline__ int t5_bucket(int rel) {
    int ret = rel > 0 ? 16 : 0; const int n = rel < 0 ? -rel : rel;
    if (n < 8) return ret + n;
    const float nf = (float)n;
    int large = 8 + (int)(logf(nf / 8.0f) / logf(128.0f) * 8.0f);
    large = large < 15 ? large : 15;
    return ret + large;
}
__device__ __forceinline__ void p0_prologue(const Ctx& F0) {
    const KArgs ap = kargs();
    const Ctx F = ctx_refresh(F0);
    LAS float* scr = (LAS float*)(F.lds) + F.wave * (64 * 65);
    const int gw = F.vcu * NWAVES + F.wave, NGW = F.G * NWAVES;
    bf16_t* WGU_T = (bf16_t*)(F.ws + WS_WGU_T); bf16_t* WDN_T = (bf16_t*)(F.ws + WS_WDN_T); bf16_t* WIN_T = (bf16_t*)(F.ws + WS_WIN_T);
    bf16_t* WMEM_T = (bf16_t*)(F.ws + WS_WMEM_T); bf16_t* WABC_T = (bf16_t*)(F.ws + WS_WABC_T); bf16_t* WOUT_T = (bf16_t*)(F.ws + WS_WOUT_T);
    constexpr int I_IN = 16 * 116, I_MEM = 256, I_A = 8 * 16, I_B = 4 * 16, I_C = 8 * 16, I_O = 256;
    constexpr int NITEMS = I_IN + I_MEM + I_A + I_B + I_C + I_O;
    bf16_t* XN = (bf16_t*)(F.ws + WS_XN); bf16_t* MEMN = (bf16_t*)(F.ws + WS_MEMN);
    const int c = (int)blockIdx.x, ntr = (NITEMS - c + 255) >> 8;
    auto quad_load = [&](const float* src, const float* gain, int m, int nr, f32x4 (&v)[4][4], f32x4 (&gg)[4]) {
        const GAS f32x4* xa = (const GAS f32x4*)(src + (size_t)m * D) + F.lane; const GAS f32x4* gr = (const GAS f32x4*)gain + F.lane;
#pragma unroll
        for (int q = 0; q < 4; ++q)
#pragma unroll
            for (int j = 0; j < 4; ++j) v[q][j] = xa[(q < nr ? q : 0) * (D / 4) + 64 * j];
#pragma unroll
        for (int j = 0; j < 4; ++j) gg[j] = gr[64 * j]; };
    auto quad_finish = [&](unsigned char* dst, int m, int nr, const f32x4 (&v)[4][4], const f32x4 (&gg)[4]) {
        float ss[4];
#pragma unroll
        for (int q = 0; q < 4; ++q) { float a_ = 0.f;
#pragma unroll
            for (int j = 0; j < 4; ++j) a_ += (v[q][j].x * v[q][j].x + v[q][j].y * v[q][j].y) + (v[q][j].z * v[q][j].z + v[q][j].w * v[q][j].w);
            ss[q] = a_; }
#pragma unroll
        for (int o = 1; o < 64; o <<= 1) {
#pragma unroll
            for (int q = 0; q < 4; ++q) ss[q] += sx(ss[q], o); }
        GAS unsigned* oa = (GAS unsigned*)(dst + (size_t)m * D) + F.lane;
#pragma unroll
        for (int j = 0; j < 4; ++j) {
#pragma unroll
            for (int q = 0; q < 4; ++q) { const float r_ = 1.0f / sqrtf(ss[q] * (1.f / D) + RMS_EPS);
                int w = __builtin_amdgcn_cvt_pk_fp8_f32(v[q][j].x * r_ * gg[j].x, v[q][j].y * r_ * gg[j].y, 0, false); w = __builtin_amdgcn_cvt_pk_fp8_f32(v[q][j].z * r_ * gg[j].z, v[q][j].w * r_ * gg[j].w, w, true);
                if (q < nr) oa[q * (D / 4) + 64 * j] = (unsigned)w; } } };
    {
        const int m0 = ((2 * F.wave) * 256 + c) * 4, m1 = ((2 * F.wave + 1) * 256 + c) * 4;
        f32x4 va[4][4], vb[4][4], ga[4], gb[4];
        quad_load(ap->in[0], ap->in[2], m0, 4, va, ga); quad_load(ap->in[0], ap->in[2], m1, 4, vb, gb);
        quad_finish((unsigned char*)XN, m0, 4, va, ga); quad_finish((unsigned char*)XN, m1, 4, vb, gb);
    }
    LAS unsigned* ctr = (LAS unsigned*)(F.lds + LDS_MISC) + 41;
    for (;;) {
        unsigned dr = 0u; if (lane_id() == 0) dr = __hip_atomic_fetch_add(ctr, 1u, __ATOMIC_RELAXED, __HIP_MEMORY_SCOPE_WORKGROUP);
        const int itl = __builtin_amdgcn_readfirstlane((int)dr); if (itl >= ntr + 1) break;
        if (itl < ntr) {
            int r = c + 256 * itl;
            if (r < I_IN) { const int kb = r / 116, nb = r % 116; p0_transpose64_fp8(ap->in[4], IN_COLS, kb * 64, nb * 64, (unsigned char*)WIN_T + (size_t)(nb * 64) * 1024 + kb * 64, 1024, scr, F.lane, 64.0f); continue; } r -= I_IN;
            if (r < I_MEM) { const int kb = r >> 4, nb = r & 15; p0_transpose64_fp8(ap->in[5], 1024, kb * 64, nb * 64, (unsigned char*)WMEM_T + (size_t)(nb * 64) * 1024 + kb * 64, 1024, scr, F.lane, 64.0f); continue; } r -= I_MEM;
            if (r < I_A) { const int kb = r >> 4, nb = r & 15; p0_transpose64(ap->in[8], 1024, kb * 64, nb * 64, WABC_T + (size_t)(nb * 64) * ABC_LD + 0 + kb * 64, ABC_LD, scr, F.lane); continue; } r -= I_A;
            if (r < I_B) { const int kb = r >> 4, nb = r & 15; p0_transpose64(ap->in[9], 1024, kb * 64, nb * 64, WABC_T + (size_t)(nb * 64) * ABC_LD + 512 + kb * 64, ABC_LD, scr, F.lane); continue; } r -= I_B;
            if (r < I_C) { const int kb = r >> 4, nb = r & 15; p0_transpose64(ap->in[10], 1024, kb * 64, nb * 64, WABC_T + (size_t)(nb * 64) * ABC_LD + 768 + kb * 64, ABC_LD, scr, F.lane); continue; } r -= I_C;
            { const int kb = r >> 4, nb = r & 15; p0_transpose64(ap->in[11], 1024, kb * 64, nb * 64, WOUT_T + (size_t)(nb * 64) * 1024 + kb * 64, 1024, scr, F.lane); }
            continue;
        }
        { f32x4 vm[4][4], gm[4]; quad_load(ap->in[1], ap->in[3], c * 2, 2, vm, gm); quad_finish((unsigned char*)MEMN, c * 2, 2, vm, gm); }
    }
    const int gt = F.vcu * NTHREADS + F.tid, NGT = F.G * NTHREADS;
    float* t5 = (float*)(F.ws + WS_MISC + MO_T5); float* rp = (float*)(F.ws + WS_MISC + MO_RPB);
    for (int i = gt; i < 12 * T5_LD; i += NGT) { const int gh = i / T5_LD, j = i % T5_LD, rel = j - 79, g = gh >> 2; const int dil = g == 0 ? 1 : (g == 1 ? 4 : 16);
        float v = -INFINITY; if (rel >= -64 && rel <= 64) v = ap->in[7][t5_bucket(rel * dil) * 12 + gh] * LOG2E; t5[i] = v; }
    for (int i = gt; i < 8 * RPB_LD; i += NGT) { const int h = i / RPB_LD, j = i % RPB_LD - RPB_OFF; float v = 0.f; if (j >= 0 && j < 465) v = ap->in[6][h * 465 + j] * LOG2E; rp[i] = v; }
}

struct CvItem { const float* src; int ldw; unsigned char* dst; };
__device__ __forceinline__ CvItem cv_decode(int r, const float* GU, const float* DN, unsigned char* WGU8, unsigned char* WDN8) {
    constexpr int I_GU = 32 * 16 * 32; CvItem I;
    if (r < I_GU) { const int e = r >> 9, q = r & 511, kb = q >> 5, nb = q & 31, n0 = nb * 64; const int bj = n0 >> 10, rem = n0 & 1023, pn = rem >> 7, c0 = rem & 127;
        I.src = GU + (size_t)e * 1024 * 2048 + (size_t)(kb * 64) * 2048 + n0; I.ldw = 2048; I.dst = WGU8 + ((size_t)e * 2048 + pn * 256 + bj * 128 + c0) * 1024 + kb * 64; }
    else { r -= I_GU; const int e = r >> 8, q = r & 255, kb = q >> 4, nb = q & 15;
        I.src = DN + (size_t)e * 1024 * 1024 + (size_t)(kb * 64) * 1024 + nb * 64; I.ldw = 1024; I.dst = WDN8 + ((size_t)e * 1024 + nb * 64) * 1024 + kb * 64; }
    return I;
}
__device__ __forceinline__ void cv_load(const CvItem& I, f32x4 (&v)[16], int lane) {
#pragma unroll
    for (int i = 0; i < 16; ++i) { const int kk = 4 * i + (lane >> 4); v[i] = *(const GAS f32x4*)(I.src + (size_t)kk * I.ldw + 4 * (lane & 15)); }
}
__device__ __forceinline__ void cv_finish(const CvItem& I, const f32x4 (&v)[16], LAS float* scr, int lane) {
#pragma unroll
    for (int i = 0; i < 16; ++i) { const int kk = 4 * i + (lane >> 4); LAS float* s = scr + kk * 65 + 4 * (lane & 15); s[0] = v[i][0] * 64.0f; s[1] = v[i][1] * 64.0f; s[2] = v[i][2] * 64.0f; s[3] = v[i][3] * 64.0f; }
    LDS_WAIT(); asm volatile("" ::: "memory");
    const int c = lane & 3;
#pragma unroll
    for (int j = 0; j < 4; ++j) { const int n = (lane >> 2) + 16 * j; const LAS float* s = scr + (16 * c) * 65 + n;
        u32x4 o;
#pragma unroll
        for (int q = 0; q < 4; ++q) { int w = __builtin_amdgcn_cvt_pk_fp8_f32(s[(4 * q) * 65], s[(4 * q + 1) * 65], 0, false); w = __builtin_amdgcn_cvt_pk_fp8_f32(s[(4 * q + 2) * 65], s[(4 * q + 3) * 65], w, true); o[q] = (unsigned)w; }
        __builtin_nontemporal_store(o, (GAS u32x4*)(I.dst + (size_t)n * 1024 + 16 * c)); }
    LDS_WAIT(); asm volatile("" ::: "memory");
}
constexpr int CV_NIT = 32 * 16 * 32 + 32 * 16 * 16, CV_ROUNDS = 32, CV_MAIN = CV_ROUNDS * 768, CV_TAIL = 0, CV_X0 = 5;
static_assert(CV_NIT - CV_MAIN == CV_TAIL * (CV_X0 * 32) * 8, "conversion tail: CV_TAIL items per wave of the GEMM workgroups");
__device__ __forceinline__ void p1_convert_experts(const Ctx& F0) {
    const KArgs ap = kargs();
    const Ctx F = ctx_refresh(F0);
    const int c = (int)blockIdx.x, x = c & 7;
    LAS float* scr = (LAS float*)(F.lds) + F.wave * (64 * 65);
    const float* GU = ap->in[15]; const float* DN = ap->in[17];
    unsigned char* WGU8 = (unsigned char*)(F.ws + WS_WGU_T); unsigned char* WDN8 = (unsigned char*)(F.ws + WS_WDN_T);
    const bool conv = x >= CV_X0; const int q0 = conv ? ((x - CV_X0) + (8 - CV_X0) * (c >> 3)) * NWAVES : ((c >> 3) * CV_X0 + x) * NWAVES, nm = (conv ? CV_ROUNDS : CV_TAIL) * NWAVES;
    LAS unsigned* ctr = (LAS unsigned*)(F.lds + LDS_MISC) + 40;
    auto draw = [&]() -> int { unsigned m = 0u; if (lane_id() == 0) m = __hip_atomic_fetch_add(ctr, 1u, __ATOMIC_RELAXED, __HIP_MEMORY_SCOPE_WORKGROUP); m = (unsigned)__builtin_amdgcn_readfirstlane((int)m);
        if ((int)m >= nm) return -1; const int j = (int)m >> 3, s_ = (int)m & 7; return conv ? j * 768 + ((q0 + s_ + 37 * j) % 768) : CV_MAIN + j * (CV_X0 * 256) + q0 + s_; };
    int it = draw(); if (it < 0) return;
    CvItem I = cv_decode(it, GU, DN, WGU8, WDN8); f32x4 va[16], vb[16]; cv_load(I, va, F.lane);
    for (;;) {
        const int itn = draw(); const bool hn = itn >= 0; CvItem In = I;
        if (hn) { In = cv_decode(itn, GU, DN, WGU8, WDN8); cv_load(In, vb, F.lane); }
        cv_finish(I, va, scr, F.lane);
        if (!hn) break;
        I = In;
#pragma unroll
        for (int i = 0; i < 16; ++i) va[i] = vb[i];
    }
}

struct P1Sched {
    static constexpr bool LAZY = false;
    static constexpr bool TOUCH = true;
    unsigned* ctr; LAS int* slot; int wave, x; const char* XN; const char* WIN; const char* MEMN; const char* WMEM;
    __device__ __forceinline__ bool next(int i, pg8::Unit& u) const {
        if (x >= CV_X0) return false;
        constexpr int NST = (8 - CV_X0) * 233, PER = (NST + CV_X0 - 1) / CV_X0;
        const int L = i * 32 + ((int)blockIdx.x >> 3); int y = x, idx = L;
        if (L >= 233) { const int s_ = L - 233, g = PER * x + s_; if (s_ >= PER || g >= NST) return false; y = CV_X0 + g / 233; idx = g % 233; }
        u.rows = 0; u.nt = 8;
        if (idx == 232) { u.pm = y >> 2; u.pn = y & 3; u.A = MEMN + (size_t)u.pm * 256 * 1024; u.B = WMEM + (size_t)u.pn * 256 * 1024; u.aux = 3; u.scale = 1.f; return true; }
        u.pm = 8 * y + (idx & 7); u.pn = idx >> 3;
        u.A = XN + (size_t)u.pm * 256 * 1024; u.B = WIN + (size_t)u.pn * 256 * 1024;
        const int pn = u.pn;
        if (pn < 2 || (pn >= 6 && pn < 9)) { u.aux = 1; u.scale = QS64; } else if (pn == 15 || pn == 16) { u.aux = 1; u.scale = QS128; } else if (pn >= 17) { u.aux = 2; u.scale = 1.f; } else { u.aux = 0; u.scale = 1.f; }
        u.scale = __builtin_bit_cast(float, __builtin_amdgcn_readfirstlane(__builtin_bit_cast(int, u.scale)));
        return true;
    }
};
struct P1Epi {
    bf16_t* PROJ; bf16_t* MKV;
    __device__ __forceinline__ void operator()(const f32x4 (&acc)[2][2][4][2], const pg8::Unit& u, int wr, int wc, int fr, int fq) const {
        bf16_t* O = u.aux == 3 ? MKV : PROJ + ((size_t)(u.pm * 29 + u.pn) << 16); const int ldo = u.aux == 3 ? 1024 : 256;
        const int row0 = (u.aux == 3 ? u.pm * 256 : 0) + wr * 64 + fr, col0 = (u.aux == 3 ? u.pn * 256 : 0) + wc * 32 + 8 * fq; const float sc = u.scale; const bool sg = u.aux == 2;
#pragma unroll
        for (int ai = 0; ai < 2; ++ai)
#pragma unroll
            for (int m = 0; m < 4; ++m) { bf16_t* rowp = O + (size_t)(row0 + ai * 128 + m * 16) * ldo + col0;
#pragma unroll
                for (int bj = 0; bj < 2; ++bj) { f32x4 v0 = acc[ai][bj][m][0], v1 = acc[ai][bj][m][1];
                    if (sg) {
                        unsigned w0 = 0u, w1 = 0u;
#pragma unroll
                        for (int j = 0; j < 4; ++j) { w0 = __builtin_amdgcn_cvt_pk_u8_f32(fmaxf(255.0f * fast_sigmoid(v0[j]), 1.0f), j, w0); w1 = __builtin_amdgcn_cvt_pk_u8_f32(fmaxf(255.0f * fast_sigmoid(v1[j]), 1.0f), j, w1); }
                        *(GAS u32x2*)((unsigned char*)O + (size_t)(row0 + ai * 128 + m * 16) * 256 + col0 + bj * 128) = (u32x2){w0, w1}; continue; }
                    v0 = v0 * sc; v1 = v1 * sc;
                    u32x4 w; w.x = cvt_pk_bf16(v0[0], v0[1]); w.y = cvt_pk_bf16(v0[2], v0[3]); w.z = cvt_pk_bf16(v1[0], v1[1]); w.w = cvt_pk_bf16(v1[2], v1[3]);
                    *(GAS u32x4*)(rowp + bj * 128) = w; } }
    }
};

template <int DH> __device__ __forceinline__ int k_addr(int key, int c) {
    if (DH == 64) return key * 128 + ((c ^ ((key >> 1) & 7)) << 4);
    else return key * 256 + ((c ^ (key & 15)) << 4);
}
template <int DH> __device__ __forceinline__ int v_addr(int key, int c) {
    if (DH == 64) return key * 128 + ((c ^ (((key >> 1) & 3) << 1)) << 4);
    else return key * 256 + ((c ^ ((key & 7) << 1)) << 4);
}
__device__ __forceinline__ s16x4 vtr(const LAS unsigned char* p) { return __builtin_bit_cast(s16x4, __builtin_amdgcn_ds_read_tr16_b64_v4i16((LAS s16x4*)p)); }

template <int DH> __device__ __forceinline__ f32x4 qk_tile(const LAS unsigned char* Kl, int kbase, const bf16x8 (&qf)[DH / 32], int i, int g) {
    f32x4 acc = (f32x4){0.f, 0.f, 0.f, 0.f}; const int key = kbase + i;
#pragma unroll
    for (int s = 0; s < DH / 32; ++s) { const bf16x8 kf = *(const LAS bf16x8*)(Kl + k_addr<DH>(key, 4 * s + g)); acc = __builtin_amdgcn_mfma_f32_16x16x32_bf16(kf, qf[s], acc, 0, 0, 0); }
    return acc;
}
template <int DH> __device__ __forceinline__ void pv_step(f32x4 (&o)[DH / 16], const LAS unsigned char* Vl, int vbase, int vbase2, bf16x8 pf, int i, int g) {
    const int k0 = vbase + 4 * g + (i >> 2), k1 = vbase2 + 4 * g + (i >> 2); const int sub = (i & 3) >> 1, b8 = 8 * (i & 1);
#pragma unroll
    for (int n = 0; n < DH / 16; ++n) {
        const s16x4 lo = vtr(Vl + v_addr<DH>(k0, 2 * n + sub) + b8), hi = vtr(Vl + v_addr<DH>(k1, 2 * n + sub) + b8);
        const bf16x8 vf = (bf16x8){lo[0], lo[1], lo[2], lo[3], hi[0], hi[1], hi[2], hi[3]};
        o[n] = __builtin_amdgcn_mfma_f32_16x16x32_bf16(vf, pf, o[n], 0, 0, 0);
    }
}
template <int OFF> __device__ __forceinline__ void pv_step64i(f32x4 (&o)[4], const LAS unsigned char* const (&vb)[4], bf16x8 pf) {
#pragma unroll
    for (int n = 0; n < 4; ++n) { const s16x4 lo = vtr(vb[n] + OFF), hi = vtr(vb[n] + OFF + 16 * 128);
        const bf16x8 vf = (bf16x8){lo[0], lo[1], lo[2], lo[3], hi[0], hi[1], hi[2], hi[3]};
        o[n] = __builtin_amdgcn_mfma_f32_16x16x32_bf16(vf, pf, o[n], 0, 0, 0); }
}
__device__ __forceinline__ bf16x8 pack_p(const f32x4& a, const f32x4& b) {
    u32x4 w; w.x = cvt_pk_bf16(a[0], a[1]); w.y = cvt_pk_bf16(a[2], a[3]); w.z = cvt_pk_bf16(b[0], b[1]); w.w = cvt_pk_bf16(b[2], b[3]); return __builtin_bit_cast(bf16x8, w);
}
template <int NT> __device__ __forceinline__ void softmax_tiles(f32x4 (&s)[NT], float& m, float& l) {
    float mx = -INFINITY;
#pragma unroll
    for (int t = 0; t < NT; ++t) mx = fmaxf(fmaxf(fmaxf(mx, s[t][0]), fmaxf(s[t][1], s[t][2])), s[t][3]);
    mx = fmaxf(mx, sx(mx, 16)); mx = fmaxf(mx, sx(mx, 32));
    float sum = 0.f;
#pragma unroll
    for (int t = 0; t < NT; ++t) {
#pragma unroll
        for (int r = 0; r < 4; ++r) { const float p = __builtin_amdgcn_exp2f(s[t][r] - mx); s[t][r] = p; sum += p; } }
    sum += sx(sum, 16); sum += sx(sum, 32);
    m = mx; l = sum;
}
template <int DH> __device__ __forceinline__ void load_q(bf16x8 (&qf)[DH / 32], const bf16_t* qrow, int g) {
#pragma unroll
    for (int s = 0; s < DH / 32; ++s) qf[s] = *(const GAS bf16x8*)(qrow + 32 * s + 8 * g);
}
template <int DH> __device__ __forceinline__ void store_o(const f32x4 (&o)[DH / 16], float inv, bf16_t* orow, int g) {
#pragma unroll
    for (int n = 0; n < DH / 16; ++n) { u32x2 w; w.x = cvt_pk_bf16(o[n][0] * inv, o[n][1] * inv); w.y = cvt_pk_bf16(o[n][2] * inv, o[n][3] * inv); *(GAS u32x2*)(orow + 16 * n + 4 * g) = w; }
}

__device__ __forceinline__ u32x4 ld_sv(const void* sbase, unsigned voff) { return *(const GAS u32x4*)((const GAS unsigned char*)sbase + voff); }
template <int NPF> __device__ __forceinline__ void pf_commit64(const u32x4 (&kv)[NPF], const u32x4 (&vv)[NPF], LAS unsigned char* Kl, LAS unsigned char* Vl, int nlast, int tid) {
    const int t3 = tid >> 3, c = tid & 7; const int kl = t3 * 128 + ((c ^ ((t3 >> 1) & 7)) << 4), vl = t3 * 128 + ((c ^ (((t3 >> 1) & 3) << 1)) << 4);
#pragma unroll
    for (int j = 0; j < NPF; ++j) { if (j < NPF - 1 || tid < nlast) { *(LAS u32x4*)(Kl + kl + j * 8192) = kv[j]; *(LAS u32x4*)(Vl + vl + j * 8192) = vv[j]; } }
}
template <int NPF> __device__ __forceinline__ void pf_commit_ring(const u32x4 (&kv)[9], const u32x4 (&vv)[9], LAS unsigned char* Kl, LAS unsigned char* Vl, int row0, int tid) {
    const int t3 = tid >> 3, c = tid & 7; const int kl = t3 * 128 + ((c ^ ((t3 >> 1) & 7)) << 4), vl = t3 * 128 + ((c ^ (((t3 >> 1) & 3) << 1)) << 4);
    int sl = row0 % 9;
#pragma unroll
    for (int j = 0; j < NPF; ++j) { *(LAS u32x4*)(Kl + kl + sl * 8192) = kv[j]; *(LAS u32x4*)(Vl + vl + sl * 8192) = vv[j]; sl = sl == 8 ? 0 : sl + 1; }
}
__device__ __forceinline__ void pv_step64r(f32x4 (&o)[4], const LAS unsigned char* const (&vb)[4], int rowoff, bf16x8 pf) {
#pragma unroll
    for (int n = 0; n < 4; ++n) { const s16x4 lo = vtr(vb[n] + rowoff), hi = vtr(vb[n] + rowoff + 16 * 128);
        const bf16x8 vf = (bf16x8){lo[0], lo[1], lo[2], lo[3], hi[0], hi[1], hi[2], hi[3]};
        o[n] = __builtin_amdgcn_mfma_f32_16x16x32_bf16(vf, pf, o[n], 0, 0, 0); }
}
struct AUnit { int b, h, r0, rsU; };
__device__ __forceinline__ AUnit a_unit(int c, int rep) { const int pair = (c & 7) * 2 + ((c >> 3) & 1), rp = 4 * (c >> 4) + rep; AUnit u; u.b = pair >> 3; u.h = pair & 7; u.r0 = 2 * rp; int rs = u.r0 - 4; u.rsU = rs < 0 ? 0 : (rs > 120 ? 120 : rs); return u; }
struct BUnit { int b, hh, grp, dil, L, rho, n, p0; };
__device__ __forceinline__ BUnit b_unit(int c, int rep) { const int ub = c + 256 * rep, x = ub & 7, y = ub >> 3, combo = x * 3 + y / 64, sub = y % 64; BUnit u; u.b = combo / 12; u.hh = combo % 12; u.grp = u.hh >> 2;
    u.dil = u.grp == 0 ? 1 : (u.grp == 1 ? 4 : 16); u.L = SEQ / u.dil; const int nb = u.L / 128; u.rho = sub / nb; u.n = sub % nb; u.p0 = 128 * u.n - 64; return u; }

__device__ __forceinline__ const bf16_t* a_qptr(const bf16_t* PROJ, int c, int rep, int w, int i) { const AUnit U = a_unit(c, rep); const int r = U.r0 + (w >> 2), cq = 16 * (w & 3) + i; return PROJ + proj_off((size_t)(U.b * SEQ + r * 64 + cq), C_QA + U.h * 64); }
__device__ __forceinline__ const bf16_t* b_qptr(const bf16_t* PROJ, int c, int rep, int w, int i) { const BUnit U = b_unit(c, rep); const int pq = 128 * U.n + 16 * w + i; return PROJ + proj_off((size_t)(U.b * SEQ + pq * U.dil + U.rho), C_QB + U.hh * 64); }

__device__ __forceinline__ void p2_attention(const Ctx& F0) {
    const Ctx F = ctx_refresh(F0);
    const bf16_t* PROJ = (const bf16_t*)(F.ws + WS_PROJ); const bf16_t* MKV = (const bf16_t*)(F.ws + WS_MKV);
    bf16_t* ABC = (bf16_t*)(F.ws + WS_ABC); bf16_t* OB = (bf16_t*)(F.ws + WS_OB); float* LSE = (float*)(F.ws + WS_MISC + MO_LSE);
    const float* T5 = (const float*)(F.ws + WS_MISC + MO_T5); const float* RPB = (const float*)(F.ws + WS_MISC + MO_RPB);
    LAS unsigned char* Kl = F.lds; LAS float* tab = (LAS float*)(F.lds + LDS_TAB);
    const int w = F.wave, c = (int)blockIdx.x;
#define P2_LANE() int tid_r = F.tid; asm volatile("" : "+v"(tid_r)); const int lane = tid_r & 63, i = lane & 15, g = lane >> 4; (void)lane
#define PF_A(rep_, KV, VV, T0, T1) do { const AUnit nu = a_unit(c, rep_); const int rb0_ = nu.b * SEQ + nu.rsU * 64; const unsigned lo_ = (unsigned)(((tid_r >> 3) << 8) + (tid_r & 7) * 8) * 2u; \
        const unsigned ck_ = (unsigned)((2 + (nu.h >> 2)) << 16) + (unsigned)((nu.h & 3) * 64); \
        _Pragma("unroll") for (int j_ = 0; j_ < 9; ++j_) { int rb_ = rb0_ + j_ * 64; rb_ = rb_ < (nu.b + 1) * SEQ ? rb_ : rb0_;                  \
            const unsigned so_ = ((unsigned)((rb_ >> 8) * 29) << 16) + (unsigned)((rb_ & 255) << 8) + ck_; const char* sk_ = (const char*)PROJ + (size_t)so_ * 2; \
            KV[j_] = ld_sv(sk_, lo_); VV[j_] = ld_sv(sk_ + (size_t)(2u << 16) * 2, lo_); } \
        T0 = RPB[nu.h * RPB_LD + tid_r]; T1 = tid_r < RPB_LD - NTHREADS ? RPB[nu.h * RPB_LD + NTHREADS + tid_r] : 0.f; } while (0)
#define PF_A_HALF(rep_, ARR, VOFF_) do { const AUnit nu = a_unit(c, rep_); const int rb0_ = nu.b * SEQ + nu.rsU * 64; const unsigned lo_ = (unsigned)(((tid_r >> 3) << 8) + (tid_r & 7) * 8) * 2u; \
        const unsigned ck_ = (unsigned)((2 + (nu.h >> 2)) << 16) + (unsigned)((nu.h & 3) * 64); \
        _Pragma("unroll") for (int j_ = 0; j_ < 9; ++j_) { int rb_ = rb0_ + j_ * 64; rb_ = rb_ < (nu.b + 1) * SEQ ? rb_ : rb0_; \
            const unsigned so_ = ((unsigned)((rb_ >> 8) * 29) << 16) + (unsigned)((rb_ & 255) << 8) + ck_; const char* sk_ = (const char*)PROJ + (size_t)so_ * 2; \
            ARR[j_] = ld_sv(sk_ + (size_t)(VOFF_), lo_); } } while (0)
#define PF_A2(rep_, KV, VV) do { const AUnit nu = a_unit(c, rep_); if (nu.rsU != a_unit(c, (rep_) - 1).rsU) {     \
        const unsigned lo_ = (unsigned)(((tid_r >> 3) << 8) + (tid_r & 7) * 8) * 2u; const unsigned ck_ = (unsigned)((2 + (nu.h >> 2)) << 16) + (unsigned)((nu.h & 3) * 64); \
        _Pragma("unroll") for (int j_ = 0; j_ < 2; ++j_) { int rb_ = nu.b * SEQ + (nu.rsU + 7 + j_) * 64; rb_ = rb_ < (nu.b + 1) * SEQ ? rb_ : nu.b * SEQ;        \
            const unsigned so_ = ((unsigned)((rb_ >> 8) * 29) << 16) + (unsigned)((rb_ & 255) << 8) + ck_; const char* sk_ = (const char*)PROJ + (size_t)so_ * 2; \
            KV[j_] = ld_sv(sk_, lo_); VV[j_] = ld_sv(sk_ + (size_t)(2u << 16) * 2, lo_); } } } while (0)
#define CM_A2(rep_, KV, VV) do { const AUnit nu = a_unit(c, rep_); if (nu.rsU != a_unit(c, (rep_) - 1).rsU) pf_commit_ring<2>(KV, VV, Kl, Kl + 73728, nu.rsU + 7, tid_r); } while (0)
#define CM_A(KV, VV, T0, T1) do { pf_commit_ring<9>(KV, VV, Kl, Kl + 73728, a_unit(c, 0).rsU, tid_r); tab[tid_r] = T0; if (tid_r < RPB_LD - NTHREADS) tab[NTHREADS + tid_r] = T1; } while (0)
#define PF_B(rep_, KV, VV, T0) do { const BUnit nu = b_unit(c, rep_); const int rbase_ = nu.b * SEQ + nu.rho, t3_ = tid_r >> 3; const unsigned lc_ = (unsigned)((tid_r & 7) * 8); \
        const char* sk_ = (const char*)PROJ + (size_t)((unsigned)((9 + (nu.hh >> 2)) << 16) + (unsigned)((nu.hh & 3) * 64)) * 2; const char* sv_ = sk_ + (size_t)(3u << 16) * 2; \
        _Pragma("unroll") for (int j_ = 0; j_ < 4; ++j_) { int p_ = nu.p0 + j_ * 64 + t3_; p_ = p_ < 0 ? 0 : (p_ > nu.L - 1 ? nu.L - 1 : p_); const int row_ = rbase_ + p_ * nu.dil; \
            const unsigned off_ = (((unsigned)(row_ >> 8) * 29u) << 16) + (unsigned)((row_ & 255) << 8) + lc_; KV[j_] = ld_sv(sk_, off_ * 2u); VV[j_] = ld_sv(sv_, off_ * 2u); } \
        KV[4] = (u32x4){0u, 0u, 0u, 0u}; VV[4] = KV[4];                                       \
        T0 = tid_r < T5_LD ? T5[nu.hh * T5_LD + tid_r] : 0.f; } while (0)
#define CM_B(KV, VV, T0) do { pf_commit64<5>(KV, VV, Kl, Kl + 34816, 128, tid_r); if (tid_r < T5_LD) tab[tid_r] = T0; } while (0)
    u32x4 akv[9], avv[9]; float at0 = 0.f, at1 = 0.f; bf16x8 qn[2];
    {
        LAS unsigned char* Vl = Kl + 65536; P2_LANE();
        const int combo = c & 7, b = combo >> 2, h = combo & 3;
        const int tok0 = b * SEQ + (c >> 3) * 128 + w * 16 + i, tok1 = tok0 + 32 * 128;
        bf16x8 qa[4], qb[4]; load_q<128>(qa, PROJ + proj_off((size_t)tok0, C_QC + h * 128), g); load_q<128>(qb, PROJ + proj_off((size_t)tok1, C_QC + h * 128), g);
        __syncthreads();
        {
            const int ln_ = tid_r & 63;
#pragma unroll
            for (int j = 0; j < 8; ++j) { const int piece = w * 8 + j, key = piece * 4 + (ln_ >> 4), cp = ln_ & 15;
                const unsigned char* krow = (const unsigned char*)(MKV + (size_t)(b * MEMLEN + key) * 1024 + h * 128);
                __builtin_amdgcn_global_load_lds((const unsigned*)(krow + ((cp ^ (key & 15)) << 4)), (LAS unsigned*)(Kl + piece * 1024), 16, 0, 0);
                __builtin_amdgcn_global_load_lds((const unsigned*)(krow + 1024 + ((cp ^ ((key & 7) << 1)) << 4)), (LAS unsigned*)(Vl + piece * 1024), 16, 0, 0); }
            asm volatile("s_waitcnt vmcnt(0)" ::: "memory");
        }
        LDS_WAIT(); __syncthreads();
        {
            f32x4 sa[16], sb[16];
#pragma unroll
            for (int t = 0; t < 16; ++t) { f32x4 xa = (f32x4){0.f, 0.f, 0.f, 0.f}, xb = xa; const int key = 16 * t + i;
#pragma unroll
                for (int s4 = 0; s4 < 4; ++s4) { const bf16x8 kf = *(const LAS bf16x8*)(Kl + k_addr<128>(key, 4 * s4 + g)); xa = __builtin_amdgcn_mfma_f32_16x16x32_bf16(kf, qa[s4], xa, 0, 0, 0); xb = __builtin_amdgcn_mfma_f32_16x16x32_bf16(kf, qb[s4], xb, 0, 0, 0); }
                sa[t] = xa; sb[t] = xb; }
            float ma, la, mb, lb; softmax_tiles<16>(sa, ma, la); softmax_tiles<16>(sb, mb, lb);
            bf16x8 pa[8], pb[8];
#pragma unroll
            for (int u = 0; u < 8; ++u) { pa[u] = pack_p(sa[2 * u], sa[2 * u + 1]); pb[u] = pack_p(sb[2 * u], sb[2 * u + 1]); }
            PF_A_HALF(0, akv, 0); at0 = RPB[a_unit(c, 0).h * RPB_LD + tid_r]; at1 = tid_r < RPB_LD - NTHREADS ? RPB[a_unit(c, 0).h * RPB_LD + NTHREADS + tid_r] : 0.f;
            load_q<64>(qn, a_qptr(PROJ, c, 0, w, i), g);
            f32x4 oa[8], ob[8];
#pragma unroll
            for (int n = 0; n < 8; ++n) { oa[n] = (f32x4){0.f, 0.f, 0.f, 0.f}; ob[n] = oa[n]; }
#pragma unroll
            for (int u = 0; u < 8; ++u) { const int k0 = 32 * u + 4 * g + (i >> 2), k1 = k0 + 16; const int sub = (i & 3) >> 1, b8 = 8 * (i & 1);
#pragma unroll
                for (int n = 0; n < 8; ++n) { const s16x4 lo = vtr(Vl + v_addr<128>(k0, 2 * n + sub) + b8), hi = vtr(Vl + v_addr<128>(k1, 2 * n + sub) + b8);
                    const bf16x8 vf = (bf16x8){lo[0], lo[1], lo[2], lo[3], hi[0], hi[1], hi[2], hi[3]};
                    oa[n] = __builtin_amdgcn_mfma_f32_16x16x32_bf16(vf, pa[u], oa[n], 0, 0, 0); ob[n] = __builtin_amdgcn_mfma_f32_16x16x32_bf16(vf, pb[u], ob[n], 0, 0, 0); } }
            PF_A_HALF(0, avv, (2u << 16) * 2);
            store_o<128>(oa, 1.0f / la, ABC + (size_t)tok0 * ABC_LD + 768 + h * 128, g); store_o<128>(ob, 1.0f / lb, ABC + (size_t)tok1 * ABC_LD + 768 + h * 128, g);
        }
        __syncthreads(); CM_A(akv, avv, at0, at1); LDS_WAIT(); __syncthreads();
    }
    u32x4 bkv[5], bvv[5]; float bt0 = 0.f;
    auto a_body = [&](const int rep, auto LASTT) __attribute__((always_inline)) { constexpr bool last_ = decltype(LASTT)::value;
        LAS unsigned char* Vl = Kl + 73728; P2_LANE();
        const AUnit U = a_unit(c, rep); const int b = U.b, h = U.h, r0 = U.r0, rsU = U.rsU;
        const int r = r0 + (w >> 2), jb = w & 3; int rs = r - 4; rs = rs < 0 ? 0 : (rs > 120 ? 120 : rs);
        const int cq = 16 * jb + i; int cs = cq - 8; cs = cs < 0 ? 0 : (cs > 48 ? 48 : cs);
        const int cw = jb == 0 ? 0 : (jb == 1 ? 8 : (jb == 2 ? 24 : 32));
        const int tok = b * SEQ + r * 64 + cq;
        bf16x8 qf[2]; qf[0] = qn[0]; qf[1] = qn[1];
        if constexpr (!last_) { PF_A2(rep + 1, akv, avv); load_q<64>(qn, a_qptr(PROJ, c, rep + 1, w, i), g); } else { PF_B(0, bkv, bvv, bt0); load_q<64>(qn, b_qptr(PROJ, c, 0, w, i), g); }
        int ksl[8]; { int sl = rs % 9;
#pragma unroll
            for (int j = 0; j < 8; ++j) { ksl[j] = sl * 64; sl = sl == 8 ? 0 : sl + 1; } }
        (void)rsU;
        f32x4 s[16];
#pragma unroll
        for (int t = 0; t < 16; ++t) s[t] = qk_tile<64>(Kl, ksl[t >> 1] + cw + 16 * (t & 1), qf, i, g);
        const int bidx = RPB_OFF + (7 - (r - rs)) * 31 + (cw + 4 * g - cq + 15); const int lo = cs - cw - 4 * g;
        float lim[2][4];
#pragma unroll
        for (int q2 = 0; q2 < 2; ++q2)
#pragma unroll
            for (int rr = 0; rr < 4; ++rr) { const int kc = 16 * q2 + rr; lim[q2][rr] = (kc >= lo && kc < lo + 16) ? INFINITY : -INFINITY; }
#pragma unroll
        for (int t = 0; t < 16; ++t) {
#pragma unroll
            for (int rr = 0; rr < 4; ++rr) { const int kc = 16 * (t & 1) + rr; s[t][rr] = fminf(s[t][rr] + tab[bidx + (t >> 1) * 31 + kc], lim[t & 1][rr]); } }
        float m, l; softmax_tiles<16>(s, m, l);
        f32x4 o[4];
#pragma unroll
        for (int n = 0; n < 4; ++n) o[n] = (f32x4){0.f, 0.f, 0.f, 0.f};
        { const int k0_ = cw + 4 * g + (i >> 2), sub_ = (i & 3) >> 1, b8_ = 8 * (i & 1);
          const LAS unsigned char* const vb[4] = {Vl + v_addr<64>(k0_, 0 + sub_) + b8_, Vl + v_addr<64>(k0_, 2 + sub_) + b8_, Vl + v_addr<64>(k0_, 4 + sub_) + b8_, Vl + v_addr<64>(k0_, 6 + sub_) + b8_};
#pragma unroll
          for (int u = 0; u < 8; ++u) pv_step64r(o, vb, ksl[u] * 128, pack_p(s[2 * u], s[2 * u + 1])); }
        store_o<64>(o, 1.0f / l, ABC + (size_t)tok * ABC_LD + h * 64, g);
        __syncthreads(); if constexpr (!last_) { CM_A2(rep + 1, akv, avv); } else { CM_B(bkv, bvv, bt0); } LDS_WAIT(); __syncthreads();
    };
    for (int rep = 0; rep < 3; ++rep) a_body(rep, std::false_type{});
    a_body(3, std::true_type{});
    auto b_body = [&](const int rep, auto LASTT) __attribute__((always_inline)) { constexpr bool last_ = decltype(LASTT)::value;
        LAS unsigned char* Vl = Kl + 34816; P2_LANE();
        const BUnit U = b_unit(c, rep); const int b = U.b, hh = U.hh, grp = U.grp, dil = U.dil, L = U.L, rho = U.rho, n = U.n;
        const int pq = 128 * n + 16 * w + i; const int tok = b * SEQ + pq * dil + rho;
        bf16x8 qf[2]; qf[0] = qn[0]; qf[1] = qn[1];
        if constexpr (!last_) { PF_B(rep + 1, bkv, bvv, bt0); load_q<64>(qn, b_qptr(PROJ, c, rep + 1, w, i), g); }
        f32x4 s[10];
#pragma unroll
        for (int t = 0; t < 10; ++t) s[t] = qk_tile<64>(Kl, 16 * w + 16 * t, qf, i, g);
        const int rel0 = 4 * g - 64 - i;
        if (n == 0 || n == (L >> 7) - 1) {
#pragma unroll
            for (int t = 0; t < 10; ++t) {
#pragma unroll
                for (int rr = 0; rr < 4; ++rr) { const int rel = rel0 + 16 * t + rr; const int p = pq + rel;
                    s[t][rr] = fminf(s[t][rr] + tab[rel + 79], (unsigned)p < (unsigned)L ? INFINITY : -INFINITY); } }
        } else {
#pragma unroll
            for (int t = 0; t < 10; ++t) {
#pragma unroll
                for (int rr = 0; rr < 4; ++rr) s[t][rr] += tab[rel0 + 16 * t + rr + 79]; }
        }
        float m, l; softmax_tiles<10>(s, m, l);
        f32x4 o[4];
#pragma unroll
        for (int nn = 0; nn < 4; ++nn) o[nn] = (f32x4){0.f, 0.f, 0.f, 0.f};
        { const int k0_ = 16 * w + 4 * g + (i >> 2), sub_ = (i & 3) >> 1, b8_ = 8 * (i & 1);
          const LAS unsigned char* const vb[4] = {Vl + v_addr<64>(k0_, 0 + sub_) + b8_, Vl + v_addr<64>(k0_, 2 + sub_) + b8_, Vl + v_addr<64>(k0_, 4 + sub_) + b8_, Vl + v_addr<64>(k0_, 6 + sub_) + b8_};
          pv_step64i<0 * 4096>(o, vb, pack_p(s[0], s[1])); pv_step64i<1 * 4096>(o, vb, pack_p(s[2], s[3])); pv_step64i<2 * 4096>(o, vb, pack_p(s[4], s[5])); pv_step64i<3 * 4096>(o, vb, pack_p(s[6], s[7])); pv_step64i<4 * 4096>(o, vb, pack_p(s[8], s[9])); }
        const int h4 = hh & 3;
        store_o<64>(o, 1.0f / l, OB + ((size_t)grp * NTOK + tok) * 256 + h4 * 64, g);
        if (g == 0) LSE[((size_t)grp * NTOK + tok) * 4 + h4] = m + __builtin_amdgcn_logf(l);
        if constexpr (!last_) { __syncthreads(); CM_B(bkv, bvv, bt0); LDS_WAIT(); __syncthreads(); }
    };
    for (int rep = 0; rep < 5; ++rep) b_body(rep, std::false_type{});
    b_body(5, std::true_type{});
#undef PF_A
#undef CM_A
#undef PF_B
#undef CM_B
}
#undef P2_LANE
__device__ __forceinline__ void p2b_merge_quarter(const Ctx& F0, int pm, int q, unsigned* flag) {
    const Ctx F = ctx_refresh(F0);
    const bf16_t* OB = (const bf16_t*)(F.ws + WS_OB); const float* LSE = (const float*)(F.ws + WS_MISC + MO_LSE); bf16_t* ABC = (bf16_t*)(F.ws + WS_ABC);
    {
        u32x4 a[4], bq[4], cq[4]; float l0[4], l1[4], l2[4];
#pragma unroll
        for (int k = 0; k < 4; ++k) { const int it = F.tid + k * NTHREADS; const int tok = pm * 256 + q * 64 + (it >> 5), ch = it & 31, h = ch >> 3;
            l0[k] = LSE[(size_t)tok * 4 + h]; l1[k] = LSE[((size_t)NTOK + tok) * 4 + h]; l2[k] = LSE[((size_t)2 * NTOK + tok) * 4 + h];
            a[k] = *(const GAS u32x4*)(OB + (size_t)tok * 256 + ch * 8); bq[k] = *(const GAS u32x4*)(OB + ((size_t)NTOK + tok) * 256 + ch * 8); cq[k] = *(const GAS u32x4*)(OB + ((size_t)2 * NTOK + tok) * 256 + ch * 8); }
#pragma unroll
        for (int k = 0; k < 4; ++k) { const int it = F.tid + k * NTHREADS; const int tok = pm * 256 + q * 64 + (it >> 5), ch = it & 31;
            const float mx = fmaxf(l0[k], fmaxf(l1[k], l2[k])); float w0 = __builtin_amdgcn_exp2f(l0[k] - mx), w1 = __builtin_amdgcn_exp2f(l1[k] - mx), w2 = __builtin_amdgcn_exp2f(l2[k] - mx);
            const float inv = 1.0f / (w0 + w1 + w2); w0 *= inv; w1 *= inv; w2 *= inv;
            u32x4 o;
#pragma unroll
            for (int j = 0; j < 4; ++j) { const float lo = w0 * bf_lo(a[k][j]) + w1 * bf_lo(bq[k][j]) + w2 * bf_lo(cq[k][j]), hi = w0 * bf_hi(a[k][j]) + w1 * bf_hi(bq[k][j]) + w2 * bf_hi(cq[k][j]); o[j] = cvt_pk_bf16(lo, hi); }
            bf16_t* dp_ = ABC + (size_t)tok * ABC_LD + 512 + ch * 8;
            asm volatile("global_store_dwordx4 %0, %1, off sc0 sc1\n\ts_nop 1" :: "v"(dp_), "v"(o) : "memory"); }
    }
    VM_WAIT(); __syncthreads();
    if (F.tid == 0) __hip_atomic_fetch_add(flag + 16 * pm, 1u, __ATOMIC_RELAXED, __HIP_MEMORY_SCOPE_AGENT);
}
struct P3Sched {
    static constexpr bool LAZY = false;
    static constexpr bool TOUCH = false;
    int c; const char* ABCp; const char* WABC; const unsigned* flag; unsigned* tmo; int wave;
    __device__ __forceinline__ bool next(int i, pg8::Unit& u) const {
        if (i >= 3) return false;
        constexpr int nM = 64, nN = 4, nwg = 256;
        int wgid = c; { const int q = nwg / 8, xcd = wgid % 8, off = wgid / 8; wgid = xcd * q + off; }
        const int nig = 8 * nN, gid = wgid / nig, fm = gid * 8;
        u.pm = fm + ((wgid % nig) % 8); u.pn = (wgid % nig) / 8;
        const int sb = ((c >> 3) & 1) ? (i == 0 ? 1 : (i == 1 ? 0 : 2)) : i;
        const int koff = sb == 0 ? 0 : (sb == 1 ? 512 : 768);
        u.A = ABCp + (size_t)u.pm * 256 * (ABC_LD * 2) + koff * 2; u.B = WABC + (size_t)u.pn * 256 * (ABC_LD * 2) + koff * 2;
        const int sbn = i == 2 ? 0 : (((c >> 3) & 1) ? (i == 0 ? 0 : 2) : i + 1);
        u.rows = 0; u.nt = sb == 1 ? 4 : 8; u.aux = sb | (sbn << 4) | (i < 2 ? (1 << 30) : 0); u.scale = 1.f;
        if (sb == 1 && wave == 0) { unsigned sp = 0u;
            while ((unsigned)__builtin_amdgcn_readfirstlane((int)__hip_atomic_load(flag + 16 * u.pm, __ATOMIC_RELAXED, __HIP_MEMORY_SCOPE_AGENT)) < 4u) { __builtin_amdgcn_s_sleep(2);
                if ((++sp & 255u) == 0u) { if (__hip_atomic_load(tmo, __ATOMIC_RELAXED, __HIP_MEMORY_SCOPE_AGENT) != 0u) break; if (sp > (1u << 18)) { atomicAdd(tmo, 1u); break; } } }
            __builtin_amdgcn_fence(__ATOMIC_ACQUIRE, "agent"); asm volatile("s_waitcnt vmcnt(0)" ::: "memory"); }
        __builtin_amdgcn_s_barrier(); asm volatile("" ::: "memory");
        return true;
    }
};
struct P3Epi {
    const bf16_t* PROJ; bf16_t* MERGED;
    __device__ __forceinline__ void operator()(f32x4 (&acc)[2][2][4][2], const pg8::Unit& u, int wr, int wc, int fr, int fq) const {
        const int row0 = u.pm * 256 + wr * 64 + fr, col0 = u.pn * 256 + wc * 32 + 8 * fq; const int s = u.aux & 15, sn = (u.aux >> 4) & 15; const bool mid = (u.aux & (1 << 30)) != 0;
#define UB(w, k) ((float)(((w) >> (8 * (k))) & 0xffu))
#define GATE_PTR(row, br, col) ((const GAS u32x2*)((const unsigned char*)PROJ + ((((row) >> 8) * 29 + (size_t)(17 + 4 * (br) + u.pn)) << 17) + (((row) & 255) << 8) + (size_t)((col) & 255)))
#pragma unroll
        for (int ai = 0; ai < 2; ++ai) {
            u32x2 gc[4][2], gn[4][2];
#pragma unroll
            for (int m = 0; m < 4; ++m)
#pragma unroll
                for (int bj = 0; bj < 2; ++bj) { const size_t row = (size_t)(row0 + ai * 128 + m * 16); const int col = col0 + bj * 128;
                    gc[m][bj] = *GATE_PTR(row, s, col); gn[m][bj] = gc[m][bj]; if (mid) gn[m][bj] = *GATE_PTR(row, sn, col); }
            asm volatile("" ::: "memory");
#pragma unroll
            for (int m = 0; m < 4; ++m)
#pragma unroll
                for (int bj = 0; bj < 2; ++bj) { const size_t row = (size_t)(row0 + ai * 128 + m * 16); const int col = col0 + bj * 128;
                    const u32x2 g = gc[m][bj], h = gn[m][bj]; f32x4& v0 = acc[ai][bj][m][0]; f32x4& v1 = acc[ai][bj][m][1];
                    if (mid) {
#pragma unroll
                        for (int j = 0; j < 4; ++j) { v0[j] *= UB(g.x, j) * __builtin_amdgcn_rcpf(UB(h.x, j)); v1[j] *= UB(g.y, j) * __builtin_amdgcn_rcpf(UB(h.y, j)); }
                    } else {
                        u32x4 o;
                        o.x = cvt_pk_bf16(UB(g.x, 0) * v0[0], UB(g.x, 1) * v0[1]); o.y = cvt_pk_bf16(UB(g.x, 2) * v0[2], UB(g.x, 3) * v0[3]);
                        o.z = cvt_pk_bf16(UB(g.y, 0) * v1[0], UB(g.y, 1) * v1[1]); o.w = cvt_pk_bf16(UB(g.y, 2) * v1[2], UB(g.y, 3) * v1[3]);
                        { bf16_t* dp_ = MERGED + row * 1024 + col; asm volatile("global_store_dwordx4 %0, %1, off sc0 sc1\n\ts_nop 1" :: "v"(dp_), "v"(o) : "memory"); } } }
            asm volatile("" ::: "memory");
        }
#undef UB
#undef GATE_PTR
    }
};
struct P4Sched {
    static constexpr bool LAZY = false;
    static constexpr bool TOUCH = false;
    int c; const char* MERGED; const char* WOUT; const unsigned* flag; unsigned* tmo; int wave;
    __device__ __forceinline__ bool next(int i, pg8::Unit& u) const {
        if (i >= 1) return false;
        constexpr int nN = 4, nwg = 256;
        int wgid = c; { const int q = nwg / 8, xcd = wgid % 8, off = wgid / 8; wgid = xcd * q + off; }
        const int nig = 8 * nN, gid = wgid / nig, fm = gid * 8;
        u.pm = fm + ((wgid % nig) % 8); u.pn = (wgid % nig) / 8;
        u.A = MERGED + (size_t)u.pm * 256 * 2048; u.B = WOUT + (size_t)u.pn * 256 * 2048; u.rows = 0; u.nt = 16; u.aux = 0; u.scale = 1.f;
        if (wave == 0) { unsigned sp = 0u;
            while ((unsigned)__builtin_amdgcn_readfirstlane((int)__hip_atomic_load(flag + 16 * u.pm, __ATOMIC_RELAXED, __HIP_MEMORY_SCOPE_AGENT)) < 4u) { __builtin_amdgcn_s_sleep(2);
                if ((++sp & 255u) == 0u) { if (__hip_atomic_load(tmo, __ATOMIC_RELAXED, __HIP_MEMORY_SCOPE_AGENT) != 0u) break; if (sp > (1u << 18)) { atomicAdd(tmo, 1u); break; } } }
            __builtin_amdgcn_fence(__ATOMIC_ACQUIRE, "agent"); asm volatile("s_waitcnt vmcnt(0)" ::: "memory"); }
        __builtin_amdgcn_s_barrier(); asm volatile("" ::: "memory");
        return true;
    }
};
struct P4Epi {
    const float* X; bf16_t* X1;
    __device__ __forceinline__ void operator()(const f32x4 (&acc)[2][2][4][2], const pg8::Unit& u, int wr, int wc, int fr, int fq) const {
        const int row0 = u.pm * 256 + wr * 64 + fr, col0 = u.pn * 256 + wc * 32 + 8 * fq;
#pragma unroll
        for (int ai = 0; ai < 2; ++ai) {
            f32x4 xv[4][2][2];
#pragma unroll
            for (int m = 0; m < 4; ++m)
#pragma unroll
                for (int bj = 0; bj < 2; ++bj) { const size_t off = (size_t)(row0 + ai * 128 + m * 16) * 1024 + col0 + bj * 128; xv[m][bj][0] = *(const GAS f32x4*)(X + off); xv[m][bj][1] = *(const GAS f32x4*)(X + off + 4); }
            asm volatile("" ::: "memory");
#pragma unroll
            for (int m = 0; m < 4; ++m)
#pragma unroll
                for (int bj = 0; bj < 2; ++bj) { const size_t off = (size_t)(row0 + ai * 128 + m * 16) * 1024 + col0 + bj * 128;
                    const f32x4 o0 = xv[m][bj][0] + acc[ai][bj][m][0] * (1.0f / 255.0f), o1 = xv[m][bj][1] + acc[ai][bj][m][1] * (1.0f / 255.0f);
                    { const u32x4 ow_ = (u32x4){cvt_pk_bf16(o0[0], o0[1]), cvt_pk_bf16(o0[2], o0[3]), cvt_pk_bf16(o1[0], o1[1]), cvt_pk_bf16(o1[2], o1[3])}; bf16_t* dp_ = X1 + off;
                      asm volatile("global_store_dwordx4 %0, %1, off sc0 sc1\n\ts_nop 1" :: "v"(dp_), "v"(ow_) : "memory"); } }
            asm volatile("" ::: "memory");
        }
    }
};
__device__ __forceinline__ void p5_router(const Ctx& F0) {
    const KArgs ap = kargs(); const bf16_t* X1 = (const bf16_t*)(kargs()->ws + WS_X1B); const float* GF = ap->in[12]; const float* RW = ap->in[13]; const float* RB = ap->in[14];
    const Ctx F = ctx_refresh(F0);
    unsigned char* H8 = F.ws + WS_XN; float* RTOK = (float*)(F.ws + WS_MISC + MO_RTOK);
    int* TOPIDX = (int*)(F.ws + WS_MISC + MO_TOPIDX); float* TOPW = (float*)(F.ws + WS_MISC + MO_TOPW); int* HIST = (int*)(F.ws + WS_MISC + MO_HIST);
    LAS float* Wl = (LAS float*)F.lds;
    LAS float* xch = (LAS float*)(F.lds + 131072);
    LAS float* xss = (LAS float*)(F.lds + 131072 + 8192);
    LAS int* hist = (LAS int*)(F.lds + LDS_TAB);
    const int lane = F.lane, i = lane & 15, kq = lane >> 4, tg = F.wave & 3, kh = F.wave >> 2; const int bid = (int)blockIdx.x;
    const int tok = bid * 64 + tg * 16 + i; const int kbase = kh * 512 + 32 * kq;
    const bf16_t* xrow = X1 + (size_t)tok * D + kbase; const float* grow = GF + kbase;
    u32x4 xb[4][4];
    {
        f32x4 wv[16]; float gk[16];
#pragma unroll
        for (int u = 0; u < 16; ++u) { const int idx = F.tid + u * NTHREADS, k = idx >> 3, q = idx & 7; wv[u] = *(const GAS f32x4*)(RW + (size_t)k * 32 + 4 * q); gk[u] = GF[k]; }
        if (F.wave == 0) { const unsigned* flag = (const unsigned*)(F.ws + WS_CTL) + 25600 + 2560 + 16 * (bid >> 2); unsigned* tmo = (unsigned*)(F.ws + WS_CTL) + 4096 + XB_TMO; unsigned sp = 0u;
            while ((unsigned)__builtin_amdgcn_readfirstlane((int)__hip_atomic_load(flag, __ATOMIC_RELAXED, __HIP_MEMORY_SCOPE_AGENT)) < 4u) { __builtin_amdgcn_s_sleep(2);
                if ((++sp & 255u) == 0u) { if (__hip_atomic_load(tmo, __ATOMIC_RELAXED, __HIP_MEMORY_SCOPE_AGENT) != 0u) break; if (sp > (1u << 18)) { atomicAdd(tmo, 1u); break; } } }
            __builtin_amdgcn_fence(__ATOMIC_ACQUIRE, "agent"); asm volatile("s_waitcnt vmcnt(0)" ::: "memory"); }
        __syncthreads();
#pragma unroll
        for (int c = 0; c < 2; ++c)
#pragma unroll
            for (int q = 0; q < 4; ++q) xb[c][q] = *(const GAS u32x4*)(xrow + c * 128 + 8 * q);
        __syncthreads();
#pragma unroll
        for (int u = 0; u < 16; ++u) { const int idx = F.tid + u * NTHREADS, k = idx >> 3, q = idx & 7; *(LAS f32x4*)(Wl + k * 32 + ((4 * q) ^ (((k >> 5) & 1) << 4))) = wv[u] * gk[u]; }
    }
#pragma unroll
    for (int c = 2; c < 4; ++c)
#pragma unroll
        for (int q = 0; q < 4; ++q) xb[c][q] = *(const GAS u32x4*)(xrow + c * 128 + 8 * q);
    if (F.tid < 32) hist[F.tid] = 0;
    LDS_WAIT(); __syncthreads();
    const LAS float* wb0 = Wl + kbase * 32 + (i ^ ((kq & 1) << 4)); const LAS float* wb1 = Wl + kbase * 32 + ((i + 16) ^ ((kq & 1) << 4));
    f32x4 acc0 = {0.f, 0.f, 0.f, 0.f}, acc1 = {0.f, 0.f, 0.f, 0.f}; float ss = 0.f;
#pragma unroll
    for (int c = 0; c < 4; ++c) {
        f32x4 gv[8];
#pragma unroll
        for (int q = 0; q < 8; ++q) gv[q] = *(const GAS f32x4*)(grow + c * 128 + 4 * q);
        unsigned o[8]; f32x4 xv[8];
#pragma unroll
        for (int q = 0; q < 8; ++q) { const unsigned w0 = xb[c][q >> 1][(q & 1) * 2], w1 = xb[c][q >> 1][(q & 1) * 2 + 1]; xv[q] = (f32x4){bf_lo(w0), bf_hi(w0), bf_lo(w1), bf_hi(w1)}; }
#pragma unroll
        for (int q = 0; q < 8; ++q) { const f32x4 x = xv[q], pq = x * gv[q]; ss += (x.x * x.x + x.y * x.y) + (x.z * x.z + x.w * x.w);
            int w = __builtin_amdgcn_cvt_pk_fp8_f32(pq.x, pq.y, 0, false); w = __builtin_amdgcn_cvt_pk_fp8_f32(pq.z, pq.w, w, true); o[q] = (unsigned)w; }
        GAS u32x4* op = (GAS u32x4*)(H8 + (size_t)tok * D + kbase + c * 128);
        op[0] = (u32x4){o[0], o[1], o[2], o[3]}; op[1] = (u32x4){o[4], o[5], o[6], o[7]};
#pragma unroll
        for (int j = 0; j < 32; ++j) { const float a = xv[j >> 2][j & 3]; const float b0 = wb0[(c * 128 + j) * 32], b1 = wb1[(c * 128 + j) * 32];
            acc0 = __builtin_amdgcn_mfma_f32_16x16x4f32(a, b0, acc0, 0, 0, 0); acc1 = __builtin_amdgcn_mfma_f32_16x16x4f32(a, b1, acc1, 0, 0, 0); }
    }
    ss += sx(ss, 16); ss += sx(ss, 32);
    if (kh == 1) { LAS float* xp = xch + (tg * 64 + lane) * 8; *(LAS f32x4*)xp = acc0; *(LAS f32x4*)(xp + 4) = acc1; if (lane < 16) xss[tg * 16 + lane] = ss; }
    LDS_WAIT(); __syncthreads();
    if (kh == 0) {
        const LAS float* xp = xch + (tg * 64 + lane) * 8; acc0 += *(const LAS f32x4*)xp; acc1 += *(const LAS f32x4*)(xp + 4); ss += xss[tg * 16 + i];
        const float rt = 1.0f / sqrtf(ss * (1.f / D) + RMS_EPS);
        if (lane < 16) RTOK[tok] = rt;
        const float bias0 = RB[i], bias1 = RB[i + 16];
        float c0[4], c1[4];
#pragma unroll
        for (int r = 0; r < 4; ++r) { const float rr = sidx(rt, 4 * kq + r); c0[r] = acc0[r] * rr + bias0; c1[r] = acc1[r] * rr + bias1; }
        float tv[4][4]; int ti[4][4];
#pragma unroll
        for (int k = 0; k < 4; ++k)
#pragma unroll
            for (int r = 0; r < 4; ++r) { float bv = c0[r] >= c1[r] ? c0[r] : c1[r]; int bi = c0[r] >= c1[r] ? i : i + 16;
#define P5_STEP(ctrl) { const float ov = __builtin_bit_cast(float, __builtin_amdgcn_update_dpp(0, __builtin_bit_cast(int, bv), ctrl, 0xf, 0xf, true)); const int oi = __builtin_amdgcn_update_dpp(0, bi, ctrl, 0xf, 0xf, true); \
                    const bool take = (ov > bv) || (ov == bv && oi < bi); bv = take ? ov : bv; bi = take ? oi : bi; }
                P5_STEP(0xB1) P5_STEP(0x4E) P5_STEP(0x141) P5_STEP(0x140)
#undef P5_STEP
                tv[k][r] = bv; ti[k][r] = bi; if (bi == i) c0[r] = -INFINITY; if (bi == i + 16) c1[r] = -INFINITY; }
        if (i == 0) {
#pragma unroll
            for (int r = 0; r < 4; ++r) { const int t = bid * 64 + tg * 16 + 4 * kq + r;
                const float e1 = __expf(tv[1][r] - tv[0][r]), e2 = __expf(tv[2][r] - tv[0][r]), e3 = __expf(tv[3][r] - tv[0][r]); const float inv = 1.0f / (1.0f + e1 + e2 + e3);
                *(GAS i32x4*)(TOPIDX + t * 4) = (i32x4){ti[0][r], ti[1][r], ti[2][r], ti[3][r]}; *(GAS f32x4*)(TOPW + t * 4) = (f32x4){inv, e1 * inv, e2 * inv, e3 * inv};
                atomicAdd((int*)&hist[ti[0][r]], 1); atomicAdd((int*)&hist[ti[1][r]], 1); atomicAdd((int*)&hist[ti[2][r]], 1); atomicAdd((int*)&hist[ti[3][r]], 1); }
        }
    }
    LDS_WAIT(); __syncthreads();
    if (F.tid < 32) HIST[bid * 32 + F.tid] = hist[F.tid];
}
__device__ __forceinline__ void p6_slots(const Ctx& F0) {
    const Ctx F = ctx_refresh(F0);
    const int* TOPIDX = (const int*)(F.ws + WS_MISC + MO_TOPIDX); const float* TOPW = (const float*)(F.ws + WS_MISC + MO_TOPW); const int* HIST = (const int*)(F.ws + WS_MISC + MO_HIST);
    int* TOKSLOT = (int*)(F.ws + WS_MISC + MO_TOKSLOT); int* SLOTTOK = (int*)(F.ws + WS_MISC + MO_SLOTTOK); float* SLOTW = (float*)(F.ws + WS_MISC + MO_SLOTW); int* TILE = (int*)(F.ws + WS_MISC + MO_TILE);
    float* SLOTRS = (float*)(F.ws + WS_MISC + MO_SLOTRS); const float* RTOK = (const float*)(F.ws + WS_MISC + MO_RTOK);
    LAS int* part = (LAS int*)F.lds;
    LAS int* pref = part + 512;
    LAS int* tot = part + 1024;
    LAS int* mypre = tot + 32; LAS int* sbase = tot + 64; LAS int* wcnt = tot + 96;
    const int bid = (int)blockIdx.x, tid = F.tid;
    int e_me = 0, rank = 0; float w_me = 0.f, rs_me = 0.f; const int ent = tid;
    if (tid < 256) { e_me = TOPIDX[bid * 256 + ent]; w_me = TOPW[bid * 256 + ent]; rs_me = RTOK[bid * 64 + (ent >> 2)]; }
    __syncthreads();
    { const int e = tid & 31, ch = tid >> 5; int s = 0, p = 0;
        for (int j = 0; j < 16; ++j) { const int bb = ch * 16 + j; const int hv = HIST[bb * 32 + e]; s += hv; if (bb < bid) p += hv; }
        part[ch * 32 + e] = s; pref[ch * 32 + e] = p; }
    LDS_WAIT(); __syncthreads();
    if (tid < 32) { int s = 0, p = 0; for (int ch = 0; ch < 16; ++ch) { s += part[ch * 32 + tid]; p += pref[ch * 32 + tid]; } tot[tid] = s; mypre[tid] = p; }
    LDS_WAIT(); __syncthreads();
    if (tid == 0) { int tb = 0; for (int e = 0; e < 32; ++e) { sbase[e] = tb * 256; const int nt = (tot[e] + 255) >> 8; if (bid == 0) { for (int j = 0; j < nt; ++j) TILE[1 + tb + j] = e; } tb += nt; } if (bid == 0) TILE[0] = tb; }
    LDS_WAIT(); __syncthreads();
    if (tid < 256) {
        const int wv = tid >> 6;
        for (int e = 0; e < 32; ++e) { const unsigned long long bal = __ballot(e_me == e); if (e_me == e) rank = __builtin_popcountll(bal & ((1ull << F.lane) - 1ull)); if (F.lane == 0) wcnt[wv * 32 + e] = __builtin_popcountll(bal); } }
    LDS_WAIT(); __syncthreads();
    if (tid < 256) { const int wv = tid >> 6; for (int j = 0; j < wv; ++j) rank += wcnt[j * 32 + e_me];
        const int slot = sbase[e_me] + mypre[e_me] + rank; const int tok = bid * 64 + (ent >> 2);
        SLOTTOK[slot] = tok; SLOTW[slot] = w_me; SLOTRS[slot] = rs_me; TOKSLOT[bid * 256 + ent] = slot; }
    if (bid < 32) { const int e = bid; const int beg = sbase[e] + tot[e], end = sbase[e] + (((tot[e] + 255) >> 8) << 8); for (int s = beg + tid; s < end; s += NTHREADS) { SLOTTOK[s] = 0; SLOTW[s] = 0.f; SLOTRS[s] = 0.f; } }
}
constexpr int LDS_ROWS = 139264, LDS_TILE = 139264 + 11 * 1024;
static_assert(LDS_TILE + 4 * (1 + MAX_TILES) <= LDS_MISC, "LDS tables");
__device__ __forceinline__ int moe_tile(int x, int t, int ntile) { const int n4 = ntile & ~31, f4 = n4 >> 3; return t < f4 ? 32 * (t >> 2) + 4 * x + (t & 3) : n4 + 8 * (t - f4) + x; }
__device__ __forceinline__ void moe_unit7(int i, int c, int ntile, int& m, int& pn) { const int u = i * 32 + (c >> 3); m = moe_tile(c & 7, u >> 3, ntile); pn = u & 7; }
template <int NPN, bool ROWS> __device__ __forceinline__ void moe_tables(const Ctx& F, const int* TILE, const int* SLOTTOK) {
    LAS int* tl = (LAS int*)(F.lds + LDS_TILE);
    __syncthreads();
    for (int j = F.tid; j < 1 + MAX_TILES; j += NTHREADS) tl[j] = __hip_atomic_load((int*)TILE + j, __ATOMIC_RELAXED, __HIP_MEMORY_SCOPE_AGENT);
    if (ROWS) { const int ntile = __builtin_amdgcn_readfirstlane(__hip_atomic_load((int*)TILE, __ATOMIC_RELAXED, __HIP_MEMORY_SCOPE_AGENT));
        for (int i = 0; i < 11; ++i) { int m, pn_; moe_unit7(i, (int)blockIdx.x, ntile, m, pn_); if (m >= ntile) break;
            if (F.tid < 256) ((LAS int*)(F.lds + LDS_ROWS))[i * 256 + F.tid] = SLOTTOK[m * 256 + F.tid]; } }
    LDS_WAIT(); __syncthreads();
}
struct P7Sched {
    static constexpr bool LAZY = false;
    static constexpr bool TOUCH = false;
    int G, c; LAS const int* tl; const char* H2; const char* WGU; int ntile;
    __device__ __forceinline__ bool next(int i, pg8::Unit& u) const {
        int m, pn; moe_unit7(i, c, ntile, m, pn); if (m >= ntile || i >= 11) return false;
        const int e = __builtin_amdgcn_readfirstlane(tl[1 + m]);
        u.pm = m; u.pn = pn; u.aux = e; u.scale = 1.f; u.nt = 8; u.rows = LDS_ROWS + 1024 * i; u.A = H2; u.B = WGU + ((size_t)e * 2048 + pn * 256) * 1024; return true;
    }
};
struct P7Epi {
    const float* BGU; bf16_t* ACT; const float* SLOTRS; unsigned* done; mutable int prev;
    __device__ __forceinline__ void publish() const { if (prev >= 0 && lane_id() == 0) __hip_atomic_fetch_add(done + 16 * prev, 1u, __ATOMIC_RELAXED, __HIP_MEMORY_SCOPE_AGENT); }
    __device__ __forceinline__ void operator()(const f32x4 (&acc)[2][2][4][2], const pg8::Unit& u, int wr, int wc, int fr, int fq) const {
        const int row0 = u.pm * 256 + wr * 64 + fr, cc0 = wc * 32 + 8 * fq, e = u.aux;
        float rr[2][4];
#pragma unroll
        for (int ai = 0; ai < 2; ++ai)
#pragma unroll
            for (int m = 0; m < 4; ++m) rr[ai][m] = SLOTRS[row0 + ai * 128 + m * 16];
        const float* bg = BGU + (size_t)e * 2048 + u.pn * 128 + cc0; const float* bu = bg + 1024;
        const f32x4 bg0 = *(const GAS f32x4*)bg, bg1 = *(const GAS f32x4*)(bg + 4), bu0 = *(const GAS f32x4*)bu + 1.0f, bu1 = *(const GAS f32x4*)(bu + 4) + 1.0f;
        asm volatile("s_waitcnt vmcnt(0)" ::: "memory"); publish(); prev = u.pm;
#pragma unroll
        for (int ai = 0; ai < 2; ++ai)
#pragma unroll
            for (int m = 0; m < 4; ++m) { const size_t row = (size_t)(row0 + ai * 128 + m * 16);
                float av[8];
#pragma unroll
                for (int n = 0; n < 2; ++n) { const f32x4 gv = acc[ai][0][m][n] * rr[ai][m] + (n ? bg1 : bg0), uv = acc[ai][1][m][n] * rr[ai][m] + (n ? bu1 : bu0);
#pragma unroll
                    for (int j = 0; j < 4; ++j) { const float gg = fminf(gv[j], 7.0f); const float u1 = fminf(fmaxf(uv[j], -6.0f), 8.0f);
                        av[4 * n + j] = (u1 * gg) * __builtin_amdgcn_rcpf(1.0f + __builtin_amdgcn_exp2f(gg * (-1.702f * LOG2E))); } }
                int w0 = __builtin_amdgcn_cvt_pk_fp8_f32(av[0], av[1], 0, false); w0 = __builtin_amdgcn_cvt_pk_fp8_f32(av[2], av[3], w0, true);
                int w1 = __builtin_amdgcn_cvt_pk_fp8_f32(av[4], av[5], 0, false); w1 = __builtin_amdgcn_cvt_pk_fp8_f32(av[6], av[7], w1, true);
                const u32x2 wv_ = (u32x2){(unsigned)w0, (unsigned)w1}; unsigned char* dp_ = (unsigned char*)ACT + row * 1024 + u.pn * 128 + cc0;
                asm volatile("global_store_dwordx2 %0, %1, off sc0 sc1" :: "v"(dp_), "v"(wv_) : "memory"); }
    }
};
struct P8Sched {
    static constexpr bool LAZY = true;
    static constexpr bool TOUCH = false;
    unsigned* ctr; const unsigned* done; unsigned* tmo; LAS int* slot; int wave, x; LAS const int* tl; const char* ACT; const char* WDN; int ntile;
    __device__ __forceinline__ int predraw() const { int v = 0; if (wave == 0 && lane_id() == 0) v = (int)__hip_atomic_fetch_add(ctr, 1u, __ATOMIC_RELAXED, __HIP_MEMORY_SCOPE_AGENT); return v; }
    __device__ __forceinline__ bool next(int i, pg8::Unit& u) const { return next_pre(i, u, predraw()); }
    __device__ __forceinline__ bool next_pre(int i, pg8::Unit& u, int drawn) const {
        if (wave == 0) { const int v = __builtin_amdgcn_readfirstlane(drawn);
            const int m_ = moe_tile(x, v >> 2, ntile);
            if (m_ < ntile) { unsigned sp = 0u;
                while ((unsigned)__builtin_amdgcn_readfirstlane((int)__hip_atomic_load(done + 16 * m_, __ATOMIC_RELAXED, __HIP_MEMORY_SCOPE_AGENT)) < 64u) { __builtin_amdgcn_s_sleep(2);
                    if ((++sp & 255u) == 0u) { if (__hip_atomic_load(tmo, __ATOMIC_RELAXED, __HIP_MEMORY_SCOPE_AGENT) != 0u) break; if (sp > (1u << 18)) { atomicAdd(tmo, 1u); break; } } }
                __builtin_amdgcn_fence(__ATOMIC_ACQUIRE, "agent"); asm volatile("s_waitcnt vmcnt(0)" ::: "memory"); }
            if (lane_id() == 0) slot[i & 1] = v; }
        LDS_WAIT(); __builtin_amdgcn_s_barrier(); asm volatile("" ::: "memory");
        const int v = __builtin_amdgcn_readfirstlane(slot[i & 1]);
        const int m = moe_tile(x, v >> 2, ntile), pn = v & 3; if (m >= ntile) return false;
        const int e = __builtin_amdgcn_readfirstlane(tl[1 + m]);
        u.pm = m; u.pn = pn; u.aux = e; u.scale = 1.f; u.nt = 8; u.rows = 0; u.A = ACT + (size_t)m * 256 * 1024; u.B = WDN + ((size_t)e * 1024 + pn * 256) * 1024; return true;
    }
};
struct P8Epi {
    const float* BDN; const float* SLOTW; bf16_t* YS;
    __device__ __forceinline__ void operator()(const f32x4 (&acc)[2][2][4][2], const pg8::Unit& u, int wr, int wc, int fr, int fq) const {
        const int row0 = u.pm * 256 + wr * 64 + fr, col0 = u.pn * 256 + wc * 32 + 8 * fq, e = u.aux;
        const float* bp = BDN + (size_t)e * 1024 + col0;
        f32x4 bv[2][2]; float sw[2][4];
#pragma unroll
        for (int bj = 0; bj < 2; ++bj) { bv[bj][0] = *(const GAS f32x4*)(bp + bj * 128); bv[bj][1] = *(const GAS f32x4*)(bp + bj * 128 + 4); }
#pragma unroll
        for (int ai = 0; ai < 2; ++ai)
#pragma unroll
            for (int m = 0; m < 4; ++m) sw[ai][m] = SLOTW[row0 + ai * 128 + m * 16];
        asm volatile("" ::: "memory");
#pragma unroll
        for (int ai = 0; ai < 2; ++ai)
#pragma unroll
            for (int m = 0; m < 4; ++m) { const size_t row = (size_t)(row0 + ai * 128 + m * 16); const float w_ = sw[ai][m];
#pragma unroll
                for (int bj = 0; bj < 2; ++bj) { const f32x4 v0 = (acc[ai][bj][m][0] + bv[bj][0]) * w_, v1 = (acc[ai][bj][m][1] + bv[bj][1]) * w_;
                    int w0 = __builtin_amdgcn_cvt_pk_fp8_f32(v0[0], v0[1], 0, false); w0 = __builtin_amdgcn_cvt_pk_fp8_f32(v0[2], v0[3], w0, true);
                    int w1 = __builtin_amdgcn_cvt_pk_fp8_f32(v1[0], v1[1], 0, false); w1 = __builtin_amdgcn_cvt_pk_fp8_f32(v1[2], v1[3], w1, true);
                    *(GAS u32x2*)((unsigned char*)YS + row * 1024 + col0 + bj * 128) = (u32x2){(unsigned)w0, (unsigned)w1}; } }
    }
};
__device__ __forceinline__ void p9_final(const Ctx& F0) {
    const KArgs ap = kargs(); struct { const float* in[20]; float* out; } a; a.in[19] = ap->in[19]; a.out = ap->out;
    const Ctx F = ctx_refresh(F0);
    float* OUT = a.out; const bf16_t* X1B = (const bf16_t*)(F.ws + WS_X1B); const bf16_t* YS = (const bf16_t*)(F.ws + WS_YS); const int* TOKSLOT = (const int*)(F.ws + WS_MISC + MO_TOKSLOT); const float* GN = a.in[19];
    const int gw = F.vcu * NWAVES + F.wave, NGW = F.G * NWAVES, lane = F.lane;
    const GAS f32x4* gr = (const GAS f32x4*)GN + lane;
    const bool bad = ld_uniform((const int*)(F.ws + WS_CTL) + 4096 + XB_TMO) != 0;
    float ckscale = 1.0f;
#ifdef CKSUM
    { const int* prev = (const int*)(F.ws + WS_MISC + 7 * MiB); if (ld_uniform(prev) == 0x5EED1234) ckscale = 1.0f + 0.25f * (float)ld_uniform(prev + 1); }
#endif
    int slotv = 0; { const int k_ = lane >> 2, t_ = gw + k_ * NGW; if (lane < 32 && t_ < NTOK) slotv = __hip_atomic_load((int*)TOKSLOT + t_ * 4 + (lane & 3), __ATOMIC_RELAXED, __HIP_MEMORY_SCOPE_AGENT); }
    f32x4 gg[4];
#pragma unroll
    for (int jj = 0; jj < 4; ++jj) gg[jj] = gr[64 * jj];
    u32x2 xw[8][4]; unsigned yw[8][4][4];
#define P9_ISSUE(kt_) do { const int tok_ = gw + (kt_) * NGW; const GAS u32x2* x1r = (const GAS u32x2*)(X1B + (size_t)tok_ * D) + lane; \
        _Pragma("unroll") for (int jj = 0; jj < 4; ++jj) xw[kt_][jj] = x1r[64 * jj]; \
        _Pragma("unroll") for (int k = 0; k < 4; ++k) { const int slot_ = __builtin_amdgcn_readlane(slotv, (kt_) * 4 + k); const GAS unsigned* yr = (const GAS unsigned*)((const unsigned char*)YS + (size_t)slot_ * 1024) + lane;        \
            _Pragma("unroll") for (int jj = 0; jj < 4; ++jj) yw[kt_][k][jj] = yr[64 * jj]; } } while (0)
    P9_ISSUE(0); P9_ISSUE(1);
#pragma unroll
    for (int kt = 0; kt < 8; ++kt) {
        if (kt + 2 < 8) P9_ISSUE(kt + 2);
        const int tok = gw + kt * NGW;
        GAS f32x4* xr = (GAS f32x4*)(OUT + (size_t)tok * D) + lane;
        f32x4 v[4];
#pragma unroll
        for (int jj = 0; jj < 4; ++jj) { const u32x2 w = xw[kt][jj]; v[jj] = (f32x4){bf_lo(w.x), bf_hi(w.x), bf_lo(w.y), bf_hi(w.y)}; }
#pragma unroll
        for (int k = 0; k < 4; ++k)
#pragma unroll
            for (int jj = 0; jj < 4; ++jj) { const unsigned y = yw[kt][k][jj]; const f32x2 lo = __builtin_amdgcn_cvt_pk_f32_fp8((int)y, false), hi = __builtin_amdgcn_cvt_pk_f32_fp8((int)y, true);
                v[jj].x += lo.x; v[jj].y += lo.y; v[jj].z += hi.x; v[jj].w += hi.y; }
        float ss = 0.f;
#pragma unroll
        for (int jj = 0; jj < 4; ++jj) ss += (v[jj].x * v[jj].x + v[jj].y * v[jj].y) + (v[jj].z * v[jj].z + v[jj].w * v[jj].w);
        const float r = 1.0f / sqrtf(wave_sum(ss) * (1.f / D) + RMS_EPS);
#pragma unroll
        for (int jj = 0; jj < 4; ++jj) { f32x4 o = (f32x4){v[jj].x * r * gg[jj].x, v[jj].y * r * gg[jj].y, v[jj].z * r * gg[jj].z, v[jj].w * r * gg[jj].w} * ckscale; if (bad) o = (f32x4){__builtin_nanf(""), __builtin_nanf(""), __builtin_nanf(""), __builtin_nanf("")}; xr[64 * jj] = o; }
    }
#undef P9_ISSUE
}

__device__ __forceinline__ void grid_barrier(int wave) {
    extern __shared__ __attribute__((aligned(16))) unsigned char lds_dyn[];
    XcdBarrier b; b.bar = (unsigned*)(kargs()->ws + WS_CTL) + 4096; b.x = xb_xcc_id(); b.st = (volatile LAS unsigned*)((LAS unsigned char*)lds_dyn + LDS_MISC) + 8; b.wave = wave;
    xcd_barrier(b);
}
__global__ void __launch_bounds__(NTHREADS, 2) fwd_megakernel(Args args) {
    const int wave = __builtin_amdgcn_readfirstlane((int)threadIdx.x >> 6);
    {
        const Ctx F = make_ctx(wave);
        volatile LAS unsigned* MISC = (volatile LAS unsigned*)(F.lds + LDS_MISC);
        for (int u = F.tid; u < 128; u += NTHREADS) MISC[u] = 0u;
        __syncthreads();
        (void)xcd_barrier_post((unsigned*)(F.ws + WS_CTL) + 4096, MISC + 8, wave);
    }
#ifndef TSK
#define TSK -1
#endif
#ifndef TSB
#define TSB 0
#endif
    unsigned long long ts0_ = 0ull, ts1_ = 0ull; if (TSK >= 0) ts0_ = __builtin_amdgcn_s_memrealtime();
#ifndef TSMAX
#define TSMAX 0
#endif
#define TS(k) do { if (TSK == (k)) { ts1_ = __builtin_amdgcn_s_memrealtime(); if (TSMAX && wave == 0 && lane_id() == 0) atomicMax((unsigned*)(ws + WS_CTL) + 16384, (unsigned)ts1_); } } while (0)
#define F make_ctx(wave)
#define ws (kargs()->ws)
#define xcd_barrier(bar) grid_barrier(wave)
#ifndef PHM
#define PHM 0xFFFF
#endif
#define PH(k) ((PHM >> (k)) & 1)
#ifndef PHR
#define PHR 0
#endif
#define RP(k) ((PHR >> (k)) & 1)
#ifdef CANARY
    {
        const size_t n16 = (WS_END - WS_MISC) / 16; GAS u32x4* p = (GAS u32x4*)(ws + WS_MISC);
        for (size_t i = (size_t)blockIdx.x * NTHREADS + F.tid; i < n16; i += (size_t)F.G * NTHREADS) p[i] = (u32x4){0xffffffffu, 0xffffffffu, 0xffffffffu, 0xffffffffu};
        GAS u32x4* q = (GAS u32x4*)kargs()->out;
        for (size_t i = (size_t)blockIdx.x * NTHREADS + F.tid; i < (size_t)NTOK * D / 4; i += (size_t)F.G * NTHREADS) q[i] = (u32x4){0xffffffffu, 0xffffffffu, 0xffffffffu, 0xffffffffu};
        xcd_barrier(bar);
    }
#endif
    if (PH(0)) p0_prologue(F);
    xcd_barrier(bar);
    if (RP(0)) { p0_prologue(F); xcd_barrier(bar); }
    TS(0);
    CK(1, ws + WS_WIN_T, WS_MKV - WS_WIN_T); CK(1, ws + WS_XN, WS_ABC - WS_XN); CK(1, ws + WS_WGU_T, WS_PROJ - WS_WGU_T); CK(1, ws + WS_MISC + MO_T5, 128 * 1024);
    for (int rp_ = 0; rp_ < 1 + RP(1); ++rp_) {
    if (PH(1)) {
        P1Sched S{(unsigned*)(ws + WS_CTL) + 12288 + 64 * ((int)blockIdx.x & 7), (LAS int*)(F.lds + LDS_MISC) + 32, F.wave, (int)blockIdx.x & 7, (const char*)(ws + WS_XN), (const char*)(ws + WS_WIN_T), (const char*)(ws + WS_MEMN), (const char*)(ws + WS_WMEM_T)};
        P1Epi E{(bf16_t*)(ws + WS_PROJ), (bf16_t*)(ws + WS_MKV)};
        pg8::gemm_phase<P1Epi, P1Sched, false, true>(F.lds, F.wave, 1024u, 1024u, S, E);
        TS(12);
        p1_convert_experts(F);
        TS(14);
    }
    xcd_barrier(bar);
    }
    TS(1);
    CK(2, ws + WS_PROJ, WS_ACT - WS_PROJ); CK(2, ws + WS_MKV, 1 * MiB);
    if (PH(2)) p2_attention(F);
    xcd_barrier(bar);
    if (RP(2)) { p2_attention(F); xcd_barrier(bar); }
    TS(2);
    CK(3, ws + WS_OB, WS_MERGED - WS_OB); CK(3, ws + WS_MISC + MO_LSE, 3 * 16384 * 16);
    TS(10);
    CK(4, ws + WS_ABC, WS_OB - WS_ABC);
    for (int rp_ = 0; rp_ < 1 + RP(3); ++rp_) {
    if (PH(3)) {
        unsigned* mflag = (unsigned*)(ws + WS_CTL) + 25600;
        P3Sched S{(int)blockIdx.x, (const char*)(ws + WS_ABC), (const char*)(ws + WS_WABC_T), mflag, (unsigned*)(ws + WS_CTL) + 4096 + XB_TMO, F.wave};
        { int wgid = (int)blockIdx.x; wgid = (wgid % 8) * 32 + wgid / 8; p2b_merge_quarter(F, (wgid / 32) * 8 + (wgid % 32) % 8, (wgid % 32) / 8, mflag); }
        P3Epi E{(const bf16_t*)(ws + WS_PROJ), (bf16_t*)(ws + WS_MERGED)};
        pg8::gemm_phase<P3Epi, P3Sched, false>(F.lds, F.wave, (unsigned)(ABC_LD * 2), (unsigned)(ABC_LD * 2), S, E);
        { int wgid = (int)blockIdx.x; wgid = (wgid % 8) * 32 + wgid / 8; if (F.tid == 0) __hip_atomic_fetch_add(mflag + 1280 + 16 * ((wgid / 32) * 8 + (wgid % 32) % 8), 1u, __ATOMIC_RELAXED, __HIP_MEMORY_SCOPE_AGENT); }
    }
    }
    TS(3);
    for (int rp_ = 0; rp_ < 1 + RP(4); ++rp_) {
    if (PH(4)) {
        P4Sched S{(int)blockIdx.x, (const char*)(ws + WS_MERGED), (const char*)(ws + WS_WOUT_T), (const unsigned*)(ws + WS_CTL) + 25600 + 1280, (unsigned*)(ws + WS_CTL) + 4096 + XB_TMO, F.wave};
        P4Epi E{kargs()->in[0], (bf16_t*)(ws + WS_X1B)};
        pg8::gemm_phase<P4Epi, P4Sched, false>(F.lds, F.wave, 2048u, 2048u, S, E);
        { int wgid = (int)blockIdx.x; wgid = (wgid % 8) * 32 + wgid / 8; if (F.tid == 0) __hip_atomic_fetch_add((unsigned*)(ws + WS_CTL) + 25600 + 2560 + 16 * ((wgid / 32) * 8 + (wgid % 32) % 8), 1u, __ATOMIC_RELAXED, __HIP_MEMORY_SCOPE_AGENT); }
    }
    }
    TS(4);
    CK(6, kargs()->out, 64 * MiB);
    if (PH(5)) p5_router(F);
    xcd_barrier(bar);
    if (RP(5)) { p5_router(F); xcd_barrier(bar); }
    TS(5);
    CK(7, ws + WS_XN, 32 * MiB); CK(7, ws + WS_MISC, 512 * 1024 + 32 * 1024);
    if (PH(6)) p6_slots(F);
    xcd_barrier(bar);
    TS(6);
#ifdef CKSUM
#define ck_rows ((size_t)ld_uniform((const int*)(ws + WS_MISC + MO_TILE)) * 256)
    CK(8, ws + WS_MISC + MO_TOKSLOT, 256 * 1024); CK(8, ws + WS_MISC + MO_SLOTTOK, ck_rows * 4); CK(8, ws + WS_MISC + MO_SLOTW, ck_rows * 4); CK(8, ws + WS_MISC + MO_TILE, 1024);
#endif
    for (int rp_ = 0; rp_ < 1 + RP(7); ++rp_) {
    if (PH(7)) {
        moe_tables<8, true>(F, (const int*)(ws + WS_MISC + MO_TILE), (const int*)(ws + WS_MISC + MO_SLOTTOK));
        P7Sched S{F.G, (int)blockIdx.x, (LAS const int*)(F.lds + LDS_TILE), (const char*)(ws + WS_XN), (const char*)(ws + WS_WGU_T), __builtin_amdgcn_readfirstlane(*(LAS const int*)(F.lds + LDS_TILE))};
        P7Epi E{kargs()->in[16], (bf16_t*)(ws + WS_ACT), (const float*)(ws + WS_MISC + MO_SLOTRS), (unsigned*)(ws + WS_CTL) + 20480, -1};
        pg8::gemm_phase<P7Epi, P7Sched, true, true>(F.lds, F.wave, 1024u, 1024u, S, E);
        E.publish();
    }
    }
    TS(7);
    for (int rp_ = 0; rp_ < 1 + RP(8); ++rp_) {
    if (PH(8)) {
        P8Sched S{(unsigned*)(ws + WS_CTL) + 12288 + 64 * ((int)blockIdx.x & 7), (const unsigned*)(ws + WS_CTL) + 20480, (unsigned*)(ws + WS_CTL) + 4096 + XB_TMO, (LAS int*)(F.lds + LDS_MISC) + 32, F.wave, (int)blockIdx.x & 7,
                  (LAS const int*)(F.lds + LDS_TILE), (const char*)(ws + WS_ACT), (const char*)(ws + WS_WDN_T), __builtin_amdgcn_readfirstlane(*(LAS const int*)(F.lds + LDS_TILE))};
        P8Epi E{kargs()->in[18], (const float*)(ws + WS_MISC + MO_SLOTW), (bf16_t*)(ws + WS_YS)};
        pg8::gemm_phase<P8Epi, P8Sched, false, true>(F.lds, F.wave, 1024u, 1024u, S, E);
    }
    xcd_barrier(bar);
    }
    TS(8);
#ifdef CKSUM
    CK(10, ws + WS_YS, ck_rows * 2048);
#endif
    if (PH(9)) p9_final(F);
    if (TSMAX && TSK >= 0 && blockIdx.x == TSB) { const unsigned mx_ = __hip_atomic_load((unsigned*)(ws + WS_CTL) + 16384, __ATOMIC_RELAXED, __HIP_MEMORY_SCOPE_AGENT); ts1_ = (ts1_ & ~0xffffffffull) | mx_; }
    if (TSK >= 0 && blockIdx.x == TSB && wave == 0) { const unsigned long long te_ = __builtin_amdgcn_s_memrealtime(); const unsigned long long wait_ = 50ull * (ts1_ - ts0_); while (__builtin_amdgcn_s_memrealtime() - te_ < wait_) __builtin_amdgcn_s_sleep(32); }
#ifdef CKSUM
    xcd_barrier(bar);
    if (blockIdx.x == 0 && F.wave == 0 && lane_id() == 0) {
        unsigned* cur = (unsigned*)(ws + WS_CTL) + 8192; unsigned* prev = (unsigned*)(ws + WS_MISC + 7 * MiB);
        const bool have = __hip_atomic_load(prev, __ATOMIC_RELAXED, __HIP_MEMORY_SCOPE_AGENT) == 0x5EED1234u;
        unsigned flag = have ? __hip_atomic_load(prev + 1, __ATOMIC_RELAXED, __HIP_MEMORY_SCOPE_AGENT) : 0u;
        for (int k = 1; k <= 10; ++k) { const unsigned c = __hip_atomic_load(cur + 64 * k, __ATOMIC_RELAXED, __HIP_MEMORY_SCOPE_AGENT);
            if (have && flag == 0u && __hip_atomic_load(prev + 16 + k, __ATOMIC_RELAXED, __HIP_MEMORY_SCOPE_AGENT) != c) flag = (unsigned)k;
            __hip_atomic_store(prev + 16 + k, c, __ATOMIC_RELAXED, __HIP_MEMORY_SCOPE_AGENT); }
        __hip_atomic_store(prev + 1, flag, __ATOMIC_RELAXED, __HIP_MEMORY_SCOPE_AGENT); __hip_atomic_store(prev, 0x5EED1234u, __ATOMIC_RELAXED, __HIP_MEMORY_SCOPE_AGENT);
    }
#endif
}

#undef F
#undef ws
#undef xcd_barrier
extern "C" void kernel_launch(void* const* d_in, const int* in_sizes, int n_in, void* d_out, int out_size, void* d_ws, size_t ws_size, hipStream_t stream) {
    static int grid = 0;
    if (grid == 0) {
        if (n_in != 20 || out_size != NTOK * D || ws_size < WS_END) { fprintf(stderr, "kernel_launch: unexpected shapes (n_in %d, out %d, ws %zu); nothing launched\n", n_in, out_size, ws_size); grid = -1; return; }
        int dev = 0, cus = 0;
        if (hipGetDevice(&dev) != hipSuccess || hipDeviceGetAttribute(&cus, hipDeviceAttributeMultiprocessorCount, dev) != hipSuccess) { grid = -1; return; }
        if (hipFuncSetAttribute((const void*)fwd_megakernel, hipFuncAttributeMaxDynamicSharedMemorySize, LDS_BYTES) != hipSuccess) { fprintf(stderr, "kernel_launch: hipFuncSetAttribute failed\n"); grid = -1; return; }
        int per_cu = 0;
        if (hipOccupancyMaxActiveBlocksPerMultiprocessor(&per_cu, (const void*)fwd_megakernel, NTHREADS, LDS_BYTES) != hipSuccess || per_cu < 1) fprintf(stderr, "kernel_launch: occupancy query reports %d\n", per_cu);
        (void)hipGetLastError();
        grid = cus;
        if (grid != 256) fprintf(stderr, "kernel_launch: %d CUs; this kernel is laid out for 256\n", grid);
    }
    if (grid < 0) return;
    (void)hipMemsetAsync((char*)d_ws + WS_CTL, 0, CTL_ZERO_BYTES, stream);
    Args a{};
    for (int i = 0; i < 20; ++i) a.in[i] = (const float*)d_in[i];
    a.out = (float*)d_out; a.ws = (unsigned char*)d_ws;
    hipLaunchKernelGGL(fwd_megakernel, dim3(grid), dim3(NTHREADS), LDS_BYTES, stream, a);
}
```
